# Optimizing an MI355X kernel written in HIP

```python
import math
import jax
import jax.numpy as jnp
from jax import lax
import numpy as np

D_MODEL = 1024
BATCH = 2
SEQ = 16384
DEPTH = 1

HEAD_DIM = 64
NSA_HEADS = 8
NSA_KV_HEADS = 2
NSA_REP = NSA_HEADS // NSA_KV_HEADS
CMP_LEN = 32
CMP_STRIDE = 16
CMP_HID = 256
SEL_LEN = 64
SEL_TOPN = 16
WINDOW = 512
SEL_FORCE = 1e4

MLA_HEADS = 8
Q_LORA = 256
KV_LORA = 128
QK_NOPE = 64
QK_ROPE = 32
V_DIM = 64
ROPE_THETA = 10000.0

N_BUCKETS = 32
MAX_DISTANCE = 2048

PEER_HEADS = 8
PEER_NKEYS = 128
PEER_EXPERTS = PEER_NKEYS * PEER_NKEYS
PEER_QDIM = 256
PEER_TOPK = 16
PEER_CHUNK = 128

Q_BLOCK = 128
EPS = 1e-6
NEG = -1e30

NSA_WIDTH = NSA_HEADS * HEAD_DIM
MLA_WIDTH = MLA_HEADS * V_DIM
KV_WIDTH = NSA_KV_HEADS * HEAD_DIM
IN_SIZES = (NSA_WIDTH,) + (KV_WIDTH,) * 6 + (3 * NSA_HEADS, Q_LORA, KV_LORA, QK_ROPE)
IN_TOTAL = NSA_WIDTH + 6 * KV_WIDTH + 3 * NSA_HEADS + Q_LORA + KV_LORA + QK_ROPE

kernel_name = "hymba_nsa_mla_peer_block"


def rmsnorm(x, g):
    xf = x.astype(jnp.float32)
    y = xf * lax.rsqrt(jnp.mean(xf * xf, axis=-1, keepdims=True) + EPS)
    return (y * g.astype(jnp.float32)).astype(x.dtype)


def split_columns(z):
    out, start = [], 0
    for size in IN_SIZES:
        out.append(z[..., start:start + size])
        start += size
    return out


def t5_bucket(dist):
    dist = jnp.maximum(dist, 0)
    max_exact = N_BUCKETS // 2
    d = jnp.maximum(dist, 1).astype(jnp.float32)
    large = max_exact + (jnp.log(d / max_exact) / math.log(MAX_DISTANCE / max_exact)
                         * (N_BUCKETS - max_exact)).astype(jnp.int32)
    return jnp.where(dist < max_exact, dist, jnp.minimum(large, N_BUCKETS - 1))


def rope(x, positions):
    half = QK_ROPE // 2
    inv = ROPE_THETA ** (-jnp.arange(half, dtype=jnp.float32) / half)
    ang = positions.astype(jnp.float32)[..., None] * inv
    if x.ndim == 4:
        ang = ang[:, :, None, :]
    cos, sin = jnp.cos(ang), jnp.sin(ang)
    xf = x.astype(jnp.float32)
    x1, x2 = xf[..., :half], xf[..., half:]
    return jnp.concatenate([x1 * cos - x2 * sin, x1 * sin + x2 * cos], axis=-1).astype(x.dtype)


def nsa_mixer(q, kc, vc, ks, vs, kw, vw, gates, cmp_pos, cmp_k_w1, cmp_k_w2, cmp_v_w1, cmp_v_w2, t5_bias):
    B, S = q.shape[0], q.shape[1]
    G, R, dh = NSA_KV_HEADS, NSA_REP, HEAD_DIM
    n_cmp = (S - CMP_LEN) // CMP_STRIDE + 1
    n_sel = S // SEL_LEN
    n_top = min(SEL_TOPN, n_sel)
    n_qb = S // Q_BLOCK
    wk = WINDOW + Q_BLOCK
    scale = dh ** -0.5

    cmp_start = jnp.arange(n_cmp) * CMP_STRIDE
    cmp_end = cmp_start + CMP_LEN - 1
    cidx = cmp_start[:, None] + jnp.arange(CMP_LEN)[None, :]

    def compress(raw, w1, w2):
        blk = raw[:, cidx] + cmp_pos[None, None, :, None, :]
        blk = jnp.moveaxis(blk, 3, 2).reshape(B, n_cmp, G, CMP_LEN * dh)
        return jax.nn.gelu(blk @ w1, approximate=False) @ w2

    k_cmp = compress(kc, cmp_k_w1, cmp_k_w2)
    v_cmp = compress(vc, cmp_v_w1, cmp_v_w2)

    sel_start = jnp.arange(n_sel) * SEL_LEN
    overlap = ((cmp_start[:, None] < sel_start[None, :] + SEL_LEN)
               & (cmp_end[:, None] >= sel_start[None, :])).astype(jnp.float32)
    ks_blk = ks.reshape(B, n_sel, SEL_LEN, G, dh).transpose(0, 3, 1, 2, 4)
    vs_blk = vs.reshape(B, n_sel, SEL_LEN, G, dh).transpose(0, 3, 1, 2, 4)
    gather_blocks = jax.vmap(jax.vmap(lambda blocks, idx: blocks[idx]))

    kw_pad = jnp.pad(kw, ((0, 0), (WINDOW, 0), (0, 0), (0, 0)))
    vw_pad = jnp.pad(vw, ((0, 0), (WINDOW, 0), (0, 0), (0, 0)))
    w_dist = WINDOW + jnp.arange(Q_BLOCK)[:, None] - jnp.arange(wk)[None, :]
    w_rel_ok = (w_dist >= 0) & (w_dist < WINDOW)
    w_bias = jnp.moveaxis(t5_bias[t5_bucket(w_dist)], -1, 0).reshape(G, R, Q_BLOCK, wk).astype(jnp.float32)

    bias_tbl = t5_bias.reshape(N_BUCKETS, G, R).astype(jnp.float32)
    g_ix = jnp.arange(G)[None, :, None, None]

    q_b = q.reshape(B, n_qb, Q_BLOCK, G, R, dh).transpose(1, 0, 3, 4, 2, 5)
    g_b = gates.reshape(B, n_qb, Q_BLOCK, G, R, 3).transpose(1, 0, 3, 4, 2, 5)

    def block(args):
        i, qi, gi = args
        t = i * Q_BLOCK + jnp.arange(Q_BLOCK)
        dist_c = t[:, None] - cmp_end[None, :]
        ok_c = dist_c >= 0
        bias_c = jnp.moveaxis(t5_bias[t5_bucket(dist_c)], -1, 0).reshape(G, R, Q_BLOCK, n_cmp).astype(jnp.float32)
        s_c = jnp.einsum('bgrqd,bkgd->bgrqk', qi, k_cmp).astype(jnp.float32) * scale + bias_c
        p_c = jax.nn.softmax(jnp.where(ok_c, s_c, NEG), axis=-1) * jnp.any(ok_c, axis=-1)[:, None]
        o_c = jnp.einsum('bgrqk,bkgd->bgrqd', p_c.astype(qi.dtype), v_cmp)
        imp = jnp.einsum('bgrqk,ks->bgqs', p_c, overlap)
        cur = t // SEL_LEN
        sid = jnp.arange(n_sel)[None, :]
        forced = (sid == 0) | (sid == cur[:, None]) | (sid == cur[:, None] - 1)
        imp = jnp.where(sid <= cur[:, None], imp + jnp.where(forced, SEL_FORCE, 0.0), NEG)
        _, sel = lax.top_k(imp, n_top)
        k_g = gather_blocks(ks_blk, sel).reshape(B, G, Q_BLOCK, n_top * SEL_LEN, dh)
        v_g = gather_blocks(vs_blk, sel).reshape(B, G, Q_BLOCK, n_top * SEL_LEN, dh)
        pos_g = (sel[..., None] * SEL_LEN + jnp.arange(SEL_LEN)).reshape(B, G, Q_BLOCK, n_top * SEL_LEN)
        dist_s = t[:, None] - pos_g
        bias_s = jnp.moveaxis(bias_tbl[t5_bucket(dist_s), g_ix], -1, 2)
        s_s = jnp.einsum('bgrqd,bgqkd->bgrqk', qi, k_g).astype(jnp.float32) * scale + bias_s
        p_s = jax.nn.softmax(jnp.where((dist_s >= 0)[:, :, None], s_s, NEG), axis=-1)
        o_s = jnp.einsum('bgrqk,bgqkd->bgrqd', p_s.astype(qi.dtype), v_g)
        k_w = lax.dynamic_slice_in_dim(kw_pad, i * Q_BLOCK, wk, axis=1)
        v_w = lax.dynamic_slice_in_dim(vw_pad, i * Q_BLOCK, wk, axis=1)
        ok_w = w_rel_ok & ((i * Q_BLOCK - WINDOW + jnp.arange(wk)) >= 0)[None, :]
        s_w = jnp.einsum('bgrqd,bkgd->bgrqk', qi, k_w).astype(jnp.float32) * scale + w_bias
        p_w = jax.nn.softmax(jnp.where(ok_w, s_w, NEG), axis=-1)
        o_w = jnp.einsum('bgrqk,bkgd->bgrqd', p_w.astype(qi.dtype), v_w)
        return gi[..., 0:1] * o_c + gi[..., 1:2] * o_s + gi[..., 2:3] * o_w

    out = lax.map(block, (jnp.arange(n_qb), q_b, g_b))
    return out.transpose(1, 0, 4, 2, 3, 5).reshape(B, S, NSA_WIDTH)


def mla_mixer(c_q, c_kv, k_rope_raw, positions, q_norm_g, w_q_up, kv_norm_g, w_kv_up):
    B, S = c_q.shape[0], c_q.shape[1]
    H = MLA_HEADS
    qh = (rmsnorm(c_q, q_norm_g) @ w_q_up).reshape(B, S, H, QK_NOPE + QK_ROPE)
    q_nope, q_rope = qh[..., :QK_NOPE], rope(qh[..., QK_NOPE:], positions)
    kv = (rmsnorm(c_kv, kv_norm_g) @ w_kv_up).reshape(B, S, H, QK_NOPE + V_DIM)
    k_nope, v = kv[..., :QK_NOPE], kv[..., QK_NOPE:]
    k_rope = rope(k_rope_raw, positions)
    scale = (QK_NOPE + QK_ROPE) ** -0.5
    n_qb = S // Q_BLOCK
    qn_b = q_nope.reshape(B, n_qb, Q_BLOCK, H, QK_NOPE).transpose(1, 0, 2, 3, 4)
    qr_b = q_rope.reshape(B, n_qb, Q_BLOCK, H, QK_ROPE).transpose(1, 0, 2, 3, 4)
    kpos = jnp.arange(S)

    def block(args):
        i, qn, qr = args
        s = (jnp.einsum('bqhd,bkhd->bhqk', qn, k_nope)
             + jnp.einsum('bqhd,bkd->bhqk', qr, k_rope)).astype(jnp.float32) * scale
        t = i * Q_BLOCK + jnp.arange(Q_BLOCK)
        p = jax.nn.softmax(jnp.where(kpos[None, :] <= t[:, None], s, NEG), axis=-1)
        return jnp.einsum('bhqk,bkhd->bqhd', p.astype(v.dtype), v)

    out = lax.map(block, (jnp.arange(n_qb), qn_b, qr_b))
    return out.transpose(1, 0, 2, 3, 4).reshape(B, S, MLA_WIDTH)


def peer_ffn(h, w_q, keys1, keys2, u, v):
    B, S, D = h.shape
    K = PEER_TOPK
    q = (h @ w_q).reshape(B, S, PEER_HEADS, 2, PEER_QDIM // 2)
    s1 = jnp.einsum('bshd,nd->bshn', q[..., 0, :], keys1).astype(jnp.float32)
    s2 = jnp.einsum('bshd,nd->bshn', q[..., 1, :], keys2).astype(jnp.float32)
    v1, i1 = lax.top_k(s1, K)
    v2, i2 = lax.top_k(s2, K)
    cand = (v1[..., :, None] + v2[..., None, :]).reshape(B, S, PEER_HEADS, K * K)
    cid = (i1[..., :, None] * PEER_NKEYS + i2[..., None, :]).reshape(B, S, PEER_HEADS, K * K)
    top, pos = lax.top_k(cand, K)
    eid = jnp.take_along_axis(cid, pos, axis=-1)
    gate = jax.nn.softmax(top, axis=-1).astype(h.dtype)
    n_ch = (B * S) // PEER_CHUNK
    h_c = h.reshape(n_ch, PEER_CHUNK, D)
    e_c = eid.reshape(n_ch, PEER_CHUNK, PEER_HEADS * K)
    g_c = gate.reshape(n_ch, PEER_CHUNK, PEER_HEADS * K)

    def chunk(args):
        hx, e, g = args
        act = jax.nn.gelu(jnp.einsum('cd,ced->ce', hx, u[e]), approximate=False)
        return jnp.einsum('ce,ced->cd', g * act, v[e])

    return lax.map(chunk, (h_c, e_c, g_c)).reshape(B, S, D)


def setup_inputs(seed: int = 0) -> dict:
    key = jax.random.key(seed)
    k = jax.random.split(key, 26)
    L = DEPTH

    def nrm(kk, shape, scale):
        return jax.random.normal(kk, shape, jnp.float32) * scale

    def gain(kk, shape):
        return 1.0 + 0.05 * jax.random.normal(kk, shape, jnp.float32)

    positions = (jnp.arange(SEQ, dtype=jnp.int32)[None, :]
                 + jax.random.randint(k[1], (BATCH, 1), 0, 4096, dtype=jnp.int32))
    return {
        "x": nrm(k[0], (BATCH, SEQ, D_MODEL), 1.0),
        "positions": positions,
        "norm1_g": gain(k[2], (L, D_MODEL)),
        "w_in": nrm(k[3], (L, D_MODEL, IN_TOTAL), D_MODEL ** -0.5),
        "cmp_pos": nrm(k[4], (L, CMP_LEN, HEAD_DIM), 0.1),
        "cmp_k_w1": nrm(k[5], (L, CMP_LEN * HEAD_DIM, CMP_HID), (CMP_LEN * HEAD_DIM) ** -0.5),
        "cmp_k_w2": nrm(k[6], (L, CMP_HID, HEAD_DIM), CMP_HID ** -0.5),
        "cmp_v_w1": nrm(k[7], (L, CMP_LEN * HEAD_DIM, CMP_HID), (CMP_LEN * HEAD_DIM) ** -0.5),
        "cmp_v_w2": nrm(k[8], (L, CMP_HID, HEAD_DIM), CMP_HID ** -0.5),
        "t5_bias": nrm(k[9], (N_BUCKETS, NSA_HEADS), 0.5),
        "q_norm_g": gain(k[10], (L, Q_LORA)),
        "w_q_up": nrm(k[11], (L, Q_LORA, MLA_HEADS * (QK_NOPE + QK_ROPE)), Q_LORA ** -0.5),
        "kv_norm_g": gain(k[12], (L, KV_LORA)),
        "w_kv_up": nrm(k[13], (L, KV_LORA, MLA_HEADS * (QK_NOPE + V_DIM)), KV_LORA ** -0.5),
        "grp_norm_nsa": gain(k[14], (L, NSA_WIDTH)),
        "grp_norm_mla": gain(k[15], (L, MLA_WIDTH)),
        "w_out": nrm(k[16], (L, NSA_WIDTH + MLA_WIDTH, D_MODEL), (NSA_WIDTH + MLA_WIDTH) ** -0.5),
        "norm2_g": gain(k[17], (L, D_MODEL)),
        "peer_wq": nrm(k[18], (L, D_MODEL, PEER_HEADS * PEER_QDIM), D_MODEL ** -0.5),
        "peer_keys1": nrm(k[19], (L, PEER_NKEYS, PEER_QDIM // 2), (PEER_QDIM // 2) ** -0.5),
        "peer_keys2": nrm(k[20], (L, PEER_NKEYS, PEER_QDIM // 2), (PEER_QDIM // 2) ** -0.5),
        "peer_u": nrm(k[21], (L, PEER_EXPERTS, D_MODEL), D_MODEL ** -0.5),
        "peer_v": nrm(k[22], (L, PEER_EXPERTS, D_MODEL), PEER_HEADS ** -0.5),
        "final_g": gain(k[23], (D_MODEL,)),
    }


def reference(x, positions, norm1_g, w_in, cmp_pos, cmp_k_w1, cmp_k_w2, cmp_v_w1, cmp_v_w2, t5_bias,
              q_norm_g, w_q_up, kv_norm_g, w_kv_up, grp_norm_nsa, grp_norm_mla, w_out, norm2_g,
              peer_wq, peer_keys1, peer_keys2, peer_u, peer_v, final_g):
    B, S, _ = x.shape
    for l in range(DEPTH):
        h = rmsnorm(x, norm1_g[l])
        cols = split_columns(h @ w_in[l])
        q, kc, vc, ks, vs, kw, vw = [c.reshape(B, S, -1, HEAD_DIM) for c in cols[:7]]
        gates = jax.nn.sigmoid(cols[7].astype(jnp.float32)).astype(x.dtype).reshape(B, S, NSA_HEADS, 3)
        c_q, c_kv, k_rope = cols[8], cols[9], cols[10]
        o_nsa = nsa_mixer(q, kc, vc, ks, vs, kw, vw, gates, cmp_pos[l], cmp_k_w1[l], cmp_k_w2[l],
                          cmp_v_w1[l], cmp_v_w2[l], t5_bias)
        o_mla = mla_mixer(c_q, c_kv, k_rope, positions, q_norm_g[l], w_q_up[l], kv_norm_g[l], w_kv_up[l])
        mixed = jnp.concatenate([rmsnorm(o_nsa, grp_norm_nsa[l]), rmsnorm(o_mla, grp_norm_mla[l])], axis=-1)
        x = x + mixed @ w_out[l]
        x = x + peer_ffn(rmsnorm(x, norm2_g[l]), peer_wq[l], peer_keys1[l], peer_keys2[l], peer_u[l], peer_v[l])
    return rmsnorm(x, final_g)
```

```cpp
#include <hip/hip_runtime.h>
#include <hip/hip_cooperative_groups.h>
#include <cstdio>
#include <cstdint>
namespace cg = cooperative_groups;

#ifndef MULTI_LAUNCH
#define MULTI_LAUNCH 1
#endif

typedef _Float16 half_t;
typedef _Float16 h2v __attribute__((ext_vector_type(2)));
typedef _Float16 h4v __attribute__((ext_vector_type(4)));
typedef _Float16 h8v __attribute__((ext_vector_type(8)));
typedef float f4v __attribute__((ext_vector_type(4)));
typedef unsigned u4v __attribute__((ext_vector_type(4)));
typedef unsigned u2v __attribute__((ext_vector_type(2)));
typedef float f16v __attribute__((ext_vector_type(16)));

constexpr int BATCH = 2, SEQ = 16384, DM = 1024, NTOK = BATCH * SEQ;
constexpr int NIN = 1720, NINP = 1792;
constexpr int NCMP = 1023, NCMPP = 1024;
constexpr float EPS = 1e-6f;
constexpr float LOG2E = 1.4426950408889634f;
constexpr float QS_NSA = 0.125f * LOG2E;
constexpr float QS_MLA = 0.10206207261596575f * LOG2E;
constexpr float NEGF = -1e30f;
constexpr int LUTN = 1536;

constexpr size_t al256(size_t x) { return (x + 255) & ~(size_t)255; }
constexpr size_t OFF_CTRL = 0;
constexpr size_t OFF_LUT = 4096;
constexpr size_t OFF_CB = OFF_LUT + 2 * LUTN * 4 * 4;
constexpr size_t OFF_WIN = 65536;
constexpr size_t OFF_WQUP = OFF_WIN + (size_t)NINP * 1024 * 2;
constexpr size_t OFF_WKVUP = OFF_WQUP + 768 * 256 * 2;
constexpr size_t OFF_WC1 = OFF_WKVUP + 1024 * 128 * 2;
constexpr size_t OFF_WOUT = OFF_WC1 + 2 * 256 * 2048 * 2;
constexpr size_t OFF_WPQ = OFF_WOUT + 1024 * 1024 * 2;
constexpr size_t OFF_KEYS = OFF_WPQ + 2048 * 1024 * 2;
constexpr size_t OFF_U16 = al256(OFF_KEYS + 2 * 128 * 128 * 2);
constexpr size_t OFF_V16 = OFF_U16 + (size_t)16384 * 1024 * 2;
constexpr size_t OFF_H1 = OFF_V16 + (size_t)16384 * 1024 * 2;
constexpr size_t OFF_MIXED = OFF_H1;
constexpr size_t OFF_QH = OFF_H1 + (size_t)NTOK * 1024 * 2;
constexpr size_t SZ_KV = (size_t)2 * 2 * SEQ * 64 * 2;
constexpr size_t OFF_KC = OFF_QH + (size_t)NTOK * 512 * 2;
constexpr size_t OFF_VC = OFF_KC + SZ_KV;
constexpr size_t OFF_KS = OFF_VC + SZ_KV;
constexpr size_t OFF_VST = OFF_KS + SZ_KV;
constexpr size_t OFF_KW = OFF_VST + SZ_KV;
constexpr size_t OFF_VWT = OFF_KW + SZ_KV;
constexpr size_t OFF_GATES = OFF_VWT + SZ_KV;
constexpr size_t OFF_CQ = OFF_GATES + (size_t)NTOK * 24 * 4;
constexpr size_t OFF_CKV = OFF_CQ + (size_t)NTOK * 256 * 2;
constexpr size_t OFF_X2H = OFF_QH;
constexpr size_t OFF_QM = OFF_CKV + (size_t)NTOK * 128 * 2;
constexpr size_t OFF_KM = OFF_QM + (size_t)NTOK * 8 * 96 * 2;
constexpr size_t OFF_VT = OFF_KM + (size_t)NTOK * 8 * 96 * 2;
constexpr size_t OFF_QP = OFF_QM;
constexpr size_t OFF_HC1 = OFF_VT + (size_t)NTOK * 8 * 64 * 2;
constexpr size_t OFF_KCMP = OFF_HC1 + (size_t)8 * 1024 * 256 * 2;
constexpr size_t OFF_VCMPT = OFF_KCMP + (size_t)4 * 1024 * 64 * 2;
constexpr size_t OFF_EID = OFF_VCMPT + (size_t)4 * 1024 * 64 * 2;
constexpr size_t OFF_GW = OFF_EID + (size_t)NTOK * 128 * 4;
constexpr size_t WS_NEED = OFF_GW + (size_t)NTOK * 128 * 4;

struct Params {
    const float* x; const int* pos; const float* norm1_g; const float* w_in; const float* cmp_pos;
    const float* cmp_k_w1; const float* cmp_k_w2; const float* cmp_v_w1; const float* cmp_v_w2; const float* t5_bias;
    const float* q_norm_g; const float* w_q_up; const float* kv_norm_g; const float* w_kv_up;
    const float* grp_norm_nsa; const float* grp_norm_mla; const float* w_out; const float* norm2_g;
    const float* peer_wq; const float* peer_keys1; const float* peer_keys2; const float* peer_u; const float* peer_v; const float* final_g;
    float* out; char* ws;
};

constexpr int SMEM_BYTES = 65536;
constexpr int NTHREADS = 256;

__device__ __forceinline__ f4v mfma16(h8v a, h8v b, f4v c) { return __builtin_amdgcn_mfma_f32_16x16x32_f16(a, b, c, 0, 0, 0); }
__device__ __forceinline__ f16v mfma32(h8v a, h8v b, f16v c) { return __builtin_amdgcn_mfma_f32_32x32x16_f16(a, b, c, 0, 0, 0); }
__device__ __forceinline__ float wave_sum(float v) {
#pragma unroll
    for (int o = 32; o >= 1; o >>= 1) v += __shfl_xor(v, o);
    return v;
}
__device__ __forceinline__ float gelu_exact(float v) { return 0.5f * v * (1.0f + erff(v * 0.70710678118654752f)); }
__device__ __forceinline__ float fast_exp2(float v) { return __builtin_amdgcn_exp2f(v); }
__device__ __forceinline__ int t5_bucket(int d) {
    if (d < 16) return d < 0 ? 0 : d;
    int b = 16;
    b += (d >= 22); b += (d >= 30); b += (d >= 40); b += (d >= 54); b += (d >= 73); b += (d >= 99); b += (d >= 134); b += (d >= 182);
    b += (d >= 246); b += (d >= 332); b += (d >= 450); b += (d >= 609); b += (d >= 825); b += (d >= 1117); b += (d >= 1513);
    return b;
}

__device__ __forceinline__ void phase_prep(const Params& p, int bid, int nb) {
    const long tid = (long)bid * NTHREADS + threadIdx.x;
    const long nth = (long)nb * NTHREADS;
    char* ws = p.ws;
    if (tid < 1024) ((unsigned*)(ws + OFF_CTRL))[tid] = 0u;
    {
        float* lut = (float*)(ws + OFF_LUT);
        for (long e = tid; e < 2 * LUTN * 4; e += nth) {
            int r = e & 3, d = (e >> 2) % LUTN, g = (int)(e / (4 * LUTN));
            lut[e] = p.t5_bias[t5_bucket(d) * 8 + g * 4 + r] * LOG2E;
        }
    }
    {
        float* cb = (float*)(ws + OFF_CB);
        for (long e = tid; e < 512; e += nth) {
            int kv = (int)(e >> 8), n = (int)(e & 255);
            const float* w1 = kv ? p.cmp_v_w1 : p.cmp_k_w1;
            float s = 0.f;
            for (int k = 0; k < 2048; ++k) s += p.cmp_pos[k] * w1[(long)k * 256 + n];
            cb[e] = s;
        }
    }
    {
        half_t* W = (half_t*)(ws + OFF_WIN);
        for (long e = tid; e < (long)NINP * 1024; e += nth) {
            int k = (int)(e / NINP), n = (int)(e % NINP);
            int src;
            if (n < 1280) src = n;
            else if (n < 1536) src = 1304 + (n - 1280);
            else if (n < 1664) src = 1560 + (n - 1536);
            else if (n < 1696) src = 1688 + (n - 1664);
            else if (n < 1720) src = 1280 + (n - 1696);
            else src = -1;
            float v = src >= 0 ? p.w_in[(long)k * NIN + src] : 0.f;
            W[(long)n * 1024 + k] = (half_t)v;
        }
    }
    {
        half_t* W = (half_t*)(ws + OFF_WQUP);
        for (long e = tid; e < 768 * 256; e += nth) {
            int k = (int)(e / 768), n = (int)(e % 768);
            W[(long)n * 256 + k] = (half_t)(p.w_q_up[e] * p.q_norm_g[k]);
        }
    }
    {
        half_t* W = (half_t*)(ws + OFF_WKVUP);
        for (long e = tid; e < 1024 * 128; e += nth) {
            int k = (int)(e / 1024), n = (int)(e % 1024);
            W[(long)n * 128 + k] = (half_t)(p.w_kv_up[e] * p.kv_norm_g[k]);
        }
    }
    {
        half_t* W = (half_t*)(ws + OFF_WC1);
        for (long e = tid; e < 2L * 2048 * 256; e += nth) {
            int kv = (int)(e / (2048 * 256)); long r = e % (2048 * 256);
            int k = (int)(r / 256), n = (int)(r % 256);
            const float* w1 = kv ? p.cmp_v_w1 : p.cmp_k_w1;
            W[((long)kv * 256 + n) * 2048 + k] = (half_t)w1[r];
        }
    }
    {
        half_t* W = (half_t*)(ws + OFF_WOUT);
        for (long e = tid; e < 1024L * 1024; e += nth) {
            int k = (int)(e >> 10), n = (int)(e & 1023);
            float g = k < 512 ? p.grp_norm_nsa[k] : p.grp_norm_mla[k - 512];
            W[(long)n * 1024 + k] = (half_t)(p.w_out[e] * g);
        }
    }
    {
        half_t* W = (half_t*)(ws + OFF_WPQ);
        for (long e = tid; e < 1024L * 2048; e += nth) {
            int k = (int)(e >> 11), n = (int)(e & 2047);
            W[(long)n * 1024 + k] = (half_t)(p.peer_wq[e] * p.norm2_g[k]);
        }
    }
    {
        half_t* W = (half_t*)(ws + OFF_KEYS);
        for (long e = tid; e < 2 * 16384; e += nth) {
            W[e] = (half_t)(e < 16384 ? p.peer_keys1[e] : p.peer_keys2[e - 16384]);
        }
    }
    {
        half_t* U = (half_t*)(ws + OFF_U16);
        half_t* V = (half_t*)(ws + OFF_V16);
        const long n4 = 16384L * 1024 / 4;
        for (long e = tid; e < n4; e += nth) {
            float4 a = ((const float4*)p.peer_u)[e];
            float4 b = ((const float4*)p.peer_v)[e];
            h4v ha = {(half_t)a.x, (half_t)a.y, (half_t)a.z, (half_t)a.w};
            h4v hb = {(half_t)b.x, (half_t)b.y, (half_t)b.z, (half_t)b.w};
            ((h4v*)U)[e] = ha; ((h4v*)V)[e] = hb;
        }
    }
    {
        half_t* H1 = (half_t*)(ws + OFF_H1);
        const int lane = threadIdx.x & 63;
        const long wv = tid >> 6, nwv = nth >> 6;
        for (long row = wv; row < NTOK; row += nwv) {
            const float4* xr = (const float4*)(p.x + row * 1024);
            float4 v[4]; float ss = 0.f;
#pragma unroll
            for (int i = 0; i < 4; ++i) { v[i] = xr[lane + 64 * i]; ss += v[i].x * v[i].x + v[i].y * v[i].y + v[i].z * v[i].z + v[i].w * v[i].w; }
            ss = wave_sum(ss);
            const float rs = rsqrtf(ss * (1.0f / 1024.f) + EPS);
#pragma unroll
            for (int i = 0; i < 4; ++i) {
                float4 g = ((const float4*)p.norm1_g)[lane + 64 * i];
                h4v o = {(half_t)(v[i].x * rs * g.x), (half_t)(v[i].y * rs * g.y), (half_t)(v[i].z * rs * g.z), (half_t)(v[i].w * rs * g.w)};
                ((h4v*)(H1 + row * 1024))[lane + 64 * i] = o;
            }
        }
    }
}

struct GemmSmem { half_t A[128][72]; half_t Bt[128][72]; float rs[2][128]; };

template <bool SCALE, class Epi>
__device__ __forceinline__ void gemm_tile(const half_t* __restrict__ A, long lda, const half_t* __restrict__ Bt, long ldb, int K, int ksplit, char* smem_raw, Epi epi) {
    GemmSmem& sm = *(GemmSmem*)smem_raw;
    const int tid = threadIdx.x, lane = tid & 63, w = tid >> 6, wm = w >> 1, wn = w & 1;
    const int i16 = lane & 15, g4 = lane >> 4;
    const int lr = tid >> 3, off = tid & 7;
    if (SCALE) {
        const int row = tid >> 1, part = tid & 1;
        for (int range = 0; range < 2; ++range) {
            const int kb = range ? ksplit : 0, ke = range ? K : ksplit;
            const int L = ke - kb;
            if (L <= 0) continue;
            const int hl = L >> 1;
            const half_t* ap = A + (long)row * lda + kb + part * hl;
            float ss = 0.f;
            for (int k = 0; k < hl; k += 8) {
                h8v v = *(const h8v*)(ap + k);
#pragma unroll
                for (int j = 0; j < 8; ++j) { float f = (float)v[j]; ss += f * f; }
            }
            ss += __shfl_xor(ss, 1);
            if (part == 0) sm.rs[range][row] = rsqrtf(ss / (float)L + EPS);
        }
        __syncthreads();
    }
    f4v acc[4][4];
#pragma unroll
    for (int a = 0; a < 4; ++a)
#pragma unroll
        for (int b = 0; b < 4; ++b) acc[a][b] = (f4v){0.f, 0.f, 0.f, 0.f};
    u4v ra[4], rb[4];
    const int nk = K >> 6;
#pragma unroll
    for (int i = 0; i < 4; ++i) {
        ra[i] = *(const u4v*)(A + (long)(lr + 32 * i) * lda + off * 8);
        rb[i] = *(const u4v*)(Bt + (long)(lr + 32 * i) * ldb + off * 8);
    }
    for (int kt = 0; kt < nk; ++kt) {
#pragma unroll
        for (int i = 0; i < 4; ++i) {
            u4v va = ra[i];
            if (SCALE) {
                const float rs = sm.rs[(kt * 64 >= ksplit) ? 1 : 0][lr + 32 * i];
                h8v hv = __builtin_bit_cast(h8v, va);
#pragma unroll
                for (int j = 0; j < 8; ++j) hv[j] = (half_t)((float)hv[j] * rs);
                va = __builtin_bit_cast(u4v, hv);
            }
            *(u4v*)&sm.A[lr + 32 * i][off * 8] = va;
            *(u4v*)&sm.Bt[lr + 32 * i][off * 8] = rb[i];
        }
        __syncthreads();
        if (kt + 1 < nk) {
            const int k0 = (kt + 1) * 64;
#pragma unroll
            for (int i = 0; i < 4; ++i) {
                ra[i] = *(const u4v*)(A + (long)(lr + 32 * i) * lda + k0 + off * 8);
                rb[i] = *(const u4v*)(Bt + (long)(lr + 32 * i) * ldb + k0 + off * 8);
            }
        }
#pragma unroll
        for (int kk = 0; kk < 2; ++kk) {
            h8v af[4], bf[4];
#pragma unroll
            for (int mi = 0; mi < 4; ++mi) af[mi] = *(const h8v*)&sm.A[wm * 64 + mi * 16 + i16][kk * 32 + g4 * 8];
#pragma unroll
            for (int ni = 0; ni < 4; ++ni) bf[ni] = *(const h8v*)&sm.Bt[wn * 64 + ni * 16 + i16][kk * 32 + g4 * 8];
#pragma unroll
            for (int mi = 0; mi < 4; ++mi)
#pragma unroll
                for (int ni = 0; ni < 4; ++ni) acc[mi][ni] = mfma16(af[mi], bf[ni], acc[mi][ni]);
        }
        __syncthreads();
    }
    epi(acc, wm, wn, i16, g4);
}

__device__ __forceinline__ void rope_pair(float x1, float x2, int pos, int i, float& o1, float& o2) {
    const float inv = __builtin_amdgcn_exp2f(-(float)i * (13.287712379549449f / 16.0f));
    double t = (double)pos * (double)inv * 0.15915494309189535;
    t -= __builtin_rint(t);
    const float fr = (float)t;
    const float sn = __builtin_amdgcn_sinf(fr), cs = __builtin_amdgcn_cosf(fr);
    o1 = x1 * cs - x2 * sn; o2 = x1 * sn + x2 * cs;
}

__device__ __forceinline__ void phase_inproj(const Params& p, int bid, int nb, char* smem) {
    char* ws = p.ws;
    const half_t* H1 = (const half_t*)(ws + OFF_H1);
    const half_t* W = (const half_t*)(ws + OFF_WIN);
    half_t* QH = (half_t*)(ws + OFF_QH);
    half_t* KM = (half_t*)(ws + OFF_KM);
    half_t* CQ = (half_t*)(ws + OFF_CQ);
    half_t* CKV = (half_t*)(ws + OFF_CKV);
    float* GATES = (float*)(ws + OFF_GATES);
    const int NT_N = NINP / 128, NT_M = NTOK / 128;
    for (int tile = bid; tile < NT_M * NT_N; tile += nb) {
        const int tm = tile / NT_N, tn = tile % NT_N;
        const int row0 = tm * 128, n0 = tn * 128;
        gemm_tile<false>(H1 + (long)row0 * 1024, 1024, W + (long)n0 * 1024, 1024, 1024, 1024, smem,
            [&](f4v (&acc)[4][4], int wm, int wn, int i16, int g4) __attribute__((always_inline)) {
#pragma unroll
                for (int ni = 0; ni < 4; ++ni) {
                    const int cb = n0 + wn * 64 + ni * 16;
                    const int col = cb + i16;
#pragma unroll
                    for (int mi = 0; mi < 4; ++mi) {
                        const int rbase = row0 + wm * 64 + mi * 16 + g4 * 4;
                        const int b = rbase >> 14, s0 = rbase & (SEQ - 1);
                        if (cb < 512) {
#pragma unroll
                            for (int r = 0; r < 4; ++r) QH[(long)(rbase + r) * 512 + col] = (half_t)(acc[mi][ni][r] * QS_NSA);
                        } else if (cb < 1280) {
                            const int which = (cb - 512) >> 7;
                            const int c = (col - 512) & 127, gg = c >> 6, d = c & 63;
                            half_t* base = (half_t*)(ws + OFF_KC + (size_t)which * SZ_KV);
                            if (which == 3 || which == 5) {
                                h4v o = {(half_t)acc[mi][ni][0], (half_t)acc[mi][ni][1], (half_t)acc[mi][ni][2], (half_t)acc[mi][ni][3]};
                                *(h4v*)(base + ((long)((b * 2 + gg) * 64 + d)) * SEQ + s0) = o;
                            } else {
#pragma unroll
                                for (int r = 0; r < 4; ++r) base[((long)(b * 2 + gg) * SEQ + s0 + r) * 64 + d] = (half_t)acc[mi][ni][r];
                            }
                        } else if (cb < 1536) {
#pragma unroll
                            for (int r = 0; r < 4; ++r) CQ[(long)(rbase + r) * 256 + (col - 1280)] = (half_t)acc[mi][ni][r];
                        } else if (cb < 1664) {
#pragma unroll
                            for (int r = 0; r < 4; ++r) CKV[(long)(rbase + r) * 128 + (col - 1536)] = (half_t)acc[mi][ni][r];
                        } else if (cb == 1664) {
#pragma unroll
                            for (int r = 0; r < 4; ++r) {
                                float o1, o2;
                                rope_pair(acc[mi][ni][r], acc[mi][(ni + 1) & 3][r], p.pos[rbase + r], i16, o1, o2);
#pragma unroll
                                for (int h = 0; h < 8; ++h) {
                                    half_t* kr = KM + ((long)(b * 8 + h) * SEQ + s0 + r) * 96 + 64;
                                    kr[i16] = (half_t)o1; kr[16 + i16] = (half_t)o2;
                                }
                            }
                        } else if (cb >= 1696) {
                            if (col < 1720) {
#pragma unroll
                                for (int r = 0; r < 4; ++r) GATES[(long)(rbase + r) * 24 + (col - 1696)] = 1.0f / (1.0f + __expf(-acc[mi][ni][r]));
                            }
                        }
                    }
                }
            });
    }
}

__device__ __forceinline__ void phase_p2(const Params& p, int bid, int nb, char* smem) {
    char* ws = p.ws;
    const int NTA = 256 * 6, NTB = 256 * 8, NTC = 128;
    for (int tile = bid; tile < NTA + NTB + NTC; tile += nb) {
        if (tile < NTC) {
            const int nt = tile & 1, mt = (tile >> 1) & 7, bg = (tile >> 4) & 3, kv = tile >> 6;
            const half_t* A = (const half_t*)(ws + (kv ? OFF_VC : OFF_KC)) + (long)bg * SEQ * 64 + (long)mt * 128 * 1024;
            const half_t* Bt = (const half_t*)(ws + OFF_WC1) + ((long)kv * 256 + nt * 128) * 2048;
            const float* cbv = (const float*)(ws + OFF_CB) + kv * 256;
            half_t* HC = (half_t*)(ws + OFF_HC1) + ((long)(kv * 4 + bg) * 1024) * 256;
            gemm_tile<false>(A, 1024, Bt, 2048, 2048, 2048, smem,
                [&](f4v (&acc)[4][4], int wm, int wn, int i16, int g4) __attribute__((always_inline)) {
#pragma unroll
                    for (int ni = 0; ni < 4; ++ni) {
                        const int n = nt * 128 + wn * 64 + ni * 16 + i16;
                        const float bias = cbv[n];
#pragma unroll
                        for (int mi = 0; mi < 4; ++mi)
#pragma unroll
                            for (int r = 0; r < 4; ++r) {
                                const int m = mt * 128 + wm * 64 + mi * 16 + g4 * 4 + r;
                                if (m < NCMP) HC[(long)m * 256 + n] = (half_t)gelu_exact(acc[mi][ni][r] + bias);
                            }
                    }
                });
        } else if (tile < NTC + NTA) {
            const int t2 = tile - NTC;
            const int tm = t2 / 6, tn = t2 % 6;
            const int row0 = tm * 128, n0 = tn * 128;
            half_t* QM = (half_t*)(ws + OFF_QM);
            gemm_tile<true>((const half_t*)(ws + OFF_CQ) + (long)row0 * 256, 256, (const half_t*)(ws + OFF_WQUP) + (long)n0 * 256, 256, 256, 256, smem,
                [&](f4v (&acc)[4][4], int wm, int wn, int i16, int g4) __attribute__((always_inline)) {
#pragma unroll
                    for (int ni = 0; ni < 4; ++ni) {
                        const int cb = n0 + wn * 64 + ni * 16;
                        const int h = cb / 96, d0 = cb - h * 96;
#pragma unroll
                        for (int mi = 0; mi < 4; ++mi) {
                            const int rbase = row0 + wm * 64 + mi * 16 + g4 * 4;
                            const int b = rbase >> 14, s0 = rbase & (SEQ - 1);
#pragma unroll
                            for (int r = 0; r < 4; ++r) {
                                half_t* qr = QM + ((long)(b * 8 + h) * SEQ + s0 + r) * 96;
                                if (d0 < 64) qr[d0 + i16] = (half_t)(acc[mi][ni][r] * QS_MLA);
                                else if (d0 == 64) {
                                    float o1, o2;
                                    rope_pair(acc[mi][ni][r] * QS_MLA, acc[mi][(ni + 1) & 3][r] * QS_MLA, p.pos[rbase + r], i16, o1, o2);
                                    qr[64 + i16] = (half_t)o1; qr[80 + i16] = (half_t)o2;
                                }
                            }
                        }
                    }
                });
        } else {
            const int t2 = tile - NTC - NTA;
            const int tm = t2 >> 3, tn = t2 & 7;
            const int row0 = tm * 128, n0 = tn * 128;
            half_t* KM = (half_t*)(ws + OFF_KM);
            half_t* VT = (half_t*)(ws + OFF_VT);
            gemm_tile<true>((const half_t*)(ws + OFF_CKV) + (long)row0 * 128, 128, (const half_t*)(ws + OFF_WKVUP) + (long)n0 * 128, 128, 128, 128, smem,
                [&](f4v (&acc)[4][4], int wm, int wn, int i16, int g4) __attribute__((always_inline)) {
                    const int h = tn;
#pragma unroll
                    for (int ni = 0; ni < 4; ++ni) {
                        const int d0 = wn * 64 + ni * 16;
#pragma unroll
                        for (int mi = 0; mi < 4; ++mi) {
                            const int rbase = row0 + wm * 64 + mi * 16 + g4 * 4;
                            const int b = rbase >> 14, s0 = rbase & (SEQ - 1);
                            if (d0 < 64) {
#pragma unroll
                                for (int r = 0; r < 4; ++r) KM[((long)(b * 8 + h) * SEQ + s0 + r) * 96 + d0 + i16] = (half_t)acc[mi][ni][r];
                            } else {
                                h4v o = {(half_t)acc[mi][ni][0], (half_t)acc[mi][ni][1], (half_t)acc[mi][ni][2], (half_t)acc[mi][ni][3]};
                                *(h4v*)(VT + ((long)(b * 8 + h) * 64 + (d0 - 64 + i16)) * SEQ + s0) = o;
                            }
                        }
                    }
                });
        }
    }
}

__device__ __forceinline__ void phase_cmp2(const Params& p, int bid, int nb) {
    char* ws = p.ws;
    const long tid = (long)bid * NTHREADS + threadIdx.x, nth = (long)nb * NTHREADS;
    const half_t* HC = (const half_t*)(ws + OFF_HC1);
    half_t* KC = (half_t*)(ws + OFF_KCMP);
    half_t* VCT = (half_t*)(ws + OFF_VCMPT);
    for (long e = tid; e < 2L * 4 * 1024 * 64; e += nth) {
        const int d = (int)(e & 63), n = (int)((e >> 6) & 1023), bg = (int)((e >> 16) & 3), kv = (int)(e >> 18);
        float s = 0.f;
        if (n < NCMP) {
            const half_t* hr = HC + ((long)(kv * 4 + bg) * 1024 + n) * 256;
            const float* w2 = kv ? p.cmp_v_w2 : p.cmp_k_w2;
            for (int j = 0; j < 256; ++j) s += (float)hr[j] * w2[j * 64 + d];
        }
        if (kv == 0) KC[((long)bg * 1024 + n) * 64 + d] = (half_t)s;
        else VCT[((long)bg * 64 + d) * 1024 + n] = (half_t)s;
    }
}

struct MlaSmem { half_t K[2][64][104]; half_t V[2][64][68]; };

__device__ __forceinline__ void mla_item(const Params& p, int item, char* smem) {
    MlaSmem& sm = *(MlaSmem*)smem;
    char* ws = p.ws;
    const int qb = 127 - (item >> 4), bh = item & 15;
    const int b = bh >> 3, h = bh & 7;
    const half_t* Qp = (const half_t*)(ws + OFF_QM) + ((long)bh * SEQ + qb * 128) * 96;
    const half_t* Kp = (const half_t*)(ws + OFF_KM) + (long)bh * SEQ * 96;
    const half_t* Vp = (const half_t*)(ws + OFF_VT) + (long)bh * 64 * SEQ;
    half_t* MIX = (half_t*)(ws + OFF_MIXED);
    int tid_ = threadIdx.x; asm volatile("" : "+v"(tid_));
    const int tid = tid_, lane = tid & 63, w = tid >> 6;
    const int c = lane & 31, hh = lane >> 5;
    const int tq = qb * 128 + w * 32 + c;
    h8v qf[6];
#pragma unroll
    for (int s6 = 0; s6 < 6; ++s6) qf[s6] = *(const h8v*)(Qp + (long)(w * 32 + c) * 96 + s6 * 16 + hh * 8);
    f16v o0, o1;
#pragma unroll
    for (int i = 0; i < 16; ++i) { o0[i] = 0.f; o1[i] = 0.f; }
    float m = NEGF, l = 0.f;
    const int ntiles = 2 * qb + 2;
    u4v rk[3]; u2v rv[4];
    auto gload = [&](int j) {
#pragma unroll
        for (int i = 0; i < 3; ++i) {
            const int ci = tid + 256 * i, key = ci / 12, of = ci % 12;
            rk[i] = *(const u4v*)(Kp + (long)(j * 64 + key) * 96 + of * 8);
        }
#pragma unroll
        for (int i = 0; i < 2; ++i) {
            const int ci = tid + 256 * i, dim = ci >> 3, of = ci & 7;
            const u4v v = *(const u4v*)(Vp + (long)dim * SEQ + j * 64 + of * 8);
            rv[2 * i] = (u2v){v.x, v.y}; rv[2 * i + 1] = (u2v){v.z, v.w};
        }
    };
    auto lstore = [&](int buf) {
#pragma unroll
        for (int i = 0; i < 3; ++i) {
            const int ci = tid + 256 * i, key = ci / 12, of = ci % 12;
            *(u4v*)&sm.K[buf][key][of * 8] = rk[i];
        }
#pragma unroll
        for (int i = 0; i < 2; ++i) {
            const int ci = tid + 256 * i, dim = ci >> 3, of = ci & 7;
            *(u2v*)&sm.V[buf][dim][of * 8] = rv[2 * i];
            *(u2v*)&sm.V[buf][dim][of * 8 + 4] = rv[2 * i + 1];
        }
    };
    gload(0);
    lstore(0);
    __syncthreads();
#pragma unroll 1
    for (int j = 0; j < ntiles; ++j) {
        const int buf = j & 1;
        if (j + 1 < ntiles) gload(j + 1);
        const int qmin = qb * 128 + w * 32;
        if (64 * j <= qmin + 31) {
            f16v s0, s1;
#pragma unroll
            for (int i = 0; i < 16; ++i) { s0[i] = 0.f; s1[i] = 0.f; }
#pragma unroll
            for (int s6 = 0; s6 < 6; ++s6) {
                const h8v a0 = *(const h8v*)&sm.K[buf][c][s6 * 16 + hh * 8];
                const h8v a1 = *(const h8v*)&sm.K[buf][32 + c][s6 * 16 + hh * 8];
                s0 = mfma32(a0, qf[s6], s0);
                s1 = mfma32(a1, qf[s6], s1);
            }
            if (64 * j + 63 > qmin) {
#pragma unroll
                for (int r = 0; r < 16; ++r) {
                    const int key = 64 * j + (r & 3) + 8 * (r >> 2) + 4 * hh;
                    if (key > tq) s0[r] = NEGF;
                    if (key + 32 > tq) s1[r] = NEGF;
                }
            }
            float mx = s0[0];
#pragma unroll
            for (int r = 1; r < 16; ++r) mx = fmaxf(mx, s0[r]);
#pragma unroll
            for (int r = 0; r < 16; ++r) mx = fmaxf(mx, s1[r]);
            mx = fmaxf(mx, __shfl_xor(mx, 32));
            const float mn = fmaxf(m, mx);
            const float alpha = fast_exp2(m - mn);
            m = mn;
            float ps = 0.f;
#pragma unroll
            for (int r = 0; r < 16; ++r) { s0[r] = fast_exp2(s0[r] - mn); ps += s0[r]; }
#pragma unroll
            for (int r = 0; r < 16; ++r) { s1[r] = fast_exp2(s1[r] - mn); ps += s1[r]; }
            l = l * alpha + ps;
#pragma unroll
            for (int i = 0; i < 16; ++i) { o0[i] *= alpha; o1[i] *= alpha; }
#pragma unroll
            for (int ks = 0; ks < 4; ++ks) {
                h8v pb;
#pragma unroll
                for (int jj = 0; jj < 8; ++jj) pb[jj] = (half_t)((ks < 2) ? s0[8 * (ks & 1) + jj] : s1[8 * (ks & 1) + jj]);
#pragma unroll
                for (int md = 0; md < 2; ++md) {
                    const h4v lo = *(const h4v*)&sm.V[buf][32 * md + c][16 * ks + 4 * hh];
                    const h4v hi = *(const h4v*)&sm.V[buf][32 * md + c][16 * ks + 8 + 4 * hh];
                    const h8v a = {lo[0], lo[1], lo[2], lo[3], hi[0], hi[1], hi[2], hi[3]};
                    if (md == 0) o0 = mfma32(a, pb, o0); else o1 = mfma32(a, pb, o1);
                }
            }
        }
        if (j + 1 < ntiles) lstore(buf ^ 1);
        __syncthreads();
    }
    const float lt = l + __shfl_xor(l, 32);
    const float inv = 1.0f / lt;
    half_t* orow = MIX + (long)(b * SEQ + tq) * 1024 + 512 + h * 64;
#pragma unroll
    for (int md = 0; md < 2; ++md)
#pragma unroll
        for (int rg = 0; rg < 4; ++rg) {
            h4v o;
#pragma unroll
            for (int e = 0; e < 4; ++e) o[e] = (half_t)(((md == 0) ? o0[4 * rg + e] : o1[4 * rg + e]) * inv);
            *(h4v*)(orow + 32 * md + 8 * rg + 4 * hh) = o;
        }
}

struct NsaSmem { float lut[LUTN * 4]; float imp[4][8][256]; int sel[4][8][16]; };

__device__ __forceinline__ f16v nsa_qk(const half_t* krow, const h8v (&qf)[4]) {
    f16v s;
#pragma unroll
    for (int i = 0; i < 16; ++i) s[i] = 0.f;
#pragma unroll
    for (int s4 = 0; s4 < 4; ++s4) {
        const h8v a = *(const h8v*)(krow + s4 * 16);
        s = mfma32(a, qf[s4], s);
    }
    return s;
}
__device__ __forceinline__ void nsa_pv(const half_t* vt, long ldv, const f16v& pr, f16v& o0, f16v& o1) {
#pragma unroll
    for (int ks = 0; ks < 2; ++ks) {
        h8v pb;
#pragma unroll
        for (int jj = 0; jj < 8; ++jj) pb[jj] = (half_t)pr[8 * ks + jj];
#pragma unroll
        for (int md = 0; md < 2; ++md) {
            const half_t* vp = vt + (long)(32 * md) * ldv + 16 * ks;
            const h4v lo = *(const h4v*)(vp);
            const h4v hi = *(const h4v*)(vp + 8);
            const h8v a = {lo[0], lo[1], lo[2], lo[3], hi[0], hi[1], hi[2], hi[3]};
            if (md == 0) o0 = mfma32(a, pb, o0); else o1 = mfma32(a, pb, o1);
        }
    }
}

__device__ __forceinline__ void nsa_item(const Params& p, int item, char* smem) {
    NsaSmem& sm = *(NsaSmem*)smem;
    char* ws = p.ws;
    const int bg = item & 3, qt = item >> 2;
    const int b = bg >> 1, g = bg & 1;
    int tid_ = threadIdx.x; asm volatile("" : "+v"(tid_));
    const int tid = tid_, lane = tid & 63, w = tid >> 6;
    const int c = lane & 31, hh = lane >> 5;
    const int qi = c >> 2, r = c & 3;
    const int t0w = qt * 32 + w * 8;
    const int tq = t0w + qi;
    const int tlast = t0w + 7;
    {
        const float* lg = (const float*)(ws + OFF_LUT) + (long)g * LUTN * 4;
        for (int i = tid; i < LUTN * 4; i += NTHREADS) sm.lut[i] = lg[i];
        float* im = &sm.imp[0][0][0];
        for (int i = tid; i < 4 * 8 * 256; i += NTHREADS) im[i] = 0.f;
    }
    __syncthreads();
    const half_t* QH = (const half_t*)(ws + OFF_QH);
    h8v qf[4];
#pragma unroll
    for (int s4 = 0; s4 < 4; ++s4) qf[s4] = *(const h8v*)(QH + (long)(b * SEQ + tq) * 512 + (g * 4 + r) * 64 + s4 * 16 + hh * 8);
    const float* gp = (const float*)(ws + OFF_GATES) + (long)(b * SEQ + tq) * 24 + (g * 4 + r) * 3;
    const float g0 = gp[0], g1 = gp[1], g2 = gp[2];
    f16v of0, of1;
#pragma unroll
    for (int i = 0; i < 16; ++i) { of0[i] = 0.f; of1[i] = 0.f; }

    {
        const half_t* KC = (const half_t*)(ws + OFF_KCMP) + (long)bg * 1024 * 64;
        const half_t* VCT = (const half_t*)(ws + OFF_VCMPT) + (long)bg * 64 * 1024;
        const int kmax = (tlast >= 31) ? ((tlast - 31) >> 4) : -1;
        const int ntile = (kmax + 32) >> 5;
        float m = NEGF, l = 0.f;
#pragma unroll 1
        for (int kt = 0; kt < ntile; ++kt) {
            f16v s = nsa_qk(KC + (long)(kt * 32 + c) * 64 + hh * 8, qf);
            float mx = NEGF;
#pragma unroll
            for (int rr = 0; rr < 16; ++rr) {
                const int k = kt * 32 + (rr & 3) + 8 * (rr >> 2) + 4 * hh;
                const int dist = tq - (16 * k + 31);
                const bool valid = dist >= 0;
                const int di = dist < 0 ? 0 : (dist > LUTN - 1 ? LUTN - 1 : dist);
                const float v = valid ? s[rr] + sm.lut[di * 4 + r] : NEGF;
                s[rr] = v; mx = fmaxf(mx, v);
            }
            const float mn = fmaxf(m, mx);
            float ps = 0.f;
#pragma unroll
            for (int rr = 0; rr < 16; ++rr) ps += (s[rr] > -1e29f) ? fast_exp2(s[rr] - mn) : 0.f;
            l = l * fast_exp2(m - mn) + ps;
            m = mn;
        }
        {
            const float mo = __shfl_xor(m, 32), lo = __shfl_xor(l, 32);
            const float mt = fmaxf(m, mo);
            l = l * fast_exp2(m - mt) + lo * fast_exp2(mo - mt);
            m = mt;
        }
        const float invl = (l > 0.f) ? 1.0f / l : 0.f;
        f16v oc0, oc1;
#pragma unroll
        for (int i = 0; i < 16; ++i) { oc0[i] = 0.f; oc1[i] = 0.f; }
        float carryL = 0.f;
#pragma unroll 1
        for (int kt = 0; kt < ntile; ++kt) {
            f16v s = nsa_qk(KC + (long)(kt * 32 + c) * 64 + hh * 8, qf);
#pragma unroll
            for (int rr = 0; rr < 16; ++rr) {
                const int k = kt * 32 + (rr & 3) + 8 * (rr >> 2) + 4 * hh;
                const int dist = tq - (16 * k + 31);
                const bool valid = dist >= 0;
                const int di = dist < 0 ? 0 : (dist > LUTN - 1 ? LUTN - 1 : dist);
                s[rr] = valid ? fast_exp2(s[rr] + sm.lut[di * 4 + r] - m) * invl : 0.f;
            }
            float Gs[4], Ls[4];
#pragma unroll
            for (int jg = 0; jg < 4; ++jg) {
                float G = s[4 * jg] + s[4 * jg + 1] + s[4 * jg + 2] + s[4 * jg + 3];
                float L = s[4 * jg + 3];
                G += __shfl_xor(G, 1); G += __shfl_xor(G, 2);
                L += __shfl_xor(L, 1); L += __shfl_xor(L, 2);
                Gs[jg] = G; Ls[jg] = L;
            }
            float Lo[4];
#pragma unroll
            for (int jg = 0; jg < 4; ++jg) Lo[jg] = __shfl_xor(Ls[jg], 32);
            if (r == 0) {
#pragma unroll
                for (int jg = 0; jg < 4; ++jg) {
                    const float prevL = hh ? Lo[jg] : (jg == 0 ? carryL : Lo[jg - 1]);
                    sm.imp[w][qi][8 * kt + 2 * jg + hh] = Gs[jg] + prevL;
                }
            }
            carryL = Lo[3];
            nsa_pv(VCT + (long)c * 1024 + kt * 32 + 4 * hh, 1024, s, oc0, oc1);
        }
#pragma unroll
        for (int i = 0; i < 16; ++i) { of0[i] += g0 * oc0[i]; of1[i] += g0 * oc1[i]; }
    }
    __syncthreads();
    {
        const int q2 = lane >> 3, sub = lane & 7;
        const int tq2 = t0w + q2;
        const int cur = tq2 >> 6;
        unsigned key[32];
#pragma unroll
        for (int i = 0; i < 32; ++i) {
            const int sb = sub + 8 * i;
            const float v = sm.imp[w][q2][sb];
            unsigned u = (__float_as_uint(v) & 0x7FFFFF00u) | (unsigned)(255 - sb);
            if (sb == 0 || sb == cur || sb == cur - 1) u |= 0x80000000u;
            if (sb > cur) u = 0u;
            key[i] = u;
        }
#pragma unroll 1
        for (int round = 0; round < 16; ++round) {
            unsigned best = key[0];
#pragma unroll
            for (int i = 1; i < 32; ++i) best = best > key[i] ? best : key[i];
#pragma unroll
            for (int o = 1; o <= 4; o <<= 1) { const unsigned ob = (unsigned)__shfl_xor((int)best, o); best = best > ob ? best : ob; }
            if (sub == 0) sm.sel[w][q2][round] = best ? (int)(255u - (best & 0xFFu)) : -1;
#pragma unroll
            for (int i = 0; i < 32; ++i) key[i] = (key[i] == best) ? 0u : key[i];
        }
    }
    __syncthreads();
    {
        const half_t* KS = (const half_t*)(ws + OFF_KS) + (long)bg * SEQ * 64;
        const half_t* VST = (const half_t*)(ws + OFF_VST) + (long)bg * 64 * SEQ;
        f16v os0, os1;
#pragma unroll
        for (int i = 0; i < 16; ++i) { os0[i] = 0.f; os1[i] = 0.f; }
        float m = NEGF, l = 0.f;
#pragma unroll 1
        for (int q2 = 0; q2 < 8; ++q2) {
            const bool own = (qi == q2);
            const int tq2 = t0w + q2;
#pragma unroll 1
            for (int bi = 0; bi < 16; ++bi) {
                const int blk = __builtin_amdgcn_readfirstlane(sm.sel[w][q2][bi]);
                if (blk < 0) continue;
#pragma unroll 1
                for (int t2 = 0; t2 < 2; ++t2) {
                    const int key0 = blk * 64 + t2 * 32;
                    if (key0 > tq2) continue;
                    f16v s = nsa_qk(KS + (long)(key0 + c) * 64 + hh * 8, qf);
                    float mx = NEGF;
#pragma unroll
                    for (int rr = 0; rr < 16; ++rr) {
                        const int pos = key0 + (rr & 3) + 8 * (rr >> 2) + 4 * hh;
                        const int dist = tq - pos;
                        const bool valid = own && dist >= 0;
                        const int di = dist < 0 ? 0 : (dist > LUTN - 1 ? LUTN - 1 : dist);
                        const float v = valid ? s[rr] + sm.lut[di * 4 + r] : NEGF;
                        s[rr] = v; mx = fmaxf(mx, v);
                    }
                    mx = fmaxf(mx, __shfl_xor(mx, 32));
                    const float mn = fmaxf(m, mx);
                    const float alpha = fast_exp2(m - mn);
                    m = mn;
                    float ps = 0.f;
#pragma unroll
                    for (int rr = 0; rr < 16; ++rr) { const float pv = (s[rr] > -1e29f) ? fast_exp2(s[rr] - mn) : 0.f; s[rr] = pv; ps += pv; }
                    l = l * alpha + ps;
#pragma unroll
                    for (int i = 0; i < 16; ++i) { os0[i] *= alpha; os1[i] *= alpha; }
                    nsa_pv(VST + (long)c * SEQ + key0 + 4 * hh, SEQ, s, os0, os1);
                }
            }
        }
        const float lt = l + __shfl_xor(l, 32);
        const float sc = (lt > 0.f) ? g1 / lt : 0.f;
#pragma unroll
        for (int i = 0; i < 16; ++i) { of0[i] += sc * os0[i]; of1[i] += sc * os1[i]; }
    }
    {
        const half_t* KW = (const half_t*)(ws + OFF_KW) + (long)bg * SEQ * 64;
        const half_t* VWT = (const half_t*)(ws + OFF_VWT) + (long)bg * 64 * SEQ;
        f16v ow0, ow1;
#pragma unroll
        for (int i = 0; i < 16; ++i) { ow0[i] = 0.f; ow1[i] = 0.f; }
        float m = NEGF, l = 0.f;
        int kstart = t0w - 511; if (kstart < 0) kstart = 0; kstart &= ~31;
#pragma unroll 1
        for (int key0 = kstart; key0 <= tlast; key0 += 32) {
            f16v s = nsa_qk(KW + (long)(key0 + c) * 64 + hh * 8, qf);
            float mx = NEGF;
#pragma unroll
            for (int rr = 0; rr < 16; ++rr) {
                const int pos = key0 + (rr & 3) + 8 * (rr >> 2) + 4 * hh;
                const int dist = tq - pos;
                const bool valid = dist >= 0 && dist < 512;
                const int di = dist < 0 ? 0 : (dist > LUTN - 1 ? LUTN - 1 : dist);
                const float v = valid ? s[rr] + sm.lut[di * 4 + r] : NEGF;
                s[rr] = v; mx = fmaxf(mx, v);
            }
            mx = fmaxf(mx, __shfl_xor(mx, 32));
            const float mn = fmaxf(m, mx);
            const float alpha = fast_exp2(m - mn);
            m = mn;
            float ps = 0.f;
#pragma unroll
            for (int rr = 0; rr < 16; ++rr) { const float pv = (s[rr] > -1e29f) ? fast_exp2(s[rr] - mn) : 0.f; s[rr] = pv; ps += pv; }
            l = l * alpha + ps;
#pragma unroll
            for (int i = 0; i < 16; ++i) { ow0[i] *= alpha; ow1[i] *= alpha; }
            nsa_pv(VWT + (long)c * SEQ + key0 + 4 * hh, SEQ, s, ow0, ow1);
        }
        const float lt = l + __shfl_xor(l, 32);
        const float sc = (lt > 0.f) ? g2 / lt : 0.f;
#pragma unroll
        for (int i = 0; i < 16; ++i) { of0[i] += sc * ow0[i]; of1[i] += sc * ow1[i]; }
    }
    {
        half_t* orow = (half_t*)(ws + OFF_MIXED) + (long)(b * SEQ + tq) * 1024 + (g * 4 + r) * 64;
#pragma unroll
        for (int md = 0; md < 2; ++md)
#pragma unroll
            for (int rg = 0; rg < 4; ++rg) {
                h4v o;
#pragma unroll
                for (int e = 0; e < 4; ++e) o[e] = (half_t)((md == 0) ? of0[4 * rg + e] : of1[4 * rg + e]);
                *(h4v*)(orow + 32 * md + 8 * rg + 4 * hh) = o;
            }
    }
    __syncthreads();
}

__device__ __forceinline__ void phase_attn(const Params& p, char* smem) {
    unsigned* ctr = (unsigned*)(p.ws + OFF_CTRL);
    volatile int* s_item = (volatile int*)(smem + 65024);
    const int NMLA = 2048, NNSA = 2048;
    for (;;) {
        if (threadIdx.x == 0) *s_item = (int)atomicAdd(&ctr[0], 1u);
        __syncthreads();
        const int item = *s_item;
        __syncthreads();
        if (item >= NMLA + NNSA) break;
        if (item < NMLA) mla_item(p, item, smem);
        else nsa_item(p, item - NMLA, smem);
    }
}

__device__ __forceinline__ void phase_outproj(const Params& p, int bid, int nb, char* smem) {
    char* ws = p.ws;
    const half_t* MIX = (const half_t*)(ws + OFF_MIXED);
    const half_t* W = (const half_t*)(ws + OFF_WOUT);
    half_t* X2H = (half_t*)(ws + OFF_X2H);
    for (int tile = bid; tile < 256 * 8; tile += nb) {
        const int tm = tile >> 3, tn = tile & 7;
        const int row0 = tm * 128, n0 = tn * 128;
        gemm_tile<true>(MIX + (long)row0 * 1024, 1024, W + (long)n0 * 1024, 1024, 1024, 512, smem,
            [&](f4v (&acc)[4][4], int wm, int wn, int i16, int g4) __attribute__((always_inline)) {
#pragma unroll
                for (int mi = 0; mi < 4; ++mi)
#pragma unroll
                    for (int ni = 0; ni < 4; ++ni)
#pragma unroll
                        for (int r = 0; r < 4; ++r) {
                            const long row = row0 + wm * 64 + mi * 16 + g4 * 4 + r;
                            const int col = n0 + wn * 64 + ni * 16 + i16;
                            const float v = p.x[row * 1024 + col] + acc[mi][ni][r];
                            p.out[row * 1024 + col] = v;
                            X2H[row * 1024 + col] = (half_t)v;
                        }
            });
    }
}

__device__ __forceinline__ void phase_peerq(const Params& p, int bid, int nb, char* smem) {
    char* ws = p.ws;
    const half_t* X2H = (const half_t*)(ws + OFF_X2H);
    const half_t* W = (const half_t*)(ws + OFF_WPQ);
    half_t* QP = (half_t*)(ws + OFF_QP);
    for (int tile = bid; tile < 256 * 16; tile += nb) {
        const int tm = tile >> 4, tn = tile & 15;
        const int row0 = tm * 128, n0 = tn * 128;
        gemm_tile<true>(X2H + (long)row0 * 1024, 1024, W + (long)n0 * 1024, 1024, 1024, 1024, smem,
            [&](f4v (&acc)[4][4], int wm, int wn, int i16, int g4) __attribute__((always_inline)) {
#pragma unroll
                for (int mi = 0; mi < 4; ++mi)
#pragma unroll
                    for (int ni = 0; ni < 4; ++ni)
#pragma unroll
                        for (int r = 0; r < 4; ++r) {
                            const long row = row0 + wm * 64 + mi * 16 + g4 * 4 + r;
                            const int col = n0 + wn * 64 + ni * 16 + i16;
                            QP[row * 2048 + col] = (half_t)acc[mi][ni][r];
                        }
            });
    }
}

__device__ __forceinline__ void topk_insert(float (&tv)[16], int (&ti)[16], float v, int id) {
#pragma unroll
    for (int k = 0; k < 16; ++k) {
        const bool gt = v > tv[k];
        const float nv = gt ? tv[k] : v; const int ni = gt ? ti[k] : id;
        tv[k] = gt ? v : tv[k]; ti[k] = gt ? id : ti[k];
        v = nv; id = ni;
    }
}
__device__ __forceinline__ void route_half(const half_t* __restrict__ qsrc_h, const half_t* kb, float (&tv)[16], int (&ti)[16]) {
    h2v q[64];
    const h8v* qsrc = (const h8v*)qsrc_h;
#pragma unroll
    for (int i = 0; i < 16; ++i) {
        const h8v v = qsrc[i];
        q[4 * i] = (h2v){v[0], v[1]}; q[4 * i + 1] = (h2v){v[2], v[3]};
        q[4 * i + 2] = (h2v){v[4], v[5]}; q[4 * i + 3] = (h2v){v[6], v[7]};
    }
#pragma unroll
    for (int k = 0; k < 16; ++k) { tv[k] = -3.0e38f; ti[k] = 0; }
    for (int n = 0; n < 128; ++n) {
        float s = 0.f;
        const h8v* kr = (const h8v*)(kb + n * 128);
#pragma unroll
        for (int i = 0; i < 16; ++i) {
            const h8v kv = kr[i];
            s = __builtin_amdgcn_fdot2(q[4 * i], (h2v){kv[0], kv[1]}, s, false);
            s = __builtin_amdgcn_fdot2(q[4 * i + 1], (h2v){kv[2], kv[3]}, s, false);
            s = __builtin_amdgcn_fdot2(q[4 * i + 2], (h2v){kv[4], kv[5]}, s, false);
            s = __builtin_amdgcn_fdot2(q[4 * i + 3], (h2v){kv[6], kv[7]}, s, false);
        }
        topk_insert(tv, ti, s, n);
    }
}
__device__ __forceinline__ void phase_route(const Params& p, int bid, int nb, char* smem) {
    char* ws = p.ws;
    half_t* keys = (half_t*)smem;
    {
        const u4v* src = (const u4v*)(ws + OFF_KEYS);
        u4v* dst = (u4v*)smem;
        for (int i = threadIdx.x; i < 65536 / 16; i += NTHREADS) dst[i] = src[i];
    }
    __syncthreads();
    const half_t* QP = (const half_t*)(ws + OFF_QP);
    int* EID = (int*)(ws + OFF_EID);
    float* GW = (float*)(ws + OFF_GW);
    for (long th = (long)bid * NTHREADS + threadIdx.x; th < (long)NTOK * 8; th += (long)nb * NTHREADS) {
        float tv0[16], tv1[16]; int ti0[16], ti1[16];
        route_half(QP + th * 256, keys, tv0, ti0);
        route_half(QP + th * 256 + 128, keys + 16384, tv1, ti1);
        float fv[16]; int fi[16];
#pragma unroll
        for (int k = 0; k < 16; ++k) { fv[k] = -3.0e38f; fi[k] = 0; }
#pragma unroll
        for (int i = 0; i < 16; ++i)
#pragma unroll
            for (int j = 0; j < 16; ++j)
                if ((i + 1) * (j + 1) <= 16) topk_insert(fv, fi, tv0[i] + tv1[j], ti0[i] * 128 + ti1[j]);
        float sum = 0.f, ex[16];
#pragma unroll
        for (int k = 0; k < 16; ++k) { ex[k] = __expf(fv[k] - fv[0]); sum += ex[k]; }
        const float inv = 1.0f / sum;
#pragma unroll
        for (int k = 0; k < 16; ++k) { EID[th * 16 + k] = fi[k]; GW[th * 16 + k] = ex[k] * inv; }
    }
}

__device__ __forceinline__ void phase_experts(const Params& p, int bid, int nb) {
    char* ws = p.ws;
    const half_t* U = (const half_t*)(ws + OFF_U16);
    const half_t* V = (const half_t*)(ws + OFF_V16);
    const int* EID = (const int*)(ws + OFF_EID);
    const float* GW = (const float*)(ws + OFF_GW);
    const int lane = threadIdx.x & 63;
    const long wv = ((long)bid * NTHREADS + threadIdx.x) >> 6, nwv = ((long)nb * NTHREADS) >> 6;
    for (long t = wv; t < NTOK; t += nwv) {
        float* xr = p.out + t * 1024;
        float xv[16];
        {
            const float4 a0 = *(const float4*)(xr + 8 * lane), a1 = *(const float4*)(xr + 8 * lane + 4);
            const float4 b0 = *(const float4*)(xr + 512 + 8 * lane), b1 = *(const float4*)(xr + 512 + 8 * lane + 4);
            xv[0] = a0.x; xv[1] = a0.y; xv[2] = a0.z; xv[3] = a0.w; xv[4] = a1.x; xv[5] = a1.y; xv[6] = a1.z; xv[7] = a1.w;
            xv[8] = b0.x; xv[9] = b0.y; xv[10] = b0.z; xv[11] = b0.w; xv[12] = b1.x; xv[13] = b1.y; xv[14] = b1.z; xv[15] = b1.w;
        }
        float ss = 0.f;
#pragma unroll
        for (int i = 0; i < 16; ++i) ss += xv[i] * xv[i];
        ss = wave_sum(ss);
        const float rs = rsqrtf(ss * (1.0f / 1024.f) + EPS);
        float hv[16];
#pragma unroll
        for (int i = 0; i < 16; ++i) {
            const int col = (i < 8) ? (8 * lane + i) : (512 + 8 * lane + i - 8);
            hv[i] = xv[i] * rs * p.norm2_g[col];
        }
        const int e0 = EID[t * 128 + lane], e1 = EID[t * 128 + 64 + lane];
        const float w0 = GW[t * 128 + lane], w1 = GW[t * 128 + 64 + lane];
        float acc[16];
#pragma unroll
        for (int i = 0; i < 16; ++i) acc[i] = 0.f;
        for (int j = 0; j < 128; j += 4) {
            int ee[4]; float gw[4]; float dot[4];
            h8v ua[4], ub[4];
#pragma unroll
            for (int q = 0; q < 4; ++q) {
                const int jj = j + q;
                ee[q] = (jj < 64) ? __builtin_amdgcn_readlane(e0, jj & 63) : __builtin_amdgcn_readlane(e1, jj & 63);
                gw[q] = (jj < 64) ? __builtin_bit_cast(float, __builtin_amdgcn_readlane(__builtin_bit_cast(int, w0), jj & 63))
                                  : __builtin_bit_cast(float, __builtin_amdgcn_readlane(__builtin_bit_cast(int, w1), jj & 63));
                const half_t* ur = U + (long)ee[q] * 1024;
                ua[q] = *(const h8v*)(ur + 8 * lane); ub[q] = *(const h8v*)(ur + 512 + 8 * lane);
            }
#pragma unroll
            for (int q = 0; q < 4; ++q) {
                float d = 0.f;
#pragma unroll
                for (int i = 0; i < 8; ++i) d += hv[i] * (float)ua[q][i] + hv[8 + i] * (float)ub[q][i];
                dot[q] = wave_sum(d);
            }
#pragma unroll
            for (int q = 0; q < 4; ++q) {
                const float coef = gw[q] * gelu_exact(dot[q]);
                const half_t* vr = V + (long)ee[q] * 1024;
                const h8v va = *(const h8v*)(vr + 8 * lane), vb = *(const h8v*)(vr + 512 + 8 * lane);
#pragma unroll
                for (int i = 0; i < 8; ++i) { acc[i] += coef * (float)va[i]; acc[8 + i] += coef * (float)vb[i]; }
            }
        }
        float s3 = 0.f;
#pragma unroll
        for (int i = 0; i < 16; ++i) { acc[i] += xv[i]; s3 += acc[i] * acc[i]; }
        s3 = wave_sum(s3);
        const float rf = rsqrtf(s3 * (1.0f / 1024.f) + EPS);
        float o[16];
#pragma unroll
        for (int i = 0; i < 16; ++i) {
            const int col = (i < 8) ? (8 * lane + i) : (512 + 8 * lane + i - 8);
            o[i] = acc[i] * rf * p.final_g[col];
        }
        *(float4*)(xr + 8 * lane) = make_float4(o[0], o[1], o[2], o[3]);
        *(float4*)(xr + 8 * lane + 4) = make_float4(o[4], o[5], o[6], o[7]);
        *(float4*)(xr + 512 + 8 * lane) = make_float4(o[8], o[9], o[10], o[11]);
        *(float4*)(xr + 512 + 8 * lane + 4) = make_float4(o[12], o[13], o[14], o[15]);
    }
}

template <int PH>
__global__ void __launch_bounds__(NTHREADS, 2) phase_kernel(Params p) {
    __shared__ __attribute__((aligned(16))) char smem[SMEM_BYTES];
    const int bid = blockIdx.x, nb = gridDim.x;
    if (PH == 0) phase_prep(p, bid, nb);
    if (PH == 1) phase_inproj(p, bid, nb, smem);
    if (PH == 2) phase_p2(p, bid, nb, smem);
    if (PH == 3) phase_cmp2(p, bid, nb);
    if (PH == 4) phase_attn(p, smem);
    if (PH == 5) phase_outproj(p, bid, nb, smem);
    if (PH == 6) phase_peerq(p, bid, nb, smem);
    if (PH == 7) phase_route(p, bid, nb, smem);
    if (PH == 8) phase_experts(p, bid, nb);
}

__global__ void __launch_bounds__(NTHREADS, 2) mega_kernel(Params p) {
    __shared__ __attribute__((aligned(16))) char smem[SMEM_BYTES];
    cg::grid_group grid = cg::this_grid();
    const int bid = blockIdx.x, nb = gridDim.x;
    phase_prep(p, bid, nb); grid.sync();
    phase_inproj(p, bid, nb, smem); grid.sync();
    phase_p2(p, bid, nb, smem); grid.sync();
    phase_cmp2(p, bid, nb); grid.sync();
    phase_attn(p, smem); grid.sync();
    phase_outproj(p, bid, nb, smem); grid.sync();
    phase_peerq(p, bid, nb, smem); grid.sync();
    phase_route(p, bid, nb, smem); grid.sync();
    phase_experts(p, bid, nb);
}

extern "C" void kernel_launch(void* const* d_in, const int* in_sizes, int n_in, void* d_out, int out_size, void* d_ws, size_t ws_size, hipStream_t stream) {
    (void)in_sizes; (void)n_in; (void)out_size;
    if (ws_size < WS_NEED) { fprintf(stderr, "kernel_launch: workspace too small (%zu < %zu)\n", ws_size, (size_t)WS_NEED); return; }
    Params p{};
    p.x = (const float*)d_in[0]; p.pos = (const int*)d_in[1]; p.norm1_g = (const float*)d_in[2]; p.w_in = (const float*)d_in[3];
    p.cmp_pos = (const float*)d_in[4]; p.cmp_k_w1 = (const float*)d_in[5]; p.cmp_k_w2 = (const float*)d_in[6];
    p.cmp_v_w1 = (const float*)d_in[7]; p.cmp_v_w2 = (const float*)d_in[8]; p.t5_bias = (const float*)d_in[9];
    p.q_norm_g = (const float*)d_in[10]; p.w_q_up = (const float*)d_in[11]; p.kv_norm_g = (const float*)d_in[12]; p.w_kv_up = (const float*)d_in[13];
    p.grp_norm_nsa = (const float*)d_in[14]; p.grp_norm_mla = (const float*)d_in[15]; p.w_out = (const float*)d_in[16]; p.norm2_g = (const float*)d_in[17];
    p.peer_wq = (const float*)d_in[18]; p.peer_keys1 = (const float*)d_in[19]; p.peer_keys2 = (const float*)d_in[20];
    p.peer_u = (const float*)d_in[21]; p.peer_v = (const float*)d_in[22]; p.final_g = (const float*)d_in[23];
    p.out = (float*)d_out; p.ws = (char*)d_ws;
#if MULTI_LAUNCH
    const int G = 512;
    phase_kernel<0><<<G, NTHREADS, 0, stream>>>(p);
    phase_kernel<1><<<G, NTHREADS, 0, stream>>>(p);
    phase_kernel<2><<<G, NTHREADS, 0, stream>>>(p);
    phase_kernel<3><<<G, NTHREADS, 0, stream>>>(p);
    phase_kernel<4><<<G, NTHREADS, 0, stream>>>(p);
    phase_kernel<5><<<G, NTHREADS, 0, stream>>>(p);
    phase_kernel<6><<<G, NTHREADS, 0, stream>>>(p);
    phase_kernel<7><<<G, NTHREADS, 0, stream>>>(p);
    phase_kernel<8><<<G, NTHREADS, 0, stream>>>(p);
#else
    static int grid_blocks = 0;
    if (!grid_blocks) {
        int dev = 0, cus = 0, per_cu = 0;
        hipGetDevice(&dev);
        hipDeviceGetAttribute(&cus, hipDeviceAttributeMultiprocessorCount, dev);
        hipOccupancyMaxActiveBlocksPerMultiprocessor(&per_cu, mega_kernel, NTHREADS, 0);
        if (per_cu > 2) per_cu = 2;
        grid_blocks = cus * per_cu;
    }
    void* args[] = {&p};
    hipError_t e = hipLaunchCooperativeKernel((void*)mega_kernel, dim3(grid_blocks), dim3(NTHREADS), args, 0, stream);
    if (e != hipSuccess) fprintf(stderr, "cooperative launch failed: %s (grid %d)\n", hipGetErrorString(e), grid_blocks);
#endif
}
```

```cpp
#include <hip/hip_runtime.h>
#include <hip/hip_cooperative_groups.h>
#include <cstdio>
#include <cstdint>
namespace cg = cooperative_groups;

#ifndef MULTI_LAUNCH
#define MULTI_LAUNCH 0
#endif

typedef _Float16 half_t;
typedef _Float16 h2v __attribute__((ext_vector_type(2)));
typedef _Float16 h4v __attribute__((ext_vector_type(4)));
typedef _Float16 h8v __attribute__((ext_vector_type(8)));
typedef float f4v __attribute__((ext_vector_type(4)));
typedef unsigned u4v __attribute__((ext_vector_type(4)));
typedef unsigned u2v __attribute__((ext_vector_type(2)));
typedef float f16v __attribute__((ext_vector_type(16)));

constexpr int BATCH = 2, SEQ = 16384, DM = 1024, NTOK = BATCH * SEQ;
constexpr int NIN = 1720, NINP = 1792;
constexpr int NCMP = 1023, NCMPP = 1024;
constexpr float EPS = 1e-6f;
constexpr float LOG2E = 1.4426950408889634f;
constexpr float QS_NSA = 0.125f * LOG2E;
constexpr float QS_MLA = 0.10206207261596575f * LOG2E;
constexpr float NEGF = -1e30f;
constexpr int LUTN = 1536;

constexpr size_t al256(size_t x) { return (x + 255) & ~(size_t)255; }
constexpr size_t OFF_CTRL = 0;
constexpr size_t OFF_LUT = 4096;
constexpr size_t OFF_CB = OFF_LUT + 2 * LUTN * 4 * 4;
constexpr size_t OFF_WIN = 65536;
constexpr size_t OFF_WQUP = OFF_WIN + (size_t)NINP * 1024 * 2;
constexpr size_t OFF_WKVUP = OFF_WQUP + 768 * 256 * 2;
constexpr size_t OFF_WC1 = OFF_WKVUP + 1024 * 128 * 2;
constexpr size_t OFF_WOUT = OFF_WC1 + 2 * 256 * 2048 * 2;
constexpr size_t OFF_WPQ = OFF_WOUT + 1024 * 1024 * 2;
constexpr size_t OFF_KEYS = OFF_WPQ + 2048 * 1024 * 2;
constexpr size_t OFF_U16 = al256(OFF_KEYS + 2 * 128 * 128 * 2);
constexpr size_t OFF_V16 = OFF_U16 + (size_t)16384 * 1024 * 2;
constexpr size_t OFF_H1 = OFF_V16 + (size_t)16384 * 1024 * 2;
constexpr size_t OFF_MIXED = OFF_H1;
constexpr size_t OFF_QH = OFF_H1 + (size_t)NTOK * 1024 * 2;
constexpr size_t SZ_KV = (size_t)2 * 2 * SEQ * 64 * 2;
constexpr size_t OFF_KC = OFF_QH + (size_t)NTOK * 512 * 2;
constexpr size_t OFF_VC = OFF_KC + SZ_KV;
constexpr size_t OFF_KS = OFF_VC + SZ_KV;
constexpr size_t OFF_VST = OFF_KS + SZ_KV;
constexpr size_t OFF_KW = OFF_VST + SZ_KV;
constexpr size_t OFF_VWT = OFF_KW + SZ_KV;
constexpr size_t OFF_GATES = OFF_VWT + SZ_KV;
constexpr size_t OFF_CQ = OFF_GATES + (size_t)NTOK * 24 * 4;
constexpr size_t OFF_CKV = OFF_CQ + (size_t)NTOK * 256 * 2;
constexpr size_t OFF_X2H = OFF_QH;
constexpr size_t OFF_QM = OFF_CKV + (size_t)NTOK * 128 * 2;
constexpr size_t OFF_KM = OFF_QM + (size_t)NTOK * 8 * 96 * 2;
constexpr size_t OFF_VT = OFF_KM + (size_t)NTOK * 8 * 96 * 2;
constexpr size_t OFF_QP = OFF_QM;
constexpr size_t OFF_HC1 = OFF_VT + (size_t)NTOK * 8 * 64 * 2;
constexpr size_t OFF_KCMP = OFF_HC1 + (size_t)8 * 1024 * 256 * 2;
constexpr size_t OFF_VCMPT = OFF_KCMP + (size_t)4 * 1024 * 64 * 2;
constexpr size_t OFF_EID = OFF_VCMPT + (size_t)4 * 1024 * 64 * 2;
constexpr size_t OFF_GW = OFF_EID + (size_t)NTOK * 128 * 4;
constexpr size_t WS_NEED = OFF_GW + (size_t)NTOK * 128 * 4;

struct Params {
    const float* x; const int* pos; const float* norm1_g; const float* w_in; const float* cmp_pos;
    const float* cmp_k_w1; const float* cmp_k_w2; const float* cmp_v_w1; const float* cmp_v_w2; const float* t5_bias;
    const float* q_norm_g; const float* w_q_up; const float* kv_norm_g; const float* w_kv_up;
    const float* grp_norm_nsa; const float* grp_norm_mla; const float* w_out; const float* norm2_g;
    const float* peer_wq; const float* peer_keys1; const float* peer_keys2; const float* peer_u; const float* peer_v; const float* final_g;
    float* out; char* ws;
};

constexpr int SMEM_BYTES = 65536;
constexpr int NTHREADS = 256;

__device__ __forceinline__ f4v mfma16(h8v a, h8v b, f4v c) { return __builtin_amdgcn_mfma_f32_16x16x32_f16(a, b, c, 0, 0, 0); }
__device__ __forceinline__ f16v mfma32(h8v a, h8v b, f16v c) { return __builtin_amdgcn_mfma_f32_32x32x16_f16(a, b, c, 0, 0, 0); }
__device__ __forceinline__ float wave_sum(float v) {
#pragma unroll
    for (int o = 32; o >= 1; o >>= 1) v += __shfl_xor(v, o);
    return v;
}
__device__ __forceinline__ float gelu_exact(float v) { return 0.5f * v * (1.0f + erff(v * 0.70710678118654752f)); }
__device__ __forceinline__ float fast_exp2(float v) { return __builtin_amdgcn_exp2f(v); }
__device__ __forceinline__ int t5_bucket(int d) {
    if (d < 16) return d < 0 ? 0 : d;
    int b = 16;
    b += (d >= 22); b += (d >= 30); b += (d >= 40); b += (d >= 54); b += (d >= 73); b += (d >= 99); b += (d >= 134); b += (d >= 182);
    b += (d >= 246); b += (d >= 332); b += (d >= 450); b += (d >= 609); b += (d >= 825); b += (d >= 1117); b += (d >= 1513);
    return b;
}

__device__ __forceinline__ void phase_prep(const Params& p, int bid, int nb) {
    const long tid = (long)bid * NTHREADS + threadIdx.x;
    const long nth = (long)nb * NTHREADS;
    char* ws = p.ws;
    if (tid < 1024) ((unsigned*)(ws + OFF_CTRL))[tid] = 0u;
    {
        float* lut = (float*)(ws + OFF_LUT);
        for (long e = tid; e < 2 * LUTN * 4; e += nth) {
            int r = e & 3, d = (e >> 2) % LUTN, g = (int)(e / (4 * LUTN));
            lut[e] = p.t5_bias[t5_bucket(d) * 8 + g * 4 + r] * LOG2E;
        }
    }
    {
        float* cb = (float*)(ws + OFF_CB);
        for (long e = tid; e < 512; e += nth) {
            int kv = (int)(e >> 8), n = (int)(e & 255);
            const float* w1 = kv ? p.cmp_v_w1 : p.cmp_k_w1;
            float s = 0.f;
            for (int k = 0; k < 2048; ++k) s += p.cmp_pos[k] * w1[(long)k * 256 + n];
            cb[e] = s;
        }
    }
    {
        half_t* W = (half_t*)(ws + OFF_WIN);
        for (long e = tid; e < (long)NINP * 1024; e += nth) {
            int k = (int)(e / NINP), n = (int)(e % NINP);
            int src;
            if (n < 1280) src = n;
            else if (n < 1536) src = 1304 + (n - 1280);
            else if (n < 1664) src = 1560 + (n - 1536);
            else if (n < 1696) src = 1688 + (n - 1664);
            else if (n < 1720) src = 1280 + (n - 1696);
            else src = -1;
            float v = src >= 0 ? p.w_in[(long)k * NIN + src] : 0.f;
            W[(long)n * 1024 + k] = (half_t)v;
        }
    }
    {
        half_t* W = (half_t*)(ws + OFF_WQUP);
        for (long e = tid; e < 768 * 256; e += nth) {
            int k = (int)(e / 768), n = (int)(e % 768);
            W[(long)n * 256 + k] = (half_t)(p.w_q_up[e] * p.q_norm_g[k]);
        }
    }
    {
        half_t* W = (half_t*)(ws + OFF_WKVUP);
        for (long e = tid; e < 1024 * 128; e += nth) {
            int k = (int)(e / 1024), n = (int)(e % 1024);
            W[(long)n * 128 + k] = (half_t)(p.w_kv_up[e] * p.kv_norm_g[k]);
        }
    }
    {
        half_t* W = (half_t*)(ws + OFF_WC1);
        for (long e = tid; e < 2L * 2048 * 256; e += nth) {
            int kv = (int)(e / (2048 * 256)); long r = e % (2048 * 256);
            int k = (int)(r / 256), n = (int)(r % 256);
            const float* w1 = kv ? p.cmp_v_w1 : p.cmp_k_w1;
            W[((long)kv * 256 + n) * 2048 + k] = (half_t)w1[r];
        }
    }
    {
        half_t* W = (half_t*)(ws + OFF_WOUT);
        for (long e = tid; e < 1024L * 1024; e += nth) {
            int k = (int)(e >> 10), n = (int)(e & 1023);
            float g = k < 512 ? p.grp_norm_nsa[k] : p.grp_norm_mla[k - 512];
            W[(long)n * 1024 + k] = (half_t)(p.w_out[e] * g);
        }
    }
    {
        half_t* W = (half_t*)(ws + OFF_WPQ);
        for (long e = tid; e < 1024L * 2048; e += nth) {
            int k = (int)(e >> 11), n = (int)(e & 2047);
            W[(long)n * 1024 + k] = (half_t)(p.peer_wq[e] * p.norm2_g[k]);
        }
    }
    {
        half_t* W = (half_t*)(ws + OFF_KEYS);
        for (long e = tid; e < 2 * 16384; e += nth) {
            W[e] = (half_t)(e < 16384 ? p.peer_keys1[e] : p.peer_keys2[e - 16384]);
        }
    }
    {
        half_t* U = (half_t*)(ws + OFF_U16);
        half_t* V = (half_t*)(ws + OFF_V16);
        const long n4 = 16384L * 1024 / 4;
        for (long e = tid; e < n4; e += nth) {
            float4 a = ((const float4*)p.peer_u)[e];
            float4 b = ((const float4*)p.peer_v)[e];
            h4v ha = {(half_t)a.x, (half_t)a.y, (half_t)a.z, (half_t)a.w};
            h4v hb = {(half_t)b.x, (half_t)b.y, (half_t)b.z, (half_t)b.w};
            ((h4v*)U)[e] = ha; ((h4v*)V)[e] = hb;
        }
    }
    {
        half_t* H1 = (half_t*)(ws + OFF_H1);
        const int lane = threadIdx.x & 63;
        const long wv = tid >> 6, nwv = nth >> 6;
        for (long row = wv; row < NTOK; row += nwv) {
            const float4* xr = (const float4*)(p.x + row * 1024);
            float4 v[4]; float ss = 0.f;
#pragma unroll
            for (int i = 0; i < 4; ++i) { v[i] = xr[lane + 64 * i]; ss += v[i].x * v[i].x + v[i].y * v[i].y + v[i].z * v[i].z + v[i].w * v[i].w; }
            ss = wave_sum(ss);
            const float rs = rsqrtf(ss * (1.0f / 1024.f) + EPS);
#pragma unroll
            for (int i = 0; i < 4; ++i) {
                float4 g = ((const float4*)p.norm1_g)[lane + 64 * i];
                h4v o = {(half_t)(v[i].x * rs * g.x), (half_t)(v[i].y * rs * g.y), (half_t)(v[i].z * rs * g.z), (half_t)(v[i].w * rs * g.w)};
                ((h4v*)(H1 + row * 1024))[lane + 64 * i] = o;
            }
        }
    }
}

struct GemmSmem { half_t A[128][72]; half_t Bt[128][72]; float rs[2][128]; };

template <bool SCALE, class Epi>
__device__ __forceinline__ void gemm_tile(const half_t* __restrict__ A, long lda, const half_t* __restrict__ Bt, long ldb, int K, int ksplit, char* smem_raw, Epi epi) {
    GemmSmem& sm = *(GemmSmem*)smem_raw;
    const int tid = threadIdx.x, lane = tid & 63, w = tid >> 6, wm = w >> 1, wn = w & 1;
    const int i16 = lane & 15, g4 = lane >> 4;
    const int lr = tid >> 3, off = tid & 7;
    if (SCALE) {
        const int row = tid >> 1, part = tid & 1;
        for (int range = 0; range < 2; ++range) {
            const int kb = range ? ksplit : 0, ke = range ? K : ksplit;
            const int L = ke - kb;
            if (L <= 0) continue;
            const int hl = L >> 1;
            const half_t* ap = A + (long)row * lda + kb + part * hl;
            float ss = 0.f;
            for (int k = 0; k < hl; k += 8) {
                h8v v = *(const h8v*)(ap + k);
#pragma unroll
                for (int j = 0; j < 8; ++j) { float f = (float)v[j]; ss += f * f; }
            }
            ss += __shfl_xor(ss, 1);
            if (part == 0) sm.rs[range][row] = rsqrtf(ss / (float)L + EPS);
        }
        __syncthreads();
    }
    f4v acc[4][4];
#pragma unroll
    for (int a = 0; a < 4; ++a)
#pragma unroll
        for (int b = 0; b < 4; ++b) acc[a][b] = (f4v){0.f, 0.f, 0.f, 0.f};
    u4v ra[4], rb[4];
    const int nk = K >> 6;
#pragma unroll
    for (int i = 0; i < 4; ++i) {
        ra[i] = *(const u4v*)(A + (long)(lr + 32 * i) * lda + off * 8);
        rb[i] = *(const u4v*)(Bt + (long)(lr + 32 * i) * ldb + off * 8);
    }
    for (int kt = 0; kt < nk; ++kt) {
#pragma unroll
        for (int i = 0; i < 4; ++i) {
            u4v va = ra[i];
            if (SCALE) {
                const float rs = sm.rs[(kt * 64 >= ksplit) ? 1 : 0][lr + 32 * i];
                h8v hv = __builtin_bit_cast(h8v, va);
#pragma unroll
                for (int j = 0; j < 8; ++j) hv[j] = (half_t)((float)hv[j] * rs);
                va = __builtin_bit_cast(u4v, hv);
            }
            *(u4v*)&sm.A[lr + 32 * i][off * 8] = va;
            *(u4v*)&sm.Bt[lr + 32 * i][off * 8] = rb[i];
        }
        __syncthreads();
        if (kt + 1 < nk) {
            const int k0 = (kt + 1) * 64;
#pragma unroll
            for (int i = 0; i < 4; ++i) {
                ra[i] = *(const u4v*)(A + (long)(lr + 32 * i) * lda + k0 + off * 8);
                rb[i] = *(const u4v*)(Bt + (long)(lr + 32 * i) * ldb + k0 + off * 8);
            }
        }
#pragma unroll
        for (int kk = 0; kk < 2; ++kk) {
            h8v af[4], bf[4];
#pragma unroll
            for (int mi = 0; mi < 4; ++mi) af[mi] = *(const h8v*)&sm.A[wm * 64 + mi * 16 + i16][kk * 32 + g4 * 8];
#pragma unroll
            for (int ni = 0; ni < 4; ++ni) bf[ni] = *(const h8v*)&sm.Bt[wn * 64 + ni * 16 + i16][kk * 32 + g4 * 8];
#pragma unroll
            for (int mi = 0; mi < 4; ++mi)
#pragma unroll
                for (int ni = 0; ni < 4; ++ni) acc[mi][ni] = mfma16(af[mi], bf[ni], acc[mi][ni]);
        }
        __syncthreads();
    }
    epi(acc, wm, wn, i16, g4);
}

__device__ __forceinline__ void rope_pair(float x1, float x2, int pos, int i, float& o1, float& o2) {
    const float inv = __builtin_amdgcn_exp2f(-(float)i * (13.287712379549449f / 16.0f));
    double t = (double)pos * (double)inv * 0.15915494309189535;
    t -= __builtin_rint(t);
    const float fr = (float)t;
    const float sn = __builtin_amdgcn_sinf(fr), cs = __builtin_amdgcn_cosf(fr);
    o1 = x1 * cs - x2 * sn; o2 = x1 * sn + x2 * cs;
}

__device__ __forceinline__ void phase_inproj(const Params& p, int bid, int nb, char* smem) {
    char* ws = p.ws;
    const half_t* H1 = (const half_t*)(ws + OFF_H1);
    const half_t* W = (const half_t*)(ws + OFF_WIN);
    half_t* QH = (half_t*)(ws + OFF_QH);
    half_t* KM = (half_t*)(ws + OFF_KM);
    half_t* CQ = (half_t*)(ws + OFF_CQ);
    half_t* CKV = (half_t*)(ws + OFF_CKV);
    float* GATES = (float*)(ws + OFF_GATES);
    const int NT_N = NINP / 128, NT_M = NTOK / 128;
    for (int tile = bid; tile < NT_M * NT_N; tile += nb) {
        const int tm = tile / NT_N, tn = tile % NT_N;
        const int row0 = tm * 128, n0 = tn * 128;
        gemm_tile<false>(H1 + (long)row0 * 1024, 1024, W + (long)n0 * 1024, 1024, 1024, 1024, smem,
            [&](f4v (&acc)[4][4], int wm, int wn, int i16, int g4) __attribute__((always_inline)) {
#pragma unroll
                for (int ni = 0; ni < 4; ++ni) {
                    const int cb = n0 + wn * 64 + ni * 16;
                    const int col = cb + i16;
#pragma unroll
                    for (int mi = 0; mi < 4; ++mi) {
                        const int rbase = row0 + wm * 64 + mi * 16 + g4 * 4;
                        const int b = rbase >> 14, s0 = rbase & (SEQ - 1);
                        if (cb < 512) {
#pragma unroll
                            for (int r = 0; r < 4; ++r) QH[(long)(rbase + r) * 512 + col] = (half_t)(acc[mi][ni][r] * QS_NSA);
                        } else if (cb < 1280) {
                            const int which = (cb - 512) >> 7;
                            const int c = (col - 512) & 127, gg = c >> 6, d = c & 63;
                            half_t* base = (half_t*)(ws + OFF_KC + (size_t)which * SZ_KV);
                            if (which == 3 || which == 5) {
                                h4v o = {(half_t)acc[mi][ni][0], (half_t)acc[mi][ni][1], (half_t)acc[mi][ni][2], (half_t)acc[mi][ni][3]};
                                *(h4v*)(base + ((long)((b * 2 + gg) * 64 + d)) * SEQ + s0) = o;
                            } else {
#pragma unroll
                                for (int r = 0; r < 4; ++r) base[((long)(b * 2 + gg) * SEQ + s0 + r) * 64 + d] = (half_t)acc[mi][ni][r];
                            }
                        } else if (cb < 1536) {
#pragma unroll
                            for (int r = 0; r < 4; ++r) CQ[(long)(rbase + r) * 256 + (col - 1280)] = (half_t)acc[mi][ni][r];
                        } else if (cb < 1664) {
#pragma unroll
                            for (int r = 0; r < 4; ++r) CKV[(long)(rbase + r) * 128 + (col - 1536)] = (half_t)acc[mi][ni][r];
                        } else if (cb == 1664) {
#pragma unroll
                            for (int r = 0; r < 4; ++r) {
                                float o1, o2;
                                rope_pair(acc[mi][ni][r], acc[mi][(ni + 1) & 3][r], p.pos[rbase + r], i16, o1, o2);
#pragma unroll
                                for (int h = 0; h < 8; ++h) {
                                    half_t* kr = KM + ((long)(b * 8 + h) * SEQ + s0 + r) * 96 + 64;
                                    kr[i16] = (half_t)o1; kr[16 + i16] = (half_t)o2;
                                }
                            }
                        } else if (cb >= 1696) {
                            if (col < 1720) {
#pragma unroll
                                for (int r = 0; r < 4; ++r) GATES[(long)(rbase + r) * 24 + (col - 1696)] = 1.0f / (1.0f + __expf(-acc[mi][ni][r]));
                            }
                        }
                    }
                }
            });
    }
}

__device__ __forceinline__ void phase_p2(const Params& p, int bid, int nb, char* smem) {
    char* ws = p.ws;
    const int NTA = 256 * 6, NTB = 256 * 8, NTC = 128;
    for (int tile = bid; tile < NTA + NTB + NTC; tile += nb) {
        if (tile < NTC) {
            const int nt = tile & 1, mt = (tile >> 1) & 7, bg = (tile >> 4) & 3, kv = tile >> 6;
            const half_t* A = (const half_t*)(ws + (kv ? OFF_VC : OFF_KC)) + (long)bg * SEQ * 64 + (long)mt * 128 * 1024;
            const half_t* Bt = (const half_t*)(ws + OFF_WC1) + ((long)kv * 256 + nt * 128) * 2048;
            const float* cbv = (const float*)(ws + OFF_CB) + kv * 256;
            half_t* HC = (half_t*)(ws + OFF_HC1) + ((long)(kv * 4 + bg) * 1024) * 256;
            gemm_tile<false>(A, 1024, Bt, 2048, 2048, 2048, smem,
                [&](f4v (&acc)[4][4], int wm, int wn, int i16, int g4) __attribute__((always_inline)) {
#pragma unroll
                    for (int ni = 0; ni < 4; ++ni) {
                        const int n = nt * 128 + wn * 64 + ni * 16 + i16;
                        const float bias = cbv[n];
#pragma unroll
                        for (int mi = 0; mi < 4; ++mi)
#pragma unroll
                            for (int r = 0; r < 4; ++r) {
                                const int m = mt * 128 + wm * 64 + mi * 16 + g4 * 4 + r;
                                if (m < NCMP) HC[(long)m * 256 + n] = (half_t)gelu_exact(acc[mi][ni][r] + bias);
                            }
                    }
                });
        } else if (tile < NTC + NTA) {
            const int t2 = tile - NTC;
            const int tm = t2 / 6, tn = t2 % 6;
            const int row0 = tm * 128, n0 = tn * 128;
            half_t* QM = (half_t*)(ws + OFF_QM);
            gemm_tile<true>((const half_t*)(ws + OFF_CQ) + (long)row0 * 256, 256, (const half_t*)(ws + OFF_WQUP) + (long)n0 * 256, 256, 256, 256, smem,
                [&](f4v (&acc)[4][4], int wm, int wn, int i16, int g4) __attribute__((always_inline)) {
#pragma unroll
                    for (int ni = 0; ni < 4; ++ni) {
                        const int cb = n0 + wn * 64 + ni * 16;
                        const int h = cb / 96, d0 = cb - h * 96;
#pragma unroll
                        for (int mi = 0; mi < 4; ++mi) {
                            const int rbase = row0 + wm * 64 + mi * 16 + g4 * 4;
                            const int b = rbase >> 14, s0 = rbase & (SEQ - 1);
#pragma unroll
                            for (int r = 0; r < 4; ++r) {
                                half_t* qr = QM + ((long)(b * 8 + h) * SEQ + s0 + r) * 96;
                                if (d0 < 64) qr[d0 + i16] = (half_t)(acc[mi][ni][r] * QS_MLA);
                                else if (d0 == 64) {
                                    float o1, o2;
                                    rope_pair(acc[mi][ni][r] * QS_MLA, acc[mi][(ni + 1) & 3][r] * QS_MLA, p.pos[rbase + r], i16, o1, o2);
                                    qr[64 + i16] = (half_t)o1; qr[80 + i16] = (half_t)o2;
                                }
                            }
                        }
                    }
                });
        } else {
            const int t2 = tile - NTC - NTA;
            const int tm = t2 >> 3, tn = t2 & 7;
            const int row0 = tm * 128, n0 = tn * 128;
            half_t* KM = (half_t*)(ws + OFF_KM);
            half_t* VT = (half_t*)(ws + OFF_VT);
            gemm_tile<true>((const half_t*)(ws + OFF_CKV) + (long)row0 * 128, 128, (const half_t*)(ws + OFF_WKVUP) + (long)n0 * 128, 128, 128, 128, smem,
                [&](f4v (&acc)[4][4], int wm, int wn, int i16, int g4) __attribute__((always_inline)) {
                    const int h = tn;
#pragma unroll
                    for (int ni = 0; ni < 4; ++ni) {
                        const int d0 = wn * 64 + ni * 16;
#pragma unroll
                        for (int mi = 0; mi < 4; ++mi) {
                            const int rbase = row0 + wm * 64 + mi * 16 + g4 * 4;
                            const int b = rbase >> 14, s0 = rbase & (SEQ - 1);
                            if (d0 < 64) {
#pragma unroll
                                for (int r = 0; r < 4; ++r) KM[((long)(b * 8 + h) * SEQ + s0 + r) * 96 + d0 + i16] = (half_t)acc[mi][ni][r];
                            } else {
                                h4v o = {(half_t)acc[mi][ni][0], (half_t)acc[mi][ni][1], (half_t)acc[mi][ni][2], (half_t)acc[mi][ni][3]};
                                *(h4v*)(VT + ((long)(b * 8 + h) * 64 + (d0 - 64 + i16)) * SEQ + s0) = o;
                            }
                        }
                    }
                });
        }
    }
}

__device__ __forceinline__ void phase_cmp2(const Params& p, int bid, int nb) {
    char* ws = p.ws;
    const long tid = (long)bid * NTHREADS + threadIdx.x, nth = (long)nb * NTHREADS;
    const half_t* HC = (const half_t*)(ws + OFF_HC1);
    half_t* KC = (half_t*)(ws + OFF_KCMP);
    half_t* VCT = (half_t*)(ws + OFF_VCMPT);
    for (long e = tid; e < 2L * 4 * 1024 * 64; e += nth) {
        const int d = (int)(e & 63), n = (int)((e >> 6) & 1023), bg = (int)((e >> 16) & 3), kv = (int)(e >> 18);
        float s = 0.f;
        if (n < NCMP) {
            const half_t* hr = HC + ((long)(kv * 4 + bg) * 1024 + n) * 256;
            const float* w2 = kv ? p.cmp_v_w2 : p.cmp_k_w2;
            for (int j = 0; j < 256; ++j) s += (float)hr[j] * w2[j * 64 + d];
        }
        if (kv == 0) KC[((long)bg * 1024 + n) * 64 + d] = (half_t)s;
        else VCT[((long)bg * 64 + d) * 1024 + n] = (half_t)s;
    }
}

struct MlaSmem { half_t K[2][64][104]; half_t V[2][64][68]; };

__device__ __forceinline__ void mla_item(const Params& p, int item, char* smem) {
    MlaSmem& sm = *(MlaSmem*)smem;
    char* ws = p.ws;
    const int qb = 127 - (item >> 4), bh = item & 15;
    const int b = bh >> 3, h = bh & 7;
    const half_t* Qp = (const half_t*)(ws + OFF_QM) + ((long)bh * SEQ + qb * 128) * 96;
    const half_t* Kp = (const half_t*)(ws + OFF_KM) + (long)bh * SEQ * 96;
    const half_t* Vp = (const half_t*)(ws + OFF_VT) + (long)bh * 64 * SEQ;
    half_t* MIX = (half_t*)(ws + OFF_MIXED);
    int tid_ = threadIdx.x; asm volatile("" : "+v"(tid_));
    const int tid = tid_, lane = tid & 63, w = tid >> 6;
    const int c = lane & 31, hh = lane >> 5;
    const int tq = qb * 128 + w * 32 + c;
    h8v qf[6];
#pragma unroll
    for (int s6 = 0; s6 < 6; ++s6) qf[s6] = *(const h8v*)(Qp + (long)(w * 32 + c) * 96 + s6 * 16 + hh * 8);
    f16v o0, o1;
#pragma unroll
    for (int i = 0; i < 16; ++i) { o0[i] = 0.f; o1[i] = 0.f; }
    float m = NEGF, l = 0.f;
    const int ntiles = 2 * qb + 2;
    u4v rk[3]; u2v rv[4];
    auto gload = [&](int j) {
#pragma unroll
        for (int i = 0; i < 3; ++i) {
            const int ci = tid + 256 * i, key = ci / 12, of = ci % 12;
            rk[i] = *(const u4v*)(Kp + (long)(j * 64 + key) * 96 + of * 8);
        }
#pragma unroll
        for (int i = 0; i < 2; ++i) {
            const int ci = tid + 256 * i, dim = ci >> 3, of = ci & 7;
            const u4v v = *(const u4v*)(Vp + (long)dim * SEQ + j * 64 + of * 8);
            rv[2 * i] = (u2v){v.x, v.y}; rv[2 * i + 1] = (u2v){v.z, v.w};
        }
    };
    auto lstore = [&](int buf) {
#pragma unroll
        for (int i = 0; i < 3; ++i) {
            const int ci = tid + 256 * i, key = ci / 12, of = ci % 12;
            *(u4v*)&sm.K[buf][key][of * 8] = rk[i];
        }
#pragma unroll
        for (int i = 0; i < 2; ++i) {
            const int ci = tid + 256 * i, dim = ci >> 3, of = ci & 7;
            *(u2v*)&sm.V[buf][dim][of * 8] = rv[2 * i];
            *(u2v*)&sm.V[buf][dim][of * 8 + 4] = rv[2 * i + 1];
        }
    };
    gload(0);
    lstore(0);
    __syncthreads();
#pragma unroll 1
    for (int j = 0; j < ntiles; ++j) {
        const int buf = j & 1;
        if (j + 1 < ntiles) gload(j + 1);
        const int qmin = qb * 128 + w * 32;
        if (64 * j <= qmin + 31) {
            f16v s0, s1;
#pragma unroll
            for (int i = 0; i < 16; ++i) { s0[i] = 0.f; s1[i] = 0.f; }
#pragma unroll
            for (int s6 = 0; s6 < 6; ++s6) {
                const h8v a0 = *(const h8v*)&sm.K[buf][c][s6 * 16 + hh * 8];
                const h8v a1 = *(const h8v*)&sm.K[buf][32 + c][s6 * 16 + hh * 8];
                s0 = mfma32(a0, qf[s6], s0);
                s1 = mfma32(a1, qf[s6], s1);
            }
            if (64 * j + 63 > qmin) {
#pragma unroll
                for (int r = 0; r < 16; ++r) {
                    const int key = 64 * j + (r & 3) + 8 * (r >> 2) + 4 * hh;
                    if (key > tq) s0[r] = NEGF;
                    if (key + 32 > tq) s1[r] = NEGF;
                }
            }
            float mx = s0[0];
#pragma unroll
            for (int r = 1; r < 16; ++r) mx = fmaxf(mx, s0[r]);
#pragma unroll
            for (int r = 0; r < 16; ++r) mx = fmaxf(mx, s1[r]);
            mx = fmaxf(mx, __shfl_xor(mx, 32));
            const float mn = fmaxf(m, mx);
            const float alpha = fast_exp2(m - mn);
            m = mn;
            float ps = 0.f;
#pragma unroll
            for (int r = 0; r < 16; ++r) { s0[r] = fast_exp2(s0[r] - mn); ps += s0[r]; }
#pragma unroll
            for (int r = 0; r < 16; ++r) { s1[r] = fast_exp2(s1[r] - mn); ps += s1[r]; }
            l = l * alpha + ps;
#pragma unroll
            for (int i = 0; i < 16; ++i) { o0[i] *= alpha; o1[i] *= alpha; }
#pragma unroll
            for (int ks = 0; ks < 4; ++ks) {
                h8v pb;
#pragma unroll
                for (int jj = 0; jj < 8; ++jj) pb[jj] = (half_t)((ks < 2) ? s0[8 * (ks & 1) + jj] : s1[8 * (ks & 1) + jj]);
#pragma unroll
                for (int md = 0; md < 2; ++md) {
                    const h4v lo = *(const h4v*)&sm.V[buf][32 * md + c][16 * ks + 4 * hh];
                    const h4v hi = *(const h4v*)&sm.V[buf][32 * md + c][16 * ks + 8 + 4 * hh];
                    const h8v a = {lo[0], lo[1], lo[2], lo[3], hi[0], hi[1], hi[2], hi[3]};
                    if (md == 0) o0 = mfma32(a, pb, o0); else o1 = mfma32(a, pb, o1);
                }
            }
        }
        if (j + 1 < ntiles) lstore(buf ^ 1);
        __syncthreads();
    }
    const float lt = l + __shfl_xor(l, 32);
    const float inv = 1.0f / lt;
    half_t* orow = MIX + (long)(b * SEQ + tq) * 1024 + 512 + h * 64;
#pragma unroll
    for (int md = 0; md < 2; ++md)
#pragma unroll
        for (int rg = 0; rg < 4; ++rg) {
            h4v o;
#pragma unroll
            for (int e = 0; e < 4; ++e) o[e] = (half_t)(((md == 0) ? o0[4 * rg + e] : o1[4 * rg + e]) * inv);
            *(h4v*)(orow + 32 * md + 8 * rg + 4 * hh) = o;
        }
}

struct NsaSmem { float lut[LUTN * 4]; float imp[4][8][256]; int sel[4][8][16]; };

__device__ __forceinline__ f16v nsa_qk(const half_t* krow, const h8v (&qf)[4]) {
    f16v s;
#pragma unroll
    for (int i = 0; i < 16; ++i) s[i] = 0.f;
#pragma unroll
    for (int s4 = 0; s4 < 4; ++s4) {
        const h8v a = *(const h8v*)(krow + s4 * 16);
        s = mfma32(a, qf[s4], s);
    }
    return s;
}
__device__ __forceinline__ void nsa_pv(const half_t* vt, long ldv, const f16v& pr, f16v& o0, f16v& o1) {
#pragma unroll
    for (int ks = 0; ks < 2; ++ks) {
        h8v pb;
#pragma unroll
        for (int jj = 0; jj < 8; ++jj) pb[jj] = (half_t)pr[8 * ks + jj];
#pragma unroll
        for (int md = 0; md < 2; ++md) {
            const half_t* vp = vt + (long)(32 * md) * ldv + 16 * ks;
            const h4v lo = *(const h4v*)(vp);
            const h4v hi = *(const h4v*)(vp + 8);
            const h8v a = {lo[0], lo[1], lo[2], lo[3], hi[0], hi[1], hi[2], hi[3]};
            if (md == 0) o0 = mfma32(a, pb, o0); else o1 = mfma32(a, pb, o1);
        }
    }
}

__device__ __forceinline__ void nsa_item(const Params& p, int item, char* smem) {
    NsaSmem& sm = *(NsaSmem*)smem;
    char* ws = p.ws;
    const int bg = item & 3, qt = item >> 2;
    const int b = bg >> 1, g = bg & 1;
    int tid_ = threadIdx.x; asm volatile("" : "+v"(tid_));
    const int tid = tid_, lane = tid & 63, w = tid >> 6;
    const int c = lane & 31, hh = lane >> 5;
    const int qi = c >> 2, r = c & 3;
    const int t0w = qt * 32 + w * 8;
    const int tq = t0w + qi;
    const int tlast = t0w + 7;
    {
        const float* lg = (const float*)(ws + OFF_LUT) + (long)g * LUTN * 4;
        for (int i = tid; i < LUTN * 4; i += NTHREADS) sm.lut[i] = lg[i];
        float* im = &sm.imp[0][0][0];
        for (int i = tid; i < 4 * 8 * 256; i += NTHREADS) im[i] = 0.f;
    }
    __syncthreads();
    const half_t* QH = (const half_t*)(ws + OFF_QH);
    h8v qf[4];
#pragma unroll
    for (int s4 = 0; s4 < 4; ++s4) qf[s4] = *(const h8v*)(QH + (long)(b * SEQ + tq) * 512 + (g * 4 + r) * 64 + s4 * 16 + hh * 8);
    const float* gp = (const float*)(ws + OFF_GATES) + (long)(b * SEQ + tq) * 24 + (g * 4 + r) * 3;
    const float g0 = gp[0], g1 = gp[1], g2 = gp[2];
    f16v of0, of1;
#pragma unroll
    for (int i = 0; i < 16; ++i) { of0[i] = 0.f; of1[i] = 0.f; }

    {
        const half_t* KC = (const half_t*)(ws + OFF_KCMP) + (long)bg * 1024 * 64;
        const half_t* VCT = (const half_t*)(ws + OFF_VCMPT) + (long)bg * 64 * 1024;
        const int kmax = (tlast >= 31) ? ((tlast - 31) >> 4) : -1;
        const int ntile = (kmax + 32) >> 5;
        float m = NEGF, l = 0.f;
#pragma unroll 1
        for (int kt = 0; kt < ntile; ++kt) {
            f16v s = nsa_qk(KC + (long)(kt * 32 + c) * 64 + hh * 8, qf);
            float mx = NEGF;
#pragma unroll
            for (int rr = 0; rr < 16; ++rr) {
                const int k = kt * 32 + (rr & 3) + 8 * (rr >> 2) + 4 * hh;
                const int dist = tq - (16 * k + 31);
                const bool valid = dist >= 0;
                const int di = dist < 0 ? 0 : (dist > LUTN - 1 ? LUTN - 1 : dist);
                const float v = valid ? s[rr] + sm.lut[di * 4 + r] : NEGF;
                s[rr] = v; mx = fmaxf(mx, v);
            }
            const float mn = fmaxf(m, mx);
            float ps = 0.f;
#pragma unroll
            for (int rr = 0; rr < 16; ++rr) ps += (s[rr] > -1e29f) ? fast_exp2(s[rr] - mn) : 0.f;
            l = l * fast_exp2(m - mn) + ps;
            m = mn;
        }
        {
            const float mo = __shfl_xor(m, 32), lo = __shfl_xor(l, 32);
            const float mt = fmaxf(m, mo);
            l = l * fast_exp2(m - mt) + lo * fast_exp2(mo - mt);
            m = mt;
        }
        const float invl = (l > 0.f) ? 1.0f / l : 0.f;
        f16v oc0, oc1;
#pragma unroll
        for (int i = 0; i < 16; ++i) { oc0[i] = 0.f; oc1[i] = 0.f; }
        float carryL = 0.f;
#pragma unroll 1
        for (int kt = 0; kt < ntile; ++kt) {
            f16v s = nsa_qk(KC + (long)(kt * 32 + c) * 64 + hh * 8, qf);
#pragma unroll
            for (int rr = 0; rr < 16; ++rr) {
                const int k = kt * 32 + (rr & 3) + 8 * (rr >> 2) + 4 * hh;
                const int dist = tq - (16 * k + 31);
                const bool valid = dist >= 0;
                const int di = dist < 0 ? 0 : (dist > LUTN - 1 ? LUTN - 1 : dist);
                s[rr] = valid ? fast_exp2(s[rr] + sm.lut[di * 4 + r] - m) * invl : 0.f;
            }
            float Gs[4], Ls[4];
#pragma unroll
            for (int jg = 0; jg < 4; ++jg) {
                float G = s[4 * jg] + s[4 * jg + 1] + s[4 * jg + 2] + s[4 * jg + 3];
                float L = s[4 * jg + 3];
                G += __shfl_xor(G, 1); G += __shfl_xor(G, 2);
                L += __shfl_xor(L, 1); L += __shfl_xor(L, 2);
                Gs[jg] = G; Ls[jg] = L;
            }
            float Lo[4];
#pragma unroll
            for (int jg = 0; jg < 4; ++jg) Lo[jg] = __shfl_xor(Ls[jg], 32);
            if (r == 0) {
#pragma unroll
                for (int jg = 0; jg < 4; ++jg) {
                    const float prevL = hh ? Lo[jg] : (jg == 0 ? carryL : Lo[jg - 1]);
                    sm.imp[w][qi][8 * kt + 2 * jg + hh] = Gs[jg] + prevL;
                }
            }
            carryL = Lo[3];
            nsa_pv(VCT + (long)c * 1024 + kt * 32 + 4 * hh, 1024, s, oc0, oc1);
        }
#pragma unroll
        for (int i = 0; i < 16; ++i) { of0[i] += g0 * oc0[i]; of1[i] += g0 * oc1[i]; }
    }
    __syncthreads();
    {
        const int q2 = lane >> 3, sub = lane & 7;
        const int tq2 = t0w + q2;
        const int cur = tq2 >> 6;
        unsigned key[32];
#pragma unroll
        for (int i = 0; i < 32; ++i) {
            const int sb = sub + 8 * i;
            const float v = sm.imp[w][q2][sb];
            unsigned u = (__float_as_uint(v) & 0x7FFFFF00u) | (unsigned)(255 - sb);
            if (sb == 0 || sb == cur || sb == cur - 1) u |= 0x80000000u;
            if (sb > cur) u = 0u;
            key[i] = u;
        }
#pragma unroll 1
        for (int round = 0; round < 16; ++round) {
            unsigned best = key[0];
#pragma unroll
            for (int i = 1; i < 32; ++i) best = best > key[i] ? best : key[i];
#pragma unroll
            for (int o = 1; o <= 4; o <<= 1) { const unsigned ob = (unsigned)__shfl_xor((int)best, o); best = best > ob ? best : ob; }
            if (sub == 0) sm.sel[w][q2][round] = best ? (int)(255u - (best & 0xFFu)) : -1;
#pragma unroll
            for (int i = 0; i < 32; ++i) key[i] = (key[i] == best) ? 0u : key[i];
        }
    }
    __syncthreads();
    {
        const half_t* KS = (const half_t*)(ws + OFF_KS) + (long)bg * SEQ * 64;
        const half_t* VST = (const half_t*)(ws + OFF_VST) + (long)bg * 64 * SEQ;
        f16v os0, os1;
#pragma unroll
        for (int i = 0; i < 16; ++i) { os0[i] = 0.f; os1[i] = 0.f; }
        float m = NEGF, l = 0.f;
#pragma unroll 1
        for (int q2 = 0; q2 < 8; ++q2) {
            const bool own = (qi == q2);
            const int tq2 = t0w + q2;
#pragma unroll 1
            for (int bi = 0; bi < 16; ++bi) {
                const int blk = __builtin_amdgcn_readfirstlane(sm.sel[w][q2][bi]);
                if (blk < 0) continue;
#pragma unroll 1
                for (int t2 = 0; t2 < 2; ++t2) {
                    const int key0 = blk * 64 + t2 * 32;
                    if (key0 > tq2) continue;
                    f16v s = nsa_qk(KS + (long)(key0 + c) * 64 + hh * 8, qf);
                    float mx = NEGF;
#pragma unroll
                    for (int rr = 0; rr < 16; ++rr) {
                        const int pos = key0 + (rr & 3) + 8 * (rr >> 2) + 4 * hh;
                        const int dist = tq - pos;
                        const bool valid = own && dist >= 0;
                        const int di = dist < 0 ? 0 : (dist > LUTN - 1 ? LUTN - 1 : dist);
                        const float v = valid ? s[rr] + sm.lut[di * 4 + r] : NEGF;
                        s[rr] = v; mx = fmaxf(mx, v);
                    }
                    mx = fmaxf(mx, __shfl_xor(mx, 32));
                    const float mn = fmaxf(m, mx);
                    const float alpha = fast_exp2(m - mn);
                    m = mn;
                    float ps = 0.f;
#pragma unroll
                    for (int rr = 0; rr < 16; ++rr) { const float pv = (s[rr] > -1e29f) ? fast_exp2(s[rr] - mn) : 0.f; s[rr] = pv; ps += pv; }
                    l = l * alpha + ps;
#pragma unroll
                    for (int i = 0; i < 16; ++i) { os0[i] *= alpha; os1[i] *= alpha; }
                    nsa_pv(VST + (long)c * SEQ + key0 + 4 * hh, SEQ, s, os0, os1);
                }
            }
        }
        const float lt = l + __shfl_xor(l, 32);
        const float sc = (lt > 0.f) ? g1 / lt : 0.f;
#pragma unroll
        for (int i = 0; i < 16; ++i) { of0[i] += sc * os0[i]; of1[i] += sc * os1[i]; }
    }
    {
        const half_t* KW = (const half_t*)(ws + OFF_KW) + (long)bg * SEQ * 64;
        const half_t* VWT = (const half_t*)(ws + OFF_VWT) + (long)bg * 64 * SEQ;
        f16v ow0, ow1;
#pragma unroll
        for (int i = 0; i < 16; ++i) { ow0[i] = 0.f; ow1[i] = 0.f; }
        float m = NEGF, l = 0.f;
        int kstart = t0w - 511; if (kstart < 0) kstart = 0; kstart &= ~31;
#pragma unroll 1
        for (int key0 = kstart; key0 <= tlast; key0 += 32) {
            f16v s = nsa_qk(KW + (long)(key0 + c) * 64 + hh * 8, qf);
            float mx = NEGF;
#pragma unroll
            for (int rr = 0; rr < 16; ++rr) {
                const int pos = key0 + (rr & 3) + 8 * (rr >> 2) + 4 * hh;
                const int dist = tq - pos;
                const bool valid = dist >= 0 && dist < 512;
                const int di = dist < 0 ? 0 : (dist > LUTN - 1 ? LUTN - 1 : dist);
                const float v = valid ? s[rr] + sm.lut[di * 4 + r] : NEGF;
                s[rr] = v; mx = fmaxf(mx, v);
            }
            mx = fmaxf(mx, __shfl_xor(mx, 32));
            const float mn = fmaxf(m, mx);
            const float alpha = fast_exp2(m - mn);
            m = mn;
            float ps = 0.f;
#pragma unroll
            for (int rr = 0; rr < 16; ++rr) { const float pv = (s[rr] > -1e29f) ? fast_exp2(s[rr] - mn) : 0.f; s[rr] = pv; ps += pv; }
            l = l * alpha + ps;
#pragma unroll
            for (int i = 0; i < 16; ++i) { ow0[i] *= alpha; ow1[i] *= alpha; }
            nsa_pv(VWT + (long)c * SEQ + key0 + 4 * hh, SEQ, s, ow0, ow1);
        }
        const float lt = l + __shfl_xor(l, 32);
        const float sc = (lt > 0.f) ? g2 / lt : 0.f;
#pragma unroll
        for (int i = 0; i < 16; ++i) { of0[i] += sc * ow0[i]; of1[i] += sc * ow1[i]; }
    }
    {
        half_t* orow = (half_t*)(ws + OFF_MIXED) + (long)(b * SEQ + tq) * 1024 + (g * 4 + r) * 64;
#pragma unroll
        for (int md = 0; md < 2; ++md)
#pragma unroll
            for (int rg = 0; rg < 4; ++rg) {
                h4v o;
#pragma unroll
                for (int e = 0; e < 4; ++e) o[e] = (half_t)((md == 0) ? of0[4 * rg + e] : of1[4 * rg + e]);
                *(h4v*)(orow + 32 * md + 8 * rg + 4 * hh) = o;
            }
    }
    __syncthreads();
}

__device__ __forceinline__ void phase_attn(const Params& p, char* smem) {
    unsigned* ctr = (unsigned*)(p.ws + OFF_CTRL);
    volatile int* s_item = (volatile int*)(smem + 65024);
    const int NMLA = 2048, NNSA = 2048;
    for (;;) {
        if (threadIdx.x == 0) *s_item = (int)atomicAdd(&ctr[0], 1u);
        __syncthreads();
        const int item = *s_item;
        __syncthreads();
        if (item >= NMLA + NNSA) break;
        if (item < NMLA) mla_item(p, item, smem);
        else nsa_item(p, item - NMLA, smem);
    }
}

__device__ __forceinline__ void phase_outproj(const Params& p, int bid, int nb, char* smem) {
    char* ws = p.ws;
    const half_t* MIX = (const half_t*)(ws + OFF_MIXED);
    const half_t* W = (const half_t*)(ws + OFF_WOUT);
    half_t* X2H = (half_t*)(ws + OFF_X2H);
    for (int tile = bid; tile < 256 * 8; tile += nb) {
        const int tm = tile >> 3, tn = tile & 7;
        const int row0 = tm * 128, n0 = tn * 128;
        gemm_tile<true>(MIX + (long)row0 * 1024, 1024, W + (long)n0 * 1024, 1024, 1024, 512, smem,
            [&](f4v (&acc)[4][4], int wm, int wn, int i16, int g4) __attribute__((always_inline)) {
#pragma unroll
                for (int mi = 0; mi < 4; ++mi)
#pragma unroll
                    for (int ni = 0; ni < 4; ++ni)
#pragma unroll
                        for (int r = 0; r < 4; ++r) {
                            const long row = row0 + wm * 64 + mi * 16 + g4 * 4 + r;
                            const int col = n0 + wn * 64 + ni * 16 + i16;
                            const float v = p.x[row * 1024 + col] + acc[mi][ni][r];
                            p.out[row * 1024 + col] = v;
                            X2H[row * 1024 + col] = (half_t)v;
                        }
            });
    }
}

__device__ __forceinline__ void phase_peerq(const Params& p, int bid, int nb, char* smem) {
    char* ws = p.ws;
    const half_t* X2H = (const half_t*)(ws + OFF_X2H);
    const half_t* W = (const half_t*)(ws + OFF_WPQ);
    half_t* QP = (half_t*)(ws + OFF_QP);
    for (int tile = bid; tile < 256 * 16; tile += nb) {
        const int tm = tile >> 4, tn = tile & 15;
        const int row0 = tm * 128, n0 = tn * 128;
        gemm_tile<true>(X2H + (long)row0 * 1024, 1024, W + (long)n0 * 1024, 1024, 1024, 1024, smem,
            [&](f4v (&acc)[4][4], int wm, int wn, int i16, int g4) __attribute__((always_inline)) {
#pragma unroll
                for (int mi = 0; mi < 4; ++mi)
#pragma unroll
                    for (int ni = 0; ni < 4; ++ni)
#pragma unroll
                        for (int r = 0; r < 4; ++r) {
                            const long row = row0 + wm * 64 + mi * 16 + g4 * 4 + r;
                            const int col = n0 + wn * 64 + ni * 16 + i16;
                            QP[row * 2048 + col] = (half_t)acc[mi][ni][r];
                        }
            });
    }
}

__device__ __forceinline__ void topk_insert(float (&tv)[16], int (&ti)[16], float v, int id) {
#pragma unroll
    for (int k = 0; k < 16; ++k) {
        const bool gt = v > tv[k];
        const float nv = gt ? tv[k] : v; const int ni = gt ? ti[k] : id;
        tv[k] = gt ? v : tv[k]; ti[k] = gt ? id : ti[k];
        v = nv; id = ni;
    }
}
__device__ __forceinline__ void route_half(const half_t* __restrict__ qsrc_h, const half_t* kb, float (&tv)[16], int (&ti)[16]) {
    h2v q[64];
    const h8v* qsrc = (const h8v*)qsrc_h;
#pragma unroll
    for (int i = 0; i < 16; ++i) {
        const h8v v = qsrc[i];
        q[4 * i] = (h2v){v[0], v[1]}; q[4 * i + 1] = (h2v){v[2], v[3]};
        q[4 * i + 2] = (h2v){v[4], v[5]}; q[4 * i + 3] = (h2v){v[6], v[7]};
    }
#pragma unroll
    for (int k = 0; k < 16; ++k) { tv[k] = -3.0e38f; ti[k] = 0; }
    for (int n = 0; n < 128; ++n) {
        float s = 0.f;
        const h8v* kr = (const h8v*)(kb + n * 128);
#pragma unroll
        for (int i = 0; i < 16; ++i) {
            const h8v kv = kr[i];
            s = __builtin_amdgcn_fdot2(q[4 * i], (h2v){kv[0], kv[1]}, s, false);
            s = __builtin_amdgcn_fdot2(q[4 * i + 1], (h2v){kv[2], kv[3]}, s, false);
            s = __builtin_amdgcn_fdot2(q[4 * i + 2], (h2v){kv[4], kv[5]}, s, false);
            s = __builtin_amdgcn_fdot2(q[4 * i + 3], (h2v){kv[6], kv[7]}, s, false);
        }
        topk_insert(tv, ti, s, n);
    }
}
__device__ __forceinline__ void phase_route(const Params& p, int bid, int nb, char* smem) {
    char* ws = p.ws;
    half_t* keys = (half_t*)smem;
    {
        const u4v* src = (const u4v*)(ws + OFF_KEYS);
        u4v* dst = (u4v*)smem;
        for (int i = threadIdx.x; i < 65536 / 16; i += NTHREADS) dst[i] = src[i];
    }
    __syncthreads();
    const half_t* QP = (const half_t*)(ws + OFF_QP);
    int* EID = (int*)(ws + OFF_EID);
    float* GW = (float*)(ws + OFF_GW);
    for (long th = (long)bid * NTHREADS + threadIdx.x; th < (long)NTOK * 8; th += (long)nb * NTHREADS) {
        float tv0[16], tv1[16]; int ti0[16], ti1[16];
        route_half(QP + th * 256, keys, tv0, ti0);
        route_half(QP + th * 256 + 128, keys + 16384, tv1, ti1);
        float fv[16]; int fi[16];
#pragma unroll
        for (int k = 0; k < 16; ++k) { fv[k] = -3.0e38f; fi[k] = 0; }
#pragma unroll
        for (int i = 0; i < 16; ++i)
#pragma unroll
            for (int j = 0; j < 16; ++j)
                if ((i + 1) * (j + 1) <= 16) topk_insert(fv, fi, tv0[i] + tv1[j], ti0[i] * 128 + ti1[j]);
        float sum = 0.f, ex[16];
#pragma unroll
        for (int k = 0; k < 16; ++k) { ex[k] = __expf(fv[k] - fv[0]); sum += ex[k]; }
        const float inv = 1.0f / sum;
#pragma unroll
        for (int k = 0; k < 16; ++k) { EID[th * 16 + k] = fi[k]; GW[th * 16 + k] = ex[k] * inv; }
    }
}

__device__ __forceinline__ void phase_experts(const Params& p, int bid, int nb) {
    char* ws = p.ws;
    const half_t* U = (const half_t*)(ws + OFF_U16);
    const half_t* V = (const half_t*)(ws + OFF_V16);
    const int* EID = (const int*)(ws + OFF_EID);
    const float* GW = (const float*)(ws + OFF_GW);
    const int lane = threadIdx.x & 63;
    const long wv = ((long)bid * NTHREADS + threadIdx.x) >> 6, nwv = ((long)nb * NTHREADS) >> 6;
    for (long t = wv; t < NTOK; t += nwv) {
        float* xr = p.out + t * 1024;
        float xv[16];
        {
            const float4 a0 = *(const float4*)(xr + 8 * lane), a1 = *(const float4*)(xr + 8 * lane + 4);
            const float4 b0 = *(const float4*)(xr + 512 + 8 * lane), b1 = *(const float4*)(xr + 512 + 8 * lane + 4);
            xv[0] = a0.x; xv[1] = a0.y; xv[2] = a0.z; xv[3] = a0.w; xv[4] = a1.x; xv[5] = a1.y; xv[6] = a1.z; xv[7] = a1.w;
            xv[8] = b0.x; xv[9] = b0.y; xv[10] = b0.z; xv[11] = b0.w; xv[12] = b1.x; xv[13] = b1.y; xv[14] = b1.z; xv[15] = b1.w;
        }
        float ss = 0.f;
#pragma unroll
        for (int i = 0; i < 16; ++i) ss += xv[i] * xv[i];
        ss = wave_sum(ss);
        const float rs = rsqrtf(ss * (1.0f / 1024.f) + EPS);
        float hv[16];
#pragma unroll
        for (int i = 0; i < 16; ++i) {
            const int col = (i < 8) ? (8 * lane + i) : (512 + 8 * lane + i - 8);
            hv[i] = xv[i] * rs * p.norm2_g[col];
        }
        const int e0 = EID[t * 128 + lane], e1 = EID[t * 128 + 64 + lane];
        const float w0 = GW[t * 128 + lane], w1 = GW[t * 128 + 64 + lane];
        float acc[16];
#pragma unroll
        for (int i = 0; i < 16; ++i) acc[i] = 0.f;
        for (int j = 0; j < 128; j += 4) {
            int ee[4]; float gw[4]; float dot[4];
            h8v ua[4], ub[4];
#pragma unroll
            for (int q = 0; q < 4; ++q) {
                const int jj = j + q;
                ee[q] = (jj < 64) ? __builtin_amdgcn_readlane(e0, jj & 63) : __builtin_amdgcn_readlane(e1, jj & 63);
                gw[q] = (jj < 64) ? __builtin_bit_cast(float, __builtin_amdgcn_readlane(__builtin_bit_cast(int, w0), jj & 63))
                                  : __builtin_bit_cast(float, __builtin_amdgcn_readlane(__builtin_bit_cast(int, w1), jj & 63));
                const half_t* ur = U + (long)ee[q] * 1024;
                ua[q] = *(const h8v*)(ur + 8 * lane); ub[q] = *(const h8v*)(ur + 512 + 8 * lane);
            }
#pragma unroll
            for (int q = 0; q < 4; ++q) {
                float d = 0.f;
#pragma unroll
                for (int i = 0; i < 8; ++i) d += hv[i] * (float)ua[q][i] + hv[8 + i] * (float)ub[q][i];
                dot[q] = wave_sum(d);
            }
#pragma unroll
            for (int q = 0; q < 4; ++q) {
                const float coef = gw[q] * gelu_exact(dot[q]);
                const half_t* vr = V + (long)ee[q] * 1024;
                const h8v va = *(const h8v*)(vr + 8 * lane), vb = *(const h8v*)(vr + 512 + 8 * lane);
#pragma unroll
                for (int i = 0; i < 8; ++i) { acc[i] += coef * (float)va[i]; acc[8 + i] += coef * (float)vb[i]; }
            }
        }
        float s3 = 0.f;
#pragma unroll
        for (int i = 0; i < 16; ++i) { acc[i] += xv[i]; s3 += acc[i] * acc[i]; }
        s3 = wave_sum(s3);
        const float rf = rsqrtf(s3 * (1.0f / 1024.f) + EPS);
        float o[16];
#pragma unroll
        for (int i = 0; i < 16; ++i) {
            const int col = (i < 8) ? (8 * lane + i) : (512 + 8 * lane + i - 8);
            o[i] = acc[i] * rf * p.final_g[col];
        }
        *(float4*)(xr + 8 * lane) = make_float4(o[0], o[1], o[2], o[3]);
        *(float4*)(xr + 8 * lane + 4) = make_float4(o[4], o[5], o[6], o[7]);
        *(float4*)(xr + 512 + 8 * lane) = make_float4(o[8], o[9], o[10], o[11]);
        *(float4*)(xr + 512 + 8 * lane + 4) = make_float4(o[12], o[13], o[14], o[15]);
    }
}

template <int PH>
__global__ void __launch_bounds__(NTHREADS, 2) phase_kernel(Params p) {
    __shared__ __attribute__((aligned(16))) char smem[SMEM_BYTES];
    const int bid = blockIdx.x, nb = gridDim.x;
    if (PH == 0) phase_prep(p, bid, nb);
    if (PH == 1) phase_inproj(p, bid, nb, smem);
    if (PH == 2) phase_p2(p, bid, nb, smem);
    if (PH == 3) phase_cmp2(p, bid, nb);
    if (PH == 4) phase_attn(p, smem);
    if (PH == 5) phase_outproj(p, bid, nb, smem);
    if (PH == 6) phase_peerq(p, bid, nb, smem);
    if (PH == 7) phase_route(p, bid, nb, smem);
    if (PH == 8) phase_experts(p, bid, nb);
}

__global__ void __launch_bounds__(NTHREADS, 2) mega_kernel(Params p) {
    __shared__ __attribute__((aligned(16))) char smem[SMEM_BYTES];
    cg::grid_group grid = cg::this_grid();
    const int bid = blockIdx.x, nb = gridDim.x;
    phase_prep(p, bid, nb); grid.sync();
    phase_inproj(p, bid, nb, smem); grid.sync();
    phase_p2(p, bid, nb, smem); grid.sync();
    phase_cmp2(p, bid, nb); grid.sync();
    phase_attn(p, smem); grid.sync();
    phase_outproj(p, bid, nb, smem); grid.sync();
    phase_peerq(p, bid, nb, smem); grid.sync();
    phase_route(p, bid, nb, smem); grid.sync();
    phase_experts(p, bid, nb);
}

extern "C" void kernel_launch(void* const* d_in, const int* in_sizes, int n_in, void* d_out, int out_size, void* d_ws, size_t ws_size, hipStream_t stream) {
    (void)in_sizes; (void)n_in; (void)out_size;
    if (ws_size < WS_NEED) { fprintf(stderr, "kernel_launch: workspace too small (%zu < %zu)\n", ws_size, (size_t)WS_NEED); return; }
    Params p{};
    p.x = (const float*)d_in[0]; p.pos = (const int*)d_in[1]; p.norm1_g = (const float*)d_in[2]; p.w_in = (const float*)d_in[3];
    p.cmp_pos = (const float*)d_in[4]; p.cmp_k_w1 = (const float*)d_in[5]; p.cmp_k_w2 = (const float*)d_in[6];
    p.cmp_v_w1 = (const float*)d_in[7]; p.cmp_v_w2 = (const float*)d_in[8]; p.t5_bias = (const float*)d_in[9];
    p.q_norm_g = (const float*)d_in[10]; p.w_q_up = (const float*)d_in[11]; p.kv_norm_g = (const float*)d_in[12]; p.w_kv_up = (const float*)d_in[13];
    p.grp_norm_nsa = (const float*)d_in[14]; p.grp_norm_mla = (const float*)d_in[15]; p.w_out = (const float*)d_in[16]; p.norm2_g = (const float*)d_in[17];
    p.peer_wq = (const float*)d_in[18]; p.peer_keys1 = (const float*)d_in[19]; p.peer_keys2 = (const float*)d_in[20];
    p.peer_u = (const float*)d_in[21]; p.peer_v = (const float*)d_in[22]; p.final_g = (const float*)d_in[23];
    p.out = (float*)d_out; p.ws = (char*)d_ws;
#if MULTI_LAUNCH
    const int G = 512;
    phase_kernel<0><<<G, NTHREADS, 0, stream>>>(p);
    phase_kernel<1><<<G, NTHREADS, 0, stream>>>(p);
    phase_kernel<2><<<G, NTHREADS, 0, stream>>>(p);
    phase_kernel<3><<<G, NTHREADS, 0, stream>>>(p);
    phase_kernel<4><<<G, NTHREADS, 0, stream>>>(p);
    phase_kernel<5><<<G, NTHREADS, 0, stream>>>(p);
    phase_kernel<6><<<G, NTHREADS, 0, stream>>>(p);
    phase_kernel<7><<<G, NTHREADS, 0, stream>>>(p);
    phase_kernel<8><<<G, NTHREADS, 0, stream>>>(p);
#else
    static int grid_blocks = 0;
    if (!grid_blocks) {
        int dev = 0, cus = 0, per_cu = 0;
        hipGetDevice(&dev);
        hipDeviceGetAttribute(&cus, hipDeviceAttributeMultiprocessorCount, dev);
        hipOccupancyMaxActiveBlocksPerMultiprocessor(&per_cu, mega_kernel, NTHREADS, 0);
        if (per_cu > 2) per_cu = 2;
        grid_blocks = cus * per_cu;
    }
    void* args[] = {&p};
    hipError_t e = hipLaunchCooperativeKernel((void*)mega_kernel, dim3(grid_blocks), dim3(NTHREADS), args, 0, stream);
    if (e != hipSuccess) fprintf(stderr, "cooperative launch failed: %s (grid %d)\n", hipGetErrorString(e), grid_blocks);
#endif
}
```

```cpp
#include <hip/hip_runtime.h>
#include <hip/hip_cooperative_groups.h>
#include <cstdio>
#include <cstdint>
namespace cg = cooperative_groups;

#ifndef MULTI_LAUNCH
#define MULTI_LAUNCH 0
#endif

typedef _Float16 half_t;
typedef _Float16 h2v __attribute__((ext_vector_type(2)));
typedef _Float16 h4v __attribute__((ext_vector_type(4)));
typedef _Float16 h8v __attribute__((ext_vector_type(8)));
typedef float f4v __attribute__((ext_vector_type(4)));
typedef unsigned u4v __attribute__((ext_vector_type(4)));
typedef unsigned u2v __attribute__((ext_vector_type(2)));
typedef float f16v __attribute__((ext_vector_type(16)));

constexpr int BATCH = 2, SEQ = 16384, DM = 1024, NTOK = BATCH * SEQ;
constexpr int NIN = 1720, NINP = 1792;
constexpr int NCMP = 1023, NCMPP = 1024;
constexpr float EPS = 1e-6f;
constexpr float LOG2E = 1.4426950408889634f;
constexpr float QS_NSA = 0.125f * LOG2E;
constexpr float QS_MLA = 0.10206207261596575f * LOG2E;
constexpr float NEGF = -1e30f;
constexpr int LUTN = 1536;

constexpr size_t al256(size_t x) { return (x + 255) & ~(size_t)255; }
constexpr size_t OFF_CTRL = 0;
constexpr size_t OFF_LUT = 4096;
constexpr size_t OFF_CB = OFF_LUT + 2 * LUTN * 4 * 4;
constexpr size_t OFF_WIN = 65536;
constexpr size_t OFF_WQUP = OFF_WIN + (size_t)NINP * 1024 * 2;
constexpr size_t OFF_WKVUP = OFF_WQUP + 768 * 256 * 2;
constexpr size_t OFF_WC1 = OFF_WKVUP + 1024 * 128 * 2;
constexpr size_t OFF_WOUT = OFF_WC1 + 2 * 256 * 2048 * 2;
constexpr size_t OFF_WPQ = OFF_WOUT + 1024 * 1024 * 2;
constexpr size_t OFF_KEYS = OFF_WPQ + 2048 * 1024 * 2;
constexpr size_t OFF_U16 = al256(OFF_KEYS + 2 * 128 * 128 * 2);
constexpr size_t OFF_V16 = OFF_U16 + (size_t)16384 * 1024 * 2;
constexpr size_t OFF_H1 = OFF_V16 + (size_t)16384 * 1024 * 2;
constexpr size_t OFF_MIXED = OFF_H1;
constexpr size_t OFF_QH = OFF_H1 + (size_t)NTOK * 1024 * 2;
constexpr size_t SZ_KV = (size_t)2 * 2 * SEQ * 64 * 2;
constexpr size_t OFF_KC = OFF_QH + (size_t)NTOK * 512 * 2;
constexpr size_t OFF_VC = OFF_KC + SZ_KV;
constexpr size_t OFF_KS = OFF_VC + SZ_KV;
constexpr size_t OFF_VST = OFF_KS + SZ_KV;
constexpr size_t OFF_KW = OFF_VST + SZ_KV;
constexpr size_t OFF_VWT = OFF_KW + SZ_KV;
constexpr size_t OFF_GATES = OFF_VWT + SZ_KV;
constexpr size_t OFF_CQ = OFF_GATES + (size_t)NTOK * 24 * 4;
constexpr size_t OFF_CKV = OFF_CQ + (size_t)NTOK * 256 * 2;
constexpr size_t OFF_X2H = OFF_QH;
constexpr size_t OFF_QM = OFF_CKV + (size_t)NTOK * 128 * 2;
constexpr size_t OFF_KM = OFF_QM + (size_t)NTOK * 8 * 96 * 2;
constexpr size_t OFF_VT = OFF_KM + (size_t)NTOK * 8 * 96 * 2;
constexpr size_t OFF_QP = OFF_QM;
constexpr size_t OFF_HC1 = OFF_VT + (size_t)NTOK * 8 * 64 * 2;
constexpr size_t OFF_KCMP = OFF_HC1 + (size_t)8 * 1024 * 256 * 2;
constexpr size_t OFF_VCMPT = OFF_KCMP + (size_t)4 * 1024 * 64 * 2;
constexpr size_t OFF_EID = OFF_VCMPT + (size_t)4 * 1024 * 64 * 2;
constexpr size_t OFF_GW = OFF_EID + (size_t)NTOK * 128 * 4;
constexpr size_t WS_NEED = OFF_GW + (size_t)NTOK * 128 * 4;

struct Params {
    const float* x; const int* pos; const float* norm1_g; const float* w_in; const float* cmp_pos;
    const float* cmp_k_w1; const float* cmp_k_w2; const float* cmp_v_w1; const float* cmp_v_w2; const float* t5_bias;
    const float* q_norm_g; const float* w_q_up; const float* kv_norm_g; const float* w_kv_up;
    const float* grp_norm_nsa; const float* grp_norm_mla; const float* w_out; const float* norm2_g;
    const float* peer_wq; const float* peer_keys1; const float* peer_keys2; const float* peer_u; const float* peer_v; const float* final_g;
    float* out; char* ws;
};

constexpr int SMEM_BYTES = 66560;
constexpr int NTHREADS = 256;

__device__ __forceinline__ f4v mfma16(h8v a, h8v b, f4v c) { return __builtin_amdgcn_mfma_f32_16x16x32_f16(a, b, c, 0, 0, 0); }
__device__ __forceinline__ f16v mfma32(h8v a, h8v b, f16v c) { return __builtin_amdgcn_mfma_f32_32x32x16_f16(a, b, c, 0, 0, 0); }
__device__ __forceinline__ float wave_sum(float v) {
#pragma unroll
    for (int o = 32; o >= 1; o >>= 1) v += __shfl_xor(v, o);
    return v;
}
__device__ __forceinline__ float gelu_exact(float v) { return 0.5f * v * (1.0f + erff(v * 0.70710678118654752f)); }
__device__ __forceinline__ float fast_exp2(float v) { return __builtin_amdgcn_exp2f(v); }
__device__ __forceinline__ int t5_bucket(int d) {
    if (d < 16) return d < 0 ? 0 : d;
    int b = 16;
    b += (d >= 22); b += (d >= 30); b += (d >= 40); b += (d >= 54); b += (d >= 73); b += (d >= 99); b += (d >= 134); b += (d >= 182);
    b += (d >= 246); b += (d >= 332); b += (d >= 450); b += (d >= 609); b += (d >= 825); b += (d >= 1117); b += (d >= 1513);
    return b;
}

__device__ __forceinline__ void phase_prep(const Params& p, int bid, int nb) {
    const long tid = (long)bid * NTHREADS + threadIdx.x;
    const long nth = (long)nb * NTHREADS;
    char* ws = p.ws;
    if (tid < 1024) ((unsigned*)(ws + OFF_CTRL))[tid] = 0u;
    {
        float* lut = (float*)(ws + OFF_LUT);
        for (long e = tid; e < 2 * LUTN * 4; e += nth) {
            int r = e & 3, d = (e >> 2) % LUTN, g = (int)(e / (4 * LUTN));
            lut[e] = p.t5_bias[t5_bucket(d) * 8 + g * 4 + r] * LOG2E;
        }
    }
    {
        float* cb = (float*)(ws + OFF_CB);
        for (long e = tid; e < 512; e += nth) {
            int kv = (int)(e >> 8), n = (int)(e & 255);
            const float* w1 = kv ? p.cmp_v_w1 : p.cmp_k_w1;
            float s = 0.f;
            for (int k = 0; k < 2048; ++k) s += p.cmp_pos[k] * w1[(long)k * 256 + n];
            cb[e] = s;
        }
    }
    {
        half_t* W = (half_t*)(ws + OFF_WIN);
        for (long e = tid; e < (long)NINP * 1024; e += nth) {
            int k = (int)(e / NINP), n = (int)(e % NINP);
            int src;
            if (n < 1280) src = n;
            else if (n < 1536) src = 1304 + (n - 1280);
            else if (n < 1664) src = 1560 + (n - 1536);
            else if (n < 1696) src = 1688 + (n - 1664);
            else if (n < 1720) src = 1280 + (n - 1696);
            else src = -1;
            float v = src >= 0 ? p.w_in[(long)k * NIN + src] : 0.f;
            W[(long)n * 1024 + k] = (half_t)v;
        }
    }
    {
        half_t* W = (half_t*)(ws + OFF_WQUP);
        for (long e = tid; e < 768 * 256; e += nth) {
            int k = (int)(e / 768), n = (int)(e % 768);
            W[(long)n * 256 + k] = (half_t)(p.w_q_up[e] * p.q_norm_g[k]);
        }
    }
    {
        half_t* W = (half_t*)(ws + OFF_WKVUP);
        for (long e = tid; e < 1024 * 128; e += nth) {
            int k = (int)(e / 1024), n = (int)(e % 1024);
            W[(long)n * 128 + k] = (half_t)(p.w_kv_up[e] * p.kv_norm_g[k]);
        }
    }
    {
        half_t* W = (half_t*)(ws + OFF_WC1);
        for (long e = tid; e < 2L * 2048 * 256; e += nth) {
            int kv = (int)(e / (2048 * 256)); long r = e % (2048 * 256);
            int k = (int)(r / 256), n = (int)(r % 256);
            const float* w1 = kv ? p.cmp_v_w1 : p.cmp_k_w1;
            W[((long)kv * 256 + n) * 2048 + k] = (half_t)w1[r];
        }
    }
    {
        half_t* W = (half_t*)(ws + OFF_WOUT);
        for (long e = tid; e < 1024L * 1024; e += nth) {
            int k = (int)(e >> 10), n = (int)(e & 1023);
            float g = k < 512 ? p.grp_norm_nsa[k] : p.grp_norm_mla[k - 512];
            W[(long)n * 1024 + k] = (half_t)(p.w_out[e] * g);
        }
    }
    {
        half_t* W = (half_t*)(ws + OFF_WPQ);
        for (long e = tid; e < 1024L * 2048; e += nth) {
            int k = (int)(e >> 11), n = (int)(e & 2047);
            W[(long)n * 1024 + k] = (half_t)(p.peer_wq[e] * p.norm2_g[k]);
        }
    }
    {
        half_t* W = (half_t*)(ws + OFF_KEYS);
        for (long e = tid; e < 2 * 16384; e += nth) {
            W[e] = (half_t)(e < 16384 ? p.peer_keys1[e] : p.peer_keys2[e - 16384]);
        }
    }
    {
        half_t* U = (half_t*)(ws + OFF_U16);
        half_t* V = (half_t*)(ws + OFF_V16);
        const long n4 = 16384L * 1024 / 4;
        for (long e = tid; e < n4; e += nth) {
            float4 a = ((const float4*)p.peer_u)[e];
            float4 b = ((const float4*)p.peer_v)[e];
            h4v ha = {(half_t)a.x, (half_t)a.y, (half_t)a.z, (half_t)a.w};
            h4v hb = {(half_t)b.x, (half_t)b.y, (half_t)b.z, (half_t)b.w};
            ((h4v*)U)[e] = ha; ((h4v*)V)[e] = hb;
        }
    }
    {
        half_t* H1 = (half_t*)(ws + OFF_H1);
        const int lane = threadIdx.x & 63;
        const long wv = tid >> 6, nwv = nth >> 6;
        for (long row = wv; row < NTOK; row += nwv) {
            const float4* xr = (const float4*)(p.x + row * 1024);
            float4 v[4]; float ss = 0.f;
#pragma unroll
            for (int i = 0; i < 4; ++i) { v[i] = xr[lane + 64 * i]; ss += v[i].x * v[i].x + v[i].y * v[i].y + v[i].z * v[i].z + v[i].w * v[i].w; }
            ss = wave_sum(ss);
            const float rs = rsqrtf(ss * (1.0f / 1024.f) + EPS);
#pragma unroll
            for (int i = 0; i < 4; ++i) {
                float4 g = ((const float4*)p.norm1_g)[lane + 64 * i];
                h4v o = {(half_t)(v[i].x * rs * g.x), (half_t)(v[i].y * rs * g.y), (half_t)(v[i].z * rs * g.z), (half_t)(v[i].w * rs * g.w)};
                ((h4v*)(H1 + row * 1024))[lane + 64 * i] = o;
            }
        }
    }
}

struct GemmSmem { half_t A[128][72]; half_t Bt[128][72]; float rs[2][128]; };

template <bool SCALE, class Epi>
__device__ __forceinline__ void gemm_tile(const half_t* __restrict__ A, long lda, const half_t* __restrict__ Bt, long ldb, int K, int ksplit, char* smem_raw, Epi epi) {
    GemmSmem& sm = *(GemmSmem*)smem_raw;
    const int tid = threadIdx.x, lane = tid & 63, w = tid >> 6, wm = w >> 1, wn = w & 1;
    const int i16 = lane & 15, g4 = lane >> 4;
    const int lr = tid >> 3, off = tid & 7;
    if (SCALE) {
        const int row = tid >> 1, part = tid & 1;
        for (int range = 0; range < 2; ++range) {
            const int kb = range ? ksplit : 0, ke = range ? K : ksplit;
            const int L = ke - kb;
            if (L <= 0) continue;
            const int hl = L >> 1;
            const half_t* ap = A + (long)row * lda + kb + part * hl;
            float ss = 0.f;
            for (int k = 0; k < hl; k += 8) {
                h8v v = *(const h8v*)(ap + k);
#pragma unroll
                for (int j = 0; j < 8; ++j) { float f = (float)v[j]; ss += f * f; }
            }
            ss += __shfl_xor(ss, 1);
            if (part == 0) sm.rs[range][row] = rsqrtf(ss / (float)L + EPS);
        }
        __syncthreads();
    }
    f4v acc[4][4];
#pragma unroll
    for (int a = 0; a < 4; ++a)
#pragma unroll
        for (int b = 0; b < 4; ++b) acc[a][b] = (f4v){0.f, 0.f, 0.f, 0.f};
    u4v ra[4], rb[4];
    const int nk = K >> 6;
#pragma unroll
    for (int i = 0; i < 4; ++i) {
        ra[i] = *(const u4v*)(A + (long)(lr + 32 * i) * lda + off * 8);
        rb[i] = *(const u4v*)(Bt + (long)(lr + 32 * i) * ldb + off * 8);
    }
    for (int kt = 0; kt < nk; ++kt) {
#pragma unroll
        for (int i = 0; i < 4; ++i) {
            u4v va = ra[i];
            if (SCALE) {
                const float rs = sm.rs[(kt * 64 >= ksplit) ? 1 : 0][lr + 32 * i];
                h8v hv = __builtin_bit_cast(h8v, va);
#pragma unroll
                for (int j = 0; j < 8; ++j) hv[j] = (half_t)((float)hv[j] * rs);
                va = __builtin_bit_cast(u4v, hv);
            }
            *(u4v*)&sm.A[lr + 32 * i][off * 8] = va;
            *(u4v*)&sm.Bt[lr + 32 * i][off * 8] = rb[i];
        }
        __syncthreads();
        if (kt + 1 < nk) {
            const int k0 = (kt + 1) * 64;
#pragma unroll
            for (int i = 0; i < 4; ++i) {
                ra[i] = *(const u4v*)(A + (long)(lr + 32 * i) * lda + k0 + off * 8);
                rb[i] = *(const u4v*)(Bt + (long)(lr + 32 * i) * ldb + k0 + off * 8);
            }
        }
#pragma unroll
        for (int kk = 0; kk < 2; ++kk) {
            h8v af[4], bf[4];
#pragma unroll
            for (int mi = 0; mi < 4; ++mi) af[mi] = *(const h8v*)&sm.A[wm * 64 + mi * 16 + i16][kk * 32 + g4 * 8];
#pragma unroll
            for (int ni = 0; ni < 4; ++ni) bf[ni] = *(const h8v*)&sm.Bt[wn * 64 + ni * 16 + i16][kk * 32 + g4 * 8];
#pragma unroll
            for (int mi = 0; mi < 4; ++mi)
#pragma unroll
                for (int ni = 0; ni < 4; ++ni) acc[mi][ni] = mfma16(af[mi], bf[ni], acc[mi][ni]);
        }
        __syncthreads();
    }
    epi(acc, wm, wn, i16, g4);
}

__device__ __forceinline__ void rope_pair(float x1, float x2, int pos, int i, float& o1, float& o2) {
    const float inv = __builtin_amdgcn_exp2f(-(float)i * (13.287712379549449f / 16.0f));
    double t = (double)pos * (double)inv * 0.15915494309189535;
    t -= __builtin_rint(t);
    const float fr = (float)t;
    const float sn = __builtin_amdgcn_sinf(fr), cs = __builtin_amdgcn_cosf(fr);
    o1 = x1 * cs - x2 * sn; o2 = x1 * sn + x2 * cs;
}

__device__ __forceinline__ void phase_inproj(const Params& p, int bid, int nb, char* smem) {
    char* ws = p.ws;
    const half_t* H1 = (const half_t*)(ws + OFF_H1);
    const half_t* W = (const half_t*)(ws + OFF_WIN);
    half_t* QH = (half_t*)(ws + OFF_QH);
    half_t* KM = (half_t*)(ws + OFF_KM);
    half_t* CQ = (half_t*)(ws + OFF_CQ);
    half_t* CKV = (half_t*)(ws + OFF_CKV);
    float* GATES = (float*)(ws + OFF_GATES);
    const int NT_N = NINP / 128, NT_M = NTOK / 128;
    for (int tile = bid; tile < NT_M * NT_N; tile += nb) {
        const int tm = tile / NT_N, tn = tile % NT_N;
        const int row0 = tm * 128, n0 = tn * 128;
        gemm_tile<false>(H1 + (long)row0 * 1024, 1024, W + (long)n0 * 1024, 1024, 1024, 1024, smem,
            [&](f4v (&acc)[4][4], int wm, int wn, int i16, int g4) __attribute__((always_inline)) {
#pragma unroll
                for (int ni = 0; ni < 4; ++ni) {
                    const int cb = n0 + wn * 64 + ni * 16;
                    const int col = cb + i16;
#pragma unroll
                    for (int mi = 0; mi < 4; ++mi) {
                        const int rbase = row0 + wm * 64 + mi * 16 + g4 * 4;
                        const int b = rbase >> 14, s0 = rbase & (SEQ - 1);
                        if (cb < 512) {
#pragma unroll
                            for (int r = 0; r < 4; ++r) QH[(long)(rbase + r) * 512 + col] = (half_t)(acc[mi][ni][r] * QS_NSA);
                        } else if (cb < 1280) {
                            const int which = (cb - 512) >> 7;
                            const int c = (col - 512) & 127, gg = c >> 6, d = c & 63;
                            half_t* base = (half_t*)(ws + OFF_KC + (size_t)which * SZ_KV);
                            if (which == 3 || which == 5) {
                                h4v o = {(half_t)acc[mi][ni][0], (half_t)acc[mi][ni][1], (half_t)acc[mi][ni][2], (half_t)acc[mi][ni][3]};
                                *(h4v*)(base + ((long)((b * 2 + gg) * 64 + d)) * SEQ + s0) = o;
                            } else {
#pragma unroll
                                for (int r = 0; r < 4; ++r) base[((long)(b * 2 + gg) * SEQ + s0 + r) * 64 + d] = (half_t)acc[mi][ni][r];
                            }
                        } else if (cb < 1536) {
#pragma unroll
                            for (int r = 0; r < 4; ++r) CQ[(long)(rbase + r) * 256 + (col - 1280)] = (half_t)acc[mi][ni][r];
                        } else if (cb < 1664) {
#pragma unroll
                            for (int r = 0; r < 4; ++r) CKV[(long)(rbase + r) * 128 + (col - 1536)] = (half_t)acc[mi][ni][r];
                        } else if (cb == 1664) {
#pragma unroll
                            for (int r = 0; r < 4; ++r) {
                                float o1, o2;
                                rope_pair(acc[mi][ni][r], acc[mi][(ni + 1) & 3][r], p.pos[rbase + r], i16, o1, o2);
#pragma unroll
                                for (int h = 0; h < 8; ++h) {
                                    half_t* kr = KM + ((long)(b * 8 + h) * SEQ + s0 + r) * 96 + 64;
                                    kr[i16] = (half_t)o1; kr[16 + i16] = (half_t)o2;
                                }
                            }
                        } else if (cb >= 1696) {
                            if (col < 1720) {
#pragma unroll
                                for (int r = 0; r < 4; ++r) GATES[(long)(rbase + r) * 24 + (col - 1696)] = 1.0f / (1.0f + __expf(-acc[mi][ni][r]));
                            }
                        }
                    }
                }
            });
    }
}

__device__ __forceinline__ void phase_p2(const Params& p, int bid, int nb, char* smem) {
    char* ws = p.ws;
    const int NTA = 256 * 6, NTB = 256 * 8, NTC = 128;
    for (int tile = bid; tile < NTA + NTB + NTC; tile += nb) {
        if (tile < NTC) {
            const int nt = tile & 1, mt = (tile >> 1) & 7, bg = (tile >> 4) & 3, kv = tile >> 6;
            const half_t* A = (const half_t*)(ws + (kv ? OFF_VC : OFF_KC)) + (long)bg * SEQ * 64 + (long)mt * 128 * 1024;
            const half_t* Bt = (const half_t*)(ws + OFF_WC1) + ((long)kv * 256 + nt * 128) * 2048;
            const float* cbv = (const float*)(ws + OFF_CB) + kv * 256;
            half_t* HC = (half_t*)(ws + OFF_HC1) + ((long)(kv * 4 + bg) * 1024) * 256;
            gemm_tile<false>(A, 1024, Bt, 2048, 2048, 2048, smem,
                [&](f4v (&acc)[4][4], int wm, int wn, int i16, int g4) __attribute__((always_inline)) {
#pragma unroll
                    for (int ni = 0; ni < 4; ++ni) {
                        const int n = nt * 128 + wn * 64 + ni * 16 + i16;
                        const float bias = cbv[n];
#pragma unroll
                        for (int mi = 0; mi < 4; ++mi)
#pragma unroll
                            for (int r = 0; r < 4; ++r) {
                                const int m = mt * 128 + wm * 64 + mi * 16 + g4 * 4 + r;
                                if (m < NCMP) HC[(long)m * 256 + n] = (half_t)gelu_exact(acc[mi][ni][r] + bias);
                            }
                    }
                });
        } else if (tile < NTC + NTA) {
            const int t2 = tile - NTC;
            const int tm = t2 / 6, tn = t2 % 6;
            const int row0 = tm * 128, n0 = tn * 128;
            half_t* QM = (half_t*)(ws + OFF_QM);
            gemm_tile<true>((const half_t*)(ws + OFF_CQ) + (long)row0 * 256, 256, (const half_t*)(ws + OFF_WQUP) + (long)n0 * 256, 256, 256, 256, smem,
                [&](f4v (&acc)[4][4], int wm, int wn, int i16, int g4) __attribute__((always_inline)) {
#pragma unroll
                    for (int ni = 0; ni < 4; ++ni) {
                        const int cb = n0 + wn * 64 + ni * 16;
                        const int h = cb / 96, d0 = cb - h * 96;
#pragma unroll
                        for (int mi = 0; mi < 4; ++mi) {
                            const int rbase = row0 + wm * 64 + mi * 16 + g4 * 4;
                            const int b = rbase >> 14, s0 = rbase & (SEQ - 1);
#pragma unroll
                            for (int r = 0; r < 4; ++r) {
                                half_t* qr = QM + ((long)(b * 8 + h) * SEQ + s0 + r) * 96;
                                if (d0 < 64) qr[d0 + i16] = (half_t)(acc[mi][ni][r] * QS_MLA);
                                else if (d0 == 64) {
                                    float o1, o2;
                                    rope_pair(acc[mi][ni][r] * QS_MLA, acc[mi][(ni + 1) & 3][r] * QS_MLA, p.pos[rbase + r], i16, o1, o2);
                                    qr[64 + i16] = (half_t)o1; qr[80 + i16] = (half_t)o2;
                                }
                            }
                        }
                    }
                });
        } else {
            const int t2 = tile - NTC - NTA;
            const int tm = t2 >> 3, tn = t2 & 7;
            const int row0 = tm * 128, n0 = tn * 128;
            half_t* KM = (half_t*)(ws + OFF_KM);
            half_t* VT = (half_t*)(ws + OFF_VT);
            gemm_tile<true>((const half_t*)(ws + OFF_CKV) + (long)row0 * 128, 128, (const half_t*)(ws + OFF_WKVUP) + (long)n0 * 128, 128, 128, 128, smem,
                [&](f4v (&acc)[4][4], int wm, int wn, int i16, int g4) __attribute__((always_inline)) {
                    const int h = tn;
#pragma unroll
                    for (int ni = 0; ni < 4; ++ni) {
                        const int d0 = wn * 64 + ni * 16;
#pragma unroll
                        for (int mi = 0; mi < 4; ++mi) {
                            const int rbase = row0 + wm * 64 + mi * 16 + g4 * 4;
                            const int b = rbase >> 14, s0 = rbase & (SEQ - 1);
                            if (d0 < 64) {
#pragma unroll
                                for (int r = 0; r < 4; ++r) KM[((long)(b * 8 + h) * SEQ + s0 + r) * 96 + d0 + i16] = (half_t)acc[mi][ni][r];
                            } else {
                                h4v o = {(half_t)acc[mi][ni][0], (half_t)acc[mi][ni][1], (half_t)acc[mi][ni][2], (half_t)acc[mi][ni][3]};
                                *(h4v*)(VT + ((long)(b * 8 + h) * 64 + (d0 - 64 + i16)) * SEQ + s0) = o;
                            }
                        }
                    }
                });
        }
    }
}

__device__ __forceinline__ void phase_cmp2(const Params& p, int bid, int nb) {
    char* ws = p.ws;
    const long tid = (long)bid * NTHREADS + threadIdx.x, nth = (long)nb * NTHREADS;
    const half_t* HC = (const half_t*)(ws + OFF_HC1);
    half_t* KC = (half_t*)(ws + OFF_KCMP);
    half_t* VCT = (half_t*)(ws + OFF_VCMPT);
    for (long e = tid; e < 2L * 4 * 1024 * 64; e += nth) {
        const int d = (int)(e & 63), n = (int)((e >> 6) & 1023), bg = (int)((e >> 16) & 3), kv = (int)(e >> 18);
        float s = 0.f;
        if (n < NCMP) {
            const half_t* hr = HC + ((long)(kv * 4 + bg) * 1024 + n) * 256;
            const float* w2 = kv ? p.cmp_v_w2 : p.cmp_k_w2;
            for (int j = 0; j < 256; ++j) s += (float)hr[j] * w2[j * 64 + d];
        }
        if (kv == 0) KC[((long)bg * 1024 + n) * 64 + d] = (half_t)s;
        else VCT[((long)bg * 64 + d) * 1024 + n] = (half_t)s;
    }
}

struct MlaSmem { half_t K[2][64][104]; half_t V[2][64][68]; };

__device__ __forceinline__ void mla_item(const Params& p, int item, char* smem) {
    MlaSmem& sm = *(MlaSmem*)smem;
    char* ws = p.ws;
    const int qb = 127 - (item >> 4), bh = item & 15;
    const int b = bh >> 3, h = bh & 7;
    const half_t* Qp = (const half_t*)(ws + OFF_QM) + ((long)bh * SEQ + qb * 128) * 96;
    const half_t* Kp = (const half_t*)(ws + OFF_KM) + (long)bh * SEQ * 96;
    const half_t* Vp = (const half_t*)(ws + OFF_VT) + (long)bh * 64 * SEQ;
    half_t* MIX = (half_t*)(ws + OFF_MIXED);
    int tid_ = threadIdx.x; asm volatile("" : "+v"(tid_));
    const int tid = tid_, lane = tid & 63, w = tid >> 6;
    const int c = lane & 31, hh = lane >> 5;
    const int tq = qb * 128 + w * 32 + c;
    h8v qf[6];
#pragma unroll
    for (int s6 = 0; s6 < 6; ++s6) qf[s6] = *(const h8v*)(Qp + (long)(w * 32 + c) * 96 + s6 * 16 + hh * 8);
    f16v o0, o1;
#pragma unroll
    for (int i = 0; i < 16; ++i) { o0[i] = 0.f; o1[i] = 0.f; }
    float m = NEGF, l = 0.f;
    const int ntiles = 2 * qb + 2;
    u4v rk[3]; u2v rv[4];
    auto gload = [&](int j) {
#pragma unroll
        for (int i = 0; i < 3; ++i) {
            const int ci = tid + 256 * i, key = ci / 12, of = ci % 12;
            rk[i] = *(const u4v*)(Kp + (long)(j * 64 + key) * 96 + of * 8);
        }
#pragma unroll
        for (int i = 0; i < 2; ++i) {
            const int ci = tid + 256 * i, dim = ci >> 3, of = ci & 7;
            const u4v v = *(const u4v*)(Vp + (long)dim * SEQ + j * 64 + of * 8);
            rv[2 * i] = (u2v){v.x, v.y}; rv[2 * i + 1] = (u2v){v.z, v.w};
        }
    };
    auto lstore = [&](int buf) {
#pragma unroll
        for (int i = 0; i < 3; ++i) {
            const int ci = tid + 256 * i, key = ci / 12, of = ci % 12;
            *(u4v*)&sm.K[buf][key][of * 8] = rk[i];
        }
#pragma unroll
        for (int i = 0; i < 2; ++i) {
            const int ci = tid + 256 * i, dim = ci >> 3, of = ci & 7;
            *(u2v*)&sm.V[buf][dim][of * 8] = rv[2 * i];
            *(u2v*)&sm.V[buf][dim][of * 8 + 4] = rv[2 * i + 1];
        }
    };
    gload(0);
    lstore(0);
    __syncthreads();
#pragma unroll 1
    for (int j = 0; j < ntiles; ++j) {
        const int buf = j & 1;
        if (j + 1 < ntiles) gload(j + 1);
        const int qmin = qb * 128 + w * 32;
        if (64 * j <= qmin + 31) {
            f16v s0, s1;
#pragma unroll
            for (int i = 0; i < 16; ++i) { s0[i] = 0.f; s1[i] = 0.f; }
#pragma unroll
            for (int s6 = 0; s6 < 6; ++s6) {
                const h8v a0 = *(const h8v*)&sm.K[buf][c][s6 * 16 + hh * 8];
                const h8v a1 = *(const h8v*)&sm.K[buf][32 + c][s6 * 16 + hh * 8];
                s0 = mfma32(a0, qf[s6], s0);
                s1 = mfma32(a1, qf[s6], s1);
            }
            if (64 * j + 63 > qmin) {
#pragma unroll
                for (int r = 0; r < 16; ++r) {
                    const int key = 64 * j + (r & 3) + 8 * (r >> 2) + 4 * hh;
                    if (key > tq) s0[r] = NEGF;
                    if (key + 32 > tq) s1[r] = NEGF;
                }
            }
            float mx = s0[0];
#pragma unroll
            for (int r = 1; r < 16; ++r) mx = fmaxf(mx, s0[r]);
#pragma unroll
            for (int r = 0; r < 16; ++r) mx = fmaxf(mx, s1[r]);
            mx = fmaxf(mx, __shfl_xor(mx, 32));
            const float mn = fmaxf(m, mx);
            const float alpha = fast_exp2(m - mn);
            m = mn;
            float ps = 0.f;
#pragma unroll
            for (int r = 0; r < 16; ++r) { s0[r] = fast_exp2(s0[r] - mn); ps += s0[r]; }
#pragma unroll
            for (int r = 0; r < 16; ++r) { s1[r] = fast_exp2(s1[r] - mn); ps += s1[r]; }
            l = l * alpha + ps;
#pragma unroll
            for (int i = 0; i < 16; ++i) { o0[i] *= alpha; o1[i] *= alpha; }
#pragma unroll
            for (int ks = 0; ks < 4; ++ks) {
                h8v pb;
#pragma unroll
                for (int jj = 0; jj < 8; ++jj) pb[jj] = (half_t)((ks < 2) ? s0[8 * (ks & 1) + jj] : s1[8 * (ks & 1) + jj]);
#pragma unroll
                for (int md = 0; md < 2; ++md) {
                    const h4v lo = *(const h4v*)&sm.V[buf][32 * md + c][16 * ks + 4 * hh];
                    const h4v hi = *(const h4v*)&sm.V[buf][32 * md + c][16 * ks + 8 + 4 * hh];
                    const h8v a = {lo[0], lo[1], lo[2], lo[3], hi[0], hi[1], hi[2], hi[3]};
                    if (md == 0) o0 = mfma32(a, pb, o0); else o1 = mfma32(a, pb, o1);
                }
            }
        }
        if (j + 1 < ntiles) lstore(buf ^ 1);
        __syncthreads();
    }
    const float lt = l + __shfl_xor(l, 32);
    const float inv = 1.0f / lt;
    half_t* orow = MIX + (long)(b * SEQ + tq) * 1024 + 512 + h * 64;
#pragma unroll
    for (int md = 0; md < 2; ++md)
#pragma unroll
        for (int rg = 0; rg < 4; ++rg) {
            h4v o;
#pragma unroll
            for (int e = 0; e < 4; ++e) o[e] = (half_t)(((md == 0) ? o0[4 * rg + e] : o1[4 * rg + e]) * inv);
            *(h4v*)(orow + 32 * md + 8 * rg + 4 * hh) = o;
        }
}

struct NsaStage { half_t K[64][72]; half_t V[64][68]; };
constexpr int NSA_LUT = 0;
constexpr int NSA_ST0 = 12288;
constexpr int NSA_RB = NSA_ST0 + 17920;
constexpr int NSA_SEL = NSA_RB + 32768;
constexpr int NSA_MASK = NSA_SEL + 2048;
constexpr int NSA_END = NSA_MASK + 1024;
constexpr float MINIT = -30000.0f;

__device__ __forceinline__ void nsa_item(const Params& p, int item, char* smem) {
    char* ws = p.ws;
    half_t* lut = (half_t*)(smem + NSA_LUT);
    float (*imp)[8][256] = (float (*)[8][256])(smem + NSA_RB);
    int (*sel)[8][16] = (int (*)[8][16])(smem + NSA_SEL);
    unsigned* masks = (unsigned*)(smem + NSA_MASK);
    const int bg = item & 3, qt = item >> 2;
    const int b = bg >> 1, g = bg & 1;
    int tid_ = threadIdx.x; asm volatile("" : "+v"(tid_));
    const int tid = tid_, lane = tid & 63, w = tid >> 6;
    const int c = lane & 31, hh = lane >> 5;
    const int qi = c >> 2, r = c & 3;
    const int t0 = qt * 32;
    const int t0w = t0 + w * 8;
    const int tq = t0w + qi;
    const int tlast = t0w + 7;
    {
        const float* lg = (const float*)(ws + OFF_LUT) + (long)g * LUTN * 4;
        for (int i = tid; i < LUTN * 4; i += NTHREADS) lut[i] = (half_t)lg[i];
        float* im = &imp[0][0][0];
        for (int i = tid; i < 4 * 8 * 256; i += NTHREADS) im[i] = 0.f;
    }
    __syncthreads();
    const float cfar = (float)lut[(LUTN - 1) * 4 + r];
    const half_t* QH = (const half_t*)(ws + OFF_QH);
    h8v qf[4];
#pragma unroll
    for (int s4 = 0; s4 < 4; ++s4) qf[s4] = *(const h8v*)(QH + (long)(b * SEQ + tq) * 512 + (g * 4 + r) * 64 + s4 * 16 + hh * 8);
    const float* gp = (const float*)(ws + OFF_GATES) + (long)(b * SEQ + tq) * 24 + (g * 4 + r) * 3;
    const float g0 = gp[0], g1 = gp[1], g2 = gp[2];
    f16v of0, of1;
#pragma unroll
    for (int i = 0; i < 16; ++i) { of0[i] = 0.f; of1[i] = 0.f; }

    u4v rk[2], rvv[2];
    auto stage_gload = [&](const half_t* Kg, const half_t* Vg, long ldv, int key0, bool withv) __attribute__((always_inline)) {
#pragma unroll
        for (int i = 0; i < 2; ++i) {
            const int ci = tid + 256 * i, row = ci >> 3, of = ci & 7;
            rk[i] = *(const u4v*)(Kg + (long)(key0 + row) * 64 + of * 8);
            if (withv) rvv[i] = *(const u4v*)(Vg + (long)row * ldv + key0 + of * 8);
        }
    };
    auto stage_lstore = [&](NsaStage& st, bool withv) __attribute__((always_inline)) {
#pragma unroll
        for (int i = 0; i < 2; ++i) {
            const int ci = tid + 256 * i, row = ci >> 3, of = ci & 7;
            *(u4v*)&st.K[row][of * 8] = rk[i];
            if (withv) {
                *(u2v*)&st.V[row][of * 8] = (u2v){rvv[i][0], rvv[i][1]};
                *(u2v*)&st.V[row][of * 8 + 4] = (u2v){rvv[i][2], rvv[i][3]};
            }
        }
    };
    auto qk32 = [&](const NsaStage& st, int mt) __attribute__((always_inline)) -> f16v {
        f16v s;
#pragma unroll
        for (int i = 0; i < 16; ++i) s[i] = 0.f;
#pragma unroll
        for (int s4 = 0; s4 < 4; ++s4) {
            const h8v a = *(const h8v*)&st.K[32 * mt + c][s4 * 16 + hh * 8];
            s = mfma32(a, qf[s4], s);
        }
        return s;
    };
    auto pv32 = [&](const NsaStage& st, int mt, const f16v& pr, f16v& oa, f16v& ob) __attribute__((always_inline)) {
#pragma unroll
        for (int ks = 0; ks < 2; ++ks) {
            h8v pb;
#pragma unroll
            for (int jj = 0; jj < 8; ++jj) pb[jj] = (half_t)pr[8 * ks + jj];
#pragma unroll
            for (int md = 0; md < 2; ++md) {
                const h4v lo = *(const h4v*)&st.V[32 * md + c][32 * mt + 16 * ks + 4 * hh];
                const h4v hi = *(const h4v*)&st.V[32 * md + c][32 * mt + 16 * ks + 8 + 4 * hh];
                const h8v a = {lo[0], lo[1], lo[2], lo[3], hi[0], hi[1], hi[2], hi[3]};
                if (md == 0) oa = mfma32(a, pb, oa); else ob = mfma32(a, pb, ob);
            }
        }
    };
    NsaStage& st0 = *(NsaStage*)(smem + NSA_ST0);
    NsaStage& st1 = *(NsaStage*)(smem + NSA_RB);

    {
        const half_t* KC = (const half_t*)(ws + OFF_KCMP) + (long)bg * 1024 * 64;
        const half_t* VCT = (const half_t*)(ws + OFF_VCMPT) + (long)bg * 64 * 1024;
        const int nst = ((t0 >> 4) >> 6) + 1;
        auto cmp_scores = [&](f16v& s, int kbase) __attribute__((always_inline)) {
            const bool far = (t0w - (16 * (kbase + 31) + 31)) >= 1513;
            if (far) {
#pragma unroll
                for (int rr = 0; rr < 16; ++rr) s[rr] += cfar;
            } else {
#pragma unroll
                for (int rr = 0; rr < 16; ++rr) {
                    const int k = kbase + (rr & 3) + 8 * (rr >> 2) + 4 * hh;
                    const int dist = tq - (16 * k + 31);
                    const int di = dist < 0 ? 0 : (dist > LUTN - 1 ? LUTN - 1 : dist);
                    s[rr] = (dist >= 0) ? s[rr] + (float)lut[di * 4 + r] : NEGF;
                }
            }
        };
        float m = MINIT, l = 0.f;
        stage_gload(KC, VCT, 1024, 0, false);
#pragma unroll 1
        for (int sg = 0; sg < nst; ++sg) {
            stage_lstore(st0, false);
            __syncthreads();
            if (sg + 1 < nst) stage_gload(KC, VCT, 1024, (sg + 1) * 64, false);
#pragma unroll
            for (int mt = 0; mt < 2; ++mt) {
                const int kbase = sg * 64 + mt * 32;
                if (16 * kbase + 31 <= tlast) {
                    f16v s = qk32(st0, mt);
                    cmp_scores(s, kbase);
                    float mx = s[0];
#pragma unroll
                    for (int rr = 1; rr < 16; ++rr) mx = fmaxf(mx, s[rr]);
                    const float mn = fmaxf(m, mx);
                    float ps = 0.f;
#pragma unroll
                    for (int rr = 0; rr < 16; ++rr) ps += fast_exp2(s[rr] - mn);
                    l = l * fast_exp2(m - mn) + ps;
                    m = mn;
                }
            }
            __syncthreads();
        }
        {
            const float mo = __shfl_xor(m, 32), lo = __shfl_xor(l, 32);
            const float mt_ = fmaxf(m, mo);
            l = l * fast_exp2(m - mt_) + lo * fast_exp2(mo - mt_);
            m = mt_;
        }
        const float ml2 = (l > 0.f) ? m + __builtin_amdgcn_logf(l) : 1e30f;
        f16v oc0, oc1;
#pragma unroll
        for (int i = 0; i < 16; ++i) { oc0[i] = 0.f; oc1[i] = 0.f; }
        float carryL = 0.f;
        stage_gload(KC, VCT, 1024, 0, true);
#pragma unroll 1
        for (int sg = 0; sg < nst; ++sg) {
            stage_lstore(st0, true);
            __syncthreads();
            if (sg + 1 < nst) stage_gload(KC, VCT, 1024, (sg + 1) * 64, true);
#pragma unroll
            for (int mt = 0; mt < 2; ++mt) {
                const int kbase = sg * 64 + mt * 32;
                const int kt = sg * 2 + mt;
                if (16 * kbase + 31 <= tlast) {
                    f16v s = qk32(st0, mt);
                    cmp_scores(s, kbase);
#pragma unroll
                    for (int rr = 0; rr < 16; ++rr) s[rr] = fast_exp2(s[rr] - ml2);
                    float Gs[4], Ls[4];
#pragma unroll
                    for (int jg = 0; jg < 4; ++jg) {
                        float G = s[4 * jg] + s[4 * jg + 1] + s[4 * jg + 2] + s[4 * jg + 3];
                        float L = s[4 * jg + 3];
                        G += __shfl_xor(G, 1); G += __shfl_xor(G, 2);
                        L += __shfl_xor(L, 1); L += __shfl_xor(L, 2);
                        Gs[jg] = G; Ls[jg] = L;
                    }
                    float Lo[4];
#pragma unroll
                    for (int jg = 0; jg < 4; ++jg) Lo[jg] = __shfl_xor(Ls[jg], 32);
                    if (r == 0) {
#pragma unroll
                        for (int jg = 0; jg < 4; ++jg) {
                            const float prevL = hh ? Lo[jg] : (jg == 0 ? carryL : Lo[jg - 1]);
                            imp[w][qi][8 * kt + 2 * jg + hh] = Gs[jg] + prevL;
                        }
                    }
                    carryL = Lo[3];
                    pv32(st0, mt, s, oc0, oc1);
                }
            }
            __syncthreads();
        }
#pragma unroll
        for (int i = 0; i < 16; ++i) { of0[i] += g0 * oc0[i]; of1[i] += g0 * oc1[i]; }
    }
    {
        const int q2 = lane >> 3, sub = lane & 7;
        const int tq2 = t0w + q2;
        const int cur = tq2 >> 6;
        unsigned key[32];
#pragma unroll
        for (int i = 0; i < 32; ++i) {
            const int sb = sub + 8 * i;
            const float v = imp[w][q2][sb];
            unsigned u = (__float_as_uint(v) & 0x7FFFFF00u) | (unsigned)(255 - sb);
            if (sb == 0 || sb == cur || sb == cur - 1) u |= 0x80000000u;
            if (sb > cur) u = 0u;
            key[i] = u;
        }
#pragma unroll 1
        for (int round = 0; round < 16; ++round) {
            unsigned best = key[0];
#pragma unroll
            for (int i = 1; i < 32; ++i) best = best > key[i] ? best : key[i];
#pragma unroll
            for (int o = 1; o <= 4; o <<= 1) { const unsigned ob = (unsigned)__shfl_xor((int)best, o); best = best > ob ? best : ob; }
            if (sub == 0) sel[w][q2][round] = best ? (int)(255u - (best & 0xFFu)) : -1;
#pragma unroll
            for (int i = 0; i < 32; ++i) key[i] = (key[i] == best) ? 0u : key[i];
        }
    }
    for (int i = tid; i < 256; i += NTHREADS) masks[i] = 0u;
    __syncthreads();
    for (int e = lane; e < 128; e += 64) {
        const int q2 = e >> 4, bi = e & 15;
        const int blk = sel[w][q2][bi];
        if (blk >= 0) atomicOr(&masks[blk], 1u << (8 * w + q2));
    }
    __syncthreads();
    auto block_attend = [&](const NsaStage& st, int key0, bool colsel, bool window, float& m, float& l, f16v& oa, f16v& ob) __attribute__((always_inline)) {
        f16v s0 = qk32(st, 0), s1 = qk32(st, 1);
        const bool far = !window && (t0w - (key0 + 63)) >= 1513;
        if (far) {
            const float cb = colsel ? cfar : NEGF;
#pragma unroll
            for (int rr = 0; rr < 16; ++rr) { s0[rr] += cb; s1[rr] += cb; }
        } else {
#pragma unroll
            for (int rr = 0; rr < 16; ++rr) {
                const int pos = key0 + (rr & 3) + 8 * (rr >> 2) + 4 * hh;
                {
                    const int dist = tq - pos;
                    const bool valid = colsel && dist >= 0 && (!window || dist < 512);
                    const int di = dist < 0 ? 0 : (dist > LUTN - 1 ? LUTN - 1 : dist);
                    s0[rr] = valid ? s0[rr] + (float)lut[di * 4 + r] : NEGF;
                }
                {
                    const int dist = tq - pos - 32;
                    const bool valid = colsel && dist >= 0 && (!window || dist < 512);
                    const int di = dist < 0 ? 0 : (dist > LUTN - 1 ? LUTN - 1 : dist);
                    s1[rr] = valid ? s1[rr] + (float)lut[di * 4 + r] : NEGF;
                }
            }
        }
        float mx = s0[0];
#pragma unroll
        for (int rr = 1; rr < 16; ++rr) mx = fmaxf(mx, s0[rr]);
#pragma unroll
        for (int rr = 0; rr < 16; ++rr) mx = fmaxf(mx, s1[rr]);
        mx = fmaxf(mx, __shfl_xor(mx, 32));
        const float mn = fmaxf(m, mx);
        const float alpha = fast_exp2(m - mn);
        m = mn;
        float ps = 0.f;
#pragma unroll
        for (int rr = 0; rr < 16; ++rr) { s0[rr] = fast_exp2(s0[rr] - mn); ps += s0[rr]; }
#pragma unroll
        for (int rr = 0; rr < 16; ++rr) { s1[rr] = fast_exp2(s1[rr] - mn); ps += s1[rr]; }
        l = l * alpha + ps;
        if (__ballot(alpha != 1.0f)) {
#pragma unroll
            for (int i = 0; i < 16; ++i) { oa[i] *= alpha; ob[i] *= alpha; }
        }
        pv32(st, 0, s0, oa, ob);
        pv32(st, 1, s1, oa, ob);
    };
    {
        const half_t* KS = (const half_t*)(ws + OFF_KS) + (long)bg * SEQ * 64;
        const half_t* VST = (const half_t*)(ws + OFF_VST) + (long)bg * 64 * SEQ;
        f16v os0, os1;
#pragma unroll
        for (int i = 0; i < 16; ++i) { os0[i] = 0.f; os1[i] = 0.f; }
        float m = MINIT, l = 0.f;
        const int jmax = (t0 + 31) >> 6;
        int j = 0;
        while (j <= jmax && masks[j] == 0u) ++j;
        int buf = 0;
        if (j <= jmax) stage_gload(KS, VST, SEQ, j * 64, true);
#pragma unroll 1
        while (j <= jmax) {
            NsaStage& st = buf ? st1 : st0;
            stage_lstore(st, true);
            __syncthreads();
            int jn = j + 1;
            while (jn <= jmax && masks[jn] == 0u) ++jn;
            if (jn <= jmax) stage_gload(KS, VST, SEQ, jn * 64, true);
            const unsigned mk = masks[j];
            if ((mk >> (8 * w)) & 0xFFu) {
                const bool colsel = (mk >> (8 * w + qi)) & 1u;
                block_attend(st, j * 64, colsel, false, m, l, os0, os1);
            }
            buf ^= 1; j = jn;
        }
        const float lt = l + __shfl_xor(l, 32);
        const float sc = (lt > 0.f) ? g1 / lt : 0.f;
#pragma unroll
        for (int i = 0; i < 16; ++i) { of0[i] += sc * os0[i]; of1[i] += sc * os1[i]; }
    }
    __syncthreads();
    {
        const half_t* KW = (const half_t*)(ws + OFF_KW) + (long)bg * SEQ * 64;
        const half_t* VWT = (const half_t*)(ws + OFF_VWT) + (long)bg * 64 * SEQ;
        f16v ow0, ow1;
#pragma unroll
        for (int i = 0; i < 16; ++i) { ow0[i] = 0.f; ow1[i] = 0.f; }
        float m = MINIT, l = 0.f;
        const int jmax = (t0 + 31) >> 6;
        int j = (t0 >= 511) ? ((t0 - 511) >> 6) : 0;
        int buf = 0;
        stage_gload(KW, VWT, SEQ, j * 64, true);
#pragma unroll 1
        while (j <= jmax) {
            NsaStage& st = buf ? st1 : st0;
            stage_lstore(st, true);
            __syncthreads();
            if (j + 1 <= jmax) stage_gload(KW, VWT, SEQ, (j + 1) * 64, true);
            block_attend(st, j * 64, true, true, m, l, ow0, ow1);
            buf ^= 1; ++j;
        }
        const float lt = l + __shfl_xor(l, 32);
        const float sc = (lt > 0.f) ? g2 / lt : 0.f;
#pragma unroll
        for (int i = 0; i < 16; ++i) { of0[i] += sc * ow0[i]; of1[i] += sc * ow1[i]; }
    }
    {
        half_t* orow = (half_t*)(ws + OFF_MIXED) + (long)(b * SEQ + tq) * 1024 + (g * 4 + r) * 64;
#pragma unroll
        for (int md = 0; md < 2; ++md)
#pragma unroll
            for (int rg = 0; rg < 4; ++rg) {
                h4v o;
#pragma unroll
                for (int e = 0; e < 4; ++e) o[e] = (half_t)((md == 0) ? of0[4 * rg + e] : of1[4 * rg + e]);
                *(h4v*)(orow + 32 * md + 8 * rg + 4 * hh) = o;
            }
    }
    __syncthreads();
}

__device__ __forceinline__ void phase_attn(const Params& p, char* smem, int cidx = 0, int nlimit = 4096) {
    unsigned* ctr = (unsigned*)(p.ws + OFF_CTRL) + cidx;
    volatile int* s_item = (volatile int*)(smem + 66048);
    const int NMLA = 2048, NNSA = 2048;
    for (;;) {
        if (threadIdx.x == 0) *s_item = (int)atomicAdd(&ctr[0], 1u);
        __syncthreads();
        const int item = *s_item;
        __syncthreads();
        if (item >= NMLA + NNSA || item >= nlimit) break;
        if (item < NMLA) mla_item(p, item, smem);
        else nsa_item(p, item - NMLA, smem);
    }
}

__device__ __forceinline__ void phase_outproj(const Params& p, int bid, int nb, char* smem) {
    char* ws = p.ws;
    const half_t* MIX = (const half_t*)(ws + OFF_MIXED);
    const half_t* W = (const half_t*)(ws + OFF_WOUT);
    half_t* X2H = (half_t*)(ws + OFF_X2H);
    for (int tile = bid; tile < 256 * 8; tile += nb) {
        const int tm = tile >> 3, tn = tile & 7;
        const int row0 = tm * 128, n0 = tn * 128;
        gemm_tile<true>(MIX + (long)row0 * 1024, 1024, W + (long)n0 * 1024, 1024, 1024, 512, smem,
            [&](f4v (&acc)[4][4], int wm, int wn, int i16, int g4) __attribute__((always_inline)) {
#pragma unroll
                for (int mi = 0; mi < 4; ++mi)
#pragma unroll
                    for (int ni = 0; ni < 4; ++ni)
#pragma unroll
                        for (int r = 0; r < 4; ++r) {
                            const long row = row0 + wm * 64 + mi * 16 + g4 * 4 + r;
                            const int col = n0 + wn * 64 + ni * 16 + i16;
                            const float v = p.x[row * 1024 + col] + acc[mi][ni][r];
                            p.out[row * 1024 + col] = v;
                            X2H[row * 1024 + col] = (half_t)v;
                        }
            });
    }
}

__device__ __forceinline__ void phase_peerq(const Params& p, int bid, int nb, char* smem) {
    char* ws = p.ws;
    const half_t* X2H = (const half_t*)(ws + OFF_X2H);
    const half_t* W = (const half_t*)(ws + OFF_WPQ);
    half_t* QP = (half_t*)(ws + OFF_QP);
    for (int tile = bid; tile < 256 * 16; tile += nb) {
        const int tm = tile >> 4, tn = tile & 15;
        const int row0 = tm * 128, n0 = tn * 128;
        gemm_tile<true>(X2H + (long)row0 * 1024, 1024, W + (long)n0 * 1024, 1024, 1024, 1024, smem,
            [&](f4v (&acc)[4][4], int wm, int wn, int i16, int g4) __attribute__((always_inline)) {
#pragma unroll
                for (int mi = 0; mi < 4; ++mi)
#pragma unroll
                    for (int ni = 0; ni < 4; ++ni)
#pragma unroll
                        for (int r = 0; r < 4; ++r) {
                            const long row = row0 + wm * 64 + mi * 16 + g4 * 4 + r;
                            const int col = n0 + wn * 64 + ni * 16 + i16;
                            QP[row * 2048 + col] = (half_t)acc[mi][ni][r];
                        }
            });
    }
}

__device__ __forceinline__ void topk_insert(float (&tv)[16], int (&ti)[16], float v, int id) {
#pragma unroll
    for (int k = 0; k < 16; ++k) {
        const bool gt = v > tv[k];
        const float nv = gt ? tv[k] : v; const int ni = gt ? ti[k] : id;
        tv[k] = gt ? v : tv[k]; ti[k] = gt ? id : ti[k];
        v = nv; id = ni;
    }
}
__device__ __forceinline__ void route_half(const half_t* __restrict__ qsrc_h, const half_t* kb, float (&tv)[16], int (&ti)[16]) {
    h2v q[64];
    const h8v* qsrc = (const h8v*)qsrc_h;
#pragma unroll
    for (int i = 0; i < 16; ++i) {
        const h8v v = qsrc[i];
        q[4 * i] = (h2v){v[0], v[1]}; q[4 * i + 1] = (h2v){v[2], v[3]};
        q[4 * i + 2] = (h2v){v[4], v[5]}; q[4 * i + 3] = (h2v){v[6], v[7]};
    }
#pragma unroll
    for (int k = 0; k < 16; ++k) { tv[k] = -3.0e38f; ti[k] = 0; }
    for (int n = 0; n < 128; ++n) {
        float s = 0.f;
        const h8v* kr = (const h8v*)(kb + n * 128);
#pragma unroll
        for (int i = 0; i < 16; ++i) {
            const h8v kv = kr[i];
            s = __builtin_amdgcn_fdot2(q[4 * i], (h2v){kv[0], kv[1]}, s, false);
            s = __builtin_amdgcn_fdot2(q[4 * i + 1], (h2v){kv[2], kv[3]}, s, false);
            s = __builtin_amdgcn_fdot2(q[4 * i + 2], (h2v){kv[4], kv[5]}, s, false);
            s = __builtin_amdgcn_fdot2(q[4 * i + 3], (h2v){kv[6], kv[7]}, s, false);
        }
        topk_insert(tv, ti, s, n);
    }
}
__device__ __forceinline__ void phase_route(const Params& p, int bid, int nb, char* smem) {
    char* ws = p.ws;
    half_t* keys = (half_t*)smem;
    {
        const u4v* src = (const u4v*)(ws + OFF_KEYS);
        u4v* dst = (u4v*)smem;
        for (int i = threadIdx.x; i < 65536 / 16; i += NTHREADS) dst[i] = src[i];
    }
    __syncthreads();
    const half_t* QP = (const half_t*)(ws + OFF_QP);
    int* EID = (int*)(ws + OFF_EID);
    float* GW = (float*)(ws + OFF_GW);
    for (long th = (long)bid * NTHREADS + threadIdx.x; th < (long)NTOK * 8; th += (long)nb * NTHREADS) {
        float tv0[16], tv1[16]; int ti0[16], ti1[16];
        route_half(QP + th * 256, keys, tv0, ti0);
        route_half(QP + th * 256 + 128, keys + 16384, tv1, ti1);
        float fv[16]; int fi[16];
#pragma unroll
        for (int k = 0; k < 16; ++k) { fv[k] = -3.0e38f; fi[k] = 0; }
#pragma unroll
        for (int i = 0; i < 16; ++i)
#pragma unroll
            for (int j = 0; j < 16; ++j)
                if ((i + 1) * (j + 1) <= 16) topk_insert(fv, fi, tv0[i] + tv1[j], ti0[i] * 128 + ti1[j]);
        float sum = 0.f, ex[16];
#pragma unroll
        for (int k = 0; k < 16; ++k) { ex[k] = __expf(fv[k] - fv[0]); sum += ex[k]; }
        const float inv = 1.0f / sum;
#pragma unroll
        for (int k = 0; k < 16; ++k) { EID[th * 16 + k] = fi[k]; GW[th * 16 + k] = ex[k] * inv; }
    }
}

__device__ __forceinline__ void phase_experts(const Params& p, int bid, int nb) {
    char* ws = p.ws;
    const half_t* U = (const half_t*)(ws + OFF_U16);
    const half_t* V = (const half_t*)(ws + OFF_V16);
    const int* EID = (const int*)(ws + OFF_EID);
    const float* GW = (const float*)(ws + OFF_GW);
    const int lane = threadIdx.x & 63;
    const long wv = ((long)bid * NTHREADS + threadIdx.x) >> 6, nwv = ((long)nb * NTHREADS) >> 6;
    for (long t = wv; t < NTOK; t += nwv) {
        float* xr = p.out + t * 1024;
        float xv[16];
        {
            const float4 a0 = *(const float4*)(xr + 8 * lane), a1 = *(const float4*)(xr + 8 * lane + 4);
            const float4 b0 = *(const float4*)(xr + 512 + 8 * lane), b1 = *(const float4*)(xr + 512 + 8 * lane + 4);
            xv[0] = a0.x; xv[1] = a0.y; xv[2] = a0.z; xv[3] = a0.w; xv[4] = a1.x; xv[5] = a1.y; xv[6] = a1.z; xv[7] = a1.w;
            xv[8] = b0.x; xv[9] = b0.y; xv[10] = b0.z; xv[11] = b0.w; xv[12] = b1.x; xv[13] = b1.y; xv[14] = b1.z; xv[15] = b1.w;
        }
        float ss = 0.f;
#pragma unroll
        for (int i = 0; i < 16; ++i) ss += xv[i] * xv[i];
        ss = wave_sum(ss);
        const float rs = rsqrtf(ss * (1.0f / 1024.f) + EPS);
        float hv[16];
#pragma unroll
        for (int i = 0; i < 16; ++i) {
            const int col = (i < 8) ? (8 * lane + i) : (512 + 8 * lane + i - 8);
            hv[i] = xv[i] * rs * p.norm2_g[col];
        }
        const int e0 = EID[t * 128 + lane], e1 = EID[t * 128 + 64 + lane];
        const float w0 = GW[t * 128 + lane], w1 = GW[t * 128 + 64 + lane];
        float acc[16];
#pragma unroll
        for (int i = 0; i < 16; ++i) acc[i] = 0.f;
        for (int j = 0; j < 128; j += 4) {
            int ee[4]; float gw[4]; float dot[4];
            h8v ua[4], ub[4];
#pragma unroll
            for (int q = 0; q < 4; ++q) {
                const int jj = j + q;
                ee[q] = (jj < 64) ? __builtin_amdgcn_readlane(e0, jj & 63) : __builtin_amdgcn_readlane(e1, jj & 63);
                gw[q] = (jj < 64) ? __builtin_bit_cast(float, __builtin_amdgcn_readlane(__builtin_bit_cast(int, w0), jj & 63))
                                  : __builtin_bit_cast(float, __builtin_amdgcn_readlane(__builtin_bit_cast(int, w1), jj & 63));
                const half_t* ur = U + (long)ee[q] * 1024;
                ua[q] = *(const h8v*)(ur + 8 * lane); ub[q] = *(const h8v*)(ur + 512 + 8 * lane);
            }
#pragma unroll
            for (int q = 0; q < 4; ++q) {
                float d = 0.f;
#pragma unroll
                for (int i = 0; i < 8; ++i) d += hv[i] * (float)ua[q][i] + hv[8 + i] * (float)ub[q][i];
                dot[q] = wave_sum(d);
            }
#pragma unroll
            for (int q = 0; q < 4; ++q) {
                const float coef = gw[q] * gelu_exact(dot[q]);
                const half_t* vr = V + (long)ee[q] * 1024;
                const h8v va = *(const h8v*)(vr + 8 * lane), vb = *(const h8v*)(vr + 512 + 8 * lane);
#pragma unroll
                for (int i = 0; i < 8; ++i) { acc[i] += coef * (float)va[i]; acc[8 + i] += coef * (float)vb[i]; }
            }
        }
        float s3 = 0.f;
#pragma unroll
        for (int i = 0; i < 16; ++i) { acc[i] += xv[i]; s3 += acc[i] * acc[i]; }
        s3 = wave_sum(s3);
        const float rf = rsqrtf(s3 * (1.0f / 1024.f) + EPS);
        float o[16];
#pragma unroll
        for (int i = 0; i < 16; ++i) {
            const int col = (i < 8) ? (8 * lane + i) : (512 + 8 * lane + i - 8);
            o[i] = acc[i] * rf * p.final_g[col];
        }
        *(float4*)(xr + 8 * lane) = make_float4(o[0], o[1], o[2], o[3]);
        *(float4*)(xr + 8 * lane + 4) = make_float4(o[4], o[5], o[6], o[7]);
        *(float4*)(xr + 512 + 8 * lane) = make_float4(o[8], o[9], o[10], o[11]);
        *(float4*)(xr + 512 + 8 * lane + 4) = make_float4(o[12], o[13], o[14], o[15]);
    }
}

template <int PH>
__global__ void __launch_bounds__(NTHREADS, 2) phase_kernel(Params p) {
    extern __shared__ __attribute__((aligned(16))) char smem[];
    const int bid = blockIdx.x, nb = gridDim.x;
    if (PH == 0) phase_prep(p, bid, nb);
    if (PH == 1) phase_inproj(p, bid, nb, smem);
    if (PH == 2) phase_p2(p, bid, nb, smem);
    if (PH == 3) phase_cmp2(p, bid, nb);
    if (PH == 4) phase_attn(p, smem);
    if (PH == 5) phase_outproj(p, bid, nb, smem);
    if (PH == 6) phase_peerq(p, bid, nb, smem);
    if (PH == 7) phase_route(p, bid, nb, smem);
    if (PH == 8) phase_experts(p, bid, nb);
}

#ifndef PROBE_PHASE
#define PROBE_PHASE -1
#endif
__global__ void __launch_bounds__(NTHREADS, 2) mega_kernel(Params p) {
    extern __shared__ __attribute__((aligned(16))) char smem[];
    cg::grid_group grid = cg::this_grid();
    const int bid = blockIdx.x, nb = gridDim.x;
    phase_prep(p, bid, nb); grid.sync();
    if (PROBE_PHASE == 0) { phase_prep(p, bid, nb); grid.sync(); }
    phase_inproj(p, bid, nb, smem); grid.sync();
    if (PROBE_PHASE == 1) { phase_inproj(p, bid, nb, smem); grid.sync(); }
    phase_p2(p, bid, nb, smem); grid.sync();
    if (PROBE_PHASE == 2) { phase_p2(p, bid, nb, smem); grid.sync(); }
    phase_cmp2(p, bid, nb); grid.sync();
    phase_attn(p, smem, 0); grid.sync();
    if (PROBE_PHASE == 3) { phase_attn(p, smem, 1); grid.sync(); }
    if (PROBE_PHASE == 9) { phase_attn(p, smem, 1, 2048); grid.sync(); }
    phase_outproj(p, bid, nb, smem); grid.sync();
    if (PROBE_PHASE == 4) { phase_outproj(p, bid, nb, smem); grid.sync(); }
    phase_peerq(p, bid, nb, smem); grid.sync();
    if (PROBE_PHASE == 5) { phase_peerq(p, bid, nb, smem); grid.sync(); }
    phase_route(p, bid, nb, smem); grid.sync();
    if (PROBE_PHASE == 6) { phase_route(p, bid, nb, smem); grid.sync(); }
    if (PROBE_PHASE == 8) { grid.sync(); grid.sync(); grid.sync(); grid.sync(); grid.sync(); grid.sync(); grid.sync(); grid.sync(); }
    phase_experts(p, bid, nb);
}

extern "C" void kernel_launch(void* const* d_in, const int* in_sizes, int n_in, void* d_out, int out_size, void* d_ws, size_t ws_size, hipStream_t stream) {
    (void)in_sizes; (void)n_in; (void)out_size;
    if (ws_size < WS_NEED) { fprintf(stderr, "kernel_launch: workspace too small (%zu < %zu)\n", ws_size, (size_t)WS_NEED); return; }
    Params p{};
    p.x = (const float*)d_in[0]; p.pos = (const int*)d_in[1]; p.norm1_g = (const float*)d_in[2]; p.w_in = (const float*)d_in[3];
    p.cmp_pos = (const float*)d_in[4]; p.cmp_k_w1 = (const float*)d_in[5]; p.cmp_k_w2 = (const float*)d_in[6];
    p.cmp_v_w1 = (const float*)d_in[7]; p.cmp_v_w2 = (const float*)d_in[8]; p.t5_bias = (const float*)d_in[9];
    p.q_norm_g = (const float*)d_in[10]; p.w_q_up = (const float*)d_in[11]; p.kv_norm_g = (const float*)d_in[12]; p.w_kv_up = (const float*)d_in[13];
    p.grp_norm_nsa = (const float*)d_in[14]; p.grp_norm_mla = (const float*)d_in[15]; p.w_out = (const float*)d_in[16]; p.norm2_g = (const float*)d_in[17];
    p.peer_wq = (const float*)d_in[18]; p.peer_keys1 = (const float*)d_in[19]; p.peer_keys2 = (const float*)d_in[20];
    p.peer_u = (const float*)d_in[21]; p.peer_v = (const float*)d_in[22]; p.final_g = (const float*)d_in[23];
    p.out = (float*)d_out; p.ws = (char*)d_ws;
#if MULTI_LAUNCH
    const int G = 512;
    phase_kernel<0><<<G, NTHREADS, 0, stream>>>(p);
    phase_kernel<1><<<G, NTHREADS, 0, stream>>>(p);
    phase_kernel<2><<<G, NTHREADS, 0, stream>>>(p);
    phase_kernel<3><<<G, NTHREADS, 0, stream>>>(p);
    phase_kernel<4><<<G, NTHREADS, 0, stream>>>(p);
    phase_kernel<5><<<G, NTHREADS, 0, stream>>>(p);
    phase_kernel<6><<<G, NTHREADS, 0, stream>>>(p);
    phase_kernel<7><<<G, NTHREADS, 0, stream>>>(p);
    phase_kernel<8><<<G, NTHREADS, 0, stream>>>(p);
#else
    static int grid_blocks = 0;
    if (!grid_blocks) {
        int dev = 0, cus = 0, per_cu = 0;
        hipGetDevice(&dev);
        hipDeviceGetAttribute(&cus, hipDeviceAttributeMultiprocessorCount, dev);
        hipFuncSetAttribute((const void*)mega_kernel, hipFuncAttributeMaxDynamicSharedMemorySize, SMEM_BYTES);
        hipOccupancyMaxActiveBlocksPerMultiprocessor(&per_cu, mega_kernel, NTHREADS, SMEM_BYTES);
        if (per_cu > 2) per_cu = 2;
        grid_blocks = cus * per_cu;
    }
    void* args[] = {&p};
    hipError_t e = hipLaunchCooperativeKernel((void*)mega_kernel, dim3(grid_blocks), dim3(NTHREADS), args, SMEM_BYTES, stream);
    if (e != hipSuccess) fprintf(stderr, "cooperative launch failed: %s (grid %d)\n", hipGetErrorString(e), grid_blocks);
#endif
}
```

```cpp
#include <hip/hip_runtime.h>
#include <hip/hip_cooperative_groups.h>
#include <cstdio>
#include <cstdint>
namespace cg = cooperative_groups;

#ifndef MULTI_LAUNCH
#define MULTI_LAUNCH 0
#endif

typedef _Float16 half_t;
typedef _Float16 h2v __attribute__((ext_vector_type(2)));
typedef _Float16 h4v __attribute__((ext_vector_type(4)));
typedef _Float16 h8v __attribute__((ext_vector_type(8)));
typedef float f4v __attribute__((ext_vector_type(4)));
typedef unsigned u4v __attribute__((ext_vector_type(4)));
typedef unsigned u2v __attribute__((ext_vector_type(2)));
typedef float f16v __attribute__((ext_vector_type(16)));

constexpr int BATCH = 2, SEQ = 16384, DM = 1024, NTOK = BATCH * SEQ;
constexpr int NIN = 1720, NINP = 1792;
constexpr int NCMP = 1023, NCMPP = 1024;
constexpr float EPS = 1e-6f;
constexpr float LOG2E = 1.4426950408889634f;
constexpr float QS_NSA = 0.125f * LOG2E;
constexpr float QS_MLA = 0.10206207261596575f * LOG2E;
constexpr float NEGF = -1e30f;
constexpr int LUTN = 1536;
constexpr float USCALE = 128.0f, VSCALE = 16.0f;

constexpr size_t al256(size_t x) { return (x + 255) & ~(size_t)255; }
constexpr size_t OFF_CTRL = 0;
constexpr size_t OFF_LUT = 4096;
constexpr size_t OFF_CB = OFF_LUT + 2 * LUTN * 4 * 4;
constexpr size_t OFF_WIN = 65536;
constexpr size_t OFF_WQUP = OFF_WIN + (size_t)NINP * 1024 * 2;
constexpr size_t OFF_WKVUP = OFF_WQUP + 768 * 256 * 2;
constexpr size_t OFF_WC1 = OFF_WKVUP + 1024 * 128 * 2;
constexpr size_t OFF_WOUT = OFF_WC1 + 2 * 256 * 2048 * 2;
constexpr size_t OFF_WPQ = OFF_WOUT + 1024 * 1024 * 2;
constexpr size_t OFF_KEYS = OFF_WPQ + 2048 * 1024 * 2;
constexpr size_t OFF_U16 = al256(OFF_KEYS + 2 * 128 * 128 * 2);
constexpr size_t OFF_V16 = OFF_U16 + (size_t)16384 * 1024 * 2;
constexpr size_t OFF_H1 = OFF_V16 + (size_t)16384 * 1024 * 2;
constexpr size_t OFF_MIXED = OFF_H1;
constexpr size_t OFF_QH = OFF_H1 + (size_t)NTOK * 1024 * 2;
constexpr size_t SZ_KV = (size_t)2 * 2 * SEQ * 64 * 2;
constexpr size_t OFF_KC = OFF_QH + (size_t)NTOK * 512 * 2;
constexpr size_t OFF_VC = OFF_KC + SZ_KV;
constexpr size_t OFF_KS = OFF_VC + SZ_KV;
constexpr size_t OFF_VST = OFF_KS + SZ_KV;
constexpr size_t OFF_KW = OFF_VST + SZ_KV;
constexpr size_t OFF_VWT = OFF_KW + SZ_KV;
constexpr size_t OFF_GATES = OFF_VWT + SZ_KV;
constexpr size_t OFF_CQ = OFF_GATES + (size_t)NTOK * 24 * 4;
constexpr size_t OFF_CKV = OFF_CQ + (size_t)NTOK * 256 * 2;
constexpr size_t OFF_X2H = OFF_QH;
constexpr size_t OFF_QM = OFF_CKV + (size_t)NTOK * 128 * 2;
constexpr size_t OFF_KM = OFF_QM + (size_t)NTOK * 8 * 96 * 2;
constexpr size_t OFF_VT = OFF_KM + (size_t)NTOK * 8 * 96 * 2;
constexpr size_t OFF_QP = OFF_QM;
constexpr size_t OFF_PD = OFF_QM;
constexpr size_t OFF_COEF = OFF_H1;
constexpr size_t OFF_SSQ = OFF_H1 + (size_t)NTOK * 128 * 4;
constexpr size_t OFF_HC1 = OFF_VT + (size_t)NTOK * 8 * 64 * 2;
constexpr size_t OFF_KCMP = OFF_HC1 + (size_t)8 * 1024 * 256 * 2;
constexpr size_t OFF_VCMPT = OFF_KCMP + (size_t)4 * 1024 * 64 * 2;
constexpr size_t OFF_EID = OFF_VCMPT + (size_t)4 * 1024 * 64 * 2;
constexpr size_t OFF_GW = OFF_EID + (size_t)NTOK * 128 * 4;
constexpr size_t OFF_BAR = OFF_GW + (size_t)NTOK * 128 * 4;
constexpr size_t WS_NEED = OFF_BAR + 16384;

struct Params {
    const float* x; const int* pos; const float* norm1_g; const float* w_in; const float* cmp_pos;
    const float* cmp_k_w1; const float* cmp_k_w2; const float* cmp_v_w1; const float* cmp_v_w2; const float* t5_bias;
    const float* q_norm_g; const float* w_q_up; const float* kv_norm_g; const float* w_kv_up;
    const float* grp_norm_nsa; const float* grp_norm_mla; const float* w_out; const float* norm2_g;
    const float* peer_wq; const float* peer_keys1; const float* peer_keys2; const float* peer_u; const float* peer_v; const float* final_g;
    float* out; char* ws;
};

constexpr int SMEM_BYTES = 66560;
constexpr int NTHREADS = 256;

__device__ __forceinline__ f4v mfma16(h8v a, h8v b, f4v c) { return __builtin_amdgcn_mfma_f32_16x16x32_f16(a, b, c, 0, 0, 0); }
__device__ __forceinline__ f16v mfma32(h8v a, h8v b, f16v c) { return __builtin_amdgcn_mfma_f32_32x32x16_f16(a, b, c, 0, 0, 0); }
__device__ __forceinline__ float wave_sum(float v) {
#pragma unroll
    for (int o = 32; o >= 1; o >>= 1) v += __shfl_xor(v, o);
    return v;
}
__device__ __forceinline__ float gelu_exact(float v) { return 0.5f * v * (1.0f + erff(v * 0.70710678118654752f)); }
__device__ __forceinline__ float fast_exp2(float v) { return __builtin_amdgcn_exp2f(v); }
__device__ __forceinline__ int t5_bucket(int d) {
    if (d < 16) return d < 0 ? 0 : d;
    int b = 16;
    b += (d >= 22); b += (d >= 30); b += (d >= 40); b += (d >= 54); b += (d >= 73); b += (d >= 99); b += (d >= 134); b += (d >= 182);
    b += (d >= 246); b += (d >= 332); b += (d >= 450); b += (d >= 609); b += (d >= 825); b += (d >= 1117); b += (d >= 1513);
    return b;
}

__device__ __forceinline__ unsigned xb_xcc_id();

__device__ __forceinline__ void phase_prep(const Params& p, int bid, int nb) {
    int tx_ = threadIdx.x; asm volatile("" : "+v"(tx_));
    const long tid = (long)bid * NTHREADS + tx_;
    const long nth = (long)nb * NTHREADS;
    char* ws = p.ws;
    if (tid < 1024) ((unsigned*)(ws + OFF_CTRL))[tid] = 0u;
    {
        float* lut = (float*)(ws + OFF_LUT);
        for (long e = tid; e < 2 * LUTN * 4; e += nth) {
            int r = e & 3, d = (e >> 2) % LUTN, g = (int)(e / (4 * LUTN));
            lut[e] = p.t5_bias[t5_bucket(d) * 8 + g * 4 + r] * LOG2E;
        }
    }
    {
        float* cb = (float*)(ws + OFF_CB);
        for (long e = tid; e < 512; e += nth) {
            int kv = (int)(e >> 8), n = (int)(e & 255);
            const float* w1 = kv ? p.cmp_v_w1 : p.cmp_k_w1;
            float s = 0.f;
            for (int k = 0; k < 2048; ++k) s += p.cmp_pos[k] * w1[(long)k * 256 + n];
            cb[e] = s;
        }
    }
    {
        half_t* W = (half_t*)(ws + OFF_WIN);
        for (long e = tid; e < (long)NINP * 1024; e += nth) {
            int k = (int)(e / NINP), n = (int)(e % NINP);
            int src;
            if (n < 1280) src = n;
            else if (n < 1536) src = 1304 + (n - 1280);
            else if (n < 1664) src = 1560 + (n - 1536);
            else if (n < 1696) src = 1688 + (n - 1664);
            else if (n < 1720) src = 1280 + (n - 1696);
            else src = -1;
            float v = src >= 0 ? p.w_in[(long)k * NIN + src] : 0.f;
            W[(long)n * 1024 + k] = (half_t)v;
        }
    }
    {
        half_t* W = (half_t*)(ws + OFF_WQUP);
        for (long e = tid; e < 768 * 256; e += nth) {
            int k = (int)(e / 768), n = (int)(e % 768);
            W[(long)n * 256 + k] = (half_t)(p.w_q_up[e] * p.q_norm_g[k]);
        }
    }
    {
        half_t* W = (half_t*)(ws + OFF_WKVUP);
        for (long e = tid; e < 1024 * 128; e += nth) {
            int k = (int)(e / 1024), n = (int)(e % 1024);
            W[(long)n * 128 + k] = (half_t)(p.w_kv_up[e] * p.kv_norm_g[k]);
        }
    }
    {
        half_t* W = (half_t*)(ws + OFF_WC1);
        for (long e = tid; e < 2L * 2048 * 256; e += nth) {
            int kv = (int)(e / (2048 * 256)); long r = e % (2048 * 256);
            int k = (int)(r / 256), n = (int)(r % 256);
            const float* w1 = kv ? p.cmp_v_w1 : p.cmp_k_w1;
            W[((long)kv * 256 + n) * 2048 + k] = (half_t)w1[r];
        }
    }
    {
        half_t* W = (half_t*)(ws + OFF_WOUT);
        for (long e = tid; e < 1024L * 1024; e += nth) {
            int k = (int)(e >> 10), n = (int)(e & 1023);
            float g = k < 512 ? p.grp_norm_nsa[k] : p.grp_norm_mla[k - 512];
            W[(long)n * 1024 + k] = (half_t)(p.w_out[e] * g);
        }
    }
    {
        half_t* W = (half_t*)(ws + OFF_WPQ);
        for (long e = tid; e < 1024L * 2048; e += nth) {
            int k = (int)(e >> 11), n = (int)(e & 2047);
            W[(long)n * 1024 + k] = (half_t)(p.peer_wq[e] * p.norm2_g[k]);
        }
    }
    {
        half_t* W = (half_t*)(ws + OFF_KEYS);
        for (long e = tid; e < 2 * 16384; e += nth) {
            W[e] = (half_t)(e < 16384 ? p.peer_keys1[e] : p.peer_keys2[e - 16384]);
        }
    }
    {
        unsigned* U8 = (unsigned*)(ws + OFF_U16);
        unsigned* V8 = (unsigned*)(ws + OFF_V16);
        const long n4 = 16384L * 256;
        for (long e4 = tid; e4 < n4; e4 += nth) {
            const int e = (int)(e4 >> 8), d = (int)(e4 & 255) * 4, x = d >> 7, dd = d & 127;
            const float4 a = ((const float4*)p.peer_u)[e4];
            const float4 b = ((const float4*)p.peer_v)[e4];
            int pa = __builtin_amdgcn_cvt_pk_fp8_f32(a.x * USCALE, a.y * USCALE, 0, false);
            pa = __builtin_amdgcn_cvt_pk_fp8_f32(a.z * USCALE, a.w * USCALE, pa, true);
            int pb = __builtin_amdgcn_cvt_pk_fp8_f32(b.x * VSCALE, b.y * VSCALE, 0, false);
            pb = __builtin_amdgcn_cvt_pk_fp8_f32(b.z * VSCALE, b.w * VSCALE, pb, true);
            const long o = (((long)x * 16384 + e) * 128 + dd) >> 2;
            U8[o] = (unsigned)pa; V8[o] = (unsigned)pb;
        }
    }
    {
        half_t* H1 = (half_t*)(ws + OFF_H1);
        const int lane = threadIdx.x & 63;
        const long wv = tid >> 6, nwv = nth >> 6;
        for (long row = wv; row < NTOK; row += nwv) {
            const float4* xr = (const float4*)(p.x + row * 1024);
            float4 v[4]; float ss = 0.f;
#pragma unroll
            for (int i = 0; i < 4; ++i) { v[i] = xr[lane + 64 * i]; ss += v[i].x * v[i].x + v[i].y * v[i].y + v[i].z * v[i].z + v[i].w * v[i].w; }
            ss = wave_sum(ss);
            const float rs = rsqrtf(ss * (1.0f / 1024.f) + EPS);
#pragma unroll
            for (int i = 0; i < 4; ++i) {
                float4 g = ((const float4*)p.norm1_g)[lane + 64 * i];
                h4v o = {(half_t)(v[i].x * rs * g.x), (half_t)(v[i].y * rs * g.y), (half_t)(v[i].z * rs * g.z), (half_t)(v[i].w * rs * g.w)};
                ((h4v*)(H1 + row * 1024))[lane + 64 * i] = o;
            }
        }
    }
}

struct GemmSmem { half_t A[128][72]; half_t Bt[128][72]; float rs[2][128]; };

template <bool SCALE, class Epi>
__device__ __forceinline__ void gemm_tile(const half_t* __restrict__ A, long lda, const half_t* __restrict__ Bt, long ldb, int K, int ksplit, char* smem_raw, Epi epi) {
    GemmSmem& sm = *(GemmSmem*)smem_raw;
    const int tid = threadIdx.x, lane = tid & 63, w = tid >> 6, wm = w >> 1, wn = w & 1;
    const int i16 = lane & 15, g4 = lane >> 4;
    const int lr = tid >> 3, off = tid & 7;
    if (SCALE) {
        const int row = tid >> 1, part = tid & 1;
        for (int range = 0; range < 2; ++range) {
            const int kb = range ? ksplit : 0, ke = range ? K : ksplit;
            const int L = ke - kb;
            if (L <= 0) continue;
            const int hl = L >> 1;
            const half_t* ap = A + (long)row * lda + kb + part * hl;
            float ss = 0.f;
            for (int k = 0; k < hl; k += 8) {
                h8v v = *(const h8v*)(ap + k);
#pragma unroll
                for (int j = 0; j < 8; ++j) { float f = (float)v[j]; ss += f * f; }
            }
            ss += __shfl_xor(ss, 1);
            if (part == 0) sm.rs[range][row] = rsqrtf(ss / (float)L + EPS);
        }
        __syncthreads();
    }
    f4v acc[4][4];
#pragma unroll
    for (int a = 0; a < 4; ++a)
#pragma unroll
        for (int b = 0; b < 4; ++b) acc[a][b] = (f4v){0.f, 0.f, 0.f, 0.f};
    u4v ra[4], rb[4];
    const int nk = K >> 6;
#pragma unroll
    for (int i = 0; i < 4; ++i) {
        ra[i] = *(const u4v*)(A + (long)(lr + 32 * i) * lda + off * 8);
        rb[i] = *(const u4v*)(Bt + (long)(lr + 32 * i) * ldb + off * 8);
    }
    for (int kt = 0; kt < nk; ++kt) {
#pragma unroll
        for (int i = 0; i < 4; ++i) {
            u4v va = ra[i];
            if (SCALE) {
                const float rs = sm.rs[(kt * 64 >= ksplit) ? 1 : 0][lr + 32 * i];
                h8v hv = __builtin_bit_cast(h8v, va);
#pragma unroll
                for (int j = 0; j < 8; ++j) hv[j] = (half_t)((float)hv[j] * rs);
                va = __builtin_bit_cast(u4v, hv);
            }
            *(u4v*)&sm.A[lr + 32 * i][off * 8] = va;
            *(u4v*)&sm.Bt[lr + 32 * i][off * 8] = rb[i];
        }
        __syncthreads();
        if (kt + 1 < nk) {
            const int k0 = (kt + 1) * 64;
#pragma unroll
            for (int i = 0; i < 4; ++i) {
                ra[i] = *(const u4v*)(A + (long)(lr + 32 * i) * lda + k0 + off * 8);
                rb[i] = *(const u4v*)(Bt + (long)(lr + 32 * i) * ldb + k0 + off * 8);
            }
        }
#pragma unroll
        for (int kk = 0; kk < 2; ++kk) {
            h8v af[4], bf[4];
#pragma unroll
            for (int mi = 0; mi < 4; ++mi) af[mi] = *(const h8v*)&sm.A[wm * 64 + mi * 16 + i16][kk * 32 + g4 * 8];
#pragma unroll
            for (int ni = 0; ni < 4; ++ni) bf[ni] = *(const h8v*)&sm.Bt[wn * 64 + ni * 16 + i16][kk * 32 + g4 * 8];
#pragma unroll
            for (int mi = 0; mi < 4; ++mi)
#pragma unroll
                for (int ni = 0; ni < 4; ++ni) acc[mi][ni] = mfma16(af[mi], bf[ni], acc[mi][ni]);
        }
        __syncthreads();
    }
    epi(acc, wm, wn, i16, g4);
}

__device__ __forceinline__ void rope_pair(float x1, float x2, int pos, int i, float& o1, float& o2) {
    const float inv = __builtin_amdgcn_exp2f(-(float)i * (13.287712379549449f / 16.0f));
    double t = (double)pos * (double)inv * 0.15915494309189535;
    t -= __builtin_rint(t);
    const float fr = (float)t;
    const float sn = __builtin_amdgcn_sinf(fr), cs = __builtin_amdgcn_cosf(fr);
    o1 = x1 * cs - x2 * sn; o2 = x1 * sn + x2 * cs;
}

__device__ __forceinline__ void phase_inproj(const Params& p, int bid, int nb, char* smem) {
    char* ws = p.ws;
    const half_t* H1 = (const half_t*)(ws + OFF_H1);
    const half_t* W = (const half_t*)(ws + OFF_WIN);
    half_t* QH = (half_t*)(ws + OFF_QH);
    half_t* KM = (half_t*)(ws + OFF_KM);
    half_t* CQ = (half_t*)(ws + OFF_CQ);
    half_t* CKV = (half_t*)(ws + OFF_CKV);
    float* GATES = (float*)(ws + OFF_GATES);
    const int NT_N = NINP / 128, NT_M = NTOK / 128;
    for (int tile = bid; tile < NT_M * NT_N; tile += nb) {
        const int tm = tile / NT_N, tn = tile % NT_N;
        const int row0 = tm * 128, n0 = tn * 128;
        gemm_tile<false>(H1 + (long)row0 * 1024, 1024, W + (long)n0 * 1024, 1024, 1024, 1024, smem,
            [&](f4v (&acc)[4][4], int wm, int wn, int i16, int g4) __attribute__((always_inline)) {
#pragma unroll
                for (int ni = 0; ni < 4; ++ni) {
                    const int cb = n0 + wn * 64 + ni * 16;
                    const int col = cb + i16;
#pragma unroll
                    for (int mi = 0; mi < 4; ++mi) {
                        const int rbase = row0 + wm * 64 + mi * 16 + g4 * 4;
                        const int b = rbase >> 14, s0 = rbase & (SEQ - 1);
                        if (cb < 512) {
#pragma unroll
                            for (int r = 0; r < 4; ++r) QH[(long)(rbase + r) * 512 + col] = (half_t)(acc[mi][ni][r] * QS_NSA);
                        } else if (cb < 1280) {
                            const int which = (cb - 512) >> 7;
                            const int c = (col - 512) & 127, gg = c >> 6, d = c & 63;
                            half_t* base = (half_t*)(ws + OFF_KC + (size_t)which * SZ_KV);
                            if (which == 3 || which == 5) {
                                h4v o = {(half_t)acc[mi][ni][0], (half_t)acc[mi][ni][1], (half_t)acc[mi][ni][2], (half_t)acc[mi][ni][3]};
                                *(h4v*)(base + ((long)((b * 2 + gg) * 64 + d)) * SEQ + s0) = o;
                            } else {
#pragma unroll
                                for (int r = 0; r < 4; ++r) base[((long)(b * 2 + gg) * SEQ + s0 + r) * 64 + d] = (half_t)acc[mi][ni][r];
                            }
                        } else if (cb < 1536) {
#pragma unroll
                            for (int r = 0; r < 4; ++r) CQ[(long)(rbase + r) * 256 + (col - 1280)] = (half_t)acc[mi][ni][r];
                        } else if (cb < 1664) {
#pragma unroll
                            for (int r = 0; r < 4; ++r) CKV[(long)(rbase + r) * 128 + (col - 1536)] = (half_t)acc[mi][ni][r];
                        } else if (cb == 1664) {
#pragma unroll
                            for (int r = 0; r < 4; ++r) {
                                float o1, o2;
                                rope_pair(acc[mi][ni][r], acc[mi][(ni + 1) & 3][r], p.pos[rbase + r], i16, o1, o2);
#pragma unroll
                                for (int h = 0; h < 8; ++h) {
                                    half_t* kr = KM + ((long)(b * 8 + h) * SEQ + s0 + r) * 96 + 64;
                                    kr[i16] = (half_t)o1; kr[16 + i16] = (half_t)o2;
                                }
                            }
                        } else if (cb >= 1696) {
                            if (col < 1720) {
#pragma unroll
                                for (int r = 0; r < 4; ++r) GATES[(long)(rbase + r) * 24 + (col - 1696)] = 1.0f / (1.0f + __expf(-acc[mi][ni][r]));
                            }
                        }
                    }
                }
            });
    }
}

__device__ __forceinline__ void phase_p2(const Params& p, int bid, int nb, char* smem) {
    char* ws = p.ws;
    const int NTA = 256 * 6, NTB = 256 * 8, NTC = 128;
    for (int tile = bid; tile < NTA + NTB + NTC; tile += nb) {
        if (tile < NTC) {
            const int nt = tile & 1, mt = (tile >> 1) & 7, bg = (tile >> 4) & 3, kv = tile >> 6;
            const half_t* A = (const half_t*)(ws + (kv ? OFF_VC : OFF_KC)) + (long)bg * SEQ * 64 + (long)mt * 128 * 1024;
            const half_t* Bt = (const half_t*)(ws + OFF_WC1) + ((long)kv * 256 + nt * 128) * 2048;
            const float* cbv = (const float*)(ws + OFF_CB) + kv * 256;
            half_t* HC = (half_t*)(ws + OFF_HC1) + ((long)(kv * 4 + bg) * 1024) * 256;
            gemm_tile<false>(A, 1024, Bt, 2048, 2048, 2048, smem,
                [&](f4v (&acc)[4][4], int wm, int wn, int i16, int g4) __attribute__((always_inline)) {
#pragma unroll
                    for (int ni = 0; ni < 4; ++ni) {
                        const int n = nt * 128 + wn * 64 + ni * 16 + i16;
                        const float bias = cbv[n];
#pragma unroll
                        for (int mi = 0; mi < 4; ++mi)
#pragma unroll
                            for (int r = 0; r < 4; ++r) {
                                const int m = mt * 128 + wm * 64 + mi * 16 + g4 * 4 + r;
                                if (m < NCMP) HC[(long)m * 256 + n] = (half_t)gelu_exact(acc[mi][ni][r] + bias);
                            }
                    }
                });
        } else if (tile < NTC + NTA) {
            const int t2 = tile - NTC;
            const int tm = t2 / 6, tn = t2 % 6;
            const int row0 = tm * 128, n0 = tn * 128;
            half_t* QM = (half_t*)(ws + OFF_QM);
            gemm_tile<true>((const half_t*)(ws + OFF_CQ) + (long)row0 * 256, 256, (const half_t*)(ws + OFF_WQUP) + (long)n0 * 256, 256, 256, 256, smem,
                [&](f4v (&acc)[4][4], int wm, int wn, int i16, int g4) __attribute__((always_inline)) {
#pragma unroll
                    for (int ni = 0; ni < 4; ++ni) {
                        const int cb = n0 + wn * 64 + ni * 16;
                        const int h = cb / 96, d0 = cb - h * 96;
#pragma unroll
                        for (int mi = 0; mi < 4; ++mi) {
                            const int rbase = row0 + wm * 64 + mi * 16 + g4 * 4;
                            const int b = rbase >> 14, s0 = rbase & (SEQ - 1);
#pragma unroll
                            for (int r = 0; r < 4; ++r) {
                                half_t* qr = QM + ((long)(b * 8 + h) * SEQ + s0 + r) * 96;
                                if (d0 < 64) qr[d0 + i16] = (half_t)(acc[mi][ni][r] * QS_MLA);
                                else if (d0 == 64) {
                                    float o1, o2;
                                    rope_pair(acc[mi][ni][r] * QS_MLA, acc[mi][(ni + 1) & 3][r] * QS_MLA, p.pos[rbase + r], i16, o1, o2);
                                    qr[64 + i16] = (half_t)o1; qr[80 + i16] = (half_t)o2;
                                }
                            }
                        }
                    }
                });
        } else {
            const int t2 = tile - NTC - NTA;
            const int tm = t2 >> 3, tn = t2 & 7;
            const int row0 = tm * 128, n0 = tn * 128;
            half_t* KM = (half_t*)(ws + OFF_KM);
            half_t* VT = (half_t*)(ws + OFF_VT);
            gemm_tile<true>((const half_t*)(ws + OFF_CKV) + (long)row0 * 128, 128, (const half_t*)(ws + OFF_WKVUP) + (long)n0 * 128, 128, 128, 128, smem,
                [&](f4v (&acc)[4][4], int wm, int wn, int i16, int g4) __attribute__((always_inline)) {
                    const int h = tn;
#pragma unroll
                    for (int ni = 0; ni < 4; ++ni) {
                        const int d0 = wn * 64 + ni * 16;
#pragma unroll
                        for (int mi = 0; mi < 4; ++mi) {
                            const int rbase = row0 + wm * 64 + mi * 16 + g4 * 4;
                            const int b = rbase >> 14, s0 = rbase & (SEQ - 1);
                            if (d0 < 64) {
#pragma unroll
                                for (int r = 0; r < 4; ++r) KM[((long)(b * 8 + h) * SEQ + s0 + r) * 96 + d0 + i16] = (half_t)acc[mi][ni][r];
                            } else {
                                h4v o = {(half_t)acc[mi][ni][0], (half_t)acc[mi][ni][1], (half_t)acc[mi][ni][2], (half_t)acc[mi][ni][3]};
                                *(h4v*)(VT + ((long)(b * 8 + h) * 64 + (d0 - 64 + i16)) * SEQ + s0) = o;
                            }
                        }
                    }
                });
        }
    }
}

__device__ __forceinline__ void phase_cmp2(const Params& p, int bid, int nb) {
    char* ws = p.ws;
    const long tid = (long)bid * NTHREADS + threadIdx.x, nth = (long)nb * NTHREADS;
    const half_t* HC = (const half_t*)(ws + OFF_HC1);
    half_t* KC = (half_t*)(ws + OFF_KCMP);
    half_t* VCT = (half_t*)(ws + OFF_VCMPT);
    for (long e = tid; e < 2L * 4 * 1024 * 64; e += nth) {
        const int d = (int)(e & 63), n = (int)((e >> 6) & 1023), bg = (int)((e >> 16) & 3), kv = (int)(e >> 18);
        float s = 0.f;
        if (n < NCMP) {
            const half_t* hr = HC + ((long)(kv * 4 + bg) * 1024 + n) * 256;
            const float* w2 = kv ? p.cmp_v_w2 : p.cmp_k_w2;
            for (int j = 0; j < 256; ++j) s += (float)hr[j] * w2[j * 64 + d];
        }
        if (kv == 0) KC[((long)bg * 1024 + n) * 64 + d] = (half_t)s;
        else VCT[((long)bg * 64 + d) * 1024 + n] = (half_t)s;
    }
}

struct MlaSmem { half_t K[2][64][104]; half_t V[2][64][68]; };

__device__ __forceinline__ void mla_item(const Params& p, int bh, int qb, char* smem) {
    MlaSmem& sm = *(MlaSmem*)smem;
    char* ws = p.ws;
    const int b = bh >> 3, h = bh & 7;
    const half_t* Qp = (const half_t*)(ws + OFF_QM) + ((long)bh * SEQ + qb * 128) * 96;
    const half_t* Kp = (const half_t*)(ws + OFF_KM) + (long)bh * SEQ * 96;
    const half_t* Vp = (const half_t*)(ws + OFF_VT) + (long)bh * 64 * SEQ;
    half_t* MIX = (half_t*)(ws + OFF_MIXED);
    int tid_ = threadIdx.x; asm volatile("" : "+v"(tid_));
    const int tid = tid_, lane = tid & 63, w = tid >> 6;
    const int c = lane & 31, hh = lane >> 5;
    const int tq = qb * 128 + w * 32 + c;
    h8v qf[6];
#pragma unroll
    for (int s6 = 0; s6 < 6; ++s6) qf[s6] = *(const h8v*)(Qp + (long)(w * 32 + c) * 96 + s6 * 16 + hh * 8);
    f16v o0, o1;
#pragma unroll
    for (int i = 0; i < 16; ++i) { o0[i] = 0.f; o1[i] = 0.f; }
    float m = NEGF, l = 0.f;
    const int ntiles = 2 * qb + 2;
    u4v rk[3]; u2v rv[4];
    auto gload = [&](int j) {
#pragma unroll
        for (int i = 0; i < 3; ++i) {
            const int ci = tid + 256 * i, key = ci / 12, of = ci % 12;
            rk[i] = *(const u4v*)(Kp + (long)(j * 64 + key) * 96 + of * 8);
        }
#pragma unroll
        for (int i = 0; i < 2; ++i) {
            const int ci = tid + 256 * i, dim = ci >> 3, of = ci & 7;
            const u4v v = *(const u4v*)(Vp + (long)dim * SEQ + j * 64 + of * 8);
            rv[2 * i] = (u2v){v.x, v.y}; rv[2 * i + 1] = (u2v){v.z, v.w};
        }
    };
    auto lstore = [&](int buf) {
#pragma unroll
        for (int i = 0; i < 3; ++i) {
            const int ci = tid + 256 * i, key = ci / 12, of = ci % 12;
            *(u4v*)&sm.K[buf][key][of * 8] = rk[i];
        }
#pragma unroll
        for (int i = 0; i < 2; ++i) {
            const int ci = tid + 256 * i, dim = ci >> 3, of = ci & 7;
            *(u2v*)&sm.V[buf][dim][of * 8] = rv[2 * i];
            *(u2v*)&sm.V[buf][dim][of * 8 + 4] = rv[2 * i + 1];
        }
    };
    gload(0);
    lstore(0);
    __syncthreads();
#pragma unroll 1
    for (int j = 0; j < ntiles; ++j) {
        const int buf = j & 1;
        if (j + 1 < ntiles) gload(j + 1);
        const int qmin = qb * 128 + w * 32;
        if (64 * j <= qmin + 31) {
            f16v s0, s1;
#pragma unroll
            for (int i = 0; i < 16; ++i) { s0[i] = 0.f; s1[i] = 0.f; }
#pragma unroll
            for (int s6 = 0; s6 < 6; ++s6) {
                const h8v a0 = *(const h8v*)&sm.K[buf][c][s6 * 16 + hh * 8];
                const h8v a1 = *(const h8v*)&sm.K[buf][32 + c][s6 * 16 + hh * 8];
                s0 = mfma32(a0, qf[s6], s0);
                s1 = mfma32(a1, qf[s6], s1);
            }
            if (64 * j + 63 > qmin) {
#pragma unroll
                for (int r = 0; r < 16; ++r) {
                    const int key = 64 * j + (r & 3) + 8 * (r >> 2) + 4 * hh;
                    if (key > tq) s0[r] = NEGF;
                    if (key + 32 > tq) s1[r] = NEGF;
                }
            }
            float mx = s0[0];
#pragma unroll
            for (int r = 1; r < 16; ++r) mx = fmaxf(mx, s0[r]);
#pragma unroll
            for (int r = 0; r < 16; ++r) mx = fmaxf(mx, s1[r]);
            mx = fmaxf(mx, __shfl_xor(mx, 32));
            const float mn = fmaxf(m, mx);
            const float alpha = fast_exp2(m - mn);
            m = mn;
            float ps = 0.f;
#pragma unroll
            for (int r = 0; r < 16; ++r) { s0[r] = fast_exp2(s0[r] - mn); ps += s0[r]; }
#pragma unroll
            for (int r = 0; r < 16; ++r) { s1[r] = fast_exp2(s1[r] - mn); ps += s1[r]; }
            l = l * alpha + ps;
#pragma unroll
            for (int i = 0; i < 16; ++i) { o0[i] *= alpha; o1[i] *= alpha; }
#pragma unroll
            for (int ks = 0; ks < 4; ++ks) {
                h8v pb;
#pragma unroll
                for (int jj = 0; jj < 8; ++jj) pb[jj] = (half_t)((ks < 2) ? s0[8 * (ks & 1) + jj] : s1[8 * (ks & 1) + jj]);
#pragma unroll
                for (int md = 0; md < 2; ++md) {
                    const h4v lo = *(const h4v*)&sm.V[buf][32 * md + c][16 * ks + 4 * hh];
                    const h4v hi = *(const h4v*)&sm.V[buf][32 * md + c][16 * ks + 8 + 4 * hh];
                    const h8v a = {lo[0], lo[1], lo[2], lo[3], hi[0], hi[1], hi[2], hi[3]};
                    if (md == 0) o0 = mfma32(a, pb, o0); else o1 = mfma32(a, pb, o1);
                }
            }
        }
        if (j + 1 < ntiles) lstore(buf ^ 1);
        __syncthreads();
    }
    const float lt = l + __shfl_xor(l, 32);
    const float inv = 1.0f / lt;
    half_t* orow = MIX + (long)(b * SEQ + tq) * 1024 + 512 + h * 64;
#pragma unroll
    for (int md = 0; md < 2; ++md)
#pragma unroll
        for (int rg = 0; rg < 4; ++rg) {
            h4v o;
#pragma unroll
            for (int e = 0; e < 4; ++e) o[e] = (half_t)(((md == 0) ? o0[4 * rg + e] : o1[4 * rg + e]) * inv);
            *(h4v*)(orow + 32 * md + 8 * rg + 4 * hh) = o;
        }
}

struct NsaStage { half_t K[64][72]; half_t V[64][68]; };
constexpr int NSA_LUT = 0;
constexpr int NSA_ST0 = 12288;
constexpr int NSA_RB = NSA_ST0 + 17920;
constexpr int NSA_SEL = NSA_RB + 32768;
constexpr int NSA_MASK = NSA_SEL + 2048;
constexpr int NSA_END = NSA_MASK + 1024;
constexpr float MINIT = -30000.0f;

__device__ __forceinline__ void nsa_item(const Params& p, int bg, int qt, char* smem) {
    char* ws = p.ws;
    half_t* lut = (half_t*)(smem + NSA_LUT);
    float (*imp)[8][256] = (float (*)[8][256])(smem + NSA_RB);
    int (*sel)[8][16] = (int (*)[8][16])(smem + NSA_SEL);
    unsigned* masks = (unsigned*)(smem + NSA_MASK);
    const int b = bg >> 1, g = bg & 1;
    int tid_ = threadIdx.x; asm volatile("" : "+v"(tid_));
    const int tid = tid_, lane = tid & 63, w = tid >> 6;
    const int c = lane & 31, hh = lane >> 5;
    const int qi = c >> 2, r = c & 3;
    const int t0 = qt * 32;
    const int t0w = t0 + w * 8;
    const int tq = t0w + qi;
    const int tlast = t0w + 7;
    {
        const float* lg = (const float*)(ws + OFF_LUT) + (long)g * LUTN * 4;
        for (int i = tid; i < LUTN * 4; i += NTHREADS) lut[i] = (half_t)lg[i];
        float* im = &imp[0][0][0];
        for (int i = tid; i < 4 * 8 * 256; i += NTHREADS) im[i] = 0.f;
    }
    __syncthreads();
    const float cfar = (float)lut[(LUTN - 1) * 4 + r];
    const half_t* QH = (const half_t*)(ws + OFF_QH);
    h8v qf[4];
#pragma unroll
    for (int s4 = 0; s4 < 4; ++s4) qf[s4] = *(const h8v*)(QH + (long)(b * SEQ + tq) * 512 + (g * 4 + r) * 64 + s4 * 16 + hh * 8);
    const float* gp = (const float*)(ws + OFF_GATES) + (long)(b * SEQ + tq) * 24 + (g * 4 + r) * 3;
    const float g0 = gp[0], g1 = gp[1], g2 = gp[2];
    f16v of0, of1;
#pragma unroll
    for (int i = 0; i < 16; ++i) { of0[i] = 0.f; of1[i] = 0.f; }

    u4v rk[2], rvv[2];
    auto stage_gload = [&](const half_t* Kg, const half_t* Vg, long ldv, int key0, bool withv) __attribute__((always_inline)) {
#pragma unroll
        for (int i = 0; i < 2; ++i) {
            const int ci = tid + 256 * i, row = ci >> 3, of = ci & 7;
            rk[i] = *(const u4v*)(Kg + (long)(key0 + row) * 64 + of * 8);
            if (withv) rvv[i] = *(const u4v*)(Vg + (long)row * ldv + key0 + of * 8);
        }
    };
    auto stage_lstore = [&](NsaStage& st, bool withv) __attribute__((always_inline)) {
#pragma unroll
        for (int i = 0; i < 2; ++i) {
            const int ci = tid + 256 * i, row = ci >> 3, of = ci & 7;
            *(u4v*)&st.K[row][of * 8] = rk[i];
            if (withv) {
                *(u2v*)&st.V[row][of * 8] = (u2v){rvv[i][0], rvv[i][1]};
                *(u2v*)&st.V[row][of * 8 + 4] = (u2v){rvv[i][2], rvv[i][3]};
            }
        }
    };
    auto qk32 = [&](const NsaStage& st, int mt) __attribute__((always_inline)) -> f16v {
        f16v s;
#pragma unroll
        for (int i = 0; i < 16; ++i) s[i] = 0.f;
#pragma unroll
        for (int s4 = 0; s4 < 4; ++s4) {
            const h8v a = *(const h8v*)&st.K[32 * mt + c][s4 * 16 + hh * 8];
            s = mfma32(a, qf[s4], s);
        }
        return s;
    };
    auto pv32 = [&](const NsaStage& st, int mt, const f16v& pr, f16v& oa, f16v& ob) __attribute__((always_inline)) {
#pragma unroll
        for (int ks = 0; ks < 2; ++ks) {
            h8v pb;
#pragma unroll
            for (int jj = 0; jj < 8; ++jj) pb[jj] = (half_t)pr[8 * ks + jj];
#pragma unroll
            for (int md = 0; md < 2; ++md) {
                const h4v lo = *(const h4v*)&st.V[32 * md + c][32 * mt + 16 * ks + 4 * hh];
                const h4v hi = *(const h4v*)&st.V[32 * md + c][32 * mt + 16 * ks + 8 + 4 * hh];
                const h8v a = {lo[0], lo[1], lo[2], lo[3], hi[0], hi[1], hi[2], hi[3]};
                if (md == 0) oa = mfma32(a, pb, oa); else ob = mfma32(a, pb, ob);
            }
        }
    };
    NsaStage& st0 = *(NsaStage*)(smem + NSA_ST0);
    NsaStage& st1 = *(NsaStage*)(smem + NSA_RB);

    {
        const half_t* KC = (const half_t*)(ws + OFF_KCMP) + (long)bg * 1024 * 64;
        const half_t* VCT = (const half_t*)(ws + OFF_VCMPT) + (long)bg * 64 * 1024;
        const int nst = ((t0 >> 4) >> 6) + 1;
        auto cmp_scores = [&](f16v& s, int kbase) __attribute__((always_inline)) {
            const bool far = (t0w - (16 * (kbase + 31) + 31)) >= 1513;
            if (far) {
#pragma unroll
                for (int rr = 0; rr < 16; ++rr) s[rr] += cfar;
            } else {
#pragma unroll
                for (int rr = 0; rr < 16; ++rr) {
                    const int k = kbase + (rr & 3) + 8 * (rr >> 2) + 4 * hh;
                    const int dist = tq - (16 * k + 31);
                    const int di = dist < 0 ? 0 : (dist > LUTN - 1 ? LUTN - 1 : dist);
                    s[rr] = (dist >= 0) ? s[rr] + (float)lut[di * 4 + r] : NEGF;
                }
            }
        };
        float m = MINIT, l = 0.f;
        stage_gload(KC, VCT, 1024, 0, false);
#pragma unroll 1
        for (int sg = 0; sg < nst; ++sg) {
            stage_lstore(st0, false);
            __syncthreads();
            if (sg + 1 < nst) stage_gload(KC, VCT, 1024, (sg + 1) * 64, false);
#pragma unroll
            for (int mt = 0; mt < 2; ++mt) {
                const int kbase = sg * 64 + mt * 32;
                if (16 * kbase + 31 <= tlast) {
                    f16v s = qk32(st0, mt);
                    cmp_scores(s, kbase);
                    float mx = s[0];
#pragma unroll
                    for (int rr = 1; rr < 16; ++rr) mx = fmaxf(mx, s[rr]);
                    const float mn = fmaxf(m, mx);
                    float ps = 0.f;
#pragma unroll
                    for (int rr = 0; rr < 16; ++rr) ps += fast_exp2(s[rr] - mn);
                    l = l * fast_exp2(m - mn) + ps;
                    m = mn;
                }
            }
            __syncthreads();
        }
        {
            const float mo = __shfl_xor(m, 32), lo = __shfl_xor(l, 32);
            const float mt_ = fmaxf(m, mo);
            l = l * fast_exp2(m - mt_) + lo * fast_exp2(mo - mt_);
            m = mt_;
        }
        const float ml2 = (l > 0.f) ? m + __builtin_amdgcn_logf(l) : 1e30f;
        f16v oc0, oc1;
#pragma unroll
        for (int i = 0; i < 16; ++i) { oc0[i] = 0.f; oc1[i] = 0.f; }
        float carryL = 0.f;
        stage_gload(KC, VCT, 1024, 0, true);
#pragma unroll 1
        for (int sg = 0; sg < nst; ++sg) {
            stage_lstore(st0, true);
            __syncthreads();
            if (sg + 1 < nst) stage_gload(KC, VCT, 1024, (sg + 1) * 64, true);
#pragma unroll
            for (int mt = 0; mt < 2; ++mt) {
                const int kbase = sg * 64 + mt * 32;
                const int kt = sg * 2 + mt;
                if (16 * kbase + 31 <= tlast) {
                    f16v s = qk32(st0, mt);
                    cmp_scores(s, kbase);
#pragma unroll
                    for (int rr = 0; rr < 16; ++rr) s[rr] = fast_exp2(s[rr] - ml2);
                    float Gs[4], Ls[4];
#pragma unroll
                    for (int jg = 0; jg < 4; ++jg) {
                        float G = s[4 * jg] + s[4 * jg + 1] + s[4 * jg + 2] + s[4 * jg + 3];
                        float L = s[4 * jg + 3];
                        G += __shfl_xor(G, 1); G += __shfl_xor(G, 2);
                        L += __shfl_xor(L, 1); L += __shfl_xor(L, 2);
                        Gs[jg] = G; Ls[jg] = L;
                    }
                    float Lo[4];
#pragma unroll
                    for (int jg = 0; jg < 4; ++jg) Lo[jg] = __shfl_xor(Ls[jg], 32);
                    if (r == 0) {
#pragma unroll
                        for (int jg = 0; jg < 4; ++jg) {
                            const float prevL = hh ? Lo[jg] : (jg == 0 ? carryL : Lo[jg - 1]);
                            imp[w][qi][8 * kt + 2 * jg + hh] = Gs[jg] + prevL;
                        }
                    }
                    carryL = Lo[3];
                    pv32(st0, mt, s, oc0, oc1);
                }
            }
            __syncthreads();
        }
#pragma unroll
        for (int i = 0; i < 16; ++i) { of0[i] += g0 * oc0[i]; of1[i] += g0 * oc1[i]; }
    }
    {
        const int q2 = lane >> 3, sub = lane & 7;
        const int tq2 = t0w + q2;
        const int cur = tq2 >> 6;
        unsigned key[32];
#pragma unroll
        for (int i = 0; i < 32; ++i) {
            const int sb = sub + 8 * i;
            const float v = imp[w][q2][sb];
            unsigned u = (__float_as_uint(v) & 0x7FFFFF00u) | (unsigned)(255 - sb);
            if (sb == 0 || sb == cur || sb == cur - 1) u |= 0x80000000u;
            if (sb > cur) u = 0u;
            key[i] = u;
        }
#pragma unroll 1
        for (int round = 0; round < 16; ++round) {
            unsigned best = key[0];
#pragma unroll
            for (int i = 1; i < 32; ++i) best = best > key[i] ? best : key[i];
#pragma unroll
            for (int o = 1; o <= 4; o <<= 1) { const unsigned ob = (unsigned)__shfl_xor((int)best, o); best = best > ob ? best : ob; }
            if (sub == 0) sel[w][q2][round] = best ? (int)(255u - (best & 0xFFu)) : -1;
#pragma unroll
            for (int i = 0; i < 32; ++i) key[i] = (key[i] == best) ? 0u : key[i];
        }
    }
    for (int i = tid; i < 256; i += NTHREADS) masks[i] = 0u;
    __syncthreads();
    for (int e = lane; e < 128; e += 64) {
        const int q2 = e >> 4, bi = e & 15;
        const int blk = sel[w][q2][bi];
        if (blk >= 0) atomicOr(&masks[blk], 1u << (8 * w + q2));
    }
    __syncthreads();
    auto block_attend = [&](const NsaStage& st, int key0, bool colsel, bool window, float& m, float& l, f16v& oa, f16v& ob) __attribute__((always_inline)) {
        f16v s0 = qk32(st, 0), s1 = qk32(st, 1);
        const bool far = !window && (t0w - (key0 + 63)) >= 1513;
        if (far) {
            const float cb = colsel ? cfar : NEGF;
#pragma unroll
            for (int rr = 0; rr < 16; ++rr) { s0[rr] += cb; s1[rr] += cb; }
        } else {
#pragma unroll
            for (int rr = 0; rr < 16; ++rr) {
                const int pos = key0 + (rr & 3) + 8 * (rr >> 2) + 4 * hh;
                {
                    const int dist = tq - pos;
                    const bool valid = colsel && dist >= 0 && (!window || dist < 512);
                    const int di = dist < 0 ? 0 : (dist > LUTN - 1 ? LUTN - 1 : dist);
                    s0[rr] = valid ? s0[rr] + (float)lut[di * 4 + r] : NEGF;
                }
                {
                    const int dist = tq - pos - 32;
                    const bool valid = colsel && dist >= 0 && (!window || dist < 512);
                    const int di = dist < 0 ? 0 : (dist > LUTN - 1 ? LUTN - 1 : dist);
                    s1[rr] = valid ? s1[rr] + (float)lut[di * 4 + r] : NEGF;
                }
            }
        }
        float mx = s0[0];
#pragma unroll
        for (int rr = 1; rr < 16; ++rr) mx = fmaxf(mx, s0[rr]);
#pragma unroll
        for (int rr = 0; rr < 16; ++rr) mx = fmaxf(mx, s1[rr]);
        mx = fmaxf(mx, __shfl_xor(mx, 32));
        const float mn = fmaxf(m, mx);
        const float alpha = fast_exp2(m - mn);
        m = mn;
        float ps = 0.f;
#pragma unroll
        for (int rr = 0; rr < 16; ++rr) { s0[rr] = fast_exp2(s0[rr] - mn); ps += s0[rr]; }
#pragma unroll
        for (int rr = 0; rr < 16; ++rr) { s1[rr] = fast_exp2(s1[rr] - mn); ps += s1[rr]; }
        l = l * alpha + ps;
        if (__ballot(alpha != 1.0f)) {
#pragma unroll
            for (int i = 0; i < 16; ++i) { oa[i] *= alpha; ob[i] *= alpha; }
        }
        pv32(st, 0, s0, oa, ob);
        pv32(st, 1, s1, oa, ob);
    };
    {
        const half_t* KS = (const half_t*)(ws + OFF_KS) + (long)bg * SEQ * 64;
        const half_t* VST = (const half_t*)(ws + OFF_VST) + (long)bg * 64 * SEQ;
        f16v os0, os1;
#pragma unroll
        for (int i = 0; i < 16; ++i) { os0[i] = 0.f; os1[i] = 0.f; }
        float m = MINIT, l = 0.f;
        const int jmax = (t0 + 31) >> 6;
        int j = 0;
        while (j <= jmax && masks[j] == 0u) ++j;
        int buf = 0;
        if (j <= jmax) stage_gload(KS, VST, SEQ, j * 64, true);
#pragma unroll 1
        while (j <= jmax) {
            NsaStage& st = buf ? st1 : st0;
            stage_lstore(st, true);
            __syncthreads();
            int jn = j + 1;
            while (jn <= jmax && masks[jn] == 0u) ++jn;
            if (jn <= jmax) stage_gload(KS, VST, SEQ, jn * 64, true);
            const unsigned mk = masks[j];
            if ((mk >> (8 * w)) & 0xFFu) {
                const bool colsel = (mk >> (8 * w + qi)) & 1u;
                block_attend(st, j * 64, colsel, false, m, l, os0, os1);
            }
            buf ^= 1; j = jn;
        }
        const float lt = l + __shfl_xor(l, 32);
        const float sc = (lt > 0.f) ? g1 / lt : 0.f;
#pragma unroll
        for (int i = 0; i < 16; ++i) { of0[i] += sc * os0[i]; of1[i] += sc * os1[i]; }
    }
    __syncthreads();
    {
        const half_t* KW = (const half_t*)(ws + OFF_KW) + (long)bg * SEQ * 64;
        const half_t* VWT = (const half_t*)(ws + OFF_VWT) + (long)bg * 64 * SEQ;
        f16v ow0, ow1;
#pragma unroll
        for (int i = 0; i < 16; ++i) { ow0[i] = 0.f; ow1[i] = 0.f; }
        float m = MINIT, l = 0.f;
        const int jmax = (t0 + 31) >> 6;
        int j = (t0 >= 511) ? ((t0 - 511) >> 6) : 0;
        int buf = 0;
        stage_gload(KW, VWT, SEQ, j * 64, true);
#pragma unroll 1
        while (j <= jmax) {
            NsaStage& st = buf ? st1 : st0;
            stage_lstore(st, true);
            __syncthreads();
            if (j + 1 <= jmax) stage_gload(KW, VWT, SEQ, (j + 1) * 64, true);
            block_attend(st, j * 64, true, true, m, l, ow0, ow1);
            buf ^= 1; ++j;
        }
        const float lt = l + __shfl_xor(l, 32);
        const float sc = (lt > 0.f) ? g2 / lt : 0.f;
#pragma unroll
        for (int i = 0; i < 16; ++i) { of0[i] += sc * ow0[i]; of1[i] += sc * ow1[i]; }
    }
    {
        half_t* orow = (half_t*)(ws + OFF_MIXED) + (long)(b * SEQ + tq) * 1024 + (g * 4 + r) * 64;
#pragma unroll
        for (int md = 0; md < 2; ++md)
#pragma unroll
            for (int rg = 0; rg < 4; ++rg) {
                h4v o;
#pragma unroll
                for (int e = 0; e < 4; ++e) o[e] = (half_t)((md == 0) ? of0[4 * rg + e] : of1[4 * rg + e]);
                *(h4v*)(orow + 32 * md + 8 * rg + 4 * hh) = o;
            }
    }
    __syncthreads();
}

__device__ __forceinline__ void phase_attn(const Params& p, char* smem, int cidx = 64, int mode = 0) {
    unsigned* ctr = (unsigned*)(p.ws + OFF_CTRL) + cidx;
    volatile int* s_item = (volatile int*)(smem + 66048);
    const int x0 = (int)(xb_xcc_id() & 7u);
    const int lo = (mode == 2) ? 256 : 0, hi = (mode == 1) ? 256 : 512;
    for (int k = 0; k < 8; ++k) {
        const int q = (x0 + k) & 7;
        for (;;) {
            if (threadIdx.x == 0) {
                int v = -1;
                if (__hip_atomic_load(&ctr[q], __ATOMIC_RELAXED, __HIP_MEMORY_SCOPE_AGENT) < (unsigned)(hi - lo)) v = (int)atomicAdd(&ctr[q], 1u) + lo;
                *s_item = v;
            }
            __syncthreads();
            const int li = *s_item;
            __syncthreads();
            if (li < 0 || li >= hi) break;
            if (li < 256) mla_item(p, 2 * q + (li & 1), 127 - (li >> 1), smem);
            else nsa_item(p, q & 3, 511 - 2 * (li - 256) - (q >> 2), smem);
        }
    }
}

__device__ __forceinline__ void phase_outproj(const Params& p, int bid, int nb, char* smem) {
    char* ws = p.ws;
    const half_t* MIX = (const half_t*)(ws + OFF_MIXED);
    const half_t* W = (const half_t*)(ws + OFF_WOUT);
    half_t* X2H = (half_t*)(ws + OFF_X2H);
    for (int tile = bid; tile < 256 * 8; tile += nb) {
        const int tm = tile >> 3, tn = tile & 7;
        const int row0 = tm * 128, n0 = tn * 128;
        gemm_tile<true>(MIX + (long)row0 * 1024, 1024, W + (long)n0 * 1024, 1024, 1024, 512, smem,
            [&](f4v (&acc)[4][4], int wm, int wn, int i16, int g4) __attribute__((always_inline)) {
#pragma unroll
                for (int mi = 0; mi < 4; ++mi)
#pragma unroll
                    for (int ni = 0; ni < 4; ++ni)
#pragma unroll
                        for (int r = 0; r < 4; ++r) {
                            const long row = row0 + wm * 64 + mi * 16 + g4 * 4 + r;
                            const int col = n0 + wn * 64 + ni * 16 + i16;
                            const float v = p.x[row * 1024 + col] + acc[mi][ni][r];
                            p.out[row * 1024 + col] = v;
                            X2H[row * 1024 + col] = (half_t)v;
                        }
            });
    }
}

__device__ __forceinline__ void phase_peerq(const Params& p, int bid, int nb, char* smem) {
    char* ws = p.ws;
    const half_t* X2H = (const half_t*)(ws + OFF_X2H);
    const half_t* W = (const half_t*)(ws + OFF_WPQ);
    half_t* QP = (half_t*)(ws + OFF_QP);
    for (int tile = bid; tile < 256 * 16; tile += nb) {
        const int tm = tile >> 4, tn = tile & 15;
        const int row0 = tm * 128, n0 = tn * 128;
        gemm_tile<true>(X2H + (long)row0 * 1024, 1024, W + (long)n0 * 1024, 1024, 1024, 1024, smem,
            [&](f4v (&acc)[4][4], int wm, int wn, int i16, int g4) __attribute__((always_inline)) {
#pragma unroll
                for (int mi = 0; mi < 4; ++mi)
#pragma unroll
                    for (int ni = 0; ni < 4; ++ni)
#pragma unroll
                        for (int r = 0; r < 4; ++r) {
                            const long row = row0 + wm * 64 + mi * 16 + g4 * 4 + r;
                            const int col = n0 + wn * 64 + ni * 16 + i16;
                            QP[row * 2048 + col] = (half_t)acc[mi][ni][r];
                        }
            });
    }
}

__device__ __forceinline__ void topk_insert(float (&tv)[16], int (&ti)[16], float v, int id) {
#pragma unroll
    for (int k = 0; k < 16; ++k) {
        const bool gt = v > tv[k];
        const float nv = gt ? tv[k] : v; const int ni = gt ? ti[k] : id;
        tv[k] = gt ? v : tv[k]; ti[k] = gt ? id : ti[k];
        v = nv; id = ni;
    }
}
__device__ __forceinline__ void route_half(const half_t* __restrict__ qsrc_h, const half_t* kb, float (&tv)[16], int (&ti)[16]) {
    h2v q[64];
    const h8v* qsrc = (const h8v*)qsrc_h;
#pragma unroll
    for (int i = 0; i < 16; ++i) {
        const h8v v = qsrc[i];
        q[4 * i] = (h2v){v[0], v[1]}; q[4 * i + 1] = (h2v){v[2], v[3]};
        q[4 * i + 2] = (h2v){v[4], v[5]}; q[4 * i + 3] = (h2v){v[6], v[7]};
    }
#pragma unroll
    for (int k = 0; k < 16; ++k) { tv[k] = -3.0e38f; ti[k] = 0; }
    for (int n = 0; n < 128; ++n) {
        float s = 0.f;
        const h8v* kr = (const h8v*)(kb + n * 128);
#pragma unroll
        for (int i = 0; i < 16; ++i) {
            const h8v kv = kr[i];
            s = __builtin_amdgcn_fdot2(q[4 * i], (h2v){kv[0], kv[1]}, s, false);
            s = __builtin_amdgcn_fdot2(q[4 * i + 1], (h2v){kv[2], kv[3]}, s, false);
            s = __builtin_amdgcn_fdot2(q[4 * i + 2], (h2v){kv[4], kv[5]}, s, false);
            s = __builtin_amdgcn_fdot2(q[4 * i + 3], (h2v){kv[6], kv[7]}, s, false);
        }
        topk_insert(tv, ti, s, n);
    }
}
__device__ __forceinline__ void phase_route(const Params& p, int bid, int nb, char* smem) {
    char* ws = p.ws;
    half_t* keys = (half_t*)smem;
    {
        const u4v* src = (const u4v*)(ws + OFF_KEYS);
        u4v* dst = (u4v*)smem;
        for (int i = threadIdx.x; i < 65536 / 16; i += NTHREADS) dst[i] = src[i];
    }
    __syncthreads();
    const half_t* QP = (const half_t*)(ws + OFF_QP);
    int* EID = (int*)(ws + OFF_EID);
    float* GW = (float*)(ws + OFF_GW);
    for (long th = (long)bid * NTHREADS + threadIdx.x; th < (long)NTOK * 8; th += (long)nb * NTHREADS) {
        float tv0[16], tv1[16]; int ti0[16], ti1[16];
        route_half(QP + th * 256, keys, tv0, ti0);
        route_half(QP + th * 256 + 128, keys + 16384, tv1, ti1);
        float fv[16]; int fi[16];
#pragma unroll
        for (int k = 0; k < 16; ++k) { fv[k] = -3.0e38f; fi[k] = 0; }
#pragma unroll
        for (int i = 0; i < 16; ++i)
#pragma unroll
            for (int j = 0; j < 16; ++j)
                if ((i + 1) * (j + 1) <= 16) topk_insert(fv, fi, tv0[i] + tv1[j], ti0[i] * 128 + ti1[j]);
        float sum = 0.f, ex[16];
#pragma unroll
        for (int k = 0; k < 16; ++k) { ex[k] = __expf(fv[k] - fv[0]); sum += ex[k]; }
        const float inv = 1.0f / sum;
#pragma unroll
        for (int k = 0; k < 16; ++k) { EID[th * 16 + k] = fi[k]; GW[th * 16 + k] = ex[k] * inv; }
    }
}

__device__ __forceinline__ float red8(float v) {
    v += __builtin_bit_cast(float, __builtin_amdgcn_update_dpp(0, __builtin_bit_cast(int, v), 0xB1, 0xF, 0xF, true));
    v += __builtin_bit_cast(float, __builtin_amdgcn_update_dpp(0, __builtin_bit_cast(int, v), 0x4E, 0xF, 0xF, true));
    v += __builtin_bit_cast(float, __builtin_amdgcn_update_dpp(0, __builtin_bit_cast(int, v), 0x141, 0xF, 0xF, true));
    return v;
}
__device__ __forceinline__ int peer_next_task(unsigned* q, int xpref, int ntask_per_slice, volatile int* s_task) {
    if (threadIdx.x == 0) {
        int res = -1;
        for (int k = 0; k < 8; ++k) {
            const int x = (xpref + k) & 7;
            if (__hip_atomic_load(&q[x], __ATOMIC_RELAXED, __HIP_MEMORY_SCOPE_AGENT) >= (unsigned)ntask_per_slice) continue;
            const unsigned c = atomicAdd(&q[x], 1u);
            if (c < (unsigned)ntask_per_slice) { res = x * ntask_per_slice + (int)c; break; }
        }
        *s_task = res;
    }
    __syncthreads();
    const int r = *s_task;
    __syncthreads();
    return r;
}
template <int PMODE>
__device__ __forceinline__ void phase_peer_udot(const Params& p, char* smem, int qoff = 16) {
    char* ws = p.ws;
    unsigned* q = (unsigned*)(ws + OFF_CTRL) + qoff;
    volatile int* s_task = (volatile int*)(smem + 66048);
    const unsigned char* U8 = (const unsigned char*)(ws + OFF_U16);
    const half_t* X2H = (const half_t*)(ws + OFF_X2H);
    const int* EID = (const int*)(ws + OFF_EID);
    float* PD = (float*)(ws + OFF_PD);
    const int xpref = (int)(xb_xcc_id() & 7u);
    for (;;) {
        const int task = peer_next_task(q, xpref, 512, s_task);
        if (task < 0) break;
        const int x = task >> 9, chunk = task & 511;
        int tid_ = threadIdx.x; asm volatile("" : "+v"(tid_));
        const int lane = tid_ & 63, w = tid_ >> 6, seg = lane & 7, eg = lane >> 3;
        h2v gs[8];
#pragma unroll
        for (int i = 0; i < 8; ++i) gs[i] = (h2v){(half_t)p.norm2_g[128 * x + 16 * seg + 2 * i], (half_t)p.norm2_g[128 * x + 16 * seg + 2 * i + 1]};
        const unsigned char* Ux = U8 + (long)x * 16384 * 128 + 16 * seg;
        const int tbase = chunk * 64 + w * 16;
        const int* Eb = EID + (long)tbase * 128 + 16 * eg;
        const half_t* Xb = X2H + (long)tbase * 1024 + 128 * x + 16 * seg;
#define LOAD_E(dst, k) { const u4v* ep_ = (const u4v*)(Eb + (long)(k) * 128); dst[0] = ep_[0]; dst[1] = ep_[1]; dst[2] = ep_[2]; dst[3] = ep_[3]; }
#define LOAD_X(xa_, xb_, k) { xa_ = *(const h8v*)(Xb + (long)(k) * 1024); xb_ = *(const h8v*)(Xb + (long)(k) * 1024 + 8); }
#define ISSUE_U(uu, e_) { _Pragma("unroll") for (int i = 0; i < 16; ++i) uu[i] = *(const u4v*)(Ux + (long)e_[i >> 2][i & 3] * 128); }
        auto compute = [&](int k, const h8v& xa, const h8v& xb, const u4v (&uu)[16]) __attribute__((always_inline)) {
            h2v hs[8];
#pragma unroll
            for (int i = 0; i < 4; ++i) {
                hs[i] = (h2v){xa[2 * i], xa[2 * i + 1]} * gs[i];
                hs[4 + i] = (h2v){xb[2 * i], xb[2 * i + 1]} * gs[4 + i];
            }
            float res0 = 0.f, res1 = 0.f;
            if (PMODE == 1) {
                unsigned acc_ = 0;
#pragma unroll
                for (int i = 0; i < 16; ++i) acc_ ^= uu[i][0] ^ uu[i][1] ^ uu[i][2] ^ uu[i][3];
                float* po = (float*)(p.ws + OFF_HC1) + (((long)(tbase + k) * 128 + 16 * eg + seg) & 0xFFFFF);
                po[0] = __builtin_bit_cast(float, acc_) + (float)hs[0][0];
                return;
            }
#pragma unroll
            for (int i = 0; i < 16; ++i) {
                float d = 0.f;
#pragma unroll
                for (int j = 0; j < 4; ++j) {
                    const h2v lo = __builtin_amdgcn_cvt_scalef32_pk_f16_fp8((int)uu[i][j], 1.0f, false);
                    const h2v hi = __builtin_amdgcn_cvt_scalef32_pk_f16_fp8((int)uu[i][j], 1.0f, true);
                    d = __builtin_amdgcn_fdot2(hs[2 * j], lo, d, false);
                    d = __builtin_amdgcn_fdot2(hs[2 * j + 1], hi, d, false);
                }
                d = red8(d);
                if (i < 8) res0 = (seg == i) ? d : res0; else res1 = (seg == (i - 8)) ? d : res1;
            }
            float* po = PD + ((long)x * NTOK + tbase + k) * 128 + 16 * eg + seg;
            po[0] = res0; po[8] = res1;
        };
        u4v uuA[16], uuB[16];
        u4v eA[4], eB[4];
        h8v xaA, xbA, xaB, xbB;
        LOAD_E(eA, 0); LOAD_X(xaA, xbA, 0);
        LOAD_E(eB, 1); LOAD_X(xaB, xbB, 1);
        ISSUE_U(uuA, eA);
#pragma unroll 1
        for (int k = 0; k < 16; k += 2) {
            ISSUE_U(uuB, eB);
            if (k + 2 < 16) LOAD_E(eA, k + 2);
            compute(k, xaA, xbA, uuA);
            if (k + 2 < 16) { LOAD_X(xaA, xbA, k + 2); ISSUE_U(uuA, eA); LOAD_E(eB, k + 3); }
            compute(k + 1, xaB, xbB, uuB);
            if (k + 2 < 16) LOAD_X(xaB, xbB, k + 3);
        }
    }
}
__device__ __forceinline__ void phase_peer_coef(const Params& p, int bid, int nb) {
    char* ws = p.ws;
    const half_t* X2H = (const half_t*)(ws + OFF_X2H);
    const float* PD = (const float*)(ws + OFF_PD);
    const float* GW = (const float*)(ws + OFF_GW);
    float* COEF = (float*)(ws + OFF_COEF);
    const int lane = threadIdx.x & 63;
    const long wv = ((long)bid * NTHREADS + threadIdx.x) >> 6, nwv = ((long)nb * NTHREADS) >> 6;
    for (long t = wv; t < NTOK; t += nwv) {
        const h8v a = *(const h8v*)(X2H + t * 1024 + 8 * lane), b2 = *(const h8v*)(X2H + t * 1024 + 512 + 8 * lane);
        float ss = 0.f;
#pragma unroll
        for (int i = 0; i < 8; ++i) { const float f0 = (float)a[i], f1 = (float)b2[i]; ss += f0 * f0 + f1 * f1; }
        ss = wave_sum(ss);
        const float rs = rsqrtf(ss * (1.0f / 1024.f) + EPS) * (1.0f / USCALE);
        float d0 = 0.f, d1 = 0.f;
#pragma unroll
        for (int x = 0; x < 8; ++x) {
            const float* pp = PD + ((long)x * NTOK + t) * 128;
            d0 += pp[lane]; d1 += pp[64 + lane];
        }
        COEF[t * 128 + lane] = GW[t * 128 + lane] * gelu_exact(d0 * rs);
        COEF[t * 128 + 64 + lane] = GW[t * 128 + 64 + lane] * gelu_exact(d1 * rs);
    }
}
__device__ __forceinline__ void phase_peer_vacc(const Params& p, char* smem) {
    char* ws = p.ws;
    unsigned* q = (unsigned*)(ws + OFF_CTRL) + 32;
    volatile int* s_task = (volatile int*)(smem + 66048);
    const unsigned char* V8 = (const unsigned char*)(ws + OFF_V16);
    const int* EID = (const int*)(ws + OFF_EID);
    const float* COEF = (const float*)(ws + OFF_COEF);
    float* SSQ = (float*)(ws + OFF_SSQ);
    const int xpref = (int)(xb_xcc_id() & 7u);
    for (;;) {
        const int task = peer_next_task(q, xpref, 512, s_task);
        if (task < 0) break;
        const int x = task >> 9, chunk = task & 511;
        int tid_ = threadIdx.x; asm volatile("" : "+v"(tid_));
        const int lane = tid_ & 63, w = tid_ >> 6, seg = lane & 7, eg = lane >> 3;
        const unsigned char* Vx = V8 + (long)x * 16384 * 128 + 16 * seg;
#pragma unroll 1
        for (int round = 0; round < 2; ++round) {
            const int t = chunk * 64 + w * 16 + round * 8 + eg;
            const int* Eb = EID + (long)t * 128;
            const float* Cb = COEF + (long)t * 128;
#define LOAD_EC(e_, c_, ci) { const u4v* ep_ = (const u4v*)(Eb + 8 * (ci)); const f4v* cp_ = (const f4v*)(Cb + 8 * (ci)); e_[0] = ep_[0]; e_[1] = ep_[1]; c_[0] = cp_[0]; c_[1] = cp_[1]; }
#define ISSUE_V(vv, e_) { _Pragma("unroll") for (int i = 0; i < 8; ++i) vv[i] = *(const u4v*)(Vx + (long)e_[i >> 2][i & 3] * 128); }
            float acc[16];
#pragma unroll
            for (int i = 0; i < 16; ++i) acc[i] = 0.f;
            auto compute = [&](const f4v (&c_)[2], const u4v (&vv)[8]) __attribute__((always_inline)) {
#pragma unroll
                for (int i = 0; i < 8; ++i) {
                    const float cf = c_[i >> 2][i & 3];
#pragma unroll
                    for (int j = 0; j < 4; ++j) {
                        const auto lo = __builtin_amdgcn_cvt_pk_f32_fp8((int)vv[i][j], false);
                        const auto hi = __builtin_amdgcn_cvt_pk_f32_fp8((int)vv[i][j], true);
                        acc[4 * j] += cf * lo[0]; acc[4 * j + 1] += cf * lo[1];
                        acc[4 * j + 2] += cf * hi[0]; acc[4 * j + 3] += cf * hi[1];
                    }
                }
            };
            u4v vvA[8], vvB[8];
            u4v eA[2], eB[2]; f4v cA[2], cB[2];
            LOAD_EC(eA, cA, 0); LOAD_EC(eB, cB, 1);
            ISSUE_V(vvA, eA);
#pragma unroll 1
            for (int ci = 0; ci < 16; ci += 2) {
                ISSUE_V(vvB, eB);
                compute(cA, vvA);
                if (ci + 2 < 16) { LOAD_EC(eA, cA, ci + 2); ISSUE_V(vvA, eA); }
                compute(cB, vvB);
                if (ci + 2 < 16) LOAD_EC(eB, cB, ci + 3);
            }
            float* xr = p.out + (long)t * 1024 + 128 * x + 16 * seg;
            float ssq = 0.f;
#pragma unroll
            for (int i4 = 0; i4 < 4; ++i4) {
                float4 xv = *(const float4*)(xr + 4 * i4);
                xv.x += acc[4 * i4] * (1.0f / VSCALE); xv.y += acc[4 * i4 + 1] * (1.0f / VSCALE);
                xv.z += acc[4 * i4 + 2] * (1.0f / VSCALE); xv.w += acc[4 * i4 + 3] * (1.0f / VSCALE);
                ssq += xv.x * xv.x + xv.y * xv.y + xv.z * xv.z + xv.w * xv.w;
                *(float4*)(xr + 4 * i4) = xv;
            }
            ssq = red8(ssq);
            if (seg == 0) SSQ[(long)x * NTOK + t] = ssq;
        }
    }
}
__device__ __forceinline__ void phase_final_norm(const Params& p, int bid, int nb) {
    const float* SSQ = (const float*)(p.ws + OFF_SSQ);
    const int lane = threadIdx.x & 63;
    const long wv = ((long)bid * NTHREADS + threadIdx.x) >> 6, nwv = ((long)nb * NTHREADS) >> 6;
    for (long t = wv; t < NTOK; t += nwv) {
        float ss = 0.f;
#pragma unroll
        for (int x = 0; x < 8; ++x) ss += SSQ[(long)x * NTOK + t];
        const float rf = rsqrtf(ss * (1.0f / 1024.f) + EPS);
        float4* xr = (float4*)(p.out + t * 1024);
#pragma unroll
        for (int i = 0; i < 4; ++i) {
            float4 v = xr[lane + 64 * i];
            const float4 g = ((const float4*)p.final_g)[lane + 64 * i];
            v.x *= rf * g.x; v.y *= rf * g.y; v.z *= rf * g.z; v.w *= rf * g.w;
            xr[lane + 64 * i] = v;
        }
    }
}

#define XB_TMO      128
#define XB_XCNT(j)  (256  + 64 * (j))
#define XB_XSUB(j)  (1280 + 64 * (j))
#define XB_XGEN(j)  (2304 + 64 * (j))
#define XB_TOP      3328
#define XB_TOPGEN   3392
#define XCD_BAR_WORDS 3456
#define XB_SPIN_CAP (1u << 22)
__device__ __forceinline__ unsigned xb_ld(unsigned* p)              { return __hip_atomic_load(p, __ATOMIC_RELAXED, __HIP_MEMORY_SCOPE_AGENT); }
__device__ __forceinline__ unsigned xb_add(unsigned* p, unsigned v) { return __hip_atomic_fetch_add(p, v, __ATOMIC_RELAXED, __HIP_MEMORY_SCOPE_AGENT); }
__device__ __forceinline__ unsigned xb_xcc_id() { return (unsigned)__builtin_amdgcn_s_getreg((3 << 11) | 20) & 0xFu; }
#define XB_SPIN(cond, bar) do { unsigned _sp = 0; while (cond) { __builtin_amdgcn_s_sleep(1); \
    if ((++_sp & 255u) == 0u) { if (xb_ld(&(bar)[XB_TMO])) break; if (_sp > XB_SPIN_CAP) { atomicAdd(&(bar)[XB_TMO], 1u); break; } } } } while (0)
struct XcdBarrier { unsigned* bar; unsigned x; volatile unsigned* st; };
__device__ __forceinline__ XcdBarrier xcd_barrier_post(unsigned* bar, volatile unsigned* st) {
    XcdBarrier b; b.bar = bar; b.x = xb_xcc_id(); b.st = st;
    if (threadIdx.x == 0) (void)xb_add(&bar[XB_XCNT(b.x)], 1u);
    return b;
}
__device__ __forceinline__ void xcd_barrier_complete(unsigned* bar, unsigned x, unsigned& nloc, unsigned& nx) {
    const unsigned G = gridDim.x * gridDim.y * gridDim.z;
    unsigned sum, cnt, mine, sp = 0u;
    for (;;) {
        sum = 0u; cnt = 0u; mine = 0u;
#pragma unroll
        for (unsigned j = 0; j < 16; ++j) { const unsigned c = xb_ld(&bar[XB_XCNT(j)]); sum += c; cnt += (c > 0u) ? 1u : 0u; mine = (j == x) ? c : mine; }
        if (sum == G) break;
        __builtin_amdgcn_s_sleep(1);
        if ((++sp & 255u) == 0u) { if (xb_ld(&bar[XB_TMO])) break; if (sp > XB_SPIN_CAP) { atomicAdd(&bar[XB_TMO], 1u); break; } }
    }
    nloc = mine > 0u ? mine : 1u; nx = cnt > 0u ? cnt : 1u;
}
__device__ __forceinline__ void xcd_barrier(const XcdBarrier& b) {
    asm volatile("s_waitcnt vmcnt(0)" ::: "memory");
    __syncthreads();
    if (threadIdx.x == 0) {
        unsigned* bar = b.bar;
        __builtin_amdgcn_s_waitcnt(0);
        unsigned nloc = b.st[0], nx = b.st[1];
        if (nloc == 0u) { xcd_barrier_complete(bar, b.x, nloc, nx); b.st[0] = nloc; b.st[1] = nx; }
        const unsigned old = xb_add(&bar[XB_XSUB(b.x)], 1u);
        const unsigned gen = old / nloc;
        if (old + 1u == (gen + 1u) * nloc) {
            __builtin_amdgcn_fence(__ATOMIC_RELEASE, "agent");
            asm volatile("s_waitcnt vmcnt(0)" ::: "memory");
            const unsigned og = xb_add(&bar[XB_TOP], 1u);
            const unsigned tg = og / nx;
            if (og + 1u == (tg + 1u) * nx) xb_add(&bar[XB_TOPGEN], 1u);
            else XB_SPIN(xb_ld(&bar[XB_TOPGEN]) == tg, bar);
            __builtin_amdgcn_fence(__ATOMIC_ACQUIRE, "agent");
            xb_add(&bar[XB_XGEN(b.x)], 1u);
            asm volatile("s_waitcnt vmcnt(0)" ::: "memory");
        } else {
            XB_SPIN(xb_ld(&bar[XB_XGEN(b.x)]) == gen, bar);
            __builtin_amdgcn_fence(__ATOMIC_ACQUIRE, "agent");
            asm volatile("s_waitcnt vmcnt(0)" ::: "memory");
        }
    }
    __syncthreads();
}

template <int PH>
__global__ void __launch_bounds__(NTHREADS, 2) phase_kernel(Params p) {
    extern __shared__ __attribute__((aligned(16))) char smem[];
    const int bid = blockIdx.x, nb = gridDim.x;
    if (PH == 0) phase_prep(p, bid, nb);
    if (PH == 1) phase_inproj(p, bid, nb, smem);
    if (PH == 2) phase_p2(p, bid, nb, smem);
    if (PH == 3) phase_cmp2(p, bid, nb);
    if (PH == 4) phase_attn(p, smem);
    if (PH == 5) phase_outproj(p, bid, nb, smem);
    if (PH == 6) phase_peerq(p, bid, nb, smem);
    if (PH == 7) phase_route(p, bid, nb, smem);
}

#ifndef PROBE_PHASE
#define PROBE_PHASE -1
#endif
__global__ void __launch_bounds__(NTHREADS, 2) mega_kernel(Params p) {
    extern __shared__ __attribute__((aligned(16))) char smem[];
    const int bid = blockIdx.x, nb = gridDim.x;
    volatile unsigned* xbst = (volatile unsigned*)(smem + 66064);
    if (threadIdx.x == 0) { xbst[0] = 0u; xbst[1] = 0u; }
    __syncthreads();
    const XcdBarrier gb = xcd_barrier_post((unsigned*)(p.ws + OFF_BAR), xbst);
#define GRID_SYNC() xcd_barrier(gb)
    phase_prep(p, bid, nb); GRID_SYNC();
    if (PROBE_PHASE == 0) { phase_prep(p, bid, nb); GRID_SYNC(); }
    phase_inproj(p, bid, nb, smem); GRID_SYNC();
    if (PROBE_PHASE == 1) { phase_inproj(p, bid, nb, smem); GRID_SYNC(); }
    phase_p2(p, bid, nb, smem); GRID_SYNC();
    if (PROBE_PHASE == 2) { phase_p2(p, bid, nb, smem); GRID_SYNC(); }
    phase_cmp2(p, bid, nb); GRID_SYNC();
    phase_attn(p, smem, 64, 0); GRID_SYNC();
    if (PROBE_PHASE == 3) { phase_attn(p, smem, 80, 0); GRID_SYNC(); }
    if (PROBE_PHASE == 9) { phase_attn(p, smem, 80, 1); GRID_SYNC(); }
    if (PROBE_PHASE == 13) { phase_attn(p, smem, 80, 2); GRID_SYNC(); }
    phase_outproj(p, bid, nb, smem); GRID_SYNC();
    if (PROBE_PHASE == 4) { phase_outproj(p, bid, nb, smem); GRID_SYNC(); }
    phase_peerq(p, bid, nb, smem); GRID_SYNC();
    if (PROBE_PHASE == 5) { phase_peerq(p, bid, nb, smem); GRID_SYNC(); }
    phase_route(p, bid, nb, smem); GRID_SYNC();
    if (PROBE_PHASE == 6) { phase_route(p, bid, nb, smem); GRID_SYNC(); }
    if (PROBE_PHASE == 8) { GRID_SYNC(); GRID_SYNC(); GRID_SYNC(); GRID_SYNC(); GRID_SYNC(); GRID_SYNC(); GRID_SYNC(); GRID_SYNC(); }
    phase_peer_udot<0>(p, smem); GRID_SYNC();
    if (PROBE_PHASE == 10) { phase_peer_udot<0>(p, smem, 48); GRID_SYNC(); }
    if (PROBE_PHASE == 12) { phase_peer_udot<1>(p, smem, 48); GRID_SYNC(); }
    phase_peer_coef(p, bid, nb); GRID_SYNC();
    if (PROBE_PHASE == 11) { phase_peer_coef(p, bid, nb); GRID_SYNC(); }
    phase_peer_vacc(p, smem); GRID_SYNC();
    phase_final_norm(p, bid, nb);
}

extern "C" void kernel_launch(void* const* d_in, const int* in_sizes, int n_in, void* d_out, int out_size, void* d_ws, size_t ws_size, hipStream_t stream) {
    (void)in_sizes; (void)n_in; (void)out_size;
    if (ws_size < WS_NEED) { fprintf(stderr, "kernel_launch: workspace too small (%zu < %zu)\n", ws_size, (size_t)WS_NEED); return; }
    Params p{};
    p.x = (const float*)d_in[0]; p.pos = (const int*)d_in[1]; p.norm1_g = (const float*)d_in[2]; p.w_in = (const float*)d_in[3];
    p.cmp_pos = (const float*)d_in[4]; p.cmp_k_w1 = (const float*)d_in[5]; p.cmp_k_w2 = (const float*)d_in[6];
    p.cmp_v_w1 = (const float*)d_in[7]; p.cmp_v_w2 = (const float*)d_in[8]; p.t5_bias = (const float*)d_in[9];
    p.q_norm_g = (const float*)d_in[10]; p.w_q_up = (const float*)d_in[11]; p.kv_norm_g = (const float*)d_in[12]; p.w_kv_up = (const float*)d_in[13];
    p.grp_norm_nsa = (const float*)d_in[14]; p.grp_norm_mla = (const float*)d_in[15]; p.w_out = (const float*)d_in[16]; p.norm2_g = (const float*)d_in[17];
    p.peer_wq = (const float*)d_in[18]; p.peer_keys1 = (const float*)d_in[19]; p.peer_keys2 = (const float*)d_in[20];
    p.peer_u = (const float*)d_in[21]; p.peer_v = (const float*)d_in[22]; p.final_g = (const float*)d_in[23];
    p.out = (float*)d_out; p.ws = (char*)d_ws;
#if MULTI_LAUNCH
    const int G = 512;
    phase_kernel<0><<<G, NTHREADS, 0, stream>>>(p);
    phase_kernel<1><<<G, NTHREADS, 0, stream>>>(p);
    phase_kernel<2><<<G, NTHREADS, 0, stream>>>(p);
    phase_kernel<3><<<G, NTHREADS, 0, stream>>>(p);
    phase_kernel<4><<<G, NTHREADS, 0, stream>>>(p);
    phase_kernel<5><<<G, NTHREADS, 0, stream>>>(p);
    phase_kernel<6><<<G, NTHREADS, 0, stream>>>(p);
    phase_kernel<7><<<G, NTHREADS, 0, stream>>>(p);
    phase_kernel<8><<<G, NTHREADS, 0, stream>>>(p);
#else
    static int grid_blocks = 0;
    if (!grid_blocks) {
        int dev = 0, cus = 0, per_cu = 0;
        (void)hipGetDevice(&dev);
        (void)hipDeviceGetAttribute(&cus, hipDeviceAttributeMultiprocessorCount, dev);
        (void)hipFuncSetAttribute((const void*)mega_kernel, hipFuncAttributeMaxDynamicSharedMemorySize, SMEM_BYTES);
        (void)hipOccupancyMaxActiveBlocksPerMultiprocessor(&per_cu, mega_kernel, NTHREADS, SMEM_BYTES);
        if (per_cu > 2) per_cu = 2;
        grid_blocks = cus * per_cu;
    }
    (void)hipMemsetAsync((char*)d_ws + OFF_BAR, 0, 16384, stream);
    void* args[] = {&p};
    hipError_t e = hipLaunchCooperativeKernel((void*)mega_kernel, dim3(grid_blocks), dim3(NTHREADS), args, SMEM_BYTES, stream);
    if (e != hipSuccess) fprintf(stderr, "cooperative launch failed: %s (grid %d)\n", hipGetErrorString(e), grid_blocks);
#endif
}
```

```cpp
#include <hip/hip_runtime.h>
#include <hip/hip_cooperative_groups.h>
#include <cstdio>
#include <cstdint>
namespace cg = cooperative_groups;

#ifndef MULTI_LAUNCH
#define MULTI_LAUNCH 0
#endif

typedef _Float16 half_t;
typedef _Float16 h2v __attribute__((ext_vector_type(2)));
typedef _Float16 h4v __attribute__((ext_vector_type(4)));
typedef _Float16 h8v __attribute__((ext_vector_type(8)));
typedef float f4v __attribute__((ext_vector_type(4)));
typedef unsigned u4v __attribute__((ext_vector_type(4)));
typedef unsigned u2v __attribute__((ext_vector_type(2)));
typedef float f16v __attribute__((ext_vector_type(16)));

constexpr int BATCH = 2, SEQ = 16384, DM = 1024, NTOK = BATCH * SEQ;
constexpr int NIN = 1720, NINP = 1792;
constexpr int NCMP = 1023, NCMPP = 1024;
constexpr float EPS = 1e-6f;
constexpr float LOG2E = 1.4426950408889634f;
constexpr float QS_NSA = 0.125f * LOG2E;
constexpr float QS_MLA = 0.10206207261596575f * LOG2E;
constexpr float NEGF = -1e30f;
constexpr int LUTN = 1536;
constexpr float USCALE = 128.0f, VSCALE = 16.0f;

constexpr size_t al256(size_t x) { return (x + 255) & ~(size_t)255; }
constexpr size_t OFF_CTRL = 0;
constexpr size_t OFF_LUT = 4096;
constexpr size_t OFF_CB = OFF_LUT + 2 * LUTN * 4 * 4;
constexpr size_t OFF_WIN = 65536;
constexpr size_t OFF_WQUP = OFF_WIN + (size_t)NINP * 1024 * 2;
constexpr size_t OFF_WKVUP = OFF_WQUP + 768 * 256 * 2;
constexpr size_t OFF_WC1 = OFF_WKVUP + 1024 * 128 * 2;
constexpr size_t OFF_WOUT = OFF_WC1 + 2 * 256 * 2048 * 2;
constexpr size_t OFF_WPQ = OFF_WOUT + 1024 * 1024 * 2;
constexpr size_t OFF_KEYS = OFF_WPQ + 2048 * 1024 * 2;
constexpr size_t OFF_U16 = al256(OFF_KEYS + 2 * 128 * 128 * 2);
constexpr size_t OFF_V16 = OFF_U16 + (size_t)16384 * 1024 * 2;
constexpr size_t OFF_H1 = OFF_V16 + (size_t)16384 * 1024 * 2;
constexpr size_t OFF_MIXED = OFF_H1;
constexpr size_t OFF_QH = OFF_H1 + (size_t)NTOK * 1024 * 2;
constexpr size_t SZ_KV = (size_t)2 * 2 * SEQ * 64 * 2;
constexpr size_t OFF_KC = OFF_QH + (size_t)NTOK * 512 * 2;
constexpr size_t OFF_VC = OFF_KC + SZ_KV;
constexpr size_t OFF_KS = OFF_VC + SZ_KV;
constexpr size_t OFF_VST = OFF_KS + SZ_KV;
constexpr size_t OFF_KW = OFF_VST + SZ_KV;
constexpr size_t OFF_VWT = OFF_KW + SZ_KV;
constexpr size_t OFF_GATES = OFF_VWT + SZ_KV;
constexpr size_t OFF_CQ = OFF_GATES + (size_t)NTOK * 24 * 4;
constexpr size_t OFF_CKV = OFF_CQ + (size_t)NTOK * 256 * 2;
constexpr size_t OFF_X2H = OFF_QH;
constexpr size_t OFF_QM = OFF_CKV + (size_t)NTOK * 128 * 2;
constexpr size_t OFF_KM = OFF_QM + (size_t)NTOK * 8 * 96 * 2;
constexpr size_t OFF_VT = OFF_KM + (size_t)NTOK * 8 * 96 * 2;
constexpr size_t OFF_QP = OFF_QM;
constexpr size_t OFF_PD = OFF_QM;
constexpr size_t OFF_COEF = OFF_H1;
constexpr size_t OFF_SSQ = OFF_H1 + (size_t)NTOK * 128 * 4;
constexpr size_t OFF_HC1 = OFF_VT + (size_t)NTOK * 8 * 64 * 2;
constexpr size_t OFF_KCMP = OFF_HC1 + (size_t)8 * 1024 * 256 * 2;
constexpr size_t OFF_VCMPT = OFF_KCMP + (size_t)4 * 1024 * 64 * 2;
constexpr size_t OFF_EID = OFF_VCMPT + (size_t)4 * 1024 * 64 * 2;
constexpr size_t OFF_GW = OFF_EID + (size_t)NTOK * 128 * 4;
constexpr size_t OFF_BAR = OFF_GW + (size_t)NTOK * 128 * 4;
constexpr size_t WS_NEED = OFF_BAR + 16384;

struct Params {
    const float* x; const int* pos; const float* norm1_g; const float* w_in; const float* cmp_pos;
    const float* cmp_k_w1; const float* cmp_k_w2; const float* cmp_v_w1; const float* cmp_v_w2; const float* t5_bias;
    const float* q_norm_g; const float* w_q_up; const float* kv_norm_g; const float* w_kv_up;
    const float* grp_norm_nsa; const float* grp_norm_mla; const float* w_out; const float* norm2_g;
    const float* peer_wq; const float* peer_keys1; const float* peer_keys2; const float* peer_u; const float* peer_v; const float* final_g;
    float* out; char* ws;
};

constexpr int SMEM_BYTES = 67584;
constexpr int NTHREADS = 256;

__device__ __forceinline__ f4v mfma16(h8v a, h8v b, f4v c) { return __builtin_amdgcn_mfma_f32_16x16x32_f16(a, b, c, 0, 0, 0); }
__device__ __forceinline__ f16v mfma32(h8v a, h8v b, f16v c) { return __builtin_amdgcn_mfma_f32_32x32x16_f16(a, b, c, 0, 0, 0); }
__device__ __forceinline__ float wave_sum(float v) {
#pragma unroll
    for (int o = 32; o >= 1; o >>= 1) v += __shfl_xor(v, o);
    return v;
}
__device__ __forceinline__ float gelu_exact(float v) { return 0.5f * v * (1.0f + erff(v * 0.70710678118654752f)); }
__device__ __forceinline__ float fast_exp2(float v) { return __builtin_amdgcn_exp2f(v); }
__device__ __forceinline__ int t5_bucket(int d) {
    if (d < 16) return d < 0 ? 0 : d;
    int b = 16;
    b += (d >= 22); b += (d >= 30); b += (d >= 40); b += (d >= 54); b += (d >= 73); b += (d >= 99); b += (d >= 134); b += (d >= 182);
    b += (d >= 246); b += (d >= 332); b += (d >= 450); b += (d >= 609); b += (d >= 825); b += (d >= 1117); b += (d >= 1513);
    return b;
}

__device__ __forceinline__ unsigned xb_xcc_id();
__device__ __forceinline__ float red8(float v) {
    v += __builtin_bit_cast(float, __builtin_amdgcn_update_dpp(0, __builtin_bit_cast(int, v), 0xB1, 0xF, 0xF, true));
    v += __builtin_bit_cast(float, __builtin_amdgcn_update_dpp(0, __builtin_bit_cast(int, v), 0x4E, 0xF, 0xF, true));
    v += __builtin_bit_cast(float, __builtin_amdgcn_update_dpp(0, __builtin_bit_cast(int, v), 0x141, 0xF, 0xF, true));
    return v;
}

__device__ __forceinline__ void phase_prep(const Params& p, int bid, int nb) {
    int tx_ = threadIdx.x; asm volatile("" : "+v"(tx_));
    const long tid = (long)bid * NTHREADS + tx_;
    const long nth = (long)nb * NTHREADS;
    char* ws = p.ws;
    if (tid < 1024) ((unsigned*)(ws + OFF_CTRL))[tid] = 0u;
    {
        float* lut = (float*)(ws + OFF_LUT);
        for (long e = tid; e < 2 * LUTN * 4; e += nth) {
            int r = e & 3, d = (e >> 2) % LUTN, g = (int)(e / (4 * LUTN));
            lut[e] = p.t5_bias[t5_bucket(d) * 8 + g * 4 + r] * LOG2E;
        }
    }
    {
        float* cb = (float*)(ws + OFF_CB);
        for (long e = tid; e < 512; e += nth) {
            int kv = (int)(e >> 8), n = (int)(e & 255);
            const float* w1 = kv ? p.cmp_v_w1 : p.cmp_k_w1;
            float s = 0.f;
            for (int k = 0; k < 2048; ++k) s += p.cmp_pos[k] * w1[(long)k * 256 + n];
            cb[e] = s;
        }
    }
    {
        half_t* W = (half_t*)(ws + OFF_WIN);
        for (long e = tid; e < (long)NINP * 1024; e += nth) {
            int k = (int)(e / NINP), n = (int)(e % NINP);
            int src;
            if (n < 1280) src = n;
            else if (n < 1536) src = 1304 + (n - 1280);
            else if (n < 1664) src = 1560 + (n - 1536);
            else if (n < 1696) src = 1688 + (n - 1664);
            else if (n < 1720) src = 1280 + (n - 1696);
            else src = -1;
            float v = src >= 0 ? p.w_in[(long)k * NIN + src] : 0.f;
            W[(long)n * 1024 + k] = (half_t)v;
        }
    }
    {
        half_t* W = (half_t*)(ws + OFF_WQUP);
        for (long e = tid; e < 768 * 256; e += nth) {
            int k = (int)(e / 768), n = (int)(e % 768);
            W[(long)n * 256 + k] = (half_t)(p.w_q_up[e] * p.q_norm_g[k]);
        }
    }
    {
        half_t* W = (half_t*)(ws + OFF_WKVUP);
        for (long e = tid; e < 1024 * 128; e += nth) {
            int k = (int)(e / 1024), n = (int)(e % 1024);
            W[(long)n * 128 + k] = (half_t)(p.w_kv_up[e] * p.kv_norm_g[k]);
        }
    }
    {
        half_t* W = (half_t*)(ws + OFF_WC1);
        for (long e = tid; e < 2L * 2048 * 256; e += nth) {
            int kv = (int)(e / (2048 * 256)); long r = e % (2048 * 256);
            int k = (int)(r / 256), n = (int)(r % 256);
            const float* w1 = kv ? p.cmp_v_w1 : p.cmp_k_w1;
            W[((long)kv * 256 + n) * 2048 + k] = (half_t)w1[r];
        }
    }
    {
        half_t* W = (half_t*)(ws + OFF_WOUT);
        for (long e = tid; e < 1024L * 1024; e += nth) {
            int k = (int)(e >> 10), n = (int)(e & 1023);
            float g = k < 512 ? p.grp_norm_nsa[k] : p.grp_norm_mla[k - 512];
            W[(long)n * 1024 + k] = (half_t)(p.w_out[e] * g);
        }
    }
    {
        half_t* W = (half_t*)(ws + OFF_WPQ);
        for (long e = tid; e < 1024L * 2048; e += nth) {
            int k = (int)(e >> 11), n = (int)(e & 2047);
            W[(long)n * 1024 + k] = (half_t)(p.peer_wq[e] * p.norm2_g[k]);
        }
    }
    {
        half_t* W = (half_t*)(ws + OFF_KEYS);
        for (long e = tid; e < 2 * 16384; e += nth) {
            W[e] = (half_t)(e < 16384 ? p.peer_keys1[e] : p.peer_keys2[e - 16384]);
        }
    }
    {
        unsigned* U8 = (unsigned*)(ws + OFF_U16);
        unsigned* V8 = (unsigned*)(ws + OFF_V16);
        const long n4 = 16384L * 256;
        for (long e4 = tid; e4 < n4; e4 += nth) {
            const int e = (int)(e4 >> 8), d = (int)(e4 & 255) * 4, x = d >> 7, dd = d & 127;
            const float4 a = ((const float4*)p.peer_u)[e4];
            const float4 b = ((const float4*)p.peer_v)[e4];
            int pa = __builtin_amdgcn_cvt_pk_fp8_f32(a.x * USCALE, a.y * USCALE, 0, false);
            pa = __builtin_amdgcn_cvt_pk_fp8_f32(a.z * USCALE, a.w * USCALE, pa, true);
            int pb = __builtin_amdgcn_cvt_pk_fp8_f32(b.x * VSCALE, b.y * VSCALE, 0, false);
            pb = __builtin_amdgcn_cvt_pk_fp8_f32(b.z * VSCALE, b.w * VSCALE, pb, true);
            const long o = (((long)x * 16384 + e) * 128 + dd) >> 2;
            U8[o] = (unsigned)pa; V8[o] = (unsigned)pb;
        }
    }
    {
        half_t* H1 = (half_t*)(ws + OFF_H1);
        const int lane = threadIdx.x & 63;
        const long wv = tid >> 6, nwv = nth >> 6;
        for (long row = wv; row < NTOK; row += nwv) {
            const float4* xr = (const float4*)(p.x + row * 1024);
            float4 v[4]; float ss = 0.f;
#pragma unroll
            for (int i = 0; i < 4; ++i) { v[i] = xr[lane + 64 * i]; ss += v[i].x * v[i].x + v[i].y * v[i].y + v[i].z * v[i].z + v[i].w * v[i].w; }
            ss = wave_sum(ss);
            const float rs = rsqrtf(ss * (1.0f / 1024.f) + EPS);
#pragma unroll
            for (int i = 0; i < 4; ++i) {
                float4 g = ((const float4*)p.norm1_g)[lane + 64 * i];
                h4v o = {(half_t)(v[i].x * rs * g.x), (half_t)(v[i].y * rs * g.y), (half_t)(v[i].z * rs * g.z), (half_t)(v[i].w * rs * g.w)};
                ((h4v*)(H1 + row * 1024))[lane + 64 * i] = o;
            }
        }
    }
}

constexpr int GEMM_RS_OFF = 66560;
template <bool SCALE, bool SWAP, class Epi>
__device__ __forceinline__ void gemm_tile(const half_t* __restrict__ A, long lda, const half_t* __restrict__ Bt, long ldb, int K, int ksplit, char* smem_raw, Epi epi) {
    half_t* sA = (half_t*)smem_raw;
    half_t* sB = (half_t*)(smem_raw + 32768);
    float* rs0 = (float*)(smem_raw + GEMM_RS_OFF);
    int tid_ = threadIdx.x; asm volatile("" : "+v"(tid_));
    const int tid = tid_, lane = tid & 63, w = tid >> 6, wm = w >> 1, wn = w & 1;
    const int i16 = lane & 15, g4 = lane >> 4;
    const int lr = tid >> 3, off = tid & 7;
    if (SCALE) {
        const int rg = lane >> 3, ch = lane & 7;
        const int ncg = K >> 6, cgs = ksplit >> 6;
#pragma unroll 1
        for (int rr = 0; rr < 4; ++rr) {
            const int row = w * 32 + rr * 8 + rg;
            const half_t* ap = A + (long)row * lda + ch * 8;
            float s0 = 0.f, s1 = 0.f;
#pragma unroll 8
            for (int cg = 0; cg < ncg; ++cg) {
                const h8v v = *(const h8v*)(ap + cg * 64);
                float d = 0.f;
#pragma unroll
                for (int j = 0; j < 4; ++j) d = __builtin_amdgcn_fdot2((h2v){v[2 * j], v[2 * j + 1]}, (h2v){v[2 * j], v[2 * j + 1]}, d, false);
                if (cg < cgs) s0 += d; else s1 += d;
            }
            s0 = red8(s0); s1 = red8(s1);
            if (ch == 0) {
                rs0[row] = rsqrtf(s0 / (float)ksplit + EPS);
                if (ksplit < K) rs0[128 + row] = rsqrtf(s1 / (float)(K - ksplit) + EPS);
            }
        }
    }
    f4v acc[4][4];
#pragma unroll
    for (int a = 0; a < 4; ++a)
#pragma unroll
        for (int b = 0; b < 4; ++b) acc[a][b] = (f4v){0.f, 0.f, 0.f, 0.f};
    u4v ra[4], rb[4];
    const int nk = K >> 6;
    const int wofs = lr * 64 + ((off ^ (lr & 7)) << 3);
#pragma unroll
    for (int i = 0; i < 4; ++i) {
        ra[i] = *(const u4v*)(A + (long)(lr + 32 * i) * lda + off * 8);
        rb[i] = *(const u4v*)(Bt + (long)(lr + 32 * i) * ldb + off * 8);
    }
#pragma unroll
    for (int i = 0; i < 4; ++i) {
        *(u4v*)(sA + wofs + i * 2048) = ra[i];
        *(u4v*)(sB + wofs + i * 2048) = rb[i];
    }
    __syncthreads();
#pragma unroll 1
    for (int kt = 0; kt < nk; ++kt) {
        const int cur = (kt & 1) * 8192;
        if (kt + 1 < nk) {
            const int k0 = (kt + 1) * 64;
#pragma unroll
            for (int i = 0; i < 4; ++i) {
                ra[i] = *(const u4v*)(A + (long)(lr + 32 * i) * lda + k0 + off * 8);
                rb[i] = *(const u4v*)(Bt + (long)(lr + 32 * i) * ldb + k0 + off * 8);
            }
        }
        if (SCALE && kt * 64 == ksplit) {
#pragma unroll
            for (int mi = 0; mi < 4; ++mi) {
                if (SWAP) {
                    const int row = wm * 64 + mi * 16 + i16;
                    const float ratio = rs0[row] / rs0[128 + row];
#pragma unroll
                    for (int ni = 0; ni < 4; ++ni) acc[mi][ni] *= ratio;
                } else {
#pragma unroll
                    for (int r = 0; r < 4; ++r) {
                        const int row = wm * 64 + mi * 16 + g4 * 4 + r;
                        const float ratio = rs0[row] / rs0[128 + row];
#pragma unroll
                        for (int ni = 0; ni < 4; ++ni) acc[mi][ni][r] *= ratio;
                    }
                }
            }
        }
#pragma unroll
        for (int kk = 0; kk < 2; ++kk) {
            const int cofs = (((kk * 4 + g4) ^ (i16 & 7)) << 3);
            h8v af[4], bf[4];
#pragma unroll
            for (int mi = 0; mi < 4; ++mi) af[mi] = *(const h8v*)(sA + cur + (wm * 64 + mi * 16 + i16) * 64 + cofs);
#pragma unroll
            for (int ni = 0; ni < 4; ++ni) bf[ni] = *(const h8v*)(sB + cur + (wn * 64 + ni * 16 + i16) * 64 + cofs);
#pragma unroll
            for (int mi = 0; mi < 4; ++mi)
#pragma unroll
                for (int ni = 0; ni < 4; ++ni) acc[mi][ni] = SWAP ? mfma16(bf[ni], af[mi], acc[mi][ni]) : mfma16(af[mi], bf[ni], acc[mi][ni]);
        }
        if (kt + 1 < nk) {
            const int nxt = ((kt + 1) & 1) * 8192;
#pragma unroll
            for (int i = 0; i < 4; ++i) {
                *(u4v*)(sA + nxt + wofs + i * 2048) = ra[i];
                *(u4v*)(sB + nxt + wofs + i * 2048) = rb[i];
            }
        }
        __syncthreads();
    }
    if (SCALE) {
        const int fin = (ksplit < K) ? 128 : 0;
#pragma unroll
        for (int mi = 0; mi < 4; ++mi) {
            if (SWAP) {
                const float rsv = rs0[fin + wm * 64 + mi * 16 + i16];
#pragma unroll
                for (int ni = 0; ni < 4; ++ni) acc[mi][ni] *= rsv;
            } else {
#pragma unroll
                for (int r = 0; r < 4; ++r) {
                    const float rsv = rs0[fin + wm * 64 + mi * 16 + g4 * 4 + r];
#pragma unroll
                    for (int ni = 0; ni < 4; ++ni) acc[mi][ni][r] *= rsv;
                }
            }
        }
    }
    epi(acc, wm, wn, i16, g4);
    __syncthreads();
}

__device__ __forceinline__ void rope_pair(float x1, float x2, int pos, int i, float& o1, float& o2) {
    const float inv = __builtin_amdgcn_exp2f(-(float)i * (13.287712379549449f / 16.0f));
    double t = (double)pos * (double)inv * 0.15915494309189535;
    t -= __builtin_rint(t);
    const float fr = (float)t;
    const float sn = __builtin_amdgcn_sinf(fr), cs = __builtin_amdgcn_cosf(fr);
    o1 = x1 * cs - x2 * sn; o2 = x1 * sn + x2 * cs;
}

__device__ __forceinline__ void phase_inproj(const Params& p, int bid, int nb, char* smem) {
    char* ws = p.ws;
    const half_t* H1 = (const half_t*)(ws + OFF_H1);
    const half_t* W = (const half_t*)(ws + OFF_WIN);
    half_t* QH = (half_t*)(ws + OFF_QH);
    half_t* KM = (half_t*)(ws + OFF_KM);
    half_t* CQ = (half_t*)(ws + OFF_CQ);
    half_t* CKV = (half_t*)(ws + OFF_CKV);
    float* GATES = (float*)(ws + OFF_GATES);
    const int NT_N = NINP / 128, NT_M = NTOK / 128;
    for (int tile = bid; tile < NT_M * NT_N; tile += nb) {
        const int tm = tile / NT_N, tn = tile % NT_N;
        const int row0 = tm * 128, n0 = tn * 128;
        const half_t* Ap = H1 + (long)row0 * 1024;
        const half_t* Bp = W + (long)n0 * 1024;
        if (tn == 7 || tn == 9) {
            gemm_tile<false, false>(Ap, 1024, Bp, 1024, 1024, 1024, smem,
                [&](f4v (&acc)[4][4], int wm, int wn, int i16, int g4) __attribute__((always_inline)) {
                    half_t* base = (half_t*)(ws + (tn == 7 ? OFF_VST : OFF_VWT));
#pragma unroll
                    for (int ni = 0; ni < 4; ++ni) {
                        const int c = wn * 64 + ni * 16 + i16, gg = c >> 6, d = c & 63;
#pragma unroll
                        for (int mi = 0; mi < 4; ++mi) {
                            const int rbase = row0 + wm * 64 + mi * 16 + g4 * 4;
                            const int b = rbase >> 14, s0 = rbase & (SEQ - 1);
                            const h4v o = {(half_t)acc[mi][ni][0], (half_t)acc[mi][ni][1], (half_t)acc[mi][ni][2], (half_t)acc[mi][ni][3]};
                            *(h4v*)(base + ((long)((b * 2 + gg) * 64 + d)) * SEQ + s0) = o;
                        }
                    }
                });
        } else {
            gemm_tile<false, true>(Ap, 1024, Bp, 1024, 1024, 1024, smem,
                [&](f4v (&acc)[4][4], int wm, int wn, int i16, int g4) __attribute__((always_inline)) {
#pragma unroll
                    for (int mi = 0; mi < 4; ++mi) {
                        const int t = row0 + wm * 64 + mi * 16 + i16;
                        const int b = t >> 14, sq = t & (SEQ - 1);
#pragma unroll
                        for (int ni = 0; ni < 4; ++ni) {
                            const int cb = n0 + wn * 64 + ni * 16;
                            const int n = cb + 4 * g4;
                            const f4v a = acc[mi][ni];
                            if (cb < 512) {
                                const h4v o = {(half_t)(a[0] * QS_NSA), (half_t)(a[1] * QS_NSA), (half_t)(a[2] * QS_NSA), (half_t)(a[3] * QS_NSA)};
                                *(h4v*)(QH + (long)t * 512 + n) = o;
                            } else if (cb < 1280) {
                                const int which = (cb - 512) >> 7;
                                const int c = (n - 512) & 127, gg = c >> 6, d = c & 63;
                                half_t* base = (half_t*)(ws + OFF_KC + (size_t)which * SZ_KV);
                                const h4v o = {(half_t)a[0], (half_t)a[1], (half_t)a[2], (half_t)a[3]};
                                *(h4v*)(base + ((long)(b * 2 + gg) * SEQ + sq) * 64 + d) = o;
                            } else if (cb < 1536) {
                                const h4v o = {(half_t)a[0], (half_t)a[1], (half_t)a[2], (half_t)a[3]};
                                *(h4v*)(CQ + (long)t * 256 + (n - 1280)) = o;
                            } else if (cb < 1664) {
                                const h4v o = {(half_t)a[0], (half_t)a[1], (half_t)a[2], (half_t)a[3]};
                                *(h4v*)(CKV + (long)t * 128 + (n - 1536)) = o;
                            } else if (cb == 1664) {
                                const f4v a2 = acc[mi][(ni + 1) & 3];
                                h4v o1, o2;
                                const int pos = p.pos[t];
#pragma unroll
                                for (int r = 0; r < 4; ++r) {
                                    float x1, x2;
                                    rope_pair(a[r], a2[r], pos, 4 * g4 + r, x1, x2);
                                    o1[r] = (half_t)x1; o2[r] = (half_t)x2;
                                }
#pragma unroll
                                for (int h = 0; h < 8; ++h) {
                                    half_t* kr = KM + ((long)(b * 8 + h) * SEQ + sq) * 96 + 64 + 4 * g4;
                                    *(h4v*)kr = o1; *(h4v*)(kr + 16) = o2;
                                }
                            } else if (cb >= 1696) {
                                const int j = n - 1696;
                                if (j < 24) {
                                    float4 o;
                                    o.x = 1.0f / (1.0f + __expf(-a[0])); o.y = 1.0f / (1.0f + __expf(-a[1]));
                                    o.z = 1.0f / (1.0f + __expf(-a[2])); o.w = 1.0f / (1.0f + __expf(-a[3]));
                                    *(float4*)(GATES + (long)t * 24 + j) = o;
                                }
                            }
                        }
                    }
                });
        }
    }
}

__device__ __forceinline__ void phase_p2(const Params& p, int bid, int nb, char* smem) {
    char* ws = p.ws;
    const int NTA = 256 * 6, NTB = 256 * 8, NTC = 128;
    for (int tile = bid; tile < NTA + NTB + NTC; tile += nb) {
        if (tile < NTC) {
            const int nt = tile & 1, mt = (tile >> 1) & 7, bg = (tile >> 4) & 3, kv = tile >> 6;
            const half_t* A = (const half_t*)(ws + (kv ? OFF_VC : OFF_KC)) + (long)bg * SEQ * 64 + (long)mt * 128 * 1024;
            const half_t* Bt = (const half_t*)(ws + OFF_WC1) + ((long)kv * 256 + nt * 128) * 2048;
            const float* cbv = (const float*)(ws + OFF_CB) + kv * 256;
            half_t* HC = (half_t*)(ws + OFF_HC1) + ((long)(kv * 4 + bg) * 1024) * 256;
            gemm_tile<false, true>(A, 1024, Bt, 2048, 2048, 2048, smem,
                [&](f4v (&acc)[4][4], int wm, int wn, int i16, int g4) __attribute__((always_inline)) {
#pragma unroll
                    for (int mi = 0; mi < 4; ++mi) {
                        const int m = mt * 128 + wm * 64 + mi * 16 + i16;
#pragma unroll
                        for (int ni = 0; ni < 4; ++ni) {
                            const int n = nt * 128 + wn * 64 + ni * 16 + 4 * g4;
                            const float4 bias = *(const float4*)(cbv + n);
                            const h4v o = {(half_t)gelu_exact(acc[mi][ni][0] + bias.x), (half_t)gelu_exact(acc[mi][ni][1] + bias.y),
                                           (half_t)gelu_exact(acc[mi][ni][2] + bias.z), (half_t)gelu_exact(acc[mi][ni][3] + bias.w)};
                            if (m < NCMP) *(h4v*)(HC + (long)m * 256 + n) = o;
                        }
                    }
                });
        } else if (tile < NTC + NTA) {
            const int t2 = tile - NTC;
            const int tm = t2 / 6, tn = t2 % 6;
            const int row0 = tm * 128, n0 = tn * 128;
            half_t* QM = (half_t*)(ws + OFF_QM);
            gemm_tile<true, true>((const half_t*)(ws + OFF_CQ) + (long)row0 * 256, 256, (const half_t*)(ws + OFF_WQUP) + (long)n0 * 256, 256, 256, 256, smem,
                [&](f4v (&acc)[4][4], int wm, int wn, int i16, int g4) __attribute__((always_inline)) {
#pragma unroll
                    for (int mi = 0; mi < 4; ++mi) {
                        const int t = row0 + wm * 64 + mi * 16 + i16;
                        const int b = t >> 14, sq = t & (SEQ - 1);
#pragma unroll
                        for (int ni = 0; ni < 4; ++ni) {
                            const int cb = n0 + wn * 64 + ni * 16;
                            const int h = cb / 96, d0 = cb - h * 96;
                            half_t* qr = QM + ((long)(b * 8 + h) * SEQ + sq) * 96;
                            const f4v a = acc[mi][ni];
                            if (d0 < 64) {
                                const h4v o = {(half_t)(a[0] * QS_MLA), (half_t)(a[1] * QS_MLA), (half_t)(a[2] * QS_MLA), (half_t)(a[3] * QS_MLA)};
                                *(h4v*)(qr + d0 + 4 * g4) = o;
                            } else if (d0 == 64) {
                                const f4v a2 = acc[mi][(ni + 1) & 3];
                                const int pos = p.pos[t];
                                h4v o1, o2;
#pragma unroll
                                for (int r = 0; r < 4; ++r) {
                                    float x1, x2;
                                    rope_pair(a[r] * QS_MLA, a2[r] * QS_MLA, pos, 4 * g4 + r, x1, x2);
                                    o1[r] = (half_t)x1; o2[r] = (half_t)x2;
                                }
                                *(h4v*)(qr + 64 + 4 * g4) = o1; *(h4v*)(qr + 80 + 4 * g4) = o2;
                            }
                        }
                    }
                });
        } else {
            const int t2 = tile - NTC - NTA;
            const int tm = t2 >> 3, tn = t2 & 7;
            const int row0 = tm * 128, n0 = tn * 128;
            half_t* KM = (half_t*)(ws + OFF_KM);
            half_t* VT = (half_t*)(ws + OFF_VT);
            gemm_tile<true, false>((const half_t*)(ws + OFF_CKV) + (long)row0 * 128, 128, (const half_t*)(ws + OFF_WKVUP) + (long)n0 * 128, 128, 128, 128, smem,
                [&](f4v (&acc)[4][4], int wm, int wn, int i16, int g4) __attribute__((always_inline)) {
                    const int h = tn;
#pragma unroll
                    for (int ni = 0; ni < 4; ++ni) {
                        const int d0 = wn * 64 + ni * 16;
#pragma unroll
                        for (int mi = 0; mi < 4; ++mi) {
                            const int rbase = row0 + wm * 64 + mi * 16 + g4 * 4;
                            const int b = rbase >> 14, s0 = rbase & (SEQ - 1);
                            if (d0 < 64) {
#pragma unroll
                                for (int r = 0; r < 4; ++r) KM[((long)(b * 8 + h) * SEQ + s0 + r) * 96 + d0 + i16] = (half_t)acc[mi][ni][r];
                            } else {
                                const h4v o = {(half_t)acc[mi][ni][0], (half_t)acc[mi][ni][1], (half_t)acc[mi][ni][2], (half_t)acc[mi][ni][3]};
                                *(h4v*)(VT + ((long)(b * 8 + h) * 64 + (d0 - 64 + i16)) * SEQ + s0) = o;
                            }
                        }
                    }
                });
        }
    }
}

constexpr int KMAX_KS = 128, KMAX_KW = 132, KMAX_KC = 136, KMAX_KM = 140, KMAX_BIAS = 156;
__device__ __forceinline__ void phase_cmp2(const Params& p, int bid, int nb) {
    char* ws = p.ws;
    unsigned* ctr = (unsigned*)(ws + OFF_CTRL);
    const long tid = (long)bid * NTHREADS + threadIdx.x, nth = (long)nb * NTHREADS;
    const int lane = threadIdx.x & 63;
    const half_t* HC = (const half_t*)(ws + OFF_HC1);
    half_t* KC = (half_t*)(ws + OFF_KCMP);
    half_t* VCT = (half_t*)(ws + OFF_VCMPT);
    for (long e = tid; e < 2L * 4 * 1024 * 64; e += nth) {
        const int d = (int)(e & 63), n = (int)((e >> 6) & 1023), bg = (int)((e >> 16) & 3), kv = (int)(e >> 18);
        float s = 0.f;
        if (n < NCMP) {
            const half_t* hr = HC + ((long)(kv * 4 + bg) * 1024 + n) * 256;
            const float* w2 = kv ? p.cmp_v_w2 : p.cmp_k_w2;
            for (int j = 0; j < 256; ++j) s += (float)hr[j] * w2[j * 64 + d];
        }
        const half_t sh = (half_t)s;
        if (kv == 0) {
            KC[((long)bg * 1024 + n) * 64 + d] = sh;
            const float nn = wave_sum((float)sh * (float)sh);
            if (lane == 0) atomicMax(&ctr[KMAX_KC + bg], __float_as_uint(nn));
        } else VCT[((long)bg * 64 + d) * 1024 + n] = sh;
    }
    {
        const int sub = lane & 7;
        const long grp = tid >> 3, ngrp = nth >> 3;
        for (int which = 0; which < 2; ++which) {
            const half_t* Kb = (const half_t*)(ws + (which ? OFF_KW : OFF_KS));
            float mx[4] = {0.f, 0.f, 0.f, 0.f};
            for (long row = grp; row < 4L * SEQ; row += ngrp) {
                const h8v v = *(const h8v*)(Kb + row * 64 + sub * 8);
                float d = 0.f;
#pragma unroll
                for (int j = 0; j < 4; ++j) d = __builtin_amdgcn_fdot2((h2v){v[2 * j], v[2 * j + 1]}, (h2v){v[2 * j], v[2 * j + 1]}, d, false);
                d = red8(d);
                const int bg = (int)(row >> 14);
#pragma unroll
                for (int q = 0; q < 4; ++q) mx[q] = (bg == q) ? fmaxf(mx[q], d) : mx[q];
            }
#pragma unroll
            for (int q = 0; q < 4; ++q) {
                float m = mx[q];
#pragma unroll
                for (int o = 32; o >= 1; o >>= 1) m = fmaxf(m, __shfl_xor(m, o));
                if (lane == 0 && m > 0.f) atomicMax(&ctr[(which ? KMAX_KW : KMAX_KS) + q], __float_as_uint(m));
            }
        }
        const half_t* Km = (const half_t*)(ws + OFF_KM);
        const long wv = tid >> 6, nwv = nth >> 6;
        for (long blk = wv; blk < 16L * SEQ / 64; blk += nwv) {
            const int bh = (int)(blk / (SEQ / 64));
            float mloc = 0.f;
#pragma unroll 1
            for (int rr = 0; rr < 8; ++rr) {
                const long row = blk * 64 + rr * 8 + (lane >> 3);
                const half_t* kr = Km + row * 96 + sub * 8;
                float d = 0.f;
                {
                    const h8v v = *(const h8v*)kr;
#pragma unroll
                    for (int j = 0; j < 4; ++j) d = __builtin_amdgcn_fdot2((h2v){v[2 * j], v[2 * j + 1]}, (h2v){v[2 * j], v[2 * j + 1]}, d, false);
                }
                if (sub < 4) {
                    const h8v v = *(const h8v*)(kr + 64);
#pragma unroll
                    for (int j = 0; j < 4; ++j) d = __builtin_amdgcn_fdot2((h2v){v[2 * j], v[2 * j + 1]}, (h2v){v[2 * j], v[2 * j + 1]}, d, false);
                }
                d = red8(d);
                mloc = fmaxf(mloc, d);
            }
#pragma unroll
            for (int o = 32; o >= 1; o >>= 1) mloc = fmaxf(mloc, __shfl_xor(mloc, o));
            if (lane == 0) atomicMax(&ctr[KMAX_KM + bh], __float_as_uint(mloc));
        }
    }
    if (tid == 0) {
        float mb = 0.f;
        for (int i = 0; i < 256; ++i) mb = fmaxf(mb, p.t5_bias[i] * LOG2E);
        ctr[KMAX_BIAS] = __float_as_uint(mb);
    }
}

struct MlaSmem { half_t K[2][64][104]; half_t V[2][64][68]; };

__device__ __forceinline__ void mla_item(const Params& p, int bh, int qb, char* smem) {
    MlaSmem& sm = *(MlaSmem*)smem;
    char* ws = p.ws;
    const int b = bh >> 3, h = bh & 7;
    const half_t* Qp = (const half_t*)(ws + OFF_QM) + ((long)bh * SEQ + qb * 128) * 96;
    const half_t* Kp = (const half_t*)(ws + OFF_KM) + (long)bh * SEQ * 96;
    const half_t* Vp = (const half_t*)(ws + OFF_VT) + (long)bh * 64 * SEQ;
    half_t* MIX = (half_t*)(ws + OFF_MIXED);
    int tid_ = threadIdx.x; asm volatile("" : "+v"(tid_));
    const int tid = tid_, lane = tid & 63, w = tid >> 6;
    const int c = lane & 31, hh = lane >> 5;
    const int tq = qb * 128 + w * 32 + c;
    h8v qf[6];
#pragma unroll
    for (int s6 = 0; s6 < 6; ++s6) qf[s6] = *(const h8v*)(Qp + (long)(w * 32 + c) * 96 + s6 * 16 + hh * 8);
    f16v o0, o1;
#pragma unroll
    for (int i = 0; i < 16; ++i) { o0[i] = 0.f; o1[i] = 0.f; }
    float qn2 = 0.f;
#pragma unroll
    for (int s6 = 0; s6 < 6; ++s6)
#pragma unroll
        for (int j = 0; j < 8; ++j) { const float f = (float)qf[s6][j]; qn2 += f * f; }
    qn2 += __shfl_xor(qn2, 32);
    const float kmax2 = __uint_as_float(((const unsigned*)(ws + OFF_CTRL))[KMAX_KM + bh]);
    const float nmref = 10.0f - sqrtf(qn2 * kmax2) * 1.0005f;
    float l = 0.f;
    const int ntiles = 2 * qb + 2;
    auto gload = [&](int j, u4v (&rk)[3], u4v (&rv)[2]) __attribute__((always_inline)) {
#pragma unroll
        for (int i = 0; i < 3; ++i) {
            const int ci = tid + 256 * i, key = ci / 12, of = ci % 12;
            rk[i] = *(const u4v*)(Kp + (long)(j * 64 + key) * 96 + of * 8);
        }
#pragma unroll
        for (int i = 0; i < 2; ++i) {
            const int ci = tid + 256 * i, dim = ci >> 3, of = ci & 7;
            rv[i] = *(const u4v*)(Vp + (long)dim * SEQ + j * 64 + of * 8);
        }
    };
    auto lstore = [&](int buf, const u4v (&rk)[3], const u4v (&rv)[2]) __attribute__((always_inline)) {
#pragma unroll
        for (int i = 0; i < 3; ++i) {
            const int ci = tid + 256 * i, key = ci / 12, of = ci % 12;
            *(u4v*)&sm.K[buf][key][of * 8] = rk[i];
        }
#pragma unroll
        for (int i = 0; i < 2; ++i) {
            const int ci = tid + 256 * i, dim = ci >> 3, of = ci & 7;
            *(u2v*)&sm.V[buf][dim][of * 8] = (u2v){rv[i][0], rv[i][1]};
            *(u2v*)&sm.V[buf][dim][of * 8 + 4] = (u2v){rv[i][2], rv[i][3]};
        }
    };
    const int qmin = qb * 128 + w * 32;
    auto compute = [&](int j, int buf) __attribute__((always_inline)) {
        if (64 * j <= qmin + 31) {
            f16v s0, s1;
#pragma unroll
            for (int i = 0; i < 16; ++i) { s0[i] = nmref; s1[i] = nmref; }
#pragma unroll
            for (int s6 = 0; s6 < 6; ++s6) {
                const h8v a0 = *(const h8v*)&sm.K[buf][c][s6 * 16 + hh * 8];
                const h8v a1 = *(const h8v*)&sm.K[buf][32 + c][s6 * 16 + hh * 8];
                s0 = mfma32(a0, qf[s6], s0);
                s1 = mfma32(a1, qf[s6], s1);
            }
            if (64 * j + 63 > qmin) {
#pragma unroll
                for (int r = 0; r < 16; ++r) {
                    const int key = 64 * j + (r & 3) + 8 * (r >> 2) + 4 * hh;
                    if (key > tq) s0[r] = NEGF;
                    if (key + 32 > tq) s1[r] = NEGF;
                }
            }
#pragma unroll
            for (int r = 0; r < 16; ++r) { s0[r] = fast_exp2(s0[r]); l += s0[r]; }
#pragma unroll
            for (int r = 0; r < 16; ++r) { s1[r] = fast_exp2(s1[r]); l += s1[r]; }
#pragma unroll
            for (int ks = 0; ks < 4; ++ks) {
                h8v pb;
#pragma unroll
                for (int jj = 0; jj < 8; ++jj) pb[jj] = (half_t)((ks < 2) ? s0[8 * (ks & 1) + jj] : s1[8 * (ks & 1) + jj]);
#pragma unroll
                for (int md = 0; md < 2; ++md) {
                    const h4v lo = *(const h4v*)&sm.V[buf][32 * md + c][16 * ks + 4 * hh];
                    const h4v hi = *(const h4v*)&sm.V[buf][32 * md + c][16 * ks + 8 + 4 * hh];
                    const h8v a = {lo[0], lo[1], lo[2], lo[3], hi[0], hi[1], hi[2], hi[3]};
                    if (md == 0) o0 = mfma32(a, pb, o0); else o1 = mfma32(a, pb, o1);
                }
            }
        }
    };
    u4v rkA[3], rvA[2], rkB[3], rvB[2];
    gload(0, rkA, rvA);
    gload(1, rkB, rvB);
    lstore(0, rkA, rvA);
    __syncthreads();
#pragma unroll 1
    for (int j = 0; j < ntiles; j += 2) {
        if (j + 2 < ntiles) gload(j + 2, rkA, rvA);
        compute(j, 0);
        lstore(1, rkB, rvB);
        __syncthreads();
        if (j + 3 < ntiles) gload(j + 3, rkB, rvB);
        compute(j + 1, 1);
        if (j + 2 < ntiles) lstore(0, rkA, rvA);
        __syncthreads();
    }
    const float lt = l + __shfl_xor(l, 32);
    const float inv = 1.0f / lt;
    half_t* orow = MIX + (long)(b * SEQ + tq) * 1024 + 512 + h * 64;
#pragma unroll
    for (int md = 0; md < 2; ++md)
#pragma unroll
        for (int rg = 0; rg < 4; ++rg) {
            h4v o;
#pragma unroll
            for (int e = 0; e < 4; ++e) o[e] = (half_t)(((md == 0) ? o0[4 * rg + e] : o1[4 * rg + e]) * inv);
            *(h4v*)(orow + 32 * md + 8 * rg + 4 * hh) = o;
        }
}

struct NsaStage { half_t K[64][72]; half_t V[64][68]; };
constexpr int NSA_LUT = 0;
constexpr int NSA_ST0 = 12288;
constexpr int NSA_RB = NSA_ST0 + 17920;
constexpr int NSA_SEL = NSA_RB + 32768;
constexpr int NSA_MASK = NSA_SEL + 2048;
constexpr int NSA_END = NSA_MASK + 1024;
constexpr float MINIT = -30000.0f;

__device__ __forceinline__ void nsa_item(const Params& p, int bg, int qt, char* smem) {
    char* ws = p.ws;
    half_t* lut = (half_t*)(smem + NSA_LUT);
    float (*imp)[8][256] = (float (*)[8][256])(smem + NSA_RB);
    int (*sel)[8][16] = (int (*)[8][16])(smem + NSA_SEL);
    unsigned* masks = (unsigned*)(smem + NSA_MASK);
    const int b = bg >> 1, g = bg & 1;
    int tid_ = threadIdx.x; asm volatile("" : "+v"(tid_));
    const int tid = tid_, lane = tid & 63, w = tid >> 6;
    const int c = lane & 31, hh = lane >> 5;
    const int qi = c >> 2, r = c & 3;
    const int t0 = qt * 32;
    const int t0w = t0 + w * 8;
    const int tq = t0w + qi;
    const int tlast = t0w + 7;
    {
        const float* lg = (const float*)(ws + OFF_LUT) + (long)g * LUTN * 4;
        for (int i = tid; i < LUTN * 4; i += NTHREADS) lut[i] = (half_t)lg[i];
        float* im = &imp[0][0][0];
        for (int i = tid; i < 4 * 8 * 256; i += NTHREADS) im[i] = 0.f;
    }
    __syncthreads();
    const float cfar = (float)lut[(LUTN - 1) * 4 + r];
    const half_t* QH = (const half_t*)(ws + OFF_QH);
    h8v qf[4];
#pragma unroll
    for (int s4 = 0; s4 < 4; ++s4) qf[s4] = *(const h8v*)(QH + (long)(b * SEQ + tq) * 512 + (g * 4 + r) * 64 + s4 * 16 + hh * 8);
    float nrefC, nrefS, nrefW;
    {
        float qn2 = 0.f;
#pragma unroll
        for (int s4 = 0; s4 < 4; ++s4)
#pragma unroll
            for (int j = 0; j < 8; ++j) { const float f = (float)qf[s4][j]; qn2 += f * f; }
        qn2 += __shfl_xor(qn2, 32);
        const unsigned* cw = (const unsigned*)(ws + OFF_CTRL);
        const float mb = __uint_as_float(cw[KMAX_BIAS]);
        nrefC = 10.0f - mb - sqrtf(qn2 * __uint_as_float(cw[KMAX_KC + bg])) * 1.0005f;
        nrefS = 10.0f - mb - sqrtf(qn2 * __uint_as_float(cw[KMAX_KS + bg])) * 1.0005f;
        nrefW = 10.0f - mb - sqrtf(qn2 * __uint_as_float(cw[KMAX_KW + bg])) * 1.0005f;
    }
    const float* gp = (const float*)(ws + OFF_GATES) + (long)(b * SEQ + tq) * 24 + (g * 4 + r) * 3;
    const float g0 = gp[0], g1 = gp[1], g2 = gp[2];
    f16v of0, of1;
#pragma unroll
    for (int i = 0; i < 16; ++i) { of0[i] = 0.f; of1[i] = 0.f; }

    u4v rk[2], rvv[2];
    auto stage_gload = [&](const half_t* Kg, const half_t* Vg, long ldv, int key0, bool withv) __attribute__((always_inline)) {
#pragma unroll
        for (int i = 0; i < 2; ++i) {
            const int ci = tid + 256 * i, row = ci >> 3, of = ci & 7;
            rk[i] = *(const u4v*)(Kg + (long)(key0 + row) * 64 + of * 8);
            if (withv) rvv[i] = *(const u4v*)(Vg + (long)row * ldv + key0 + of * 8);
        }
    };
    auto stage_lstore = [&](NsaStage& st, bool withv) __attribute__((always_inline)) {
#pragma unroll
        for (int i = 0; i < 2; ++i) {
            const int ci = tid + 256 * i, row = ci >> 3, of = ci & 7;
            *(u4v*)&st.K[row][of * 8] = rk[i];
            if (withv) {
                *(u2v*)&st.V[row][of * 8] = (u2v){rvv[i][0], rvv[i][1]};
                *(u2v*)&st.V[row][of * 8 + 4] = (u2v){rvv[i][2], rvv[i][3]};
            }
        }
    };
    auto qk32 = [&](const NsaStage& st, int mt, float init) __attribute__((always_inline)) -> f16v {
        f16v s;
#pragma unroll
        for (int i = 0; i < 16; ++i) s[i] = init;
#pragma unroll
        for (int s4 = 0; s4 < 4; ++s4) {
            const h8v a = *(const h8v*)&st.K[32 * mt + c][s4 * 16 + hh * 8];
            s = mfma32(a, qf[s4], s);
        }
        return s;
    };
    auto pv32 = [&](const NsaStage& st, int mt, const f16v& pr, f16v& oa, f16v& ob) __attribute__((always_inline)) {
#pragma unroll
        for (int ks = 0; ks < 2; ++ks) {
            h8v pb;
#pragma unroll
            for (int jj = 0; jj < 8; ++jj) pb[jj] = (half_t)pr[8 * ks + jj];
#pragma unroll
            for (int md = 0; md < 2; ++md) {
                const h4v lo = *(const h4v*)&st.V[32 * md + c][32 * mt + 16 * ks + 4 * hh];
                const h4v hi = *(const h4v*)&st.V[32 * md + c][32 * mt + 16 * ks + 8 + 4 * hh];
                const h8v a = {lo[0], lo[1], lo[2], lo[3], hi[0], hi[1], hi[2], hi[3]};
                if (md == 0) oa = mfma32(a, pb, oa); else ob = mfma32(a, pb, ob);
            }
        }
    };
    NsaStage& st0 = *(NsaStage*)(smem + NSA_ST0);
    NsaStage& st1 = *(NsaStage*)(smem + NSA_RB);

    {
        const half_t* KC = (const half_t*)(ws + OFF_KCMP) + (long)bg * 1024 * 64;
        const half_t* VCT = (const half_t*)(ws + OFF_VCMPT) + (long)bg * 64 * 1024;
        const int nst = ((t0 >> 4) >> 6) + 1;
        auto cmp_scores = [&](f16v& s, int kbase) __attribute__((always_inline)) {
            const bool far = (t0w - (16 * (kbase + 31) + 31)) >= 1513;
            if (far) {
#pragma unroll
                for (int rr = 0; rr < 16; ++rr) s[rr] += cfar;
            } else {
#pragma unroll
                for (int rr = 0; rr < 16; ++rr) {
                    const int k = kbase + (rr & 3) + 8 * (rr >> 2) + 4 * hh;
                    const int dist = tq - (16 * k + 31);
                    const int di = dist < 0 ? 0 : (dist > LUTN - 1 ? LUTN - 1 : dist);
                    s[rr] = (dist >= 0) ? s[rr] + (float)lut[di * 4 + r] : NEGF;
                }
            }
        };
        float l = 0.f;
        stage_gload(KC, VCT, 1024, 0, false);
#pragma unroll 1
        for (int sg = 0; sg < nst; ++sg) {
            stage_lstore(st0, false);
            __syncthreads();
            if (sg + 1 < nst) stage_gload(KC, VCT, 1024, (sg + 1) * 64, false);
#pragma unroll
            for (int mt = 0; mt < 2; ++mt) {
                const int kbase = sg * 64 + mt * 32;
                if (16 * kbase + 31 <= tlast) {
                    f16v s = qk32(st0, mt, nrefC);
                    cmp_scores(s, kbase);
#pragma unroll
                    for (int rr = 0; rr < 16; ++rr) l += fast_exp2(s[rr]);
                }
            }
            __syncthreads();
        }
        l += __shfl_xor(l, 32);
        const float ml2 = (l > 0.f) ? __builtin_amdgcn_logf(l) : 1e30f;
        f16v oc0, oc1;
#pragma unroll
        for (int i = 0; i < 16; ++i) { oc0[i] = 0.f; oc1[i] = 0.f; }
        float carryL = 0.f;
        stage_gload(KC, VCT, 1024, 0, true);
#pragma unroll 1
        for (int sg = 0; sg < nst; ++sg) {
            stage_lstore(st0, true);
            __syncthreads();
            if (sg + 1 < nst) stage_gload(KC, VCT, 1024, (sg + 1) * 64, true);
#pragma unroll
            for (int mt = 0; mt < 2; ++mt) {
                const int kbase = sg * 64 + mt * 32;
                const int kt = sg * 2 + mt;
                if (16 * kbase + 31 <= tlast) {
                    f16v s = qk32(st0, mt, nrefC);
                    cmp_scores(s, kbase);
#pragma unroll
                    for (int rr = 0; rr < 16; ++rr) s[rr] = fast_exp2(s[rr] - ml2);
                    float Gs[4], Ls[4];
#pragma unroll
                    for (int jg = 0; jg < 4; ++jg) {
                        float G = s[4 * jg] + s[4 * jg + 1] + s[4 * jg + 2] + s[4 * jg + 3];
                        float L = s[4 * jg + 3];
                        G += __shfl_xor(G, 1); G += __shfl_xor(G, 2);
                        L += __shfl_xor(L, 1); L += __shfl_xor(L, 2);
                        Gs[jg] = G; Ls[jg] = L;
                    }
                    float Lo[4];
#pragma unroll
                    for (int jg = 0; jg < 4; ++jg) Lo[jg] = __shfl_xor(Ls[jg], 32);
                    if (r == 0) {
#pragma unroll
                        for (int jg = 0; jg < 4; ++jg) {
                            const float prevL = hh ? Lo[jg] : (jg == 0 ? carryL : Lo[jg - 1]);
                            imp[w][qi][8 * kt + 2 * jg + hh] = Gs[jg] + prevL;
                        }
                    }
                    carryL = Lo[3];
                    pv32(st0, mt, s, oc0, oc1);
                }
            }
            __syncthreads();
        }
#pragma unroll
        for (int i = 0; i < 16; ++i) { of0[i] += g0 * oc0[i]; of1[i] += g0 * oc1[i]; }
    }
    {
        const int q2 = lane >> 3, sub = lane & 7;
        const int tq2 = t0w + q2;
        const int cur = tq2 >> 6;
        unsigned key[32];
#pragma unroll
        for (int i = 0; i < 32; ++i) {
            const int sb = sub + 8 * i;
            const float v = imp[w][q2][sb];
            unsigned u = (__float_as_uint(v) & 0x7FFFFF00u) | (unsigned)(255 - sb);
            if (sb == 0 || sb == cur || sb == cur - 1) u |= 0x80000000u;
            if (sb > cur) u = 0u;
            key[i] = u;
        }
#pragma unroll 1
        for (int round = 0; round < 16; ++round) {
            unsigned best = key[0];
#pragma unroll
            for (int i = 1; i < 32; ++i) best = best > key[i] ? best : key[i];
#pragma unroll
            for (int o = 1; o <= 4; o <<= 1) { const unsigned ob = (unsigned)__shfl_xor((int)best, o); best = best > ob ? best : ob; }
            if (sub == 0) sel[w][q2][round] = best ? (int)(255u - (best & 0xFFu)) : -1;
#pragma unroll
            for (int i = 0; i < 32; ++i) key[i] = (key[i] == best) ? 0u : key[i];
        }
    }
    for (int i = tid; i < 256; i += NTHREADS) masks[i] = 0u;
    __syncthreads();
    for (int e = lane; e < 128; e += 64) {
        const int q2 = e >> 4, bi = e & 15;
        const int blk = sel[w][q2][bi];
        if (blk >= 0) atomicOr(&masks[blk], 1u << (8 * w + q2));
    }
    __syncthreads();
    auto block_attend = [&](const NsaStage& st, int key0, bool colsel, bool window, float nref, float& l, f16v& oa, f16v& ob) __attribute__((always_inline)) {
        const bool far = !window && (t0w - (key0 + 63)) >= 1513;
        f16v s0, s1;
        if (far) {
            const float init = colsel ? (cfar + nref) : NEGF;
            s0 = qk32(st, 0, init); s1 = qk32(st, 1, init);
        } else {
            s0 = qk32(st, 0, nref); s1 = qk32(st, 1, nref);
#pragma unroll
            for (int rr = 0; rr < 16; ++rr) {
                const int pos = key0 + (rr & 3) + 8 * (rr >> 2) + 4 * hh;
                {
                    const int dist = tq - pos;
                    const bool valid = colsel && dist >= 0 && (!window || dist < 512);
                    const int di = dist < 0 ? 0 : (dist > LUTN - 1 ? LUTN - 1 : dist);
                    s0[rr] = valid ? s0[rr] + (float)lut[di * 4 + r] : NEGF;
                }
                {
                    const int dist = tq - pos - 32;
                    const bool valid = colsel && dist >= 0 && (!window || dist < 512);
                    const int di = dist < 0 ? 0 : (dist > LUTN - 1 ? LUTN - 1 : dist);
                    s1[rr] = valid ? s1[rr] + (float)lut[di * 4 + r] : NEGF;
                }
            }
        }
#pragma unroll
        for (int rr = 0; rr < 16; ++rr) { s0[rr] = fast_exp2(s0[rr]); l += s0[rr]; }
#pragma unroll
        for (int rr = 0; rr < 16; ++rr) { s1[rr] = fast_exp2(s1[rr]); l += s1[rr]; }
        pv32(st, 0, s0, oa, ob);
        pv32(st, 1, s1, oa, ob);
    };
    {
        const half_t* KS = (const half_t*)(ws + OFF_KS) + (long)bg * SEQ * 64;
        const half_t* VST = (const half_t*)(ws + OFF_VST) + (long)bg * 64 * SEQ;
        f16v os0, os1;
#pragma unroll
        for (int i = 0; i < 16; ++i) { os0[i] = 0.f; os1[i] = 0.f; }
        float l = 0.f;
        const int jmax = (t0 + 31) >> 6;
        int j = 0;
        while (j <= jmax && masks[j] == 0u) ++j;
        int buf = 0;
        if (j <= jmax) stage_gload(KS, VST, SEQ, j * 64, true);
#pragma unroll 1
        while (j <= jmax) {
            NsaStage& st = buf ? st1 : st0;
            stage_lstore(st, true);
            __syncthreads();
            int jn = j + 1;
            while (jn <= jmax && masks[jn] == 0u) ++jn;
            if (jn <= jmax) stage_gload(KS, VST, SEQ, jn * 64, true);
            const unsigned mk = masks[j];
            if ((mk >> (8 * w)) & 0xFFu) {
                const bool colsel = (mk >> (8 * w + qi)) & 1u;
                block_attend(st, j * 64, colsel, false, nrefS, l, os0, os1);
            }
            buf ^= 1; j = jn;
        }
        const float lt = l + __shfl_xor(l, 32);
        const float sc = (lt > 0.f) ? g1 / lt : 0.f;
#pragma unroll
        for (int i = 0; i < 16; ++i) { of0[i] += sc * os0[i]; of1[i] += sc * os1[i]; }
    }
    __syncthreads();
    {
        const half_t* KW = (const half_t*)(ws + OFF_KW) + (long)bg * SEQ * 64;
        const half_t* VWT = (const half_t*)(ws + OFF_VWT) + (long)bg * 64 * SEQ;
        f16v ow0, ow1;
#pragma unroll
        for (int i = 0; i < 16; ++i) { ow0[i] = 0.f; ow1[i] = 0.f; }
        float l = 0.f;
        const int jmax = (t0 + 31) >> 6;
        int j = (t0 >= 511) ? ((t0 - 511) >> 6) : 0;
        int buf = 0;
        stage_gload(KW, VWT, SEQ, j * 64, true);
#pragma unroll 1
        while (j <= jmax) {
            NsaStage& st = buf ? st1 : st0;
            stage_lstore(st, true);
            __syncthreads();
            if (j + 1 <= jmax) stage_gload(KW, VWT, SEQ, (j + 1) * 64, true);
            block_attend(st, j * 64, true, true, nrefW, l, ow0, ow1);
            buf ^= 1; ++j;
        }
        const float lt = l + __shfl_xor(l, 32);
        const float sc = (lt > 0.f) ? g2 / lt : 0.f;
#pragma unroll
        for (int i = 0; i < 16; ++i) { of0[i] += sc * ow0[i]; of1[i] += sc * ow1[i]; }
    }
    {
        half_t* orow = (half_t*)(ws + OFF_MIXED) + (long)(b * SEQ + tq) * 1024 + (g * 4 + r) * 64;
#pragma unroll
        for (int md = 0; md < 2; ++md)
#pragma unroll
            for (int rg = 0; rg < 4; ++rg) {
                h4v o;
#pragma unroll
                for (int e = 0; e < 4; ++e) o[e] = (half_t)((md == 0) ? of0[4 * rg + e] : of1[4 * rg + e]);
                *(h4v*)(orow + 32 * md + 8 * rg + 4 * hh) = o;
            }
    }
    __syncthreads();
}

__device__ __forceinline__ void phase_attn(const Params& p, char* smem, int cidx = 64, int mode = 0) {
    unsigned* ctr = (unsigned*)(p.ws + OFF_CTRL) + cidx;
    volatile int* s_item = (volatile int*)(smem + 66048);
    const int x0 = (int)(xb_xcc_id() & 7u);
    const int lo = (mode == 2) ? 256 : 0, hi = (mode == 1) ? 256 : 512;
    for (int k = 0; k < 8; ++k) {
        const int q = (x0 + k) & 7;
        for (;;) {
            if (threadIdx.x == 0) {
                int v = -1;
                if (__hip_atomic_load(&ctr[q], __ATOMIC_RELAXED, __HIP_MEMORY_SCOPE_AGENT) < (unsigned)(hi - lo)) v = (int)atomicAdd(&ctr[q], 1u) + lo;
                *s_item = v;
            }
            __syncthreads();
            const int li = *s_item;
            __syncthreads();
            if (li < 0 || li >= hi) break;
            if (li < 256) mla_item(p, 2 * q + (li & 1), 127 - (li >> 1), smem);
            else nsa_item(p, q & 3, 511 - 2 * (li - 256) - (q >> 2), smem);
        }
    }
}

__device__ __forceinline__ void phase_outproj(const Params& p, int bid, int nb, char* smem) {
    char* ws = p.ws;
    const half_t* MIX = (const half_t*)(ws + OFF_MIXED);
    const half_t* W = (const half_t*)(ws + OFF_WOUT);
    half_t* X2H = (half_t*)(ws + OFF_X2H);
    for (int tile = bid; tile < 256 * 8; tile += nb) {
        const int tm = tile >> 3, tn = tile & 7;
        const int row0 = tm * 128, n0 = tn * 128;
        gemm_tile<true, true>(MIX + (long)row0 * 1024, 1024, W + (long)n0 * 1024, 1024, 1024, 512, smem,
            [&](f4v (&acc)[4][4], int wm, int wn, int i16, int g4) __attribute__((always_inline)) {
#pragma unroll
                for (int mi = 0; mi < 4; ++mi) {
                    const long row = row0 + wm * 64 + mi * 16 + i16;
#pragma unroll
                    for (int ni = 0; ni < 4; ++ni) {
                        const int col = n0 + wn * 64 + ni * 16 + 4 * g4;
                        float4 v = *(const float4*)(p.x + row * 1024 + col);
                        v.x += acc[mi][ni][0]; v.y += acc[mi][ni][1]; v.z += acc[mi][ni][2]; v.w += acc[mi][ni][3];
                        *(float4*)(p.out + row * 1024 + col) = v;
                        const h4v o = {(half_t)v.x, (half_t)v.y, (half_t)v.z, (half_t)v.w};
                        *(h4v*)(X2H + row * 1024 + col) = o;
                    }
                }
            });
    }
}

__device__ __forceinline__ void phase_peerq(const Params& p, int bid, int nb, char* smem) {
    char* ws = p.ws;
    const half_t* X2H = (const half_t*)(ws + OFF_X2H);
    const half_t* W = (const half_t*)(ws + OFF_WPQ);
    half_t* QP = (half_t*)(ws + OFF_QP);
    for (int tile = bid; tile < 256 * 16; tile += nb) {
        const int tm = tile >> 4, tn = tile & 15;
        const int row0 = tm * 128, n0 = tn * 128;
        gemm_tile<true, true>(X2H + (long)row0 * 1024, 1024, W + (long)n0 * 1024, 1024, 1024, 1024, smem,
            [&](f4v (&acc)[4][4], int wm, int wn, int i16, int g4) __attribute__((always_inline)) {
#pragma unroll
                for (int mi = 0; mi < 4; ++mi) {
                    const long row = row0 + wm * 64 + mi * 16 + i16;
#pragma unroll
                    for (int ni = 0; ni < 4; ++ni) {
                        const int col = n0 + wn * 64 + ni * 16 + 4 * g4;
                        const h4v o = {(half_t)acc[mi][ni][0], (half_t)acc[mi][ni][1], (half_t)acc[mi][ni][2], (half_t)acc[mi][ni][3]};
                        *(h4v*)(QP + row * 2048 + col) = o;
                    }
                }
            });
    }
}

__device__ __forceinline__ void topk_insert(float (&tv)[16], int (&ti)[16], float v, int id) {
#pragma unroll
    for (int k = 0; k < 16; ++k) {
        const bool gt = v > tv[k];
        const float nv = gt ? tv[k] : v; const int ni = gt ? ti[k] : id;
        tv[k] = gt ? v : tv[k]; ti[k] = gt ? id : ti[k];
        v = nv; id = ni;
    }
}
__device__ __forceinline__ void route_half(const half_t* __restrict__ qsrc_h, const half_t* kb, float (&tv)[16], int (&ti)[16]) {
    h2v q[64];
    const h8v* qsrc = (const h8v*)qsrc_h;
#pragma unroll
    for (int i = 0; i < 16; ++i) {
        const h8v v = qsrc[i];
        q[4 * i] = (h2v){v[0], v[1]}; q[4 * i + 1] = (h2v){v[2], v[3]};
        q[4 * i + 2] = (h2v){v[4], v[5]}; q[4 * i + 3] = (h2v){v[6], v[7]};
    }
#pragma unroll
    for (int k = 0; k < 16; ++k) { tv[k] = -3.0e38f; ti[k] = 0; }
    for (int n = 0; n < 128; ++n) {
        float s = 0.f;
        const h8v* kr = (const h8v*)(kb + n * 128);
#pragma unroll
        for (int i = 0; i < 16; ++i) {
            const h8v kv = kr[i];
            s = __builtin_amdgcn_fdot2(q[4 * i], (h2v){kv[0], kv[1]}, s, false);
            s = __builtin_amdgcn_fdot2(q[4 * i + 1], (h2v){kv[2], kv[3]}, s, false);
            s = __builtin_amdgcn_fdot2(q[4 * i + 2], (h2v){kv[4], kv[5]}, s, false);
            s = __builtin_amdgcn_fdot2(q[4 * i + 3], (h2v){kv[6], kv[7]}, s, false);
        }
        topk_insert(tv, ti, s, n);
    }
}
__device__ __forceinline__ void phase_route(const Params& p, int bid, int nb, char* smem) {
    char* ws = p.ws;
    half_t* keys = (half_t*)smem;
    {
        const u4v* src = (const u4v*)(ws + OFF_KEYS);
        u4v* dst = (u4v*)smem;
        for (int i = threadIdx.x; i < 65536 / 16; i += NTHREADS) dst[i] = src[i];
    }
    __syncthreads();
    const half_t* QP = (const half_t*)(ws + OFF_QP);
    int* EID = (int*)(ws + OFF_EID);
    float* GW = (float*)(ws + OFF_GW);
    for (long th = (long)bid * NTHREADS + threadIdx.x; th < (long)NTOK * 8; th += (long)nb * NTHREADS) {
        float tv0[16], tv1[16]; int ti0[16], ti1[16];
        route_half(QP + th * 256, keys, tv0, ti0);
        route_half(QP + th * 256 + 128, keys + 16384, tv1, ti1);
        float fv[16]; int fi[16];
#pragma unroll
        for (int k = 0; k < 16; ++k) { fv[k] = -3.0e38f; fi[k] = 0; }
#pragma unroll
        for (int i = 0; i < 16; ++i)
#pragma unroll
            for (int j = 0; j < 16; ++j)
                if ((i + 1) * (j + 1) <= 16) topk_insert(fv, fi, tv0[i] + tv1[j], ti0[i] * 128 + ti1[j]);
        float sum = 0.f, ex[16];
#pragma unroll
        for (int k = 0; k < 16; ++k) { ex[k] = __expf(fv[k] - fv[0]); sum += ex[k]; }
        const float inv = 1.0f / sum;
#pragma unroll
        for (int k = 0; k < 16; ++k) { EID[th * 16 + k] = fi[k]; GW[th * 16 + k] = ex[k] * inv; }
    }
}

__device__ __forceinline__ int peer_next_task(unsigned* q, int xpref, int ntask_per_slice, volatile int* s_task) {
    if (threadIdx.x == 0) {
        int res = -1;
        for (int k = 0; k < 8; ++k) {
            const int x = (xpref + k) & 7;
            if (__hip_atomic_load(&q[x], __ATOMIC_RELAXED, __HIP_MEMORY_SCOPE_AGENT) >= (unsigned)ntask_per_slice) continue;
            const unsigned c = atomicAdd(&q[x], 1u);
            if (c < (unsigned)ntask_per_slice) { res = x * ntask_per_slice + (int)c; break; }
        }
        *s_task = res;
    }
    __syncthreads();
    const int r = *s_task;
    __syncthreads();
    return r;
}
template <int PMODE>
__device__ __forceinline__ void phase_peer_udot(const Params& p, char* smem, int qoff = 16) {
    char* ws = p.ws;
    unsigned* q = (unsigned*)(ws + OFF_CTRL) + qoff;
    volatile int* s_task = (volatile int*)(smem + 66048);
    const unsigned char* U8 = (const unsigned char*)(ws + OFF_U16);
    const half_t* X2H = (const half_t*)(ws + OFF_X2H);
    const int* EID = (const int*)(ws + OFF_EID);
    float* PD = (float*)(ws + OFF_PD);
    const int xpref = (int)(xb_xcc_id() & 7u);
    for (;;) {
        const int task = peer_next_task(q, xpref, 512, s_task);
        if (task < 0) break;
        const int x = task >> 9, chunk = task & 511;
        int tid_ = threadIdx.x; asm volatile("" : "+v"(tid_));
        const int lane = tid_ & 63, w = tid_ >> 6, seg = lane & 7, eg = lane >> 3;
        h2v gs[8];
#pragma unroll
        for (int i = 0; i < 8; ++i) gs[i] = (h2v){(half_t)p.norm2_g[128 * x + 16 * seg + 2 * i], (half_t)p.norm2_g[128 * x + 16 * seg + 2 * i + 1]};
        const unsigned char* Ux = U8 + (long)x * 16384 * 128 + 16 * seg;
        const int tbase = chunk * 64 + w * 16;
        const int* Eb = EID + (long)tbase * 128 + 16 * eg;
        const half_t* Xb = X2H + (long)tbase * 1024 + 128 * x + 16 * seg;
#define LOAD_E(dst, k) { const u4v* ep_ = (const u4v*)(Eb + (long)(k) * 128); dst[0] = ep_[0]; dst[1] = ep_[1]; dst[2] = ep_[2]; dst[3] = ep_[3]; }
#define LOAD_X(xa_, xb_, k) { xa_ = *(const h8v*)(Xb + (long)(k) * 1024); xb_ = *(const h8v*)(Xb + (long)(k) * 1024 + 8); }
#define ISSUE_U(uu, e_) { _Pragma("unroll") for (int i = 0; i < 16; ++i) uu[i] = *(const u4v*)(Ux + (long)e_[i >> 2][i & 3] * 128); }
        auto compute = [&](int k, const h8v& xa, const h8v& xb, const u4v (&uu)[16]) __attribute__((always_inline)) {
            h2v hs[8];
#pragma unroll
            for (int i = 0; i < 4; ++i) {
                hs[i] = (h2v){xa[2 * i], xa[2 * i + 1]} * gs[i];
                hs[4 + i] = (h2v){xb[2 * i], xb[2 * i + 1]} * gs[4 + i];
            }
            float res0 = 0.f, res1 = 0.f;
            if (PMODE == 1) {
                unsigned acc_ = 0;
#pragma unroll
                for (int i = 0; i < 16; ++i) acc_ ^= uu[i][0] ^ uu[i][1] ^ uu[i][2] ^ uu[i][3];
                float* po = (float*)(p.ws + OFF_HC1) + (((long)(tbase + k) * 128 + 16 * eg + seg) & 0xFFFFF);
                po[0] = __builtin_bit_cast(float, acc_) + (float)hs[0][0];
                return;
            }
#pragma unroll
            for (int i = 0; i < 16; ++i) {
                float d = 0.f;
#pragma unroll
                for (int j = 0; j < 4; ++j) {
                    const h2v lo = __builtin_amdgcn_cvt_scalef32_pk_f16_fp8((int)uu[i][j], 1.0f, false);
                    const h2v hi = __builtin_amdgcn_cvt_scalef32_pk_f16_fp8((int)uu[i][j], 1.0f, true);
                    d = __builtin_amdgcn_fdot2(hs[2 * j], lo, d, false);
                    d = __builtin_amdgcn_fdot2(hs[2 * j + 1], hi, d, false);
                }
                d = red8(d);
                if (i < 8) res0 = (seg == i) ? d : res0; else res1 = (seg == (i - 8)) ? d : res1;
            }
            float* po = PD + ((long)x * NTOK + tbase + k) * 128 + 16 * eg + seg;
            po[0] = res0; po[8] = res1;
        };
        u4v uuA[16], uuB[16];
        u4v eA[4], eB[4];
        h8v xaA, xbA, xaB, xbB;
        LOAD_E(eA, 0); LOAD_X(xaA, xbA, 0);
        LOAD_E(eB, 1); LOAD_X(xaB, xbB, 1);
        ISSUE_U(uuA, eA);
#pragma unroll 1
        for (int k = 0; k < 16; k += 2) {
            ISSUE_U(uuB, eB);
            if (k + 2 < 16) LOAD_E(eA, k + 2);
            compute(k, xaA, xbA, uuA);
            if (k + 2 < 16) { LOAD_X(xaA, xbA, k + 2); ISSUE_U(uuA, eA); LOAD_E(eB, k + 3); }
            compute(k + 1, xaB, xbB, uuB);
            if (k + 2 < 16) LOAD_X(xaB, xbB, k + 3);
        }
    }
}
__device__ __forceinline__ void phase_peer_coef(const Params& p, int bid, int nb) {
    char* ws = p.ws;
    const half_t* X2H = (const half_t*)(ws + OFF_X2H);
    const float* PD = (const float*)(ws + OFF_PD);
    const float* GW = (const float*)(ws + OFF_GW);
    float* COEF = (float*)(ws + OFF_COEF);
    const int lane = threadIdx.x & 63;
    const long wv = ((long)bid * NTHREADS + threadIdx.x) >> 6, nwv = ((long)nb * NTHREADS) >> 6;
    for (long t = wv; t < NTOK; t += nwv) {
        const h8v a = *(const h8v*)(X2H + t * 1024 + 8 * lane), b2 = *(const h8v*)(X2H + t * 1024 + 512 + 8 * lane);
        float ss = 0.f;
#pragma unroll
        for (int i = 0; i < 8; ++i) { const float f0 = (float)a[i], f1 = (float)b2[i]; ss += f0 * f0 + f1 * f1; }
        ss = wave_sum(ss);
        const float rs = rsqrtf(ss * (1.0f / 1024.f) + EPS) * (1.0f / USCALE);
        float d0 = 0.f, d1 = 0.f;
#pragma unroll
        for (int x = 0; x < 8; ++x) {
            const float* pp = PD + ((long)x * NTOK + t) * 128;
            d0 += pp[lane]; d1 += pp[64 + lane];
        }
        COEF[t * 128 + lane] = GW[t * 128 + lane] * gelu_exact(d0 * rs);
        COEF[t * 128 + 64 + lane] = GW[t * 128 + 64 + lane] * gelu_exact(d1 * rs);
    }
}
__device__ __forceinline__ void phase_peer_vacc(const Params& p, char* smem) {
    char* ws = p.ws;
    unsigned* q = (unsigned*)(ws + OFF_CTRL) + 32;
    volatile int* s_task = (volatile int*)(smem + 66048);
    const unsigned char* V8 = (const unsigned char*)(ws + OFF_V16);
    const int* EID = (const int*)(ws + OFF_EID);
    const float* COEF = (const float*)(ws + OFF_COEF);
    float* SSQ = (float*)(ws + OFF_SSQ);
    const int xpref = (int)(xb_xcc_id() & 7u);
    for (;;) {
        const int task = peer_next_task(q, xpref, 512, s_task);
        if (task < 0) break;
        const int x = task >> 9, chunk = task & 511;
        int tid_ = threadIdx.x; asm volatile("" : "+v"(tid_));
        const int lane = tid_ & 63, w = tid_ >> 6, seg = lane & 7, eg = lane >> 3;
        const unsigned char* Vx = V8 + (long)x * 16384 * 128 + 16 * seg;
#pragma unroll 1
        for (int round = 0; round < 2; ++round) {
            const int t = chunk * 64 + w * 16 + round * 8 + eg;
            const int* Eb = EID + (long)t * 128;
            const float* Cb = COEF + (long)t * 128;
#define LOAD_EC(e_, c_, ci) { const u4v* ep_ = (const u4v*)(Eb + 8 * (ci)); const f4v* cp_ = (const f4v*)(Cb + 8 * (ci)); e_[0] = ep_[0]; e_[1] = ep_[1]; c_[0] = cp_[0]; c_[1] = cp_[1]; }
#define ISSUE_V(vv, e_) { _Pragma("unroll") for (int i = 0; i < 8; ++i) vv[i] = *(const u4v*)(Vx + (long)e_[i >> 2][i & 3] * 128); }
            float acc[16];
#pragma unroll
            for (int i = 0; i < 16; ++i) acc[i] = 0.f;
            auto compute = [&](const f4v (&c_)[2], const u4v (&vv)[8]) __attribute__((always_inline)) {
#pragma unroll
                for (int i = 0; i < 8; ++i) {
                    const float cf = c_[i >> 2][i & 3];
#pragma unroll
                    for (int j = 0; j < 4; ++j) {
                        const auto lo = __builtin_amdgcn_cvt_pk_f32_fp8((int)vv[i][j], false);
                        const auto hi = __builtin_amdgcn_cvt_pk_f32_fp8((int)vv[i][j], true);
                        acc[4 * j] += cf * lo[0]; acc[4 * j + 1] += cf * lo[1];
                        acc[4 * j + 2] += cf * hi[0]; acc[4 * j + 3] += cf * hi[1];
                    }
                }
            };
            u4v vvA[8], vvB[8];
            u4v eA[2], eB[2]; f4v cA[2], cB[2];
            LOAD_EC(eA, cA, 0); LOAD_EC(eB, cB, 1);
            ISSUE_V(vvA, eA);
#pragma unroll 1
            for (int ci = 0; ci < 16; ci += 2) {
                ISSUE_V(vvB, eB);
                compute(cA, vvA);
                if (ci + 2 < 16) { LOAD_EC(eA, cA, ci + 2); ISSUE_V(vvA, eA); }
                compute(cB, vvB);
                if (ci + 2 < 16) LOAD_EC(eB, cB, ci + 3);
            }
            float* xr = p.out + (long)t * 1024 + 128 * x + 16 * seg;
            float ssq = 0.f;
#pragma unroll
            for (int i4 = 0; i4 < 4; ++i4) {
                float4 xv = *(const float4*)(xr + 4 * i4);
                xv.x += acc[4 * i4] * (1.0f / VSCALE); xv.y += acc[4 * i4 + 1] * (1.0f / VSCALE);
                xv.z += acc[4 * i4 + 2] * (1.0f / VSCALE); xv.w += acc[4 * i4 + 3] * (1.0f / VSCALE);
                ssq += xv.x * xv.x + xv.y * xv.y + xv.z * xv.z + xv.w * xv.w;
                *(float4*)(xr + 4 * i4) = xv;
            }
            ssq = red8(ssq);
            if (seg == 0) SSQ[(long)x * NTOK + t] = ssq;
        }
    }
}
__device__ __forceinline__ void phase_final_norm(const Params& p, int bid, int nb) {
    const float* SSQ = (const float*)(p.ws + OFF_SSQ);
    const int lane = threadIdx.x & 63;
    const long wv = ((long)bid * NTHREADS + threadIdx.x) >> 6, nwv = ((long)nb * NTHREADS) >> 6;
    for (long t = wv; t < NTOK; t += nwv) {
        float ss = 0.f;
#pragma unroll
        for (int x = 0; x < 8; ++x) ss += SSQ[(long)x * NTOK + t];
        const float rf = rsqrtf(ss * (1.0f / 1024.f) + EPS);
        float4* xr = (float4*)(p.out + t * 1024);
#pragma unroll
        for (int i = 0; i < 4; ++i) {
            float4 v = xr[lane + 64 * i];
            const float4 g = ((const float4*)p.final_g)[lane + 64 * i];
            v.x *= rf * g.x; v.y *= rf * g.y; v.z *= rf * g.z; v.w *= rf * g.w;
            xr[lane + 64 * i] = v;
        }
    }
}

#define XB_TMO      128
#define XB_XCNT(j)  (256  + 64 * (j))
#define XB_XSUB(j)  (1280 + 64 * (j))
#define XB_XGEN(j)  (2304 + 64 * (j))
#define XB_TOP      3328
#define XB_TOPGEN   3392
#define XCD_BAR_WORDS 3456
#define XB_SPIN_CAP (1u << 22)
__device__ __forceinline__ unsigned xb_ld(unsigned* p)              { return __hip_atomic_load(p, __ATOMIC_RELAXED, __HIP_MEMORY_SCOPE_AGENT); }
__device__ __forceinline__ unsigned xb_add(unsigned* p, unsigned v) { return __hip_atomic_fetch_add(p, v, __ATOMIC_RELAXED, __HIP_MEMORY_SCOPE_AGENT); }
__device__ __forceinline__ unsigned xb_xcc_id() { return (unsigned)__builtin_amdgcn_s_getreg((3 << 11) | 20) & 0xFu; }
#define XB_SPIN(cond, bar) do { unsigned _sp = 0; while (cond) { __builtin_amdgcn_s_sleep(1); \
    if ((++_sp & 255u) == 0u) { if (xb_ld(&(bar)[XB_TMO])) break; if (_sp > XB_SPIN_CAP) { atomicAdd(&(bar)[XB_TMO], 1u); break; } } } } while (0)
struct XcdBarrier { unsigned* bar; unsigned x; volatile unsigned* st; };
__device__ __forceinline__ XcdBarrier xcd_barrier_post(unsigned* bar, volatile unsigned* st) {
    XcdBarrier b; b.bar = bar; b.x = xb_xcc_id(); b.st = st;
    if (threadIdx.x == 0) (void)xb_add(&bar[XB_XCNT(b.x)], 1u);
    return b;
}
__device__ __forceinline__ void xcd_barrier_complete(unsigned* bar, unsigned x, unsigned& nloc, unsigned& nx) {
    const unsigned G = gridDim.x * gridDim.y * gridDim.z;
    unsigned sum, cnt, mine, sp = 0u;
    for (;;) {
        sum = 0u; cnt = 0u; mine = 0u;
#pragma unroll
        for (unsigned j = 0; j < 16; ++j) { const unsigned c = xb_ld(&bar[XB_XCNT(j)]); sum += c; cnt += (c > 0u) ? 1u : 0u; mine = (j == x) ? c : mine; }
        if (sum == G) break;
        __builtin_amdgcn_s_sleep(1);
        if ((++sp & 255u) == 0u) { if (xb_ld(&bar[XB_TMO])) break; if (sp > XB_SPIN_CAP) { atomicAdd(&bar[XB_TMO], 1u); break; } }
    }
    nloc = mine > 0u ? mine : 1u; nx = cnt > 0u ? cnt : 1u;
}
__device__ __forceinline__ void xcd_barrier(const XcdBarrier& b) {
    asm volatile("s_waitcnt vmcnt(0)" ::: "memory");
    __syncthreads();
    if (threadIdx.x == 0) {
        unsigned* bar = b.bar;
        __builtin_amdgcn_s_waitcnt(0);
        unsigned nloc = b.st[0], nx = b.st[1];
        if (nloc == 0u) { xcd_barrier_complete(bar, b.x, nloc, nx); b.st[0] = nloc; b.st[1] = nx; }
        const unsigned old = xb_add(&bar[XB_XSUB(b.x)], 1u);
        const unsigned gen = old / nloc;
        if (old + 1u == (gen + 1u) * nloc) {
            __builtin_amdgcn_fence(__ATOMIC_RELEASE, "agent");
            asm volatile("s_waitcnt vmcnt(0)" ::: "memory");
            const unsigned og = xb_add(&bar[XB_TOP], 1u);
            const unsigned tg = og / nx;
            if (og + 1u == (tg + 1u) * nx) xb_add(&bar[XB_TOPGEN], 1u);
            else XB_SPIN(xb_ld(&bar[XB_TOPGEN]) == tg, bar);
            __builtin_amdgcn_fence(__ATOMIC_ACQUIRE, "agent");
            xb_add(&bar[XB_XGEN(b.x)], 1u);
            asm volatile("s_waitcnt vmcnt(0)" ::: "memory");
        } else {
            XB_SPIN(xb_ld(&bar[XB_XGEN(b.x)]) == gen, bar);
            __builtin_amdgcn_fence(__ATOMIC_ACQUIRE, "agent");
            asm volatile("s_waitcnt vmcnt(0)" ::: "memory");
        }
    }
    __syncthreads();
}

template <int PH>
__global__ void __launch_bounds__(NTHREADS, 2) phase_kernel(Params p) {
    extern __shared__ __attribute__((aligned(16))) char smem[];
    const int bid = blockIdx.x, nb = gridDim.x;
    if (PH == 0) phase_prep(p, bid, nb);
    if (PH == 1) phase_inproj(p, bid, nb, smem);
    if (PH == 2) phase_p2(p, bid, nb, smem);
    if (PH == 3) phase_cmp2(p, bid, nb);
    if (PH == 4) phase_attn(p, smem);
    if (PH == 5) phase_outproj(p, bid, nb, smem);
    if (PH == 6) phase_peerq(p, bid, nb, smem);
    if (PH == 7) phase_route(p, bid, nb, smem);
}

#ifndef PROBE_PHASE
#define PROBE_PHASE -1
#endif
__global__ void __launch_bounds__(NTHREADS, 2) mega_kernel(Params p) {
    extern __shared__ __attribute__((aligned(16))) char smem[];
    const int bid = blockIdx.x, nb = gridDim.x;
    volatile unsigned* xbst = (volatile unsigned*)(smem + 66064);
    if (threadIdx.x == 0) { xbst[0] = 0u; xbst[1] = 0u; }
    __syncthreads();
    const XcdBarrier gb = xcd_barrier_post((unsigned*)(p.ws + OFF_BAR), xbst);
#define GRID_SYNC() xcd_barrier(gb)
    phase_prep(p, bid, nb); GRID_SYNC();
    if (PROBE_PHASE == 0) { phase_prep(p, bid, nb); GRID_SYNC(); }
    phase_inproj(p, bid, nb, smem); GRID_SYNC();
    if (PROBE_PHASE == 1) { phase_inproj(p, bid, nb, smem); GRID_SYNC(); }
    phase_p2(p, bid, nb, smem); GRID_SYNC();
    if (PROBE_PHASE == 2) { phase_p2(p, bid, nb, smem); GRID_SYNC(); }
    phase_cmp2(p, bid, nb); GRID_SYNC();
    phase_attn(p, smem, 64, 0); GRID_SYNC();
    if (PROBE_PHASE == 3) { phase_attn(p, smem, 80, 0); GRID_SYNC(); }
    if (PROBE_PHASE == 9) { phase_attn(p, smem, 80, 1); GRID_SYNC(); }
    if (PROBE_PHASE == 13) { phase_attn(p, smem, 80, 2); GRID_SYNC(); }
    phase_outproj(p, bid, nb, smem); GRID_SYNC();
    if (PROBE_PHASE == 4) { phase_outproj(p, bid, nb, smem); GRID_SYNC(); }
    phase_peerq(p, bid, nb, smem); GRID_SYNC();
    if (PROBE_PHASE == 5) { phase_peerq(p, bid, nb, smem); GRID_SYNC(); }
    phase_route(p, bid, nb, smem); GRID_SYNC();
    if (PROBE_PHASE == 6) { phase_route(p, bid, nb, smem); GRID_SYNC(); }
    if (PROBE_PHASE == 8) { GRID_SYNC(); GRID_SYNC(); GRID_SYNC(); GRID_SYNC(); GRID_SYNC(); GRID_SYNC(); GRID_SYNC(); GRID_SYNC(); }
    phase_peer_udot<0>(p, smem); GRID_SYNC();
    if (PROBE_PHASE == 10) { phase_peer_udot<0>(p, smem, 48); GRID_SYNC(); }
    if (PROBE_PHASE == 12) { phase_peer_udot<1>(p, smem, 48); GRID_SYNC(); }
    phase_peer_coef(p, bid, nb); GRID_SYNC();
    if (PROBE_PHASE == 11) { phase_peer_coef(p, bid, nb); GRID_SYNC(); }
    phase_peer_vacc(p, smem); GRID_SYNC();
    phase_final_norm(p, bid, nb);
}

extern "C" void kernel_launch(void* const* d_in, const int* in_sizes, int n_in, void* d_out, int out_size, void* d_ws, size_t ws_size, hipStream_t stream) {
    (void)in_sizes; (void)n_in; (void)out_size;
    if (ws_size < WS_NEED) { fprintf(stderr, "kernel_launch: workspace too small (%zu < %zu)\n", ws_size, (size_t)WS_NEED); return; }
    Params p{};
    p.x = (const float*)d_in[0]; p.pos = (const int*)d_in[1]; p.norm1_g = (const float*)d_in[2]; p.w_in = (const float*)d_in[3];
    p.cmp_pos = (const float*)d_in[4]; p.cmp_k_w1 = (const float*)d_in[5]; p.cmp_k_w2 = (const float*)d_in[6];
    p.cmp_v_w1 = (const float*)d_in[7]; p.cmp_v_w2 = (const float*)d_in[8]; p.t5_bias = (const float*)d_in[9];
    p.q_norm_g = (const float*)d_in[10]; p.w_q_up = (const float*)d_in[11]; p.kv_norm_g = (const float*)d_in[12]; p.w_kv_up = (const float*)d_in[13];
    p.grp_norm_nsa = (const float*)d_in[14]; p.grp_norm_mla = (const float*)d_in[15]; p.w_out = (const float*)d_in[16]; p.norm2_g = (const float*)d_in[17];
    p.peer_wq = (const float*)d_in[18]; p.peer_keys1 = (const float*)d_in[19]; p.peer_keys2 = (const float*)d_in[20];
    p.peer_u = (const float*)d_in[21]; p.peer_v = (const float*)d_in[22]; p.final_g = (const float*)d_in[23];
    p.out = (float*)d_out; p.ws = (char*)d_ws;
#if MULTI_LAUNCH
    const int G = 512;
    phase_kernel<0><<<G, NTHREADS, 0, stream>>>(p);
    phase_kernel<1><<<G, NTHREADS, 0, stream>>>(p);
    phase_kernel<2><<<G, NTHREADS, 0, stream>>>(p);
    phase_kernel<3><<<G, NTHREADS, 0, stream>>>(p);
    phase_kernel<4><<<G, NTHREADS, 0, stream>>>(p);
    phase_kernel<5><<<G, NTHREADS, 0, stream>>>(p);
    phase_kernel<6><<<G, NTHREADS, 0, stream>>>(p);
    phase_kernel<7><<<G, NTHREADS, 0, stream>>>(p);
    phase_kernel<8><<<G, NTHREADS, 0, stream>>>(p);
#else
    static int grid_blocks = 0;
    if (!grid_blocks) {
        int dev = 0, cus = 0, per_cu = 0;
        (void)hipGetDevice(&dev);
        (void)hipDeviceGetAttribute(&cus, hipDeviceAttributeMultiprocessorCount, dev);
        (void)hipFuncSetAttribute((const void*)mega_kernel, hipFuncAttributeMaxDynamicSharedMemorySize, SMEM_BYTES);
        (void)hipOccupancyMaxActiveBlocksPerMultiprocessor(&per_cu, mega_kernel, NTHREADS, SMEM_BYTES);
        if (per_cu > 2) per_cu = 2;
        grid_blocks = cus * per_cu;
    }
    (void)hipMemsetAsync((char*)d_ws + OFF_BAR, 0, 16384, stream);
    void* args[] = {&p};
    hipError_t e = hipLaunchCooperativeKernel((void*)mega_kernel, dim3(grid_blocks), dim3(NTHREADS), args, SMEM_BYTES, stream);
    if (e != hipSuccess) fprintf(stderr, "cooperative launch failed: %s (grid %d)\n", hipGetErrorString(e), grid_blocks);
#endif
}
```

```cpp
#include <hip/hip_runtime.h>
#include <hip/hip_cooperative_groups.h>
#include <cstdio>
#include <cstdint>
namespace cg = cooperative_groups;

#ifndef MULTI_LAUNCH
#define MULTI_LAUNCH 0
#endif

#ifndef PROBE_PHASE
#define PROBE_PHASE -1
#endif

typedef _Float16 half_t;
typedef _Float16 h2v __attribute__((ext_vector_type(2)));
typedef _Float16 h4v __attribute__((ext_vector_type(4)));
typedef _Float16 h8v __attribute__((ext_vector_type(8)));
typedef float f4v __attribute__((ext_vector_type(4)));
typedef unsigned u4v __attribute__((ext_vector_type(4)));
typedef unsigned u2v __attribute__((ext_vector_type(2)));
typedef float f16v __attribute__((ext_vector_type(16)));

constexpr int BATCH = 2, SEQ = 16384, DM = 1024, NTOK = BATCH * SEQ;
constexpr int NIN = 1720, NINP = 1792;
constexpr int NCMP = 1023, NCMPP = 1024;
constexpr float EPS = 1e-6f;
constexpr float LOG2E = 1.4426950408889634f;
constexpr float QS_NSA = 0.125f * LOG2E;
constexpr float QS_MLA = 0.10206207261596575f * LOG2E;
constexpr float NEGF = -1e30f;
constexpr int LUTN = 1536;
constexpr float USCALE = 128.0f, VSCALE = 16.0f;

constexpr size_t al256(size_t x) { return (x + 255) & ~(size_t)255; }
constexpr size_t OFF_CTRL = 0;
constexpr size_t OFF_LUT = 4096;
constexpr size_t OFF_CB = OFF_LUT + 2 * LUTN * 4 * 4;
constexpr size_t OFF_WIN = 65536;
constexpr size_t OFF_WQUP = OFF_WIN + (size_t)NINP * 1024 * 2;
constexpr size_t OFF_WKVUP = OFF_WQUP + 768 * 256 * 2;
constexpr size_t OFF_WC1 = OFF_WKVUP + 1024 * 128 * 2;
constexpr size_t OFF_WOUT = OFF_WC1 + 2 * 256 * 2048 * 2;
constexpr size_t OFF_WPQ = OFF_WOUT + 1024 * 1024 * 2;
constexpr size_t OFF_KEYS = OFF_WPQ + 2048 * 1024 * 2;
constexpr size_t OFF_U16 = al256(OFF_KEYS + 2 * 128 * 128 * 2);
constexpr size_t OFF_V16 = OFF_U16 + (size_t)16384 * 1024 * 2;
constexpr size_t OFF_H1 = OFF_V16 + (size_t)16384 * 1024 * 2;
constexpr size_t OFF_MIXED = OFF_H1;
constexpr size_t OFF_QH = OFF_H1 + (size_t)NTOK * 1024 * 2;
constexpr size_t SZ_KV = (size_t)2 * 2 * SEQ * 64 * 2;
constexpr size_t OFF_KC = OFF_QH + (size_t)NTOK * 512 * 2;
constexpr size_t OFF_VC = OFF_KC + SZ_KV;
constexpr size_t OFF_KS = OFF_VC + SZ_KV;
constexpr size_t OFF_VST = OFF_KS + SZ_KV;
constexpr size_t OFF_KW = OFF_VST + SZ_KV;
constexpr size_t OFF_VWT = OFF_KW + SZ_KV;
constexpr size_t OFF_GATES = OFF_VWT + SZ_KV;
constexpr size_t OFF_CQ = OFF_GATES + (size_t)NTOK * 24 * 4;
constexpr size_t OFF_CKV = OFF_CQ + (size_t)NTOK * 256 * 2;
constexpr size_t OFF_X2H = OFF_QH;
constexpr size_t OFF_QM = OFF_CKV + (size_t)NTOK * 128 * 2;
constexpr size_t OFF_KM = OFF_QM + (size_t)NTOK * 8 * 96 * 2;
constexpr size_t OFF_VT = OFF_KM + (size_t)NTOK * 8 * 96 * 2;
constexpr size_t OFF_QP = OFF_QM;
constexpr size_t OFF_PD = OFF_QM;
constexpr size_t OFF_COEF = OFF_H1;
constexpr size_t OFF_SSQ = OFF_H1 + (size_t)NTOK * 128 * 4;
constexpr size_t OFF_HC1 = OFF_VT + (size_t)NTOK * 8 * 64 * 2;
constexpr size_t OFF_KCMP = OFF_HC1 + (size_t)8 * 1024 * 256 * 2;
constexpr size_t OFF_VCMPT = OFF_KCMP + (size_t)4 * 1024 * 64 * 2;
constexpr size_t OFF_EID = OFF_VCMPT + (size_t)4 * 1024 * 64 * 2;
constexpr size_t OFF_GW = OFF_EID + (size_t)NTOK * 128 * 4;
constexpr size_t OFF_BAR = OFF_GW + (size_t)NTOK * 128 * 4;
constexpr size_t WS_NEED = OFF_BAR + 16384;

struct Params {
    const float* x; const int* pos; const float* norm1_g; const float* w_in; const float* cmp_pos;
    const float* cmp_k_w1; const float* cmp_k_w2; const float* cmp_v_w1; const float* cmp_v_w2; const float* t5_bias;
    const float* q_norm_g; const float* w_q_up; const float* kv_norm_g; const float* w_kv_up;
    const float* grp_norm_nsa; const float* grp_norm_mla; const float* w_out; const float* norm2_g;
    const float* peer_wq; const float* peer_keys1; const float* peer_keys2; const float* peer_u; const float* peer_v; const float* final_g;
    float* out; char* ws;
};

constexpr int SMEM_BYTES = 67584;
constexpr int NTHREADS = 256;

__device__ __forceinline__ f4v mfma16(h8v a, h8v b, f4v c) { return __builtin_amdgcn_mfma_f32_16x16x32_f16(a, b, c, 0, 0, 0); }
__device__ __forceinline__ f16v mfma32(h8v a, h8v b, f16v c) { return __builtin_amdgcn_mfma_f32_32x32x16_f16(a, b, c, 0, 0, 0); }
__device__ __forceinline__ float wave_sum(float v) {
#pragma unroll
    for (int o = 32; o >= 1; o >>= 1) v += __shfl_xor(v, o);
    return v;
}
__device__ __forceinline__ float gelu_exact(float v) { return 0.5f * v * (1.0f + erff(v * 0.70710678118654752f)); }
__device__ __forceinline__ float fast_exp2(float v) { return __builtin_amdgcn_exp2f(v); }
__device__ __forceinline__ int t5_bucket(int d) {
    if (d < 16) return d < 0 ? 0 : d;
    int b = 16;
    b += (d >= 22); b += (d >= 30); b += (d >= 40); b += (d >= 54); b += (d >= 73); b += (d >= 99); b += (d >= 134); b += (d >= 182);
    b += (d >= 246); b += (d >= 332); b += (d >= 450); b += (d >= 609); b += (d >= 825); b += (d >= 1117); b += (d >= 1513);
    return b;
}

__device__ __forceinline__ unsigned xb_xcc_id();
__device__ __forceinline__ float red8(float v) {
    v += __builtin_bit_cast(float, __builtin_amdgcn_update_dpp(0, __builtin_bit_cast(int, v), 0xB1, 0xF, 0xF, true));
    v += __builtin_bit_cast(float, __builtin_amdgcn_update_dpp(0, __builtin_bit_cast(int, v), 0x4E, 0xF, 0xF, true));
    v += __builtin_bit_cast(float, __builtin_amdgcn_update_dpp(0, __builtin_bit_cast(int, v), 0x141, 0xF, 0xF, true));
    return v;
}

__device__ __forceinline__ void phase_prep(const Params& p, int bid, int nb) {
    int tx_ = threadIdx.x; asm volatile("" : "+v"(tx_));
    const long tid = (long)bid * NTHREADS + tx_;
    const long nth = (long)nb * NTHREADS;
    char* ws = p.ws;
    if (tid < 1024) ((unsigned*)(ws + OFF_CTRL))[tid] = 0u;
    {
        float* lut = (float*)(ws + OFF_LUT);
        for (long e = tid; e < 2 * LUTN * 4; e += nth) {
            int r = e & 3, d = (e >> 2) % LUTN, g = (int)(e / (4 * LUTN));
            lut[e] = p.t5_bias[t5_bucket(d) * 8 + g * 4 + r] * LOG2E;
        }
    }
    {
        float* cb = (float*)(ws + OFF_CB);
        for (long e = tid; e < 512; e += nth) {
            int kv = (int)(e >> 8), n = (int)(e & 255);
            const float* w1 = kv ? p.cmp_v_w1 : p.cmp_k_w1;
            float s = 0.f;
            for (int k = 0; k < 2048; ++k) s += p.cmp_pos[k] * w1[(long)k * 256 + n];
            cb[e] = s;
        }
    }
    {
        half_t* W = (half_t*)(ws + OFF_WIN);
        for (long e = tid; e < (long)NINP * 1024; e += nth) {
            int k = (int)(e / NINP), n = (int)(e % NINP);
            int src;
            if (n < 1280) src = n;
            else if (n < 1536) src = 1304 + (n - 1280);
            else if (n < 1664) src = 1560 + (n - 1536);
            else if (n < 1696) src = 1688 + (n - 1664);
            else if (n < 1720) src = 1280 + (n - 1696);
            else src = -1;
            float v = src >= 0 ? p.w_in[(long)k * NIN + src] : 0.f;
            W[(long)n * 1024 + k] = (half_t)v;
        }
    }
    {
        half_t* W = (half_t*)(ws + OFF_WQUP);
        for (long e = tid; e < 768 * 256; e += nth) {
            int k = (int)(e / 768), n = (int)(e % 768);
            W[(long)n * 256 + k] = (half_t)(p.w_q_up[e] * p.q_norm_g[k]);
        }
    }
    {
        half_t* W = (half_t*)(ws + OFF_WKVUP);
        for (long e = tid; e < 1024 * 128; e += nth) {
            int k = (int)(e / 1024), n = (int)(e % 1024);
            W[(long)n * 128 + k] = (half_t)(p.w_kv_up[e] * p.kv_norm_g[k]);
        }
    }
    {
        half_t* W = (half_t*)(ws + OFF_WC1);
        for (long e = tid; e < 2L * 2048 * 256; e += nth) {
            int kv = (int)(e / (2048 * 256)); long r = e % (2048 * 256);
            int k = (int)(r / 256), n = (int)(r % 256);
            const float* w1 = kv ? p.cmp_v_w1 : p.cmp_k_w1;
            W[((long)kv * 256 + n) * 2048 + k] = (half_t)w1[r];
        }
    }
    {
        half_t* W = (half_t*)(ws + OFF_WOUT);
        for (long e = tid; e < 1024L * 1024; e += nth) {
            int k = (int)(e >> 10), n = (int)(e & 1023);
            float g = k < 512 ? p.grp_norm_nsa[k] : p.grp_norm_mla[k - 512];
            W[(long)n * 1024 + k] = (half_t)(p.w_out[e] * g);
        }
    }
    {
        half_t* W = (half_t*)(ws + OFF_WPQ);
        for (long e = tid; e < 1024L * 2048; e += nth) {
            int k = (int)(e >> 11), n = (int)(e & 2047);
            W[(long)n * 1024 + k] = (half_t)(p.peer_wq[e] * p.norm2_g[k]);
        }
    }
    {
        half_t* W = (half_t*)(ws + OFF_KEYS);
        for (long e = tid; e < 2 * 16384; e += nth) {
            W[e] = (half_t)(e < 16384 ? p.peer_keys1[e] : p.peer_keys2[e - 16384]);
        }
    }
    {
        unsigned* U8 = (unsigned*)(ws + OFF_U16);
        unsigned* V8 = (unsigned*)(ws + OFF_V16);
        const long n4 = 16384L * 256;
        for (long e4 = tid; e4 < n4; e4 += nth) {
            const int e = (int)(e4 >> 8), d = (int)(e4 & 255) * 4, x = d >> 7, dd = d & 127;
            const float4 a = ((const float4*)p.peer_u)[e4];
            const float4 b = ((const float4*)p.peer_v)[e4];
            int pa = __builtin_amdgcn_cvt_pk_fp8_f32(a.x * USCALE, a.y * USCALE, 0, false);
            pa = __builtin_amdgcn_cvt_pk_fp8_f32(a.z * USCALE, a.w * USCALE, pa, true);
            int pb = __builtin_amdgcn_cvt_pk_fp8_f32(b.x * VSCALE, b.y * VSCALE, 0, false);
            pb = __builtin_amdgcn_cvt_pk_fp8_f32(b.z * VSCALE, b.w * VSCALE, pb, true);
            const long o = (((long)x * 16384 + e) * 128 + dd) >> 2;
            U8[o] = (unsigned)pa; V8[o] = (unsigned)pb;
        }
    }
    {
        half_t* H1 = (half_t*)(ws + OFF_H1);
        const int lane = threadIdx.x & 63;
        const long wv = tid >> 6, nwv = nth >> 6;
        for (long row = wv; row < NTOK; row += nwv) {
            const float4* xr = (const float4*)(p.x + row * 1024);
            float4 v[4]; float ss = 0.f;
#pragma unroll
            for (int i = 0; i < 4; ++i) { v[i] = xr[lane + 64 * i]; ss += v[i].x * v[i].x + v[i].y * v[i].y + v[i].z * v[i].z + v[i].w * v[i].w; }
            ss = wave_sum(ss);
            const float rs = rsqrtf(ss * (1.0f / 1024.f) + EPS);
#pragma unroll
            for (int i = 0; i < 4; ++i) {
                float4 g = ((const float4*)p.norm1_g)[lane + 64 * i];
                h4v o = {(half_t)(v[i].x * rs * g.x), (half_t)(v[i].y * rs * g.y), (half_t)(v[i].z * rs * g.z), (half_t)(v[i].w * rs * g.w)};
                ((h4v*)(H1 + row * 1024))[lane + 64 * i] = o;
            }
        }
    }
}

constexpr int GEMM_RS_OFF = 66560;
template <bool SCALE, bool SWAP, class Epi>
__device__ __forceinline__ void gemm_tile(const half_t* __restrict__ A, long lda, const half_t* __restrict__ Bt, long ldb, int K, int ksplit, char* smem_raw, Epi epi) {
    half_t* sA = (half_t*)smem_raw;
    half_t* sB = (half_t*)(smem_raw + 32768);
    float* rs0 = (float*)(smem_raw + GEMM_RS_OFF);
    int tid_ = threadIdx.x; asm volatile("" : "+v"(tid_));
    const int tid = tid_, lane = tid & 63, w = tid >> 6, wm = w >> 1, wn = w & 1;
    const int i16 = lane & 15, g4 = lane >> 4;
    const int lr = tid >> 3, off = tid & 7;
    if (SCALE) {
        const int rg = lane >> 3, ch = lane & 7;
        const int ncg = K >> 6, cgs = ksplit >> 6;
#pragma unroll 1
        for (int rr = 0; rr < 4; ++rr) {
            const int row = w * 32 + rr * 8 + rg;
            const half_t* ap = A + (long)row * lda + ch * 8;
            float s0 = 0.f, s1 = 0.f;
#pragma unroll 8
            for (int cg = 0; cg < ncg; ++cg) {
                const h8v v = *(const h8v*)(ap + cg * 64);
                float d = 0.f;
#pragma unroll
                for (int j = 0; j < 4; ++j) d = __builtin_amdgcn_fdot2((h2v){v[2 * j], v[2 * j + 1]}, (h2v){v[2 * j], v[2 * j + 1]}, d, false);
                if (cg < cgs) s0 += d; else s1 += d;
            }
            s0 = red8(s0); s1 = red8(s1);
            if (ch == 0) {
                rs0[row] = rsqrtf(s0 / (float)ksplit + EPS);
                if (ksplit < K) rs0[128 + row] = rsqrtf(s1 / (float)(K - ksplit) + EPS);
            }
        }
    }
    f4v acc[4][4];
#pragma unroll
    for (int a = 0; a < 4; ++a)
#pragma unroll
        for (int b = 0; b < 4; ++b) acc[a][b] = (f4v){0.f, 0.f, 0.f, 0.f};
    u4v ra[4], rb[4];
    const int nk = K >> 6;
    const int wofs = lr * 64 + ((off ^ (lr & 7)) << 3);
#pragma unroll
    for (int i = 0; i < 4; ++i) {
        ra[i] = *(const u4v*)(A + (long)(lr + 32 * i) * lda + off * 8);
        rb[i] = *(const u4v*)(Bt + (long)(lr + 32 * i) * ldb + off * 8);
    }
#pragma unroll
    for (int i = 0; i < 4; ++i) {
        *(u4v*)(sA + wofs + i * 2048) = ra[i];
        *(u4v*)(sB + wofs + i * 2048) = rb[i];
    }
    __syncthreads();
#pragma unroll 1
    for (int kt = 0; kt < nk; ++kt) {
        const int cur = (kt & 1) * 8192;
        if (kt + 1 < nk) {
            const int k0 = (kt + 1) * 64;
#pragma unroll
            for (int i = 0; i < 4; ++i) {
                ra[i] = *(const u4v*)(A + (long)(lr + 32 * i) * lda + k0 + off * 8);
                rb[i] = *(const u4v*)(Bt + (long)(lr + 32 * i) * ldb + k0 + off * 8);
            }
        }
        if (SCALE && kt * 64 == ksplit) {
#pragma unroll
            for (int mi = 0; mi < 4; ++mi) {
                if (SWAP) {
                    const int row = wm * 64 + mi * 16 + i16;
                    const float ratio = rs0[row] / rs0[128 + row];
#pragma unroll
                    for (int ni = 0; ni < 4; ++ni) acc[mi][ni] *= ratio;
                } else {
#pragma unroll
                    for (int r = 0; r < 4; ++r) {
                        const int row = wm * 64 + mi * 16 + g4 * 4 + r;
                        const float ratio = rs0[row] / rs0[128 + row];
#pragma unroll
                        for (int ni = 0; ni < 4; ++ni) acc[mi][ni][r] *= ratio;
                    }
                }
            }
        }
#pragma unroll
        for (int kk = 0; kk < 2; ++kk) {
            const int cofs = (((kk * 4 + g4) ^ (i16 & 7)) << 3);
            h8v af[4], bf[4];
#pragma unroll
            for (int mi = 0; mi < 4; ++mi) af[mi] = *(const h8v*)(sA + cur + (wm * 64 + mi * 16 + i16) * 64 + cofs);
#pragma unroll
            for (int ni = 0; ni < 4; ++ni) bf[ni] = *(const h8v*)(sB + cur + (wn * 64 + ni * 16 + i16) * 64 + cofs);
#pragma unroll
            for (int mi = 0; mi < 4; ++mi)
#pragma unroll
                for (int ni = 0; ni < 4; ++ni) acc[mi][ni] = SWAP ? mfma16(bf[ni], af[mi], acc[mi][ni]) : mfma16(af[mi], bf[ni], acc[mi][ni]);
        }
        if (kt + 1 < nk) {
            const int nxt = ((kt + 1) & 1) * 8192;
#pragma unroll
            for (int i = 0; i < 4; ++i) {
                *(u4v*)(sA + nxt + wofs + i * 2048) = ra[i];
                *(u4v*)(sB + nxt + wofs + i * 2048) = rb[i];
            }
        }
        __syncthreads();
    }
    if (SCALE) {
        const int fin = (ksplit < K) ? 128 : 0;
#pragma unroll
        for (int mi = 0; mi < 4; ++mi) {
            if (SWAP) {
                const float rsv = rs0[fin + wm * 64 + mi * 16 + i16];
#pragma unroll
                for (int ni = 0; ni < 4; ++ni) acc[mi][ni] *= rsv;
            } else {
#pragma unroll
                for (int r = 0; r < 4; ++r) {
                    const float rsv = rs0[fin + wm * 64 + mi * 16 + g4 * 4 + r];
#pragma unroll
                    for (int ni = 0; ni < 4; ++ni) acc[mi][ni][r] *= rsv;
                }
            }
        }
    }
    epi(acc, wm, wn, i16, g4);
    __syncthreads();
}

__device__ __forceinline__ void rope_pair(float x1, float x2, int pos, int i, float& o1, float& o2) {
    const float inv = __builtin_amdgcn_exp2f(-(float)i * (13.287712379549449f / 16.0f));
    double t = (double)pos * (double)inv * 0.15915494309189535;
    t -= __builtin_rint(t);
    const float fr = (float)t;
    const float sn = __builtin_amdgcn_sinf(fr), cs = __builtin_amdgcn_cosf(fr);
    o1 = x1 * cs - x2 * sn; o2 = x1 * sn + x2 * cs;
}

__device__ __forceinline__ void phase_inproj(const Params& p, int bid, int nb, char* smem) {
    char* ws = p.ws;
    const half_t* H1 = (const half_t*)(ws + OFF_H1);
    const half_t* W = (const half_t*)(ws + OFF_WIN);
    half_t* QH = (half_t*)(ws + OFF_QH);
    half_t* KM = (half_t*)(ws + OFF_KM);
    half_t* CQ = (half_t*)(ws + OFF_CQ);
    half_t* CKV = (half_t*)(ws + OFF_CKV);
    float* GATES = (float*)(ws + OFF_GATES);
    const int NT_N = NINP / 128, NT_M = NTOK / 128;
    for (int tile = bid; tile < NT_M * NT_N; tile += nb) {
        const int tm = tile / NT_N, tn = tile % NT_N;
        const int row0 = tm * 128, n0 = tn * 128;
        const half_t* Ap = H1 + (long)row0 * 1024;
        const half_t* Bp = W + (long)n0 * 1024;
        if (tn == 7 || tn == 9) {
            gemm_tile<false, false>(Ap, 1024, Bp, 1024, 1024, 1024, smem,
                [&](f4v (&acc)[4][4], int wm, int wn, int i16, int g4) __attribute__((always_inline)) {
                    half_t* base = (half_t*)(ws + (tn == 7 ? OFF_VST : OFF_VWT));
#pragma unroll
                    for (int ni = 0; ni < 4; ++ni) {
                        const int c = wn * 64 + ni * 16 + i16, gg = c >> 6, d = c & 63;
#pragma unroll
                        for (int mi = 0; mi < 4; ++mi) {
                            const int rbase = row0 + wm * 64 + mi * 16 + g4 * 4;
                            const int b = rbase >> 14, s0 = rbase & (SEQ - 1);
                            const h4v o = {(half_t)acc[mi][ni][0], (half_t)acc[mi][ni][1], (half_t)acc[mi][ni][2], (half_t)acc[mi][ni][3]};
                            *(h4v*)(base + ((long)((b * 2 + gg) * 64 + d)) * SEQ + s0) = o;
                        }
                    }
                });
        } else {
            gemm_tile<false, true>(Ap, 1024, Bp, 1024, 1024, 1024, smem,
                [&](f4v (&acc)[4][4], int wm, int wn, int i16, int g4) __attribute__((always_inline)) {
#pragma unroll
                    for (int mi = 0; mi < 4; ++mi) {
                        const int t = row0 + wm * 64 + mi * 16 + i16;
                        const int b = t >> 14, sq = t & (SEQ - 1);
#pragma unroll
                        for (int ni = 0; ni < 4; ++ni) {
                            const int cb = n0 + wn * 64 + ni * 16;
                            const int n = cb + 4 * g4;
                            const f4v a = acc[mi][ni];
                            if (cb < 512) {
                                const h4v o = {(half_t)(a[0] * QS_NSA), (half_t)(a[1] * QS_NSA), (half_t)(a[2] * QS_NSA), (half_t)(a[3] * QS_NSA)};
                                *(h4v*)(QH + (long)t * 512 + n) = o;
                            } else if (cb < 1280) {
                                const int which = (cb - 512) >> 7;
                                const int c = (n - 512) & 127, gg = c >> 6, d = c & 63;
                                half_t* base = (half_t*)(ws + OFF_KC + (size_t)which * SZ_KV);
                                const h4v o = {(half_t)a[0], (half_t)a[1], (half_t)a[2], (half_t)a[3]};
                                *(h4v*)(base + ((long)(b * 2 + gg) * SEQ + sq) * 64 + d) = o;
                            } else if (cb < 1536) {
                                const h4v o = {(half_t)a[0], (half_t)a[1], (half_t)a[2], (half_t)a[3]};
                                *(h4v*)(CQ + (long)t * 256 + (n - 1280)) = o;
                            } else if (cb < 1664) {
                                const h4v o = {(half_t)a[0], (half_t)a[1], (half_t)a[2], (half_t)a[3]};
                                *(h4v*)(CKV + (long)t * 128 + (n - 1536)) = o;
                            } else if (cb == 1664) {
                                const f4v a2 = acc[mi][(ni + 1) & 3];
                                h4v o1, o2;
                                const int pos = p.pos[t];
#pragma unroll
                                for (int r = 0; r < 4; ++r) {
                                    float x1, x2;
                                    rope_pair(a[r], a2[r], pos, 4 * g4 + r, x1, x2);
                                    o1[r] = (half_t)x1; o2[r] = (half_t)x2;
                                }
#pragma unroll
                                for (int h = 0; h < 8; ++h) {
                                    half_t* kr = KM + ((long)(b * 8 + h) * SEQ + sq) * 96 + 64 + 4 * g4;
                                    *(h4v*)kr = o1; *(h4v*)(kr + 16) = o2;
                                }
                            } else if (cb >= 1696) {
                                const int j = n - 1696;
                                if (j < 24) {
                                    float4 o;
                                    o.x = 1.0f / (1.0f + __expf(-a[0])); o.y = 1.0f / (1.0f + __expf(-a[1]));
                                    o.z = 1.0f / (1.0f + __expf(-a[2])); o.w = 1.0f / (1.0f + __expf(-a[3]));
                                    *(float4*)(GATES + (long)t * 24 + j) = o;
                                }
                            }
                        }
                    }
                });
        }
    }
}

__device__ __forceinline__ void phase_p2(const Params& p, int bid, int nb, char* smem) {
    char* ws = p.ws;
    const int NTA = 256 * 6, NTB = 256 * 8, NTC = 128;
    for (int tile = bid; tile < NTA + NTB + NTC; tile += nb) {
        if (tile < NTC) {
            const int nt = tile & 1, mt = (tile >> 1) & 7, bg = (tile >> 4) & 3, kv = tile >> 6;
            const half_t* A = (const half_t*)(ws + (kv ? OFF_VC : OFF_KC)) + (long)bg * SEQ * 64 + (long)mt * 128 * 1024;
            const half_t* Bt = (const half_t*)(ws + OFF_WC1) + ((long)kv * 256 + nt * 128) * 2048;
            const float* cbv = (const float*)(ws + OFF_CB) + kv * 256;
            half_t* HC = (half_t*)(ws + OFF_HC1) + ((long)(kv * 4 + bg) * 1024) * 256;
            gemm_tile<false, true>(A, 1024, Bt, 2048, 2048, 2048, smem,
                [&](f4v (&acc)[4][4], int wm, int wn, int i16, int g4) __attribute__((always_inline)) {
#pragma unroll
                    for (int mi = 0; mi < 4; ++mi) {
                        const int m = mt * 128 + wm * 64 + mi * 16 + i16;
#pragma unroll
                        for (int ni = 0; ni < 4; ++ni) {
                            const int n = nt * 128 + wn * 64 + ni * 16 + 4 * g4;
                            const float4 bias = *(const float4*)(cbv + n);
                            const h4v o = {(half_t)gelu_exact(acc[mi][ni][0] + bias.x), (half_t)gelu_exact(acc[mi][ni][1] + bias.y),
                                           (half_t)gelu_exact(acc[mi][ni][2] + bias.z), (half_t)gelu_exact(acc[mi][ni][3] + bias.w)};
                            if (m < NCMP) *(h4v*)(HC + (long)m * 256 + n) = o;
                        }
                    }
                });
        } else if (tile < NTC + NTA) {
            const int t2 = tile - NTC;
            const int tm = t2 / 6, tn = t2 % 6;
            const int row0 = tm * 128, n0 = tn * 128;
            half_t* QM = (half_t*)(ws + OFF_QM);
            gemm_tile<true, true>((const half_t*)(ws + OFF_CQ) + (long)row0 * 256, 256, (const half_t*)(ws + OFF_WQUP) + (long)n0 * 256, 256, 256, 256, smem,
                [&](f4v (&acc)[4][4], int wm, int wn, int i16, int g4) __attribute__((always_inline)) {
#pragma unroll
                    for (int mi = 0; mi < 4; ++mi) {
                        const int t = row0 + wm * 64 + mi * 16 + i16;
                        const int b = t >> 14, sq = t & (SEQ - 1);
#pragma unroll
                        for (int ni = 0; ni < 4; ++ni) {
                            const int cb = n0 + wn * 64 + ni * 16;
                            const int h = cb / 96, d0 = cb - h * 96;
                            half_t* qr = QM + ((long)(b * 8 + h) * SEQ + sq) * 96;
                            const f4v a = acc[mi][ni];
                            if (d0 < 64) {
                                const h4v o = {(half_t)(a[0] * QS_MLA), (half_t)(a[1] * QS_MLA), (half_t)(a[2] * QS_MLA), (half_t)(a[3] * QS_MLA)};
                                *(h4v*)(qr + d0 + 4 * g4) = o;
                            } else if (d0 == 64) {
                                const f4v a2 = acc[mi][(ni + 1) & 3];
                                const int pos = p.pos[t];
                                h4v o1, o2;
#pragma unroll
                                for (int r = 0; r < 4; ++r) {
                                    float x1, x2;
                                    rope_pair(a[r] * QS_MLA, a2[r] * QS_MLA, pos, 4 * g4 + r, x1, x2);
                                    o1[r] = (half_t)x1; o2[r] = (half_t)x2;
                                }
                                *(h4v*)(qr + 64 + 4 * g4) = o1; *(h4v*)(qr + 80 + 4 * g4) = o2;
                            }
                        }
                    }
                });
        } else {
            const int t2 = tile - NTC - NTA;
            const int tm = t2 >> 3, tn = t2 & 7;
            const int row0 = tm * 128, n0 = tn * 128;
            half_t* KM = (half_t*)(ws + OFF_KM);
            half_t* VT = (half_t*)(ws + OFF_VT);
            gemm_tile<true, false>((const half_t*)(ws + OFF_CKV) + (long)row0 * 128, 128, (const half_t*)(ws + OFF_WKVUP) + (long)n0 * 128, 128, 128, 128, smem,
                [&](f4v (&acc)[4][4], int wm, int wn, int i16, int g4) __attribute__((always_inline)) {
                    const int h = tn;
#pragma unroll
                    for (int ni = 0; ni < 4; ++ni) {
                        const int d0 = wn * 64 + ni * 16;
#pragma unroll
                        for (int mi = 0; mi < 4; ++mi) {
                            const int rbase = row0 + wm * 64 + mi * 16 + g4 * 4;
                            const int b = rbase >> 14, s0 = rbase & (SEQ - 1);
                            if (d0 < 64) {
#pragma unroll
                                for (int r = 0; r < 4; ++r) KM[((long)(b * 8 + h) * SEQ + s0 + r) * 96 + d0 + i16] = (half_t)acc[mi][ni][r];
                            } else {
                                const h4v o = {(half_t)acc[mi][ni][0], (half_t)acc[mi][ni][1], (half_t)acc[mi][ni][2], (half_t)acc[mi][ni][3]};
                                *(h4v*)(VT + ((long)(b * 8 + h) * 64 + (d0 - 64 + i16)) * SEQ + s0) = o;
                            }
                        }
                    }
                });
        }
    }
}

constexpr int KMAX_KS = 128, KMAX_KW = 132, KMAX_KC = 136, KMAX_KM = 140, KMAX_BIAS = 156;
__device__ __forceinline__ void phase_cmp2(const Params& p, int bid, int nb) {
    char* ws = p.ws;
    unsigned* ctr = (unsigned*)(ws + OFF_CTRL);
    int tx_ = threadIdx.x; asm volatile("" : "+v"(tx_));
    const long tid = (long)bid * NTHREADS + tx_, nth = (long)nb * NTHREADS;
    const int lane = tx_ & 63;
    const half_t* HC = (const half_t*)(ws + OFF_HC1);
    half_t* KC = (half_t*)(ws + OFF_KCMP);
    half_t* VCT = (half_t*)(ws + OFF_VCMPT);
    for (long e = tid; e < 2L * 4 * 1024 * 64; e += nth) {
        const int d = (int)(e & 63), n = (int)((e >> 6) & 1023), bg = (int)((e >> 16) & 3), kv = (int)(e >> 18);
        float s = 0.f;
        if (n < NCMP) {
            const half_t* hr = HC + ((long)(kv * 4 + bg) * 1024 + n) * 256;
            const float* w2 = kv ? p.cmp_v_w2 : p.cmp_k_w2;
            for (int j = 0; j < 256; ++j) s += (float)hr[j] * w2[j * 64 + d];
        }
        const half_t sh = (half_t)s;
        if (kv == 0) {
            KC[((long)bg * 1024 + n) * 64 + d] = sh;
            const float nn = wave_sum((float)sh * (float)sh);
            if (lane == 0) atomicMax(&ctr[KMAX_KC + bg], __float_as_uint(nn));
        } else VCT[((long)bg * 64 + d) * 1024 + n] = sh;
    }
    {
        const int sub = lane & 7;
        const long grp = tid >> 3, ngrp = nth >> 3;
        for (int which = 0; which < 2; ++which) {
            const half_t* Kb = (const half_t*)(ws + (which ? OFF_KW : OFF_KS));
            float mx[4] = {0.f, 0.f, 0.f, 0.f};
            for (long row = grp; row < 4L * SEQ; row += ngrp) {
                const h8v v = *(const h8v*)(Kb + row * 64 + sub * 8);
                float d = 0.f;
#pragma unroll
                for (int j = 0; j < 4; ++j) d = __builtin_amdgcn_fdot2((h2v){v[2 * j], v[2 * j + 1]}, (h2v){v[2 * j], v[2 * j + 1]}, d, false);
                d = red8(d);
                const int bg = (int)(row >> 14);
#pragma unroll
                for (int q = 0; q < 4; ++q) mx[q] = (bg == q) ? fmaxf(mx[q], d) : mx[q];
            }
#pragma unroll
            for (int q = 0; q < 4; ++q) {
                float m = mx[q];
#pragma unroll
                for (int o = 32; o >= 1; o >>= 1) m = fmaxf(m, __shfl_xor(m, o));
                if (lane == 0 && m > 0.f) atomicMax(&ctr[(which ? KMAX_KW : KMAX_KS) + q], __float_as_uint(m));
            }
        }
        const half_t* Km = (const half_t*)(ws + OFF_KM);
        const long wv = tid >> 6, nwv = nth >> 6;
        for (long blk = wv; blk < 16L * SEQ / 64; blk += nwv) {
            const int bh = (int)(blk / (SEQ / 64));
            float mloc = 0.f;
#pragma unroll 1
            for (int rr = 0; rr < 8; ++rr) {
                const long row = blk * 64 + rr * 8 + (lane >> 3);
                const half_t* kr = Km + row * 96 + sub * 8;
                float d = 0.f;
                {
                    const h8v v = *(const h8v*)kr;
#pragma unroll
                    for (int j = 0; j < 4; ++j) d = __builtin_amdgcn_fdot2((h2v){v[2 * j], v[2 * j + 1]}, (h2v){v[2 * j], v[2 * j + 1]}, d, false);
                }
                if (sub < 4) {
                    const h8v v = *(const h8v*)(kr + 64);
#pragma unroll
                    for (int j = 0; j < 4; ++j) d = __builtin_amdgcn_fdot2((h2v){v[2 * j], v[2 * j + 1]}, (h2v){v[2 * j], v[2 * j + 1]}, d, false);
                }
                d = red8(d);
                mloc = fmaxf(mloc, d);
            }
#pragma unroll
            for (int o = 32; o >= 1; o >>= 1) mloc = fmaxf(mloc, __shfl_xor(mloc, o));
            if (lane == 0) atomicMax(&ctr[KMAX_KM + bh], __float_as_uint(mloc));
        }
    }
    if (tid == 0) {
        float mb = 0.f;
        for (int i = 0; i < 256; ++i) mb = fmaxf(mb, p.t5_bias[i] * LOG2E);
        ctr[KMAX_BIAS] = __float_as_uint(mb);
    }
}

struct MlaSmem { half_t K[2][64][104]; half_t V[2][64][68]; };

__device__ __forceinline__ void mla_item(const Params& p, int bh, int qb, char* smem) {
    MlaSmem& sm = *(MlaSmem*)smem;
    char* ws = p.ws;
    const int b = bh >> 3, h = bh & 7;
    const half_t* Qp = (const half_t*)(ws + OFF_QM) + ((long)bh * SEQ + qb * 128) * 96;
    const half_t* Kp = (const half_t*)(ws + OFF_KM) + (long)bh * SEQ * 96;
    const half_t* Vp = (const half_t*)(ws + OFF_VT) + (long)bh * 64 * SEQ;
    half_t* MIX = (half_t*)(ws + OFF_MIXED);
    int tid_ = threadIdx.x; asm volatile("" : "+v"(tid_));
    const int tid = tid_, lane = tid & 63, w = tid >> 6;
    const int c = lane & 31, hh = lane >> 5;
    const int tq = qb * 128 + w * 32 + c;
    h8v qf[6];
#pragma unroll
    for (int s6 = 0; s6 < 6; ++s6) qf[s6] = *(const h8v*)(Qp + (long)(w * 32 + c) * 96 + s6 * 16 + hh * 8);
    f16v o0, o1;
#pragma unroll
    for (int i = 0; i < 16; ++i) { o0[i] = 0.f; o1[i] = 0.f; }
    float qn2 = 0.f;
#pragma unroll
    for (int s6 = 0; s6 < 6; ++s6)
#pragma unroll
        for (int j = 0; j < 8; ++j) { const float f = (float)qf[s6][j]; qn2 += f * f; }
    qn2 += __shfl_xor(qn2, 32);
    const float kmax2 = __uint_as_float(((const unsigned*)(ws + OFF_CTRL))[KMAX_KM + bh]);
    const float nmref = 10.0f - sqrtf(qn2 * kmax2) * 1.0005f;
    float l = 0.f;
    const int ntiles = 2 * qb + 2;
    auto gload = [&](int j, u4v (&rk)[3], u4v (&rv)[2]) __attribute__((always_inline)) {
#pragma unroll
        for (int i = 0; i < 3; ++i) {
            const int ci = tid + 256 * i, key = ci / 12, of = ci % 12;
            rk[i] = *(const u4v*)(Kp + (long)(j * 64 + key) * 96 + of * 8);
        }
#pragma unroll
        for (int i = 0; i < 2; ++i) {
            const int ci = tid + 256 * i, dim = ci >> 3, of = ci & 7;
            rv[i] = *(const u4v*)(Vp + (long)dim * SEQ + j * 64 + of * 8);
        }
    };
    auto lstore = [&](int buf, const u4v (&rk)[3], const u4v (&rv)[2]) __attribute__((always_inline)) {
#pragma unroll
        for (int i = 0; i < 3; ++i) {
            const int ci = tid + 256 * i, key = ci / 12, of = ci % 12;
            *(u4v*)&sm.K[buf][key][of * 8] = rk[i];
        }
#pragma unroll
        for (int i = 0; i < 2; ++i) {
            const int ci = tid + 256 * i, dim = ci >> 3, of = ci & 7;
            *(u2v*)&sm.V[buf][dim][of * 8] = (u2v){rv[i][0], rv[i][1]};
            *(u2v*)&sm.V[buf][dim][of * 8 + 4] = (u2v){rv[i][2], rv[i][3]};
        }
    };
    const int qmin = qb * 128 + w * 32;
    auto compute = [&](int j, int buf) __attribute__((always_inline)) {
        if (64 * j <= qmin + 31) {
            f16v s0, s1;
#pragma unroll
            for (int i = 0; i < 16; ++i) { s0[i] = nmref; s1[i] = nmref; }
#pragma unroll
            for (int s6 = 0; s6 < 6; ++s6) {
                const h8v a0 = *(const h8v*)&sm.K[buf][c][s6 * 16 + hh * 8];
                const h8v a1 = *(const h8v*)&sm.K[buf][32 + c][s6 * 16 + hh * 8];
                s0 = mfma32(a0, qf[s6], s0);
                s1 = mfma32(a1, qf[s6], s1);
            }
            if (64 * j + 63 > qmin) {
#pragma unroll
                for (int r = 0; r < 16; ++r) {
                    const int key = 64 * j + (r & 3) + 8 * (r >> 2) + 4 * hh;
                    if (key > tq) s0[r] = NEGF;
                    if (key + 32 > tq) s1[r] = NEGF;
                }
            }
#pragma unroll
            for (int r = 0; r < 16; ++r) { s0[r] = fast_exp2(s0[r]); l += s0[r]; }
#pragma unroll
            for (int r = 0; r < 16; ++r) { s1[r] = fast_exp2(s1[r]); l += s1[r]; }
#pragma unroll
            for (int ks = 0; ks < 4; ++ks) {
                h8v pb;
#pragma unroll
                for (int jj = 0; jj < 8; ++jj) pb[jj] = (half_t)((ks < 2) ? s0[8 * (ks & 1) + jj] : s1[8 * (ks & 1) + jj]);
#pragma unroll
                for (int md = 0; md < 2; ++md) {
                    const h4v lo = *(const h4v*)&sm.V[buf][32 * md + c][16 * ks + 4 * hh];
                    const h4v hi = *(const h4v*)&sm.V[buf][32 * md + c][16 * ks + 8 + 4 * hh];
                    const h8v a = {lo[0], lo[1], lo[2], lo[3], hi[0], hi[1], hi[2], hi[3]};
                    if (md == 0) o0 = mfma32(a, pb, o0); else o1 = mfma32(a, pb, o1);
                }
            }
        }
    };
    u4v rkA[3], rvA[2], rkB[3], rvB[2];
    gload(0, rkA, rvA);
    gload(1, rkB, rvB);
    lstore(0, rkA, rvA);
    __syncthreads();
#pragma unroll 1
    for (int j = 0; j < ntiles; j += 2) {
        if (j + 2 < ntiles) gload(j + 2, rkA, rvA);
        compute(j, 0);
        lstore(1, rkB, rvB);
        __syncthreads();
        if (j + 3 < ntiles) gload(j + 3, rkB, rvB);
        compute(j + 1, 1);
        if (j + 2 < ntiles) lstore(0, rkA, rvA);
        __syncthreads();
    }
    const float lt = l + __shfl_xor(l, 32);
    const float inv = 1.0f / lt;
    half_t* orow = MIX + (long)(b * SEQ + tq) * 1024 + 512 + h * 64;
#pragma unroll
    for (int md = 0; md < 2; ++md)
#pragma unroll
        for (int rg = 0; rg < 4; ++rg) {
            h4v o;
#pragma unroll
            for (int e = 0; e < 4; ++e) o[e] = (half_t)(((md == 0) ? o0[4 * rg + e] : o1[4 * rg + e]) * inv);
            *(h4v*)(orow + 32 * md + 8 * rg + 4 * hh) = o;
        }
}

struct NsaStage { half_t K[64][72]; half_t V[64][68]; };
constexpr int NSA_LUT = 0;
constexpr int NSA_ST0 = 12288;
constexpr int NSA_RB = NSA_ST0 + 17920;
constexpr int NSA_SEL = NSA_RB + 32768;
constexpr int NSA_MASK = NSA_SEL + 2048;
constexpr int NSA_END = NSA_MASK + 1024;
constexpr float MINIT = -30000.0f;

__device__ __forceinline__ void nsa_item(const Params& p, int bg, int qt, char* smem) {
    char* ws = p.ws;
    half_t* lut = (half_t*)(smem + NSA_LUT);
    float (*imp)[8][256] = (float (*)[8][256])(smem + NSA_RB);
    int (*sel)[8][16] = (int (*)[8][16])(smem + NSA_SEL);
    unsigned* masks = (unsigned*)(smem + NSA_MASK);
    const int b = bg >> 1, g = bg & 1;
    int tid_ = threadIdx.x; asm volatile("" : "+v"(tid_));
    const int tid = tid_, lane = tid & 63, w = tid >> 6;
    const int c = lane & 31, hh = lane >> 5;
    const int qi = c >> 2, r = c & 3;
    const int t0 = qt * 32;
    const int t0w = t0 + w * 8;
    const int tq = t0w + qi;
    const int tlast = t0w + 7;
    {
        const float* lg = (const float*)(ws + OFF_LUT) + (long)g * LUTN * 4;
        for (int i = tid; i < LUTN * 4; i += NTHREADS) lut[i] = (half_t)lg[i];
        float* im = &imp[0][0][0];
        for (int i = tid; i < 4 * 8 * 256; i += NTHREADS) im[i] = 0.f;
    }
    __syncthreads();
    const float cfar = (float)lut[(LUTN - 1) * 4 + r];
    const half_t* QH = (const half_t*)(ws + OFF_QH);
    h8v qf[4];
#pragma unroll
    for (int s4 = 0; s4 < 4; ++s4) qf[s4] = *(const h8v*)(QH + (long)(b * SEQ + tq) * 512 + (g * 4 + r) * 64 + s4 * 16 + hh * 8);
    float nrefC, nrefS, nrefW;
    {
        float qn2 = 0.f;
#pragma unroll
        for (int s4 = 0; s4 < 4; ++s4)
#pragma unroll
            for (int j = 0; j < 8; ++j) { const float f = (float)qf[s4][j]; qn2 += f * f; }
        qn2 += __shfl_xor(qn2, 32);
        const unsigned* cw = (const unsigned*)(ws + OFF_CTRL);
        const float mb = __uint_as_float(cw[KMAX_BIAS]);
        nrefC = 10.0f - mb - sqrtf(qn2 * __uint_as_float(cw[KMAX_KC + bg])) * 1.0005f;
        nrefS = 10.0f - mb - sqrtf(qn2 * __uint_as_float(cw[KMAX_KS + bg])) * 1.0005f;
        nrefW = 10.0f - mb - sqrtf(qn2 * __uint_as_float(cw[KMAX_KW + bg])) * 1.0005f;
    }
    const float* gp = (const float*)(ws + OFF_GATES) + (long)(b * SEQ + tq) * 24 + (g * 4 + r) * 3;
    const float g0 = gp[0], g1 = gp[1], g2 = gp[2];
    f16v of0, of1;
#pragma unroll
    for (int i = 0; i < 16; ++i) { of0[i] = 0.f; of1[i] = 0.f; }

    u4v rk[2], rvv[2];
    auto stage_gload_r = [&](u4v (&rk_)[2], u4v (&rv_)[2], const half_t* Kg, const half_t* Vg, long ldv, int key0, bool withv) __attribute__((always_inline)) {
#pragma unroll
        for (int i = 0; i < 2; ++i) {
            const int ci = tid + 256 * i, row = ci >> 3, of = ci & 7;
            rk_[i] = *(const u4v*)(Kg + (long)(key0 + row) * 64 + of * 8);
            if (withv) rv_[i] = *(const u4v*)(Vg + (long)row * ldv + key0 + of * 8);
        }
    };
    auto stage_lstore_r = [&](NsaStage& st, const u4v (&rk_)[2], const u4v (&rv_)[2], bool withv) __attribute__((always_inline)) {
#pragma unroll
        for (int i = 0; i < 2; ++i) {
            const int ci = tid + 256 * i, row = ci >> 3, of = ci & 7;
            *(u4v*)&st.K[row][of * 8] = rk_[i];
            if (withv) {
                *(u2v*)&st.V[row][of * 8] = (u2v){rv_[i][0], rv_[i][1]};
                *(u2v*)&st.V[row][of * 8 + 4] = (u2v){rv_[i][2], rv_[i][3]};
            }
        }
    };
    auto stage_gload = [&](const half_t* Kg, const half_t* Vg, long ldv, int key0, bool withv) __attribute__((always_inline)) { stage_gload_r(rk, rvv, Kg, Vg, ldv, key0, withv); };
    auto stage_lstore = [&](NsaStage& st, bool withv) __attribute__((always_inline)) { stage_lstore_r(st, rk, rvv, withv); };
    auto qk32 = [&](const NsaStage& st, int mt, float init) __attribute__((always_inline)) -> f16v {
        f16v s;
#pragma unroll
        for (int i = 0; i < 16; ++i) s[i] = init;
#pragma unroll
        for (int s4 = 0; s4 < 4; ++s4) {
            const h8v a = *(const h8v*)&st.K[32 * mt + c][s4 * 16 + hh * 8];
            s = mfma32(a, qf[s4], s);
        }
        return s;
    };
    auto pv32 = [&](const NsaStage& st, int mt, const f16v& pr, f16v& oa, f16v& ob) __attribute__((always_inline)) {
#pragma unroll
        for (int ks = 0; ks < 2; ++ks) {
            h8v pb;
#pragma unroll
            for (int jj = 0; jj < 8; ++jj) pb[jj] = (half_t)pr[8 * ks + jj];
#pragma unroll
            for (int md = 0; md < 2; ++md) {
                const h4v lo = *(const h4v*)&st.V[32 * md + c][32 * mt + 16 * ks + 4 * hh];
                const h4v hi = *(const h4v*)&st.V[32 * md + c][32 * mt + 16 * ks + 8 + 4 * hh];
                const h8v a = {lo[0], lo[1], lo[2], lo[3], hi[0], hi[1], hi[2], hi[3]};
                if (md == 0) oa = mfma32(a, pb, oa); else ob = mfma32(a, pb, ob);
            }
        }
    };
    NsaStage& st0 = *(NsaStage*)(smem + NSA_ST0);
    NsaStage& st1 = *(NsaStage*)(smem + NSA_RB);

    for (int rep = 0; rep < (PROBE_PHASE == 22 ? 2 : 1); ++rep) {
        __syncthreads();
        const half_t* KC = (const half_t*)(ws + OFF_KCMP) + (long)bg * 1024 * 64;
        const half_t* VCT = (const half_t*)(ws + OFF_VCMPT) + (long)bg * 64 * 1024;
        const int nst = ((t0 >> 4) >> 6) + 1;
        auto cmp_scores = [&](f16v& s, int kbase) __attribute__((always_inline)) {
            const bool far = (t0w - (16 * (kbase + 31) + 31)) >= 1513;
            if (far) {
#pragma unroll
                for (int rr = 0; rr < 16; ++rr) s[rr] += cfar;
            } else {
#pragma unroll
                for (int rr = 0; rr < 16; ++rr) {
                    const int k = kbase + (rr & 3) + 8 * (rr >> 2) + 4 * hh;
                    const int dist = tq - (16 * k + 31);
                    const int di = dist < 0 ? 0 : (dist > LUTN - 1 ? LUTN - 1 : dist);
                    s[rr] = (dist >= 0) ? s[rr] + (float)lut[di * 4 + r] : NEGF;
                }
            }
        };
        float l = 0.f;
        stage_gload(KC, VCT, 1024, 0, false);
#pragma unroll 1
        for (int sg = 0; sg < nst; ++sg) {
            stage_lstore(st0, false);
            __syncthreads();
            if (sg + 1 < nst) stage_gload(KC, VCT, 1024, (sg + 1) * 64, false);
#pragma unroll
            for (int mt = 0; mt < 2; ++mt) {
                const int kbase = sg * 64 + mt * 32;
                if (16 * kbase + 31 <= tlast) {
                    f16v s = qk32(st0, mt, nrefC);
                    cmp_scores(s, kbase);
#pragma unroll
                    for (int rr = 0; rr < 16; ++rr) l += fast_exp2(s[rr]);
                }
            }
            __syncthreads();
        }
        l += __shfl_xor(l, 32);
        const float ml2 = (l > 0.f) ? __builtin_amdgcn_logf(l) : 1e30f;
        f16v oc0, oc1;
#pragma unroll
        for (int i = 0; i < 16; ++i) { oc0[i] = 0.f; oc1[i] = 0.f; }
        float carryL = 0.f;
        stage_gload(KC, VCT, 1024, 0, true);
#pragma unroll 1
        for (int sg = 0; sg < nst; ++sg) {
            stage_lstore(st0, true);
            __syncthreads();
            if (sg + 1 < nst) stage_gload(KC, VCT, 1024, (sg + 1) * 64, true);
#pragma unroll
            for (int mt = 0; mt < 2; ++mt) {
                const int kbase = sg * 64 + mt * 32;
                const int kt = sg * 2 + mt;
                if (16 * kbase + 31 <= tlast) {
                    f16v s = qk32(st0, mt, nrefC);
                    cmp_scores(s, kbase);
#pragma unroll
                    for (int rr = 0; rr < 16; ++rr) s[rr] = fast_exp2(s[rr] - ml2);
                    float Gs[4], Ls[4];
#pragma unroll
                    for (int jg = 0; jg < 4; ++jg) {
                        float G = s[4 * jg] + s[4 * jg + 1] + s[4 * jg + 2] + s[4 * jg + 3];
                        float L = s[4 * jg + 3];
                        G += __shfl_xor(G, 1); G += __shfl_xor(G, 2);
                        L += __shfl_xor(L, 1); L += __shfl_xor(L, 2);
                        Gs[jg] = G; Ls[jg] = L;
                    }
                    float Lo[4];
#pragma unroll
                    for (int jg = 0; jg < 4; ++jg) Lo[jg] = __shfl_xor(Ls[jg], 32);
                    if (r == 0) {
#pragma unroll
                        for (int jg = 0; jg < 4; ++jg) {
                            const float prevL = hh ? Lo[jg] : (jg == 0 ? carryL : Lo[jg - 1]);
                            imp[w][qi][8 * kt + 2 * jg + hh] = Gs[jg] + prevL;
                        }
                    }
                    carryL = Lo[3];
                    pv32(st0, mt, s, oc0, oc1);
                }
            }
            __syncthreads();
        }
#pragma unroll
        for (int i = 0; i < 16; ++i) { of0[i] += (rep == 0 ? g0 : 0.0f) * oc0[i]; of1[i] += (rep == 0 ? g0 : 0.0f) * oc1[i]; }
    }
    {
        const int q2 = lane >> 3, sub = lane & 7;
        const int tq2 = t0w + q2;
        const int cur = tq2 >> 6;
        unsigned key[32];
#pragma unroll
        for (int i = 0; i < 32; ++i) {
            const int sb = sub + 8 * i;
            const float v = imp[w][q2][sb];
            unsigned u = (__float_as_uint(v) & 0x7FFFFF00u) | (unsigned)(255 - sb);
            if (sb == 0 || sb == cur || sb == cur - 1) u |= 0x80000000u;
            if (sb > cur) u = 0u;
            key[i] = u;
        }
#pragma unroll 1
        for (int round = 0; round < 16; ++round) {
            unsigned best = key[0];
#pragma unroll
            for (int i = 1; i < 32; ++i) best = best > key[i] ? best : key[i];
#pragma unroll
            for (int o = 1; o <= 4; o <<= 1) { const unsigned ob = (unsigned)__shfl_xor((int)best, o); best = best > ob ? best : ob; }
            if (sub == 0) sel[w][q2][round] = best ? (int)(255u - (best & 0xFFu)) : -1;
#pragma unroll
            for (int i = 0; i < 32; ++i) key[i] = (key[i] == best) ? 0u : key[i];
        }
    }
    for (int i = tid; i < 256; i += NTHREADS) masks[i] = 0u;
    __syncthreads();
    for (int e = lane; e < 128; e += 64) {
        const int q2 = e >> 4, bi = e & 15;
        const int blk = sel[w][q2][bi];
        if (blk >= 0) atomicOr(&masks[blk], 1u << (8 * w + q2));
    }
    __syncthreads();
    auto block_attend = [&](const NsaStage& st, int key0, bool colsel, bool window, float nref, float& l, f16v& oa, f16v& ob) __attribute__((always_inline)) {
        const bool far = !window && (t0w - (key0 + 63)) >= 1513;
        f16v s0, s1;
        if (far) {
            const float init = colsel ? (cfar + nref) : NEGF;
            s0 = qk32(st, 0, init); s1 = qk32(st, 1, init);
        } else {
            s0 = qk32(st, 0, nref); s1 = qk32(st, 1, nref);
#pragma unroll
            for (int rr = 0; rr < 16; ++rr) {
                const int pos = key0 + (rr & 3) + 8 * (rr >> 2) + 4 * hh;
                {
                    const int dist = tq - pos;
                    const bool valid = colsel && dist >= 0 && (!window || dist < 512);
                    const int di = dist < 0 ? 0 : (dist > LUTN - 1 ? LUTN - 1 : dist);
                    s0[rr] = valid ? s0[rr] + (float)lut[di * 4 + r] : NEGF;
                }
                {
                    const int dist = tq - pos - 32;
                    const bool valid = colsel && dist >= 0 && (!window || dist < 512);
                    const int di = dist < 0 ? 0 : (dist > LUTN - 1 ? LUTN - 1 : dist);
                    s1[rr] = valid ? s1[rr] + (float)lut[di * 4 + r] : NEGF;
                }
            }
        }
#pragma unroll
        for (int rr = 0; rr < 16; ++rr) { s0[rr] = fast_exp2(s0[rr]); l += s0[rr]; }
#pragma unroll
        for (int rr = 0; rr < 16; ++rr) { s1[rr] = fast_exp2(s1[rr]); l += s1[rr]; }
        pv32(st, 0, s0, oa, ob);
        pv32(st, 1, s1, oa, ob);
    };
    unsigned char* blist = (unsigned char*)(smem + NSA_SEL);
    volatile int* bcount = (volatile int*)(smem + NSA_SEL + 256);
    if (w == 0) {
        const int jmaxb = (t0 + 31) >> 6;
        int base = 0;
#pragma unroll 1
        for (int rnd = 0; rnd < 4; ++rnd) {
            const int bb = rnd * 64 + lane;
            const bool f = (bb <= jmaxb) && (masks[bb] != 0u);
            const unsigned long long bal = __ballot(f);
            const int pos = base + __popcll(bal & ((1ull << lane) - 1ull));
            if (f) blist[pos] = (unsigned char)bb;
            base += __popcll(bal);
        }
        if (lane == 0) *bcount = base;
    }
    for (int rep = 0; rep < (PROBE_PHASE == 20 ? 2 : 1); ++rep) {
        __syncthreads();
        const half_t* KS = (const half_t*)(ws + OFF_KS) + (long)bg * SEQ * 64;
        const half_t* VST = (const half_t*)(ws + OFF_VST) + (long)bg * 64 * SEQ;
        f16v os0, os1;
#pragma unroll
        for (int i = 0; i < 16; ++i) { os0[i] = 0.f; os1[i] = 0.f; }
        float l = 0.f;
        const int nblk = *bcount;
        u4v kA[2], vA[2], kB[2], vB[2];
        if (nblk > 0) stage_gload_r(kA, vA, KS, VST, SEQ, (int)blist[0] * 64, true);
        if (nblk > 1) stage_gload_r(kB, vB, KS, VST, SEQ, (int)blist[1] * 64, true);
        if (nblk > 0) stage_lstore_r(st0, kA, vA, true);
        __syncthreads();
#define SEL_STAGE(i_, ST, STN, KX, VX, KY, VY) { \
            const int i__ = (i_); \
            if (i__ < nblk) { \
                if (i__ + 2 < nblk) stage_gload_r(KX, VX, KS, VST, SEQ, (int)blist[i__ + 2] * 64, true); \
                const int j = (int)blist[i__]; \
                const unsigned mk = masks[j]; \
                if ((mk >> (8 * w)) & 0xFFu) { \
                    const bool colsel = (mk >> (8 * w + qi)) & 1u; \
                    block_attend(ST, j * 64, colsel, false, nrefS, l, os0, os1); \
                } \
                if (i__ + 1 < nblk) stage_lstore_r(STN, KY, VY, true); \
                __syncthreads(); \
            } }
#pragma unroll 1
        for (int i = 0; i < nblk; i += 2) {
            SEL_STAGE(i, st0, st1, kA, vA, kB, vB);
            SEL_STAGE(i + 1, st1, st0, kB, vB, kA, vA);
        }
        const float lt = l + __shfl_xor(l, 32);
        const float sc = ((lt > 0.f) ? g1 / lt : 0.f) * (rep == 0 ? 1.0f : 0.0f);
#pragma unroll
        for (int i = 0; i < 16; ++i) { of0[i] += sc * os0[i]; of1[i] += sc * os1[i]; }
    }
    __syncthreads();
    for (int rep = 0; rep < (PROBE_PHASE == 21 ? 2 : 1); ++rep) {
        __syncthreads();
        const half_t* KW = (const half_t*)(ws + OFF_KW) + (long)bg * SEQ * 64;
        const half_t* VWT = (const half_t*)(ws + OFF_VWT) + (long)bg * 64 * SEQ;
        f16v ow0, ow1;
#pragma unroll
        for (int i = 0; i < 16; ++i) { ow0[i] = 0.f; ow1[i] = 0.f; }
        float l = 0.f;
        const int jmax = (t0 + 31) >> 6;
        int j = (t0 >= 511) ? ((t0 - 511) >> 6) : 0;
        int buf = 0;
        stage_gload(KW, VWT, SEQ, j * 64, true);
#pragma unroll 1
        while (j <= jmax) {
            NsaStage& st = buf ? st1 : st0;
            stage_lstore(st, true);
            __syncthreads();
            if (j + 1 <= jmax) stage_gload(KW, VWT, SEQ, (j + 1) * 64, true);
            block_attend(st, j * 64, true, true, nrefW, l, ow0, ow1);
            buf ^= 1; ++j;
        }
        const float lt = l + __shfl_xor(l, 32);
        const float sc = ((lt > 0.f) ? g2 / lt : 0.f) * (rep == 0 ? 1.0f : 0.0f);
#pragma unroll
        for (int i = 0; i < 16; ++i) { of0[i] += sc * ow0[i]; of1[i] += sc * ow1[i]; }
    }
    {
        half_t* orow = (half_t*)(ws + OFF_MIXED) + (long)(b * SEQ + tq) * 1024 + (g * 4 + r) * 64;
#pragma unroll
        for (int md = 0; md < 2; ++md)
#pragma unroll
            for (int rg = 0; rg < 4; ++rg) {
                h4v o;
#pragma unroll
                for (int e = 0; e < 4; ++e) o[e] = (half_t)((md == 0) ? of0[4 * rg + e] : of1[4 * rg + e]);
                *(h4v*)(orow + 32 * md + 8 * rg + 4 * hh) = o;
            }
    }
    __syncthreads();
}

__device__ __forceinline__ void phase_attn(const Params& p, char* smem, int cidx = 64, int mode = 0) {
    unsigned* ctr = (unsigned*)(p.ws + OFF_CTRL) + cidx;
    volatile int* s_item = (volatile int*)(smem + 66048);
    const int x0 = (int)(xb_xcc_id() & 7u);
    const int lo = (mode == 2) ? 256 : 0, hi = (mode == 1) ? 256 : 512;
    for (int k = 0; k < 8; ++k) {
        const int q = (x0 + k) & 7;
        for (;;) {
            if (threadIdx.x == 0) {
                int v = -1;
                if (__hip_atomic_load(&ctr[q], __ATOMIC_RELAXED, __HIP_MEMORY_SCOPE_AGENT) < (unsigned)(hi - lo)) v = (int)atomicAdd(&ctr[q], 1u) + lo;
                *s_item = v;
            }
            __syncthreads();
            const int li = *s_item;
            __syncthreads();
            if (li < 0 || li >= hi) break;
            if (li < 256) mla_item(p, 2 * q + (li & 1), 127 - (li >> 1), smem);
            else nsa_item(p, q & 3, 511 - 2 * (li - 256) - (q >> 2), smem);
        }
    }
}

__device__ __forceinline__ void phase_outproj(const Params& p, int bid, int nb, char* smem) {
    char* ws = p.ws;
    const half_t* MIX = (const half_t*)(ws + OFF_MIXED);
    const half_t* W = (const half_t*)(ws + OFF_WOUT);
    half_t* X2H = (half_t*)(ws + OFF_X2H);
    for (int tile = bid; tile < 256 * 8; tile += nb) {
        const int tm = tile >> 3, tn = tile & 7;
        const int row0 = tm * 128, n0 = tn * 128;
        gemm_tile<true, true>(MIX + (long)row0 * 1024, 1024, W + (long)n0 * 1024, 1024, 1024, 512, smem,
            [&](f4v (&acc)[4][4], int wm, int wn, int i16, int g4) __attribute__((always_inline)) {
#pragma unroll
                for (int mi = 0; mi < 4; ++mi) {
                    const long row = row0 + wm * 64 + mi * 16 + i16;
#pragma unroll
                    for (int ni = 0; ni < 4; ++ni) {
                        const int col = n0 + wn * 64 + ni * 16 + 4 * g4;
                        float4 v = *(const float4*)(p.x + row * 1024 + col);
                        v.x += acc[mi][ni][0]; v.y += acc[mi][ni][1]; v.z += acc[mi][ni][2]; v.w += acc[mi][ni][3];
                        const h4v o = {(half_t)v.x, (half_t)v.y, (half_t)v.z, (half_t)v.w};
                        *(h4v*)(X2H + row * 1024 + col) = o;
                    }
                }
            });
    }
}

__device__ __forceinline__ void phase_peerq(const Params& p, int bid, int nb, char* smem) {
    char* ws = p.ws;
    const half_t* X2H = (const half_t*)(ws + OFF_X2H);
    const half_t* W = (const half_t*)(ws + OFF_WPQ);
    half_t* QP = (half_t*)(ws + OFF_QP);
    for (int tile = bid; tile < 256 * 16; tile += nb) {
        const int tm = tile >> 4, tn = tile & 15;
        const int row0 = tm * 128, n0 = tn * 128;
        gemm_tile<true, true>(X2H + (long)row0 * 1024, 1024, W + (long)n0 * 1024, 1024, 1024, 1024, smem,
            [&](f4v (&acc)[4][4], int wm, int wn, int i16, int g4) __attribute__((always_inline)) {
#pragma unroll
                for (int mi = 0; mi < 4; ++mi) {
                    const long row = row0 + wm * 64 + mi * 16 + i16;
#pragma unroll
                    for (int ni = 0; ni < 4; ++ni) {
                        const int col = n0 + wn * 64 + ni * 16 + 4 * g4;
                        const h4v o = {(half_t)acc[mi][ni][0], (half_t)acc[mi][ni][1], (half_t)acc[mi][ni][2], (half_t)acc[mi][ni][3]};
                        *(h4v*)(QP + row * 2048 + col) = o;
                    }
                }
            });
    }
}

__device__ __forceinline__ void topk_insert(float (&tv)[16], int (&ti)[16], float v, int id) {
#pragma unroll
    for (int k = 0; k < 16; ++k) {
        const bool gt = v > tv[k];
        const float nv = gt ? tv[k] : v; const int ni = gt ? ti[k] : id;
        tv[k] = gt ? v : tv[k]; ti[k] = gt ? id : ti[k];
        v = nv; id = ni;
    }
}
__device__ __forceinline__ unsigned rt_flip(float f) { const unsigned b = __float_as_uint(f); return b ^ ((b >> 31) ? 0xFFFFFFFFu : 0x80000000u); }
__device__ __forceinline__ float rt_unflip(unsigned u) { return __uint_as_float((u & 0x80000000u) ? (u ^ 0x80000000u) : ~u); }
__device__ __forceinline__ void rt_insert(unsigned (&tk)[16], unsigned u) {
#pragma unroll
    for (int k = 0; k < 16; ++k) { const unsigned hi = tk[k] > u ? tk[k] : u; u = tk[k] > u ? u : tk[k]; tk[k] = hi; }
}
__device__ __forceinline__ void phase_route(const Params& p, int bid, int nb, char* smem) {
    char* ws = p.ws;
    {
        const u4v* src = (const u4v*)(ws + OFF_KEYS);
        u4v* dst = (u4v*)smem;
        for (int i = threadIdx.x; i < 4096; i += NTHREADS) {
            const int n = (i >> 4) & 127, ch = i & 15;
            dst[(i & ~15) | (ch ^ (n & 15))] = src[i];
        }
    }
    __syncthreads();
    const half_t* QP = (const half_t*)(ws + OFF_QP);
    int* EID = (int*)(ws + OFF_EID);
    float* GW = (float*)(ws + OFF_GW);
    int tid_ = threadIdx.x; asm volatile("" : "+v"(tid_));
    const int lane = tid_ & 63, w = tid_ >> 6, c = lane & 31, hh = lane >> 5;
#pragma unroll 1
    for (long blk = bid; blk < (long)NTOK * 8 / 128; blk += nb) {
        const long th = blk * 128 + w * 32 + c;
        unsigned tkA[16], tkB[16];
#pragma unroll
        for (int half = 0; half < 2; ++half) {
            unsigned (&tk)[16] = half ? tkB : tkA;
#pragma unroll
            for (int k = 0; k < 16; ++k) tk[k] = 0u;
            h8v qf[8];
#pragma unroll
            for (int ks = 0; ks < 8; ++ks) qf[ks] = *(const h8v*)(QP + th * 256 + half * 128 + ks * 16 + hh * 8);
#pragma unroll 1
            for (int mt = 0; mt < 4; ++mt) {
                f16v s;
#pragma unroll
                for (int i = 0; i < 16; ++i) s[i] = 0.f;
                const int n = mt * 32 + c;
                const char* kb = smem + (half * 128 + n) * 256;
#pragma unroll
                for (int ks = 0; ks < 8; ++ks) {
                    const h8v a = *(const h8v*)(kb + (((2 * ks + hh) ^ (n & 15)) << 4));
                    s = mfma32(a, qf[ks], s);
                }
#pragma unroll
                for (int r = 0; r < 16; ++r) {
                    const int key = mt * 32 + (r & 3) + 8 * (r >> 2) + 4 * hh;
                    rt_insert(tk, (rt_flip(s[r]) & ~0x7Fu) | (unsigned)(127 - key));
                }
            }
            unsigned other[16];
#pragma unroll
            for (int k = 0; k < 16; ++k) other[k] = (unsigned)__shfl_xor((int)tk[k], 32);
#pragma unroll
            for (int k = 0; k < 16; ++k) rt_insert(tk, other[k]);
        }
        float v1[16], v2[16]; int i1[16], i2[16];
#pragma unroll
        for (int k = 0; k < 16; ++k) {
            v1[k] = rt_unflip(tkA[k] & ~0x7Fu); i1[k] = 127 - (int)(tkA[k] & 0x7Fu);
            v2[k] = rt_unflip(tkB[k] & ~0x7Fu); i2[k] = 127 - (int)(tkB[k] & 0x7Fu);
        }
        float fv[16]; int fi[16];
#pragma unroll
        for (int k = 0; k < 16; ++k) { fv[k] = -3.0e38f; fi[k] = 0; }
        {
            constexpr int NP = 50;
            int pi[NP], pj[NP]; int np = 0;
#pragma unroll
            for (int i = 0; i < 16; ++i)
#pragma unroll
                for (int j = 0; j < 16; ++j)
                    if ((i + 1) * (j + 1) <= 16) { pi[np] = i; pj[np] = j; ++np; }
#pragma unroll
            for (int q = 0; q < NP / 2; ++q) {
                const float va = v1[pi[2 * q]] + v2[pj[2 * q]], vb = v1[pi[2 * q + 1]] + v2[pj[2 * q + 1]];
                const int ea = i1[pi[2 * q]] * 128 + i2[pj[2 * q]], eb = i1[pi[2 * q + 1]] * 128 + i2[pj[2 * q + 1]];
                topk_insert(fv, fi, hh ? vb : va, hh ? eb : ea);
            }
        }
        {
            float ov[16]; int oi[16];
#pragma unroll
            for (int k = 0; k < 16; ++k) { ov[k] = __shfl_xor(fv[k], 32); oi[k] = __shfl_xor(fi[k], 32); }
#pragma unroll
            for (int k = 0; k < 16; ++k) topk_insert(fv, fi, ov[k], oi[k]);
        }
        if (hh == 0) {
            float sum = 0.f, ex[16];
#pragma unroll
            for (int k = 0; k < 16; ++k) { ex[k] = __expf(fv[k] - fv[0]); sum += ex[k]; }
            const float inv = 1.0f / sum;
#pragma unroll
            for (int k4 = 0; k4 < 4; ++k4) {
                *(int4*)(EID + th * 16 + 4 * k4) = make_int4(fi[4 * k4], fi[4 * k4 + 1], fi[4 * k4 + 2], fi[4 * k4 + 3]);
                *(float4*)(GW + th * 16 + 4 * k4) = make_float4(ex[4 * k4] * inv, ex[4 * k4 + 1] * inv, ex[4 * k4 + 2] * inv, ex[4 * k4 + 3] * inv);
            }
        }
    }
}

__device__ __forceinline__ int peer_next_task(unsigned* q, int xpref, int ntask_per_slice, volatile int* s_task) {
    if (threadIdx.x == 0) {
        int res = -1;
        for (int k = 0; k < 8; ++k) {
            const int x = (xpref + k) & 7;
            if (__hip_atomic_load(&q[x], __ATOMIC_RELAXED, __HIP_MEMORY_SCOPE_AGENT) >= (unsigned)ntask_per_slice) continue;
            const unsigned c = atomicAdd(&q[x], 1u);
            if (c < (unsigned)ntask_per_slice) { res = x * ntask_per_slice + (int)c; break; }
        }
        *s_task = res;
    }
    __syncthreads();
    const int r = *s_task;
    __syncthreads();
    return r;
}
template <int PMODE>
__device__ __forceinline__ void phase_peer_udot(const Params& p, char* smem, int qoff = 16) {
    char* ws = p.ws;
    unsigned* q = (unsigned*)(ws + OFF_CTRL) + qoff;
    volatile int* s_task = (volatile int*)(smem + 66048);
    const unsigned char* U8 = (const unsigned char*)(ws + OFF_U16);
    const half_t* X2H = (const half_t*)(ws + OFF_X2H);
    const int* EID = (const int*)(ws + OFF_EID);
    float* PD = (float*)(ws + OFF_PD);
    const int xpref = (int)(xb_xcc_id() & 7u);
    for (;;) {
        const int task = peer_next_task(q, xpref, 512, s_task);
        if (task < 0) break;
        const int x = task >> 9, chunk = task & 511;
        int tid_ = threadIdx.x; asm volatile("" : "+v"(tid_));
        const int lane = tid_ & 63, w = tid_ >> 6, seg = lane & 7, eg = lane >> 3;
        h2v gs[8];
#pragma unroll
        for (int i = 0; i < 8; ++i) gs[i] = (h2v){(half_t)p.norm2_g[128 * x + 16 * seg + 2 * i], (half_t)p.norm2_g[128 * x + 16 * seg + 2 * i + 1]};
        const unsigned char* Ux = U8 + (long)x * 16384 * 128 + 16 * seg;
        const int tbase = chunk * 64 + w * 16;
        const int* Eb = EID + (long)tbase * 128 + 16 * eg;
        const half_t* Xb = X2H + (long)tbase * 1024 + 128 * x + 16 * seg;
#define LOAD_E(dst, k) { const u4v* ep_ = (const u4v*)(Eb + (long)(k) * 128); dst[0] = ep_[0]; dst[1] = ep_[1]; dst[2] = ep_[2]; dst[3] = ep_[3]; }
#define LOAD_X(xa_, xb_, k) { xa_ = *(const h8v*)(Xb + (long)(k) * 1024); xb_ = *(const h8v*)(Xb + (long)(k) * 1024 + 8); }
#define ISSUE_U(uu, e_) { _Pragma("unroll") for (int i = 0; i < 16; ++i) uu[i] = *(const u4v*)(Ux + (long)e_[i >> 2][i & 3] * 128); }
        auto compute = [&](int k, const h8v& xa, const h8v& xb, const u4v (&uu)[16]) __attribute__((always_inline)) {
            h2v hs[8];
#pragma unroll
            for (int i = 0; i < 4; ++i) {
                hs[i] = (h2v){xa[2 * i], xa[2 * i + 1]} * gs[i];
                hs[4 + i] = (h2v){xb[2 * i], xb[2 * i + 1]} * gs[4 + i];
            }
            float res0 = 0.f, res1 = 0.f;
            if (PMODE == 1) {
                unsigned acc_ = 0;
#pragma unroll
                for (int i = 0; i < 16; ++i) acc_ ^= uu[i][0] ^ uu[i][1] ^ uu[i][2] ^ uu[i][3];
                float* po = (float*)(p.ws + OFF_HC1) + (((long)(tbase + k) * 128 + 16 * eg + seg) & 0xFFFFF);
                po[0] = __builtin_bit_cast(float, acc_) + (float)hs[0][0];
                return;
            }
#pragma unroll
            for (int i = 0; i < 16; ++i) {
                float d = 0.f;
#pragma unroll
                for (int j = 0; j < 4; ++j) {
                    const h2v lo = __builtin_amdgcn_cvt_scalef32_pk_f16_fp8((int)uu[i][j], 1.0f, false);
                    const h2v hi = __builtin_amdgcn_cvt_scalef32_pk_f16_fp8((int)uu[i][j], 1.0f, true);
                    d = __builtin_amdgcn_fdot2(hs[2 * j], lo, d, false);
                    d = __builtin_amdgcn_fdot2(hs[2 * j + 1], hi, d, false);
                }
                d = red8(d);
                if (i < 8) res0 = (seg == i) ? d : res0; else res1 = (seg == (i - 8)) ? d : res1;
            }
            float* po = PD + ((long)x * NTOK + tbase + k) * 128 + 16 * eg + seg;
            po[0] = res0; po[8] = res1;
        };
        u4v uuA[16], uuB[16];
        u4v eA[4], eB[4];
        h8v xaA, xbA, xaB, xbB;
        LOAD_E(eA, 0); LOAD_X(xaA, xbA, 0);
        LOAD_E(eB, 1); LOAD_X(xaB, xbB, 1);
        ISSUE_U(uuA, eA);
#pragma unroll 1
        for (int k = 0; k < 16; k += 2) {
            ISSUE_U(uuB, eB);
            if (k + 2 < 16) LOAD_E(eA, k + 2);
            compute(k, xaA, xbA, uuA);
            if (k + 2 < 16) { LOAD_X(xaA, xbA, k + 2); ISSUE_U(uuA, eA); LOAD_E(eB, k + 3); }
            compute(k + 1, xaB, xbB, uuB);
            if (k + 2 < 16) LOAD_X(xaB, xbB, k + 3);
        }
    }
}
__device__ __forceinline__ void phase_peer_coef(const Params& p, int bid, int nb) {
    char* ws = p.ws;
    const half_t* X2H = (const half_t*)(ws + OFF_X2H);
    const float* PD = (const float*)(ws + OFF_PD);
    const float* GW = (const float*)(ws + OFF_GW);
    float* COEF = (float*)(ws + OFF_COEF);
    int tx_ = threadIdx.x; asm volatile("" : "+v"(tx_));
    const int lane = tx_ & 63;
    const long wv = ((long)bid * NTHREADS + tx_) >> 6, nwv = ((long)nb * NTHREADS) >> 6;
    for (long t = wv; t < NTOK; t += nwv) {
        const h8v a = *(const h8v*)(X2H + t * 1024 + 8 * lane), b2 = *(const h8v*)(X2H + t * 1024 + 512 + 8 * lane);
        float ss = 0.f;
#pragma unroll
        for (int i = 0; i < 8; ++i) { const float f0 = (float)a[i], f1 = (float)b2[i]; ss += f0 * f0 + f1 * f1; }
        ss = wave_sum(ss);
        const float rs = rsqrtf(ss * (1.0f / 1024.f) + EPS) * (1.0f / USCALE);
        float d0 = 0.f, d1 = 0.f;
#pragma unroll
        for (int x = 0; x < 8; ++x) {
            const float* pp = PD + ((long)x * NTOK + t) * 128;
            d0 += pp[lane]; d1 += pp[64 + lane];
        }
        COEF[t * 128 + lane] = GW[t * 128 + lane] * gelu_exact(d0 * rs);
        COEF[t * 128 + 64 + lane] = GW[t * 128 + 64 + lane] * gelu_exact(d1 * rs);
    }
}
__device__ __forceinline__ void phase_peer_vacc(const Params& p, char* smem) {
    char* ws = p.ws;
    unsigned* q = (unsigned*)(ws + OFF_CTRL) + 32;
    volatile int* s_task = (volatile int*)(smem + 66048);
    const unsigned char* V8 = (const unsigned char*)(ws + OFF_V16);
    const int* EID = (const int*)(ws + OFF_EID);
    const float* COEF = (const float*)(ws + OFF_COEF);
    float* SSQ = (float*)(ws + OFF_SSQ);
    const int xpref = (int)(xb_xcc_id() & 7u);
    for (;;) {
        const int task = peer_next_task(q, xpref, 512, s_task);
        if (task < 0) break;
        const int x = task >> 9, chunk = task & 511;
        int tid_ = threadIdx.x; asm volatile("" : "+v"(tid_));
        const int lane = tid_ & 63, w = tid_ >> 6, seg = lane & 7, eg = lane >> 3;
        const unsigned char* Vx = V8 + (long)x * 16384 * 128 + 16 * seg;
#pragma unroll 1
        for (int round = 0; round < 2; ++round) {
            const int t = chunk * 64 + w * 16 + round * 8 + eg;
            const int* Eb = EID + (long)t * 128;
            const float* Cb = COEF + (long)t * 128;
#define LOAD_EC(e_, c_, ci) { const u4v* ep_ = (const u4v*)(Eb + 8 * (ci)); const f4v* cp_ = (const f4v*)(Cb + 8 * (ci)); e_[0] = ep_[0]; e_[1] = ep_[1]; c_[0] = cp_[0]; c_[1] = cp_[1]; }
#define ISSUE_V(vv, e_) { _Pragma("unroll") for (int i = 0; i < 8; ++i) vv[i] = *(const u4v*)(Vx + (long)e_[i >> 2][i & 3] * 128); }
            float acc[16];
#pragma unroll
            for (int i = 0; i < 16; ++i) acc[i] = 0.f;
            auto compute = [&](const f4v (&c_)[2], const u4v (&vv)[8]) __attribute__((always_inline)) {
#pragma unroll
                for (int i = 0; i < 8; ++i) {
                    const float cf = c_[i >> 2][i & 3];
#pragma unroll
                    for (int j = 0; j < 4; ++j) {
                        const auto lo = __builtin_amdgcn_cvt_pk_f32_fp8((int)vv[i][j], false);
                        const auto hi = __builtin_amdgcn_cvt_pk_f32_fp8((int)vv[i][j], true);
                        acc[4 * j] += cf * lo[0]; acc[4 * j + 1] += cf * lo[1];
                        acc[4 * j + 2] += cf * hi[0]; acc[4 * j + 3] += cf * hi[1];
                    }
                }
            };
            u4v vvA[8], vvB[8];
            u4v eA[2], eB[2]; f4v cA[2], cB[2];
            LOAD_EC(eA, cA, 0); LOAD_EC(eB, cB, 1);
            ISSUE_V(vvA, eA);
#pragma unroll 1
            for (int ci = 0; ci < 16; ci += 2) {
                ISSUE_V(vvB, eB);
                compute(cA, vvA);
                if (ci + 2 < 16) { LOAD_EC(eA, cA, ci + 2); ISSUE_V(vvA, eA); }
                compute(cB, vvB);
                if (ci + 2 < 16) LOAD_EC(eB, cB, ci + 3);
            }
            half_t* xr = (half_t*)(ws + OFF_X2H) + (long)t * 1024 + 128 * x + 16 * seg;
            float ssq = 0.f;
#pragma unroll
            for (int i8 = 0; i8 < 2; ++i8) {
                h8v xv = *(const h8v*)(xr + 8 * i8);
#pragma unroll
                for (int e = 0; e < 8; ++e) {
                    const float f = (float)xv[e] + acc[8 * i8 + e] * (1.0f / VSCALE);
                    ssq += f * f;
                    xv[e] = (half_t)f;
                }
                *(h8v*)(xr + 8 * i8) = xv;
            }
            ssq = red8(ssq);
            if (seg == 0) SSQ[(long)x * NTOK + t] = ssq;
        }
    }
}
__device__ __forceinline__ void phase_final_norm(const Params& p, int bid, int nb) {
    const float* SSQ = (const float*)(p.ws + OFF_SSQ);
    int tx_ = threadIdx.x; asm volatile("" : "+v"(tx_));
    const int lane = tx_ & 63;
    const long wv = ((long)bid * NTHREADS + tx_) >> 6, nwv = ((long)nb * NTHREADS) >> 6;
    for (long t = wv; t < NTOK; t += nwv) {
        float ss = 0.f;
#pragma unroll
        for (int x = 0; x < 8; ++x) ss += SSQ[(long)x * NTOK + t];
        const float rf = rsqrtf(ss * (1.0f / 1024.f) + EPS);
        const half_t* xh = (const half_t*)(p.ws + OFF_X2H) + t * 1024;
        float4* xr = (float4*)(p.out + t * 1024);
#pragma unroll
        for (int i = 0; i < 4; ++i) {
            const h4v hv = *(const h4v*)(xh + 4 * (lane + 64 * i));
            const float4 g = ((const float4*)p.final_g)[lane + 64 * i];
            float4 v;
            v.x = (float)hv[0] * rf * g.x; v.y = (float)hv[1] * rf * g.y; v.z = (float)hv[2] * rf * g.z; v.w = (float)hv[3] * rf * g.w;
            xr[lane + 64 * i] = v;
        }
    }
}

#define XB_TMO      128
#define XB_XCNT(j)  (256  + 64 * (j))
#define XB_XSUB(j)  (1280 + 64 * (j))
#define XB_XGEN(j)  (2304 + 64 * (j))
#define XB_TOP      3328
#define XB_TOPGEN   3392
#define XCD_BAR_WORDS 3456
#define XB_SPIN_CAP (1u << 22)
__device__ __forceinline__ unsigned xb_ld(unsigned* p)              { return __hip_atomic_load(p, __ATOMIC_RELAXED, __HIP_MEMORY_SCOPE_AGENT); }
__device__ __forceinline__ unsigned xb_add(unsigned* p, unsigned v) { return __hip_atomic_fetch_add(p, v, __ATOMIC_RELAXED, __HIP_MEMORY_SCOPE_AGENT); }
__device__ __forceinline__ unsigned xb_xcc_id() { return (unsigned)__builtin_amdgcn_s_getreg((3 << 11) | 20) & 0xFu; }
#define XB_SPIN(cond, bar) do { unsigned _sp = 0; while (cond) { __builtin_amdgcn_s_sleep(1); \
    if ((++_sp & 255u) == 0u) { if (xb_ld(&(bar)[XB_TMO])) break; if (_sp > XB_SPIN_CAP) { atomicAdd(&(bar)[XB_TMO], 1u); break; } } } } while (0)
struct XcdBarrier { unsigned* bar; unsigned x; volatile unsigned* st; };
__device__ __forceinline__ XcdBarrier xcd_barrier_post(unsigned* bar, volatile unsigned* st) {
    XcdBarrier b; b.bar = bar; b.x = xb_xcc_id(); b.st = st;
    if (threadIdx.x == 0) (void)xb_add(&bar[XB_XCNT(b.x)], 1u);
    return b;
}
__device__ __forceinline__ void xcd_barrier_complete(unsigned* bar, unsigned x, unsigned& nloc, unsigned& nx) {
    const unsigned G = gridDim.x * gridDim.y * gridDim.z;
    unsigned sum, cnt, mine, sp = 0u;
    for (;;) {
        sum = 0u; cnt = 0u; mine = 0u;
#pragma unroll
        for (unsigned j = 0; j < 16; ++j) { const unsigned c = xb_ld(&bar[XB_XCNT(j)]); sum += c; cnt += (c > 0u) ? 1u : 0u; mine = (j == x) ? c : mine; }
        if (sum == G) break;
        __builtin_amdgcn_s_sleep(1);
        if ((++sp & 255u) == 0u) { if (xb_ld(&bar[XB_TMO])) break; if (sp > XB_SPIN_CAP) { atomicAdd(&bar[XB_TMO], 1u); break; } }
    }
    nloc = mine > 0u ? mine : 1u; nx = cnt > 0u ? cnt : 1u;
}
__device__ __forceinline__ void xcd_barrier(const XcdBarrier& b) {
    asm volatile("s_waitcnt vmcnt(0)" ::: "memory");
    __syncthreads();
    if (threadIdx.x == 0) {
        unsigned* bar = b.bar;
        __builtin_amdgcn_s_waitcnt(0);
        unsigned nloc = b.st[0], nx = b.st[1];
        if (nloc == 0u) { xcd_barrier_complete(bar, b.x, nloc, nx); b.st[0] = nloc; b.st[1] = nx; }
        const unsigned old = xb_add(&bar[XB_XSUB(b.x)], 1u);
        const unsigned gen = old / nloc;
        if (old + 1u == (gen + 1u) * nloc) {
            __builtin_amdgcn_fence(__ATOMIC_RELEASE, "agent");
            asm volatile("s_waitcnt vmcnt(0)" ::: "memory");
            const unsigned og = xb_add(&bar[XB_TOP], 1u);
            const unsigned tg = og / nx;
            if (og + 1u == (tg + 1u) * nx) xb_add(&bar[XB_TOPGEN], 1u);
            else XB_SPIN(xb_ld(&bar[XB_TOPGEN]) == tg, bar);
            __builtin_amdgcn_fence(__ATOMIC_ACQUIRE, "agent");
            xb_add(&bar[XB_XGEN(b.x)], 1u);
            asm volatile("s_waitcnt vmcnt(0)" ::: "memory");
        } else {
            XB_SPIN(xb_ld(&bar[XB_XGEN(b.x)]) == gen, bar);
            __builtin_amdgcn_fence(__ATOMIC_ACQUIRE, "agent");
            asm volatile("s_waitcnt vmcnt(0)" ::: "memory");
        }
    }
    __syncthreads();
}

template <int PH>
__global__ void __launch_bounds__(NTHREADS, 2) phase_kernel(Params p) {
    extern __shared__ __attribute__((aligned(16))) char smem[];
    const int bid = blockIdx.x, nb = gridDim.x;
    if (PH == 0) phase_prep(p, bid, nb);
    if (PH == 1) phase_inproj(p, bid, nb, smem);
    if (PH == 2) phase_p2(p, bid, nb, smem);
    if (PH == 3) phase_cmp2(p, bid, nb);
    if (PH == 4) phase_attn(p, smem);
    if (PH == 5) phase_outproj(p, bid, nb, smem);
    if (PH == 6) phase_peerq(p, bid, nb, smem);
    if (PH == 7) phase_route(p, bid, nb, smem);
}

__global__ void __launch_bounds__(NTHREADS, 2) mega_kernel(Params p) {
    extern __shared__ __attribute__((aligned(16))) char smem[];
    const int bid = blockIdx.x, nb = gridDim.x;
    {
        volatile unsigned* xbst = (volatile unsigned*)(smem + 66064);
        if (threadIdx.x == 0) { xbst[0] = 0u; xbst[1] = 0u; }
        __syncthreads();
        (void)xcd_barrier_post((unsigned*)(p.ws + OFF_BAR), xbst);
    }
#define GRID_SYNC() { XcdBarrier gb_; gb_.bar = (unsigned*)(p.ws + OFF_BAR); gb_.x = xb_xcc_id(); gb_.st = (volatile unsigned*)(smem + 66064); xcd_barrier(gb_); }
    phase_prep(p, bid, nb); GRID_SYNC();
    if (PROBE_PHASE == 0) { phase_prep(p, bid, nb); GRID_SYNC(); }
    phase_inproj(p, bid, nb, smem); GRID_SYNC();
    if (PROBE_PHASE == 1) { phase_inproj(p, bid, nb, smem); GRID_SYNC(); }
    phase_p2(p, bid, nb, smem); GRID_SYNC();
    if (PROBE_PHASE == 2) { phase_p2(p, bid, nb, smem); GRID_SYNC(); }
    phase_cmp2(p, bid, nb); GRID_SYNC();
    phase_attn(p, smem, 64, 0); GRID_SYNC();
    if (PROBE_PHASE == 3) { phase_attn(p, smem, 80, 0); GRID_SYNC(); }
    if (PROBE_PHASE == 9) { phase_attn(p, smem, 80, 1); GRID_SYNC(); }
    if (PROBE_PHASE == 13) { phase_attn(p, smem, 80, 2); GRID_SYNC(); }
    phase_outproj(p, bid, nb, smem); GRID_SYNC();
    if (PROBE_PHASE == 4) { phase_outproj(p, bid, nb, smem); GRID_SYNC(); }
    phase_peerq(p, bid, nb, smem); GRID_SYNC();
    if (PROBE_PHASE == 5) { phase_peerq(p, bid, nb, smem); GRID_SYNC(); }
    phase_route(p, bid, nb, smem); GRID_SYNC();
    if (PROBE_PHASE == 6) { phase_route(p, bid, nb, smem); GRID_SYNC(); }
    if (PROBE_PHASE == 8) { GRID_SYNC(); GRID_SYNC(); GRID_SYNC(); GRID_SYNC(); GRID_SYNC(); GRID_SYNC(); GRID_SYNC(); GRID_SYNC(); }
    phase_peer_udot<0>(p, smem); GRID_SYNC();
    if (PROBE_PHASE == 10) { phase_peer_udot<0>(p, smem, 48); GRID_SYNC(); }
    if (PROBE_PHASE == 12) { phase_peer_udot<1>(p, smem, 48); GRID_SYNC(); }
    phase_peer_coef(p, bid, nb); GRID_SYNC();
    if (PROBE_PHASE == 11) { phase_peer_coef(p, bid, nb); GRID_SYNC(); }
    phase_peer_vacc(p, smem); GRID_SYNC();
    phase_final_norm(p, bid, nb);
}

extern "C" void kernel_launch(void* const* d_in, const int* in_sizes, int n_in, void* d_out, int out_size, void* d_ws, size_t ws_size, hipStream_t stream) {
    (void)in_sizes; (void)n_in; (void)out_size;
    if (ws_size < WS_NEED) { fprintf(stderr, "kernel_launch: workspace too small (%zu < %zu)\n", ws_size, (size_t)WS_NEED); return; }
    Params p{};
    p.x = (const float*)d_in[0]; p.pos = (const int*)d_in[1]; p.norm1_g = (const float*)d_in[2]; p.w_in = (const float*)d_in[3];
    p.cmp_pos = (const float*)d_in[4]; p.cmp_k_w1 = (const float*)d_in[5]; p.cmp_k_w2 = (const float*)d_in[6];
    p.cmp_v_w1 = (const float*)d_in[7]; p.cmp_v_w2 = (const float*)d_in[8]; p.t5_bias = (const float*)d_in[9];
    p.q_norm_g = (const float*)d_in[10]; p.w_q_up = (const float*)d_in[11]; p.kv_norm_g = (const float*)d_in[12]; p.w_kv_up = (const float*)d_in[13];
    p.grp_norm_nsa = (const float*)d_in[14]; p.grp_norm_mla = (const float*)d_in[15]; p.w_out = (const float*)d_in[16]; p.norm2_g = (const float*)d_in[17];
    p.peer_wq = (const float*)d_in[18]; p.peer_keys1 = (const float*)d_in[19]; p.peer_keys2 = (const float*)d_in[20];
    p.peer_u = (const float*)d_in[21]; p.peer_v = (const float*)d_in[22]; p.final_g = (const float*)d_in[23];
    p.out = (float*)d_out; p.ws = (char*)d_ws;
#if MULTI_LAUNCH
    const int G = 512;
    phase_kernel<0><<<G, NTHREADS, 0, stream>>>(p);
    phase_kernel<1><<<G, NTHREADS, 0, stream>>>(p);
    phase_kernel<2><<<G, NTHREADS, 0, stream>>>(p);
    phase_kernel<3><<<G, NTHREADS, 0, stream>>>(p);
    phase_kernel<4><<<G, NTHREADS, 0, stream>>>(p);
    phase_kernel<5><<<G, NTHREADS, 0, stream>>>(p);
    phase_kernel<6><<<G, NTHREADS, 0, stream>>>(p);
    phase_kernel<7><<<G, NTHREADS, 0, stream>>>(p);
    phase_kernel<8><<<G, NTHREADS, 0, stream>>>(p);
#else
    static int grid_blocks = 0;
    if (!grid_blocks) {
        int dev = 0, cus = 0, per_cu = 0;
        (void)hipGetDevice(&dev);
        (void)hipDeviceGetAttribute(&cus, hipDeviceAttributeMultiprocessorCount, dev);
        (void)hipFuncSetAttribute((const void*)mega_kernel, hipFuncAttributeMaxDynamicSharedMemorySize, SMEM_BYTES);
        (void)hipOccupancyMaxActiveBlocksPerMultiprocessor(&per_cu, mega_kernel, NTHREADS, SMEM_BYTES);
        if (per_cu > 2) per_cu = 2;
        grid_blocks = cus * per_cu;
    }
    (void)hipMemsetAsync((char*)d_ws + OFF_BAR, 0, 16384, stream);
    void* args[] = {&p};
    hipError_t e = hipLaunchCooperativeKernel((void*)mega_kernel, dim3(grid_blocks), dim3(NTHREADS), args, SMEM_BYTES, stream);
    if (e != hipSuccess) fprintf(stderr, "cooperative launch failed: %s (grid %d)\n", hipGetErrorString(e), grid_blocks);
#endif
}
```

```cpp
#include <hip/hip_runtime.h>
#include <hip/hip_cooperative_groups.h>
#include <cstdio>
#include <cstdint>
namespace cg = cooperative_groups;

#ifndef MULTI_LAUNCH
#define MULTI_LAUNCH 0
#endif

#ifndef PROBE_PHASE
#define PROBE_PHASE -1
#endif

typedef _Float16 half_t;
typedef _Float16 h2v __attribute__((ext_vector_type(2)));
typedef _Float16 h4v __attribute__((ext_vector_type(4)));
typedef _Float16 h8v __attribute__((ext_vector_type(8)));
typedef float f4v __attribute__((ext_vector_type(4)));
typedef unsigned u4v __attribute__((ext_vector_type(4)));
typedef unsigned u2v __attribute__((ext_vector_type(2)));
typedef float f16v __attribute__((ext_vector_type(16)));

constexpr int BATCH = 2, SEQ = 16384, DM = 1024, NTOK = BATCH * SEQ;
constexpr int NIN = 1720, NINP = 1792;
constexpr int NCMP = 1023, NCMPP = 1024;
constexpr float EPS = 1e-6f;
constexpr float LOG2E = 1.4426950408889634f;
constexpr float QS_NSA = 0.125f * LOG2E;
constexpr float QS_MLA = 0.10206207261596575f * LOG2E;
constexpr float NEGF = -1e30f;
constexpr int LUTN = 1536;
constexpr float USCALE = 128.0f, VSCALE = 16.0f;

constexpr size_t al256(size_t x) { return (x + 255) & ~(size_t)255; }
constexpr size_t OFF_CTRL = 0;
constexpr size_t OFF_LUT = 4096;
constexpr size_t OFF_CB = OFF_LUT + 2 * LUTN * 4 * 4;
constexpr size_t OFF_WIN = 65536;
constexpr size_t OFF_WQUP = OFF_WIN + (size_t)NINP * 1024 * 2;
constexpr size_t OFF_WKVUP = OFF_WQUP + 768 * 256 * 2;
constexpr size_t OFF_WC1 = OFF_WKVUP + 1024 * 128 * 2;
constexpr size_t OFF_WOUT = OFF_WC1 + 2 * 256 * 2048 * 2;
constexpr size_t OFF_WPQ = OFF_WOUT + 1024 * 1024 * 2;
constexpr size_t OFF_KEYS = OFF_WPQ + 2048 * 1024 * 2;
constexpr size_t OFF_U16 = al256(OFF_KEYS + 2 * 128 * 128 * 2);
constexpr size_t OFF_V16 = OFF_U16 + (size_t)16384 * 1024 * 2;
constexpr size_t OFF_H1 = OFF_V16 + (size_t)16384 * 1024 * 2;
constexpr size_t OFF_MIXED = OFF_H1;
constexpr size_t OFF_QH = OFF_H1 + (size_t)NTOK * 1024 * 2;
constexpr size_t SZ_KV = (size_t)2 * 2 * SEQ * 64 * 2;
constexpr size_t OFF_KC = OFF_QH + (size_t)NTOK * 512 * 2;
constexpr size_t OFF_VC = OFF_KC + SZ_KV;
constexpr size_t OFF_KS = OFF_VC + SZ_KV;
constexpr size_t OFF_VST = OFF_KS + SZ_KV;
constexpr size_t OFF_KW = OFF_VST + SZ_KV;
constexpr size_t OFF_VWT = OFF_KW + SZ_KV;
constexpr size_t OFF_GATES = OFF_VWT + SZ_KV;
constexpr size_t OFF_CQ = OFF_GATES + (size_t)NTOK * 24 * 4;
constexpr size_t OFF_CKV = OFF_CQ + (size_t)NTOK * 256 * 2;
constexpr size_t OFF_X2H = OFF_QH;
constexpr size_t OFF_QM = OFF_CKV + (size_t)NTOK * 128 * 2;
constexpr size_t OFF_KM = OFF_QM + (size_t)NTOK * 8 * 96 * 2;
constexpr size_t OFF_VT = OFF_KM + (size_t)NTOK * 8 * 96 * 2;
constexpr size_t OFF_QP = OFF_QM;
constexpr size_t OFF_PD = OFF_QM;
constexpr size_t OFF_COEF = OFF_H1;
constexpr size_t OFF_SSQ = OFF_H1 + (size_t)NTOK * 128 * 4;
constexpr size_t OFF_HC1 = OFF_VT + (size_t)NTOK * 8 * 64 * 2;
constexpr size_t OFF_KCMP = OFF_HC1 + (size_t)8 * 1024 * 256 * 2;
constexpr size_t OFF_VCMPT = OFF_KCMP + (size_t)4 * 1024 * 64 * 2;
constexpr size_t OFF_EID = OFF_VCMPT + (size_t)4 * 1024 * 64 * 2;
constexpr size_t OFF_GW = OFF_EID + (size_t)NTOK * 128 * 4;
constexpr size_t OFF_BAR = OFF_GW + (size_t)NTOK * 128 * 4;
constexpr size_t OFF_ESC = OFF_BAR + 16384;
constexpr size_t WS_NEED = OFF_ESC + 2 * 16384 * 4;

struct Params {
    const float* x; const int* pos; const float* norm1_g; const float* w_in; const float* cmp_pos;
    const float* cmp_k_w1; const float* cmp_k_w2; const float* cmp_v_w1; const float* cmp_v_w2; const float* t5_bias;
    const float* q_norm_g; const float* w_q_up; const float* kv_norm_g; const float* w_kv_up;
    const float* grp_norm_nsa; const float* grp_norm_mla; const float* w_out; const float* norm2_g;
    const float* peer_wq; const float* peer_keys1; const float* peer_keys2; const float* peer_u; const float* peer_v; const float* final_g;
    float* out; char* ws;
};

constexpr int SMEM_BYTES = 67584;
constexpr int NTHREADS = 256;

__device__ __forceinline__ f4v mfma16(h8v a, h8v b, f4v c) { return __builtin_amdgcn_mfma_f32_16x16x32_f16(a, b, c, 0, 0, 0); }
__device__ __forceinline__ f16v mfma32(h8v a, h8v b, f16v c) { return __builtin_amdgcn_mfma_f32_32x32x16_f16(a, b, c, 0, 0, 0); }
__device__ __forceinline__ float wave_sum(float v) {
#pragma unroll
    for (int o = 32; o >= 1; o >>= 1) v += __shfl_xor(v, o);
    return v;
}
__device__ __forceinline__ float gelu_exact(float v) { return 0.5f * v * (1.0f + erff(v * 0.70710678118654752f)); }
__device__ __forceinline__ float fast_exp2(float v) { return __builtin_amdgcn_exp2f(v); }
__device__ __forceinline__ int t5_bucket(int d) {
    if (d < 16) return d < 0 ? 0 : d;
    int b = 16;
    b += (d >= 22); b += (d >= 30); b += (d >= 40); b += (d >= 54); b += (d >= 73); b += (d >= 99); b += (d >= 134); b += (d >= 182);
    b += (d >= 246); b += (d >= 332); b += (d >= 450); b += (d >= 609); b += (d >= 825); b += (d >= 1117); b += (d >= 1513);
    return b;
}

__device__ __forceinline__ unsigned xb_xcc_id();
__device__ __forceinline__ float red8(float v) {
    v += __builtin_bit_cast(float, __builtin_amdgcn_update_dpp(0, __builtin_bit_cast(int, v), 0xB1, 0xF, 0xF, true));
    v += __builtin_bit_cast(float, __builtin_amdgcn_update_dpp(0, __builtin_bit_cast(int, v), 0x4E, 0xF, 0xF, true));
    v += __builtin_bit_cast(float, __builtin_amdgcn_update_dpp(0, __builtin_bit_cast(int, v), 0x141, 0xF, 0xF, true));
    return v;
}

__device__ __forceinline__ void phase_prep(const Params& p, int bid, int nb, char* smem) {
    int tx_ = threadIdx.x; asm volatile("" : "+v"(tx_));
    const long tid = (long)bid * NTHREADS + tx_;
    const long nth = (long)nb * NTHREADS;
    char* ws = p.ws;
    if (tid < 1024) ((unsigned*)(ws + OFF_CTRL))[tid] = 0u;
    {
        float* lut = (float*)(ws + OFF_LUT);
        for (long e = tid; e < 2 * LUTN * 4; e += nth) {
            int r = e & 3, d = (e >> 2) % LUTN, g = (int)(e / (4 * LUTN));
            lut[e] = p.t5_bias[t5_bucket(d) * 8 + g * 4 + r] * LOG2E;
        }
    }
    {
        float* cb = (float*)(ws + OFF_CB);
        for (long e = tid; e < 512; e += nth) {
            int kv = (int)(e >> 8), n = (int)(e & 255);
            const float* w1 = kv ? p.cmp_v_w1 : p.cmp_k_w1;
            float s = 0.f;
            for (int k = 0; k < 2048; ++k) s += p.cmp_pos[k] * w1[(long)k * 256 + n];
            cb[e] = s;
        }
    }
    {
        float (*tl)[65] = (float (*)[65])smem;
        const int tx = tx_;
        const int jt[8] = {0, 448, 496, 528, 656, 784, 1040, 1552};
        for (int tile = bid; tile < 1552; tile += nb) {
            int job = 0;
#pragma unroll
            for (int j = 1; j < 7; ++j) job += (tile >= jt[j]) ? 1 : 0;
            const int lt = tile - jt[job];
            int K, N, ldsrc; const float* src; const float* gain; half_t* dst;
            switch (job) {
                case 0: K = 1024; N = NINP; ldsrc = NIN; src = p.w_in; gain = nullptr; dst = (half_t*)(ws + OFF_WIN); break;
                case 1: K = 256; N = 768; ldsrc = 768; src = p.w_q_up; gain = p.q_norm_g; dst = (half_t*)(ws + OFF_WQUP); break;
                case 2: K = 128; N = 1024; ldsrc = 1024; src = p.w_kv_up; gain = p.kv_norm_g; dst = (half_t*)(ws + OFF_WKVUP); break;
                case 3: K = 2048; N = 256; ldsrc = 256; src = p.cmp_k_w1; gain = nullptr; dst = (half_t*)(ws + OFF_WC1); break;
                case 4: K = 2048; N = 256; ldsrc = 256; src = p.cmp_v_w1; gain = nullptr; dst = (half_t*)(ws + OFF_WC1) + 256L * 2048; break;
                case 5: K = 1024; N = 1024; ldsrc = 1024; src = p.w_out; gain = nullptr; dst = (half_t*)(ws + OFF_WOUT); break;
                default: K = 1024; N = 2048; ldsrc = 2048; src = p.peer_wq; gain = p.norm2_g; dst = (half_t*)(ws + OFF_WPQ); break;
            }
            const int ntn = N >> 6;
            const int k0 = (lt / ntn) * 64, n0 = (lt % ntn) * 64;
            {
                const int r = tx >> 4, c4 = (tx & 15) * 4;
                const int n = n0 + c4;
                int sc = n;
                if (job == 0) {
                    if (n < 1280) sc = n;
                    else if (n < 1536) sc = 1304 + (n - 1280);
                    else if (n < 1664) sc = 1560 + (n - 1536);
                    else if (n < 1696) sc = 1688 + (n - 1664);
                    else if (n < 1720) sc = 1280 + (n - 1696);
                    else sc = -1;
                }
#pragma unroll
                for (int i = 0; i < 4; ++i) {
                    const int k = k0 + r + 16 * i;
                    float4 v = make_float4(0.f, 0.f, 0.f, 0.f);
                    if (sc >= 0) v = *(const float4*)(src + (long)k * ldsrc + sc);
                    float gk = 1.0f;
                    if (gain) gk = gain[k];
                    if (job == 5) gk = (k < 512) ? p.grp_norm_nsa[k] : p.grp_norm_mla[k - 512];
                    tl[r + 16 * i][c4] = v.x * gk; tl[r + 16 * i][c4 + 1] = v.y * gk; tl[r + 16 * i][c4 + 2] = v.z * gk; tl[r + 16 * i][c4 + 3] = v.w * gk;
                }
            }
            __syncthreads();
            {
                const int nl = tx >> 2, kq = (tx & 3) * 16;
                h8v o0, o1;
#pragma unroll
                for (int j = 0; j < 8; ++j) { o0[j] = (half_t)tl[kq + j][nl]; o1[j] = (half_t)tl[kq + 8 + j][nl]; }
                half_t* d = dst + (long)(n0 + nl) * K + k0 + kq;
                *(h8v*)d = o0; *(h8v*)(d + 8) = o1;
            }
            __syncthreads();
        }
    }
    {
        half_t* W = (half_t*)(ws + OFF_KEYS);
        for (long e = tid; e < 2 * 16384; e += nth) {
            W[e] = (half_t)(e < 16384 ? p.peer_keys1[e] : p.peer_keys2[e - 16384]);
        }
    }
    {
        unsigned char* U4 = (unsigned char*)(ws + OFF_U16);
        unsigned char* V4 = (unsigned char*)(ws + OFF_V16);
        float* ESC = (float*)(ws + OFF_ESC);
        const int ln = tx_ & 63;
        const long wv = tid >> 6, nwv = nth >> 6;
        for (long job = wv; job < 2L * 16384; job += nwv) {
            const int tbl = (int)(job >> 14), e = (int)(job & 16383);
            const float4* src = (const float4*)((tbl ? p.peer_v : p.peer_u) + (long)e * 1024 + 16 * ln);
            float4 a[4]; float amax = 0.f;
#pragma unroll
            for (int i = 0; i < 4; ++i) { a[i] = src[i]; amax = fmaxf(amax, fmaxf(fmaxf(fabsf(a[i].x), fabsf(a[i].y)), fmaxf(fabsf(a[i].z), fabsf(a[i].w)))); }
#pragma unroll
            for (int o = 32; o >= 1; o >>= 1) amax = fmaxf(amax, __shfl_xor(amax, o));
            const float sc = (amax > 0.f) ? exp2f(ceilf(log2f(amax * (1.0f / 6.0f)))) : 1.0f;
            const float inv = 1.0f / sc;
            unsigned w0 = 0u, w1 = 0u;
            w0 = __builtin_amdgcn_cvt_scalef32_pk_fp4_f32(w0, a[0].x * inv, a[0].y * inv, 1.0f, 0);
            w0 = __builtin_amdgcn_cvt_scalef32_pk_fp4_f32(w0, a[0].z * inv, a[0].w * inv, 1.0f, 1);
            w0 = __builtin_amdgcn_cvt_scalef32_pk_fp4_f32(w0, a[1].x * inv, a[1].y * inv, 1.0f, 2);
            w0 = __builtin_amdgcn_cvt_scalef32_pk_fp4_f32(w0, a[1].z * inv, a[1].w * inv, 1.0f, 3);
            w1 = __builtin_amdgcn_cvt_scalef32_pk_fp4_f32(w1, a[2].x * inv, a[2].y * inv, 1.0f, 0);
            w1 = __builtin_amdgcn_cvt_scalef32_pk_fp4_f32(w1, a[2].z * inv, a[2].w * inv, 1.0f, 1);
            w1 = __builtin_amdgcn_cvt_scalef32_pk_fp4_f32(w1, a[3].x * inv, a[3].y * inv, 1.0f, 2);
            w1 = __builtin_amdgcn_cvt_scalef32_pk_fp4_f32(w1, a[3].z * inv, a[3].w * inv, 1.0f, 3);
            unsigned char* dst = (tbl ? V4 : U4) + (((long)(ln >> 4) * 16384 + e) * 128) + (ln & 15) * 8;
            *(u2v*)dst = (u2v){w0, w1};
            if (ln == 0) ESC[tbl * 16384 + e] = sc;
        }
    }
    {
        half_t* H1 = (half_t*)(ws + OFF_H1);
        const int lane = threadIdx.x & 63;
        const long wv = tid >> 6, nwv = nth >> 6;
        for (long row = wv; row < NTOK; row += nwv) {
            const float4* xr = (const float4*)(p.x + row * 1024);
            float4 v[4]; float ss = 0.f;
#pragma unroll
            for (int i = 0; i < 4; ++i) { v[i] = xr[lane + 64 * i]; ss += v[i].x * v[i].x + v[i].y * v[i].y + v[i].z * v[i].z + v[i].w * v[i].w; }
            ss = wave_sum(ss);
            const float rs = rsqrtf(ss * (1.0f / 1024.f) + EPS);
#pragma unroll
            for (int i = 0; i < 4; ++i) {
                float4 g = ((const float4*)p.norm1_g)[lane + 64 * i];
                h4v o = {(half_t)(v[i].x * rs * g.x), (half_t)(v[i].y * rs * g.y), (half_t)(v[i].z * rs * g.z), (half_t)(v[i].w * rs * g.w)};
                ((h4v*)(H1 + row * 1024))[lane + 64 * i] = o;
            }
        }
    }
}

constexpr int GEMM_RS_OFF = 66560;
template <bool SCALE, bool SWAP, class Epi>
__device__ __forceinline__ void gemm_tile(const half_t* __restrict__ A, long lda, const half_t* __restrict__ Bt, long ldb, int K, int ksplit, char* smem_raw, Epi epi) {
    half_t* sA = (half_t*)smem_raw;
    half_t* sB = (half_t*)(smem_raw + 32768);
    float* rs0 = (float*)(smem_raw + GEMM_RS_OFF);
    int tid_ = threadIdx.x; asm volatile("" : "+v"(tid_));
    const int tid = tid_, lane = tid & 63, w = tid >> 6, wm = w >> 1, wn = w & 1;
    const int i16 = lane & 15, g4 = lane >> 4;
    const int lr = tid >> 3, off = tid & 7;
    if (SCALE) {
        const int rg = lane >> 3, ch = lane & 7;
        const int ncg = K >> 6, cgs = ksplit >> 6;
#pragma unroll 1
        for (int rr = 0; rr < 4; ++rr) {
            const int row = w * 32 + rr * 8 + rg;
            const half_t* ap = A + (long)row * lda + ch * 8;
            float s0 = 0.f, s1 = 0.f;
#pragma unroll 8
            for (int cg = 0; cg < ncg; ++cg) {
                const h8v v = *(const h8v*)(ap + cg * 64);
                float d = 0.f;
#pragma unroll
                for (int j = 0; j < 4; ++j) d = __builtin_amdgcn_fdot2((h2v){v[2 * j], v[2 * j + 1]}, (h2v){v[2 * j], v[2 * j + 1]}, d, false);
                if (cg < cgs) s0 += d; else s1 += d;
            }
            s0 = red8(s0); s1 = red8(s1);
            if (ch == 0) {
                rs0[row] = rsqrtf(s0 / (float)ksplit + EPS);
                if (ksplit < K) rs0[128 + row] = rsqrtf(s1 / (float)(K - ksplit) + EPS);
            }
        }
    }
    f4v acc[4][4];
#pragma unroll
    for (int a = 0; a < 4; ++a)
#pragma unroll
        for (int b = 0; b < 4; ++b) acc[a][b] = (f4v){0.f, 0.f, 0.f, 0.f};
    const int nk = K >> 6;
    const int srow = w * 32 + (lane >> 3);
    const int schunk = ((lane & 7) ^ ((lane >> 3) & 7)) << 3;
    const half_t* gA = A + (long)srow * lda + schunk;
    const half_t* gB = Bt + (long)srow * ldb + schunk;
    auto issue = [&](int k0, int stage) __attribute__((always_inline)) {
#pragma unroll
        for (int g = 0; g < 4; ++g) {
            __builtin_amdgcn_global_load_lds((const __attribute__((address_space(1))) void*)(gA + (long)(g * 8) * lda + k0),
                                             (__attribute__((address_space(3))) void*)(sA + stage * 8192 + (w * 32 + g * 8) * 64), 16, 0, 0);
            __builtin_amdgcn_global_load_lds((const __attribute__((address_space(1))) void*)(gB + (long)(g * 8) * ldb + k0),
                                             (__attribute__((address_space(3))) void*)(sB + stage * 8192 + (w * 32 + g * 8) * 64), 16, 0, 0);
        }
    };
    issue(0, 0);
    __syncthreads();
#pragma unroll 1
    for (int kt = 0; kt < nk; ++kt) {
        const int cur = (kt & 1) * 8192;
        if (kt + 1 < nk) issue((kt + 1) * 64, (kt + 1) & 1);
        if (SCALE && kt * 64 == ksplit) {
#pragma unroll
            for (int mi = 0; mi < 4; ++mi) {
                if (SWAP) {
                    const int row = wm * 64 + mi * 16 + i16;
                    const float ratio = rs0[row] / rs0[128 + row];
#pragma unroll
                    for (int ni = 0; ni < 4; ++ni) acc[mi][ni] *= ratio;
                } else {
#pragma unroll
                    for (int r = 0; r < 4; ++r) {
                        const int row = wm * 64 + mi * 16 + g4 * 4 + r;
                        const float ratio = rs0[row] / rs0[128 + row];
#pragma unroll
                        for (int ni = 0; ni < 4; ++ni) acc[mi][ni][r] *= ratio;
                    }
                }
            }
        }
#pragma unroll
        for (int kk = 0; kk < 2; ++kk) {
            const int cofs = (((kk * 4 + g4) ^ (i16 & 7)) << 3);
            h8v af[4], bf[4];
#pragma unroll
            for (int mi = 0; mi < 4; ++mi) af[mi] = *(const h8v*)(sA + cur + (wm * 64 + mi * 16 + i16) * 64 + cofs);
#pragma unroll
            for (int ni = 0; ni < 4; ++ni) bf[ni] = *(const h8v*)(sB + cur + (wn * 64 + ni * 16 + i16) * 64 + cofs);
#pragma unroll
            for (int mi = 0; mi < 4; ++mi)
#pragma unroll
                for (int ni = 0; ni < 4; ++ni) acc[mi][ni] = SWAP ? mfma16(bf[ni], af[mi], acc[mi][ni]) : mfma16(af[mi], bf[ni], acc[mi][ni]);
        }
        __syncthreads();
    }
    if (SCALE) {
        const int fin = (ksplit < K) ? 128 : 0;
#pragma unroll
        for (int mi = 0; mi < 4; ++mi) {
            if (SWAP) {
                const float rsv = rs0[fin + wm * 64 + mi * 16 + i16];
#pragma unroll
                for (int ni = 0; ni < 4; ++ni) acc[mi][ni] *= rsv;
            } else {
#pragma unroll
                for (int r = 0; r < 4; ++r) {
                    const float rsv = rs0[fin + wm * 64 + mi * 16 + g4 * 4 + r];
#pragma unroll
                    for (int ni = 0; ni < 4; ++ni) acc[mi][ni][r] *= rsv;
                }
            }
        }
    }
    epi(acc, wm, wn, i16, g4);
    __syncthreads();
}

__device__ __forceinline__ void rope_pair(float x1, float x2, int pos, int i, float& o1, float& o2) {
    const float inv = __builtin_amdgcn_exp2f(-(float)i * (13.287712379549449f / 16.0f));
    double t = (double)pos * (double)inv * 0.15915494309189535;
    t -= __builtin_rint(t);
    const float fr = (float)t;
    const float sn = __builtin_amdgcn_sinf(fr), cs = __builtin_amdgcn_cosf(fr);
    o1 = x1 * cs - x2 * sn; o2 = x1 * sn + x2 * cs;
}

__device__ __forceinline__ void phase_inproj(const Params& p, int bid, int nb, char* smem) {
    char* ws = p.ws;
    const half_t* H1 = (const half_t*)(ws + OFF_H1);
    const half_t* W = (const half_t*)(ws + OFF_WIN);
    half_t* QH = (half_t*)(ws + OFF_QH);
    half_t* KM = (half_t*)(ws + OFF_KM);
    half_t* CQ = (half_t*)(ws + OFF_CQ);
    half_t* CKV = (half_t*)(ws + OFF_CKV);
    float* GATES = (float*)(ws + OFF_GATES);
    const int NT_N = NINP / 128, NT_M = NTOK / 128;
    for (int tile = bid; tile < NT_M * NT_N; tile += nb) {
        const int tm = tile / NT_N, tn = tile % NT_N;
        const int row0 = tm * 128, n0 = tn * 128;
        const half_t* Ap = H1 + (long)row0 * 1024;
        const half_t* Bp = W + (long)n0 * 1024;
        if (tn == 7 || tn == 9) {
            gemm_tile<false, false>(Ap, 1024, Bp, 1024, 1024, 1024, smem,
                [&](f4v (&acc)[4][4], int wm, int wn, int i16, int g4) __attribute__((always_inline)) {
                    half_t* base = (half_t*)(ws + (tn == 7 ? OFF_VST : OFF_VWT));
#pragma unroll
                    for (int ni = 0; ni < 4; ++ni) {
                        const int c = wn * 64 + ni * 16 + i16, gg = c >> 6, d = c & 63;
#pragma unroll
                        for (int mi = 0; mi < 4; ++mi) {
                            const int rbase = row0 + wm * 64 + mi * 16 + g4 * 4;
                            const int b = rbase >> 14, s0 = rbase & (SEQ - 1);
                            const h4v o = {(half_t)acc[mi][ni][0], (half_t)acc[mi][ni][1], (half_t)acc[mi][ni][2], (half_t)acc[mi][ni][3]};
                            *(h4v*)(base + ((long)((b * 2 + gg) * 64 + d)) * SEQ + s0) = o;
                        }
                    }
                });
        } else {
            gemm_tile<false, true>(Ap, 1024, Bp, 1024, 1024, 1024, smem,
                [&](f4v (&acc)[4][4], int wm, int wn, int i16, int g4) __attribute__((always_inline)) {
#pragma unroll
                    for (int mi = 0; mi < 4; ++mi) {
                        const int t = row0 + wm * 64 + mi * 16 + i16;
                        const int b = t >> 14, sq = t & (SEQ - 1);
#pragma unroll
                        for (int ni = 0; ni < 4; ++ni) {
                            const int cb = n0 + wn * 64 + ni * 16;
                            const int n = cb + 4 * g4;
                            const f4v a = acc[mi][ni];
                            if (cb < 512) {
                                const h4v o = {(half_t)(a[0] * QS_NSA), (half_t)(a[1] * QS_NSA), (half_t)(a[2] * QS_NSA), (half_t)(a[3] * QS_NSA)};
                                *(h4v*)(QH + (long)t * 512 + n) = o;
                            } else if (cb < 1280) {
                                const int which = (cb - 512) >> 7;
                                const int c = (n - 512) & 127, gg = c >> 6, d = c & 63;
                                half_t* base = (half_t*)(ws + OFF_KC + (size_t)which * SZ_KV);
                                const h4v o = {(half_t)a[0], (half_t)a[1], (half_t)a[2], (half_t)a[3]};
                                *(h4v*)(base + ((long)(b * 2 + gg) * SEQ + sq) * 64 + d) = o;
                            } else if (cb < 1536) {
                                const h4v o = {(half_t)a[0], (half_t)a[1], (half_t)a[2], (half_t)a[3]};
                                *(h4v*)(CQ + (long)t * 256 + (n - 1280)) = o;
                            } else if (cb < 1664) {
                                const h4v o = {(half_t)a[0], (half_t)a[1], (half_t)a[2], (half_t)a[3]};
                                *(h4v*)(CKV + (long)t * 128 + (n - 1536)) = o;
                            } else if (cb == 1664) {
                                const f4v a2 = acc[mi][(ni + 1) & 3];
                                h4v o1, o2;
                                const int pos = p.pos[t];
#pragma unroll
                                for (int r = 0; r < 4; ++r) {
                                    float x1, x2;
                                    rope_pair(a[r], a2[r], pos, 4 * g4 + r, x1, x2);
                                    o1[r] = (half_t)x1; o2[r] = (half_t)x2;
                                }
#pragma unroll
                                for (int h = 0; h < 8; ++h) {
                                    half_t* kr = KM + ((long)(b * 8 + h) * SEQ + sq) * 96 + 64 + 4 * g4;
                                    *(h4v*)kr = o1; *(h4v*)(kr + 16) = o2;
                                }
                            } else if (cb >= 1696) {
                                const int j = n - 1696;
                                if (j < 24) {
                                    float4 o;
                                    o.x = 1.0f / (1.0f + __expf(-a[0])); o.y = 1.0f / (1.0f + __expf(-a[1]));
                                    o.z = 1.0f / (1.0f + __expf(-a[2])); o.w = 1.0f / (1.0f + __expf(-a[3]));
                                    *(float4*)(GATES + (long)t * 24 + j) = o;
                                }
                            }
                        }
                    }
                });
        }
    }
}

__device__ __forceinline__ void phase_p2(const Params& p, int bid, int nb, char* smem) {
    char* ws = p.ws;
    const int NTA = 256 * 6, NTB = 256 * 8, NTC = 128;
    for (int tile = bid; tile < NTA + NTB + NTC; tile += nb) {
        if (tile < NTC) {
            const int nt = tile & 1, mt = (tile >> 1) & 7, bg = (tile >> 4) & 3, kv = tile >> 6;
            const half_t* A = (const half_t*)(ws + (kv ? OFF_VC : OFF_KC)) + (long)bg * SEQ * 64 + (long)mt * 128 * 1024;
            const half_t* Bt = (const half_t*)(ws + OFF_WC1) + ((long)kv * 256 + nt * 128) * 2048;
            const float* cbv = (const float*)(ws + OFF_CB) + kv * 256;
            half_t* HC = (half_t*)(ws + OFF_HC1) + ((long)(kv * 4 + bg) * 1024) * 256;
            gemm_tile<false, true>(A, 1024, Bt, 2048, 2048, 2048, smem,
                [&](f4v (&acc)[4][4], int wm, int wn, int i16, int g4) __attribute__((always_inline)) {
#pragma unroll
                    for (int mi = 0; mi < 4; ++mi) {
                        const int m = mt * 128 + wm * 64 + mi * 16 + i16;
#pragma unroll
                        for (int ni = 0; ni < 4; ++ni) {
                            const int n = nt * 128 + wn * 64 + ni * 16 + 4 * g4;
                            const float4 bias = *(const float4*)(cbv + n);
                            const h4v o = {(half_t)gelu_exact(acc[mi][ni][0] + bias.x), (half_t)gelu_exact(acc[mi][ni][1] + bias.y),
                                           (half_t)gelu_exact(acc[mi][ni][2] + bias.z), (half_t)gelu_exact(acc[mi][ni][3] + bias.w)};
                            if (m < NCMP) *(h4v*)(HC + (long)m * 256 + n) = o;
                        }
                    }
                });
        } else if (tile < NTC + NTA) {
            const int t2 = tile - NTC;
            const int tm = t2 / 6, tn = t2 % 6;
            const int row0 = tm * 128, n0 = tn * 128;
            half_t* QM = (half_t*)(ws + OFF_QM);
            gemm_tile<true, true>((const half_t*)(ws + OFF_CQ) + (long)row0 * 256, 256, (const half_t*)(ws + OFF_WQUP) + (long)n0 * 256, 256, 256, 256, smem,
                [&](f4v (&acc)[4][4], int wm, int wn, int i16, int g4) __attribute__((always_inline)) {
#pragma unroll
                    for (int mi = 0; mi < 4; ++mi) {
                        const int t = row0 + wm * 64 + mi * 16 + i16;
                        const int b = t >> 14, sq = t & (SEQ - 1);
#pragma unroll
                        for (int ni = 0; ni < 4; ++ni) {
                            const int cb = n0 + wn * 64 + ni * 16;
                            const int h = cb / 96, d0 = cb - h * 96;
                            half_t* qr = QM + ((long)(b * 8 + h) * SEQ + sq) * 96;
                            const f4v a = acc[mi][ni];
                            if (d0 < 64) {
                                const h4v o = {(half_t)(a[0] * QS_MLA), (half_t)(a[1] * QS_MLA), (half_t)(a[2] * QS_MLA), (half_t)(a[3] * QS_MLA)};
                                *(h4v*)(qr + d0 + 4 * g4) = o;
                            } else if (d0 == 64) {
                                const f4v a2 = acc[mi][(ni + 1) & 3];
                                const int pos = p.pos[t];
                                h4v o1, o2;
#pragma unroll
                                for (int r = 0; r < 4; ++r) {
                                    float x1, x2;
                                    rope_pair(a[r] * QS_MLA, a2[r] * QS_MLA, pos, 4 * g4 + r, x1, x2);
                                    o1[r] = (half_t)x1; o2[r] = (half_t)x2;
                                }
                                *(h4v*)(qr + 64 + 4 * g4) = o1; *(h4v*)(qr + 80 + 4 * g4) = o2;
                            }
                        }
                    }
                });
        } else {
            const int t2 = tile - NTC - NTA;
            const int tm = t2 >> 3, tn = t2 & 7;
            const int row0 = tm * 128, n0 = tn * 128;
            half_t* KM = (half_t*)(ws + OFF_KM);
            half_t* VT = (half_t*)(ws + OFF_VT);
            gemm_tile<true, false>((const half_t*)(ws + OFF_CKV) + (long)row0 * 128, 128, (const half_t*)(ws + OFF_WKVUP) + (long)n0 * 128, 128, 128, 128, smem,
                [&](f4v (&acc)[4][4], int wm, int wn, int i16, int g4) __attribute__((always_inline)) {
                    const int h = tn;
#pragma unroll
                    for (int ni = 0; ni < 4; ++ni) {
                        const int d0 = wn * 64 + ni * 16;
#pragma unroll
                        for (int mi = 0; mi < 4; ++mi) {
                            const int rbase = row0 + wm * 64 + mi * 16 + g4 * 4;
                            const int b = rbase >> 14, s0 = rbase & (SEQ - 1);
                            if (d0 < 64) {
#pragma unroll
                                for (int r = 0; r < 4; ++r) KM[((long)(b * 8 + h) * SEQ + s0 + r) * 96 + d0 + i16] = (half_t)acc[mi][ni][r];
                            } else {
                                const h4v o = {(half_t)acc[mi][ni][0], (half_t)acc[mi][ni][1], (half_t)acc[mi][ni][2], (half_t)acc[mi][ni][3]};
                                *(h4v*)(VT + ((long)(b * 8 + h) * 64 + (d0 - 64 + i16)) * SEQ + s0) = o;
                            }
                        }
                    }
                });
        }
    }
}

constexpr int KMAX_KS = 128, KMAX_KW = 132, KMAX_KC = 136, KMAX_KM = 140, KMAX_BIAS = 156;
__device__ __forceinline__ void phase_cmp2(const Params& p, int bid, int nb) {
    char* ws = p.ws;
    unsigned* ctr = (unsigned*)(ws + OFF_CTRL);
    int tx_ = threadIdx.x; asm volatile("" : "+v"(tx_));
    const long tid = (long)bid * NTHREADS + tx_, nth = (long)nb * NTHREADS;
    const int lane = tx_ & 63;
    const half_t* HC = (const half_t*)(ws + OFF_HC1);
    half_t* KC = (half_t*)(ws + OFF_KCMP);
    half_t* VCT = (half_t*)(ws + OFF_VCMPT);
    for (long e = tid; e < 2L * 4 * 1024 * 64; e += nth) {
        const int d = (int)(e & 63), n = (int)((e >> 6) & 1023), bg = (int)((e >> 16) & 3), kv = (int)(e >> 18);
        float s = 0.f;
        if (n < NCMP) {
            const half_t* hr = HC + ((long)(kv * 4 + bg) * 1024 + n) * 256;
            const float* w2 = kv ? p.cmp_v_w2 : p.cmp_k_w2;
            for (int j = 0; j < 256; ++j) s += (float)hr[j] * w2[j * 64 + d];
        }
        const half_t sh = (half_t)s;
        if (kv == 0) {
            KC[((long)bg * 1024 + n) * 64 + d] = sh;
            const float nn = wave_sum((float)sh * (float)sh);
            if (lane == 0) atomicMax(&ctr[KMAX_KC + bg], __float_as_uint(nn));
        } else VCT[((long)bg * 64 + d) * 1024 + n] = sh;
    }
    {
        const int sub = lane & 7;
        const long grp = tid >> 3, ngrp = nth >> 3;
        for (int which = 0; which < 2; ++which) {
            const half_t* Kb = (const half_t*)(ws + (which ? OFF_KW : OFF_KS));
            float mx[4] = {0.f, 0.f, 0.f, 0.f};
            for (long row = grp; row < 4L * SEQ; row += ngrp) {
                const h8v v = *(const h8v*)(Kb + row * 64 + sub * 8);
                float d = 0.f;
#pragma unroll
                for (int j = 0; j < 4; ++j) d = __builtin_amdgcn_fdot2((h2v){v[2 * j], v[2 * j + 1]}, (h2v){v[2 * j], v[2 * j + 1]}, d, false);
                d = red8(d);
                const int bg = (int)(row >> 14);
#pragma unroll
                for (int q = 0; q < 4; ++q) mx[q] = (bg == q) ? fmaxf(mx[q], d) : mx[q];
            }
#pragma unroll
            for (int q = 0; q < 4; ++q) {
                float m = mx[q];
#pragma unroll
                for (int o = 32; o >= 1; o >>= 1) m = fmaxf(m, __shfl_xor(m, o));
                if (lane == 0 && m > 0.f) atomicMax(&ctr[(which ? KMAX_KW : KMAX_KS) + q], __float_as_uint(m));
            }
        }
        const half_t* Km = (const half_t*)(ws + OFF_KM);
        const long wv = tid >> 6, nwv = nth >> 6;
        for (long blk = wv; blk < 16L * SEQ / 64; blk += nwv) {
            const int bh = (int)(blk / (SEQ / 64));
            float mloc = 0.f;
#pragma unroll 1
            for (int rr = 0; rr < 8; ++rr) {
                const long row = blk * 64 + rr * 8 + (lane >> 3);
                const half_t* kr = Km + row * 96 + sub * 8;
                float d = 0.f;
                {
                    const h8v v = *(const h8v*)kr;
#pragma unroll
                    for (int j = 0; j < 4; ++j) d = __builtin_amdgcn_fdot2((h2v){v[2 * j], v[2 * j + 1]}, (h2v){v[2 * j], v[2 * j + 1]}, d, false);
                }
                if (sub < 4) {
                    const h8v v = *(const h8v*)(kr + 64);
#pragma unroll
                    for (int j = 0; j < 4; ++j) d = __builtin_amdgcn_fdot2((h2v){v[2 * j], v[2 * j + 1]}, (h2v){v[2 * j], v[2 * j + 1]}, d, false);
                }
                d = red8(d);
                mloc = fmaxf(mloc, d);
            }
#pragma unroll
            for (int o = 32; o >= 1; o >>= 1) mloc = fmaxf(mloc, __shfl_xor(mloc, o));
            if (lane == 0) atomicMax(&ctr[KMAX_KM + bh], __float_as_uint(mloc));
        }
    }
    if (tid == 0) {
        float mb = 0.f;
        for (int i = 0; i < 256; ++i) mb = fmaxf(mb, p.t5_bias[i] * LOG2E);
        ctr[KMAX_BIAS] = __float_as_uint(mb);
    }
}

struct MlaSmem { half_t K[2][64][104]; half_t V[2][64][68]; };

__device__ __forceinline__ void mla_item(const Params& p, int bh, int qb, char* smem) {
    MlaSmem& sm = *(MlaSmem*)smem;
    char* ws = p.ws;
    const int b = bh >> 3, h = bh & 7;
    const half_t* Qp = (const half_t*)(ws + OFF_QM) + ((long)bh * SEQ + qb * 128) * 96;
    const half_t* Kp = (const half_t*)(ws + OFF_KM) + (long)bh * SEQ * 96;
    const half_t* Vp = (const half_t*)(ws + OFF_VT) + (long)bh * 64 * SEQ;
    half_t* MIX = (half_t*)(ws + OFF_MIXED);
    int tid_ = threadIdx.x; asm volatile("" : "+v"(tid_));
    const int tid = tid_, lane = tid & 63, w = tid >> 6;
    const int c = lane & 31, hh = lane >> 5;
    const int tq = qb * 128 + w * 32 + c;
    h8v qf[6];
#pragma unroll
    for (int s6 = 0; s6 < 6; ++s6) qf[s6] = *(const h8v*)(Qp + (long)(w * 32 + c) * 96 + s6 * 16 + hh * 8);
    f16v o0, o1;
#pragma unroll
    for (int i = 0; i < 16; ++i) { o0[i] = 0.f; o1[i] = 0.f; }
    float qn2 = 0.f;
#pragma unroll
    for (int s6 = 0; s6 < 6; ++s6)
#pragma unroll
        for (int j = 0; j < 8; ++j) { const float f = (float)qf[s6][j]; qn2 += f * f; }
    qn2 += __shfl_xor(qn2, 32);
    const float kmax2 = __uint_as_float(((const unsigned*)(ws + OFF_CTRL))[KMAX_KM + bh]);
    const float nmref = 10.0f - sqrtf(qn2 * kmax2) * 1.0005f;
    float l = 0.f;
    const int ntiles = 2 * qb + 2;
    auto gload = [&](int j, u4v (&rk)[3], u4v (&rv)[2]) __attribute__((always_inline)) {
#pragma unroll
        for (int i = 0; i < 3; ++i) {
            const int ci = tid + 256 * i, key = ci / 12, of = ci % 12;
            rk[i] = *(const u4v*)(Kp + (long)(j * 64 + key) * 96 + of * 8);
        }
#pragma unroll
        for (int i = 0; i < 2; ++i) {
            const int ci = tid + 256 * i, dim = ci >> 3, of = ci & 7;
            rv[i] = *(const u4v*)(Vp + (long)dim * SEQ + j * 64 + of * 8);
        }
    };
    auto lstore = [&](int buf, const u4v (&rk)[3], const u4v (&rv)[2]) __attribute__((always_inline)) {
#pragma unroll
        for (int i = 0; i < 3; ++i) {
            const int ci = tid + 256 * i, key = ci / 12, of = ci % 12;
            *(u4v*)&sm.K[buf][key][of * 8] = rk[i];
        }
#pragma unroll
        for (int i = 0; i < 2; ++i) {
            const int ci = tid + 256 * i, dim = ci >> 3, of = ci & 7;
            *(u2v*)&sm.V[buf][dim][of * 8] = (u2v){rv[i][0], rv[i][1]};
            *(u2v*)&sm.V[buf][dim][of * 8 + 4] = (u2v){rv[i][2], rv[i][3]};
        }
    };
    const int qmin = qb * 128 + w * 32;
    auto compute = [&](int j, int buf) __attribute__((always_inline)) {
        if (64 * j <= qmin + 31) {
            f16v s0, s1;
#pragma unroll
            for (int i = 0; i < 16; ++i) { s0[i] = nmref; s1[i] = nmref; }
#pragma unroll
            for (int s6 = 0; s6 < 6; ++s6) {
                const h8v a0 = *(const h8v*)&sm.K[buf][c][s6 * 16 + hh * 8];
                const h8v a1 = *(const h8v*)&sm.K[buf][32 + c][s6 * 16 + hh * 8];
                s0 = mfma32(a0, qf[s6], s0);
                s1 = mfma32(a1, qf[s6], s1);
            }
            if (64 * j + 63 > qmin) {
#pragma unroll
                for (int r = 0; r < 16; ++r) {
                    const int key = 64 * j + (r & 3) + 8 * (r >> 2) + 4 * hh;
                    if (key > tq) s0[r] = NEGF;
                    if (key + 32 > tq) s1[r] = NEGF;
                }
            }
#pragma unroll
            for (int r = 0; r < 16; ++r) { s0[r] = fast_exp2(s0[r]); l += s0[r]; }
#pragma unroll
            for (int r = 0; r < 16; ++r) { s1[r] = fast_exp2(s1[r]); l += s1[r]; }
#pragma unroll
            for (int ks = 0; ks < 4; ++ks) {
                h8v pb;
#pragma unroll
                for (int jj = 0; jj < 8; ++jj) pb[jj] = (half_t)((ks < 2) ? s0[8 * (ks & 1) + jj] : s1[8 * (ks & 1) + jj]);
#pragma unroll
                for (int md = 0; md < 2; ++md) {
                    const h4v lo = *(const h4v*)&sm.V[buf][32 * md + c][16 * ks + 4 * hh];
                    const h4v hi = *(const h4v*)&sm.V[buf][32 * md + c][16 * ks + 8 + 4 * hh];
                    const h8v a = {lo[0], lo[1], lo[2], lo[3], hi[0], hi[1], hi[2], hi[3]};
                    if (md == 0) o0 = mfma32(a, pb, o0); else o1 = mfma32(a, pb, o1);
                }
            }
        }
    };
    u4v rkA[3], rvA[2], rkB[3], rvB[2];
    gload(0, rkA, rvA);
    gload(1, rkB, rvB);
    lstore(0, rkA, rvA);
    __syncthreads();
#pragma unroll 1
    for (int j = 0; j < ntiles; j += 2) {
        if (j + 2 < ntiles) gload(j + 2, rkA, rvA);
        compute(j, 0);
        lstore(1, rkB, rvB);
        __syncthreads();
        if (j + 3 < ntiles) gload(j + 3, rkB, rvB);
        compute(j + 1, 1);
        if (j + 2 < ntiles) lstore(0, rkA, rvA);
        __syncthreads();
    }
    const float lt = l + __shfl_xor(l, 32);
    const float inv = 1.0f / lt;
    half_t* orow = MIX + (long)(b * SEQ + tq) * 1024 + 512 + h * 64;
#pragma unroll
    for (int md = 0; md < 2; ++md)
#pragma unroll
        for (int rg = 0; rg < 4; ++rg) {
            h4v o;
#pragma unroll
            for (int e = 0; e < 4; ++e) o[e] = (half_t)(((md == 0) ? o0[4 * rg + e] : o1[4 * rg + e]) * inv);
            *(h4v*)(orow + 32 * md + 8 * rg + 4 * hh) = o;
        }
}

struct NsaStage { half_t K[64][72]; half_t V[64][68]; };
constexpr int NSA_LUT = 0;
constexpr int NSA_ST0 = 12288;
constexpr int NSA_RB = NSA_ST0 + 17920;
constexpr int NSA_SEL = NSA_RB + 32768;
constexpr int NSA_MASK = NSA_SEL + 2048;
constexpr int NSA_END = NSA_MASK + 1024;
constexpr float MINIT = -30000.0f;

__device__ __forceinline__ void nsa_item(const Params& p, int bg, int qt, char* smem) {
    char* ws = p.ws;
    half_t* lut = (half_t*)(smem + NSA_LUT);
    float (*imp)[8][256] = (float (*)[8][256])(smem + NSA_RB);
    int (*sel)[8][16] = (int (*)[8][16])(smem + NSA_SEL);
    unsigned* masks = (unsigned*)(smem + NSA_MASK);
    const int b = bg >> 1, g = bg & 1;
    int tid_ = threadIdx.x; asm volatile("" : "+v"(tid_));
    const int tid = tid_, lane = tid & 63, w = tid >> 6;
    const int c = lane & 31, hh = lane >> 5;
    const int qi = c >> 2, r = c & 3;
    const int t0 = qt * 32;
    const int t0w = t0 + w * 8;
    const int tq = t0w + qi;
    const int tlast = t0w + 7;
    {
        const float* lg = (const float*)(ws + OFF_LUT) + (long)g * LUTN * 4;
        for (int i = tid; i < LUTN * 4; i += NTHREADS) lut[i] = (half_t)lg[i];
        float* im = &imp[0][0][0];
        for (int i = tid; i < 4 * 8 * 256; i += NTHREADS) im[i] = 0.f;
    }
    __syncthreads();
    const float cfar = (float)lut[(LUTN - 1) * 4 + r];
    const half_t* QH = (const half_t*)(ws + OFF_QH);
    h8v qf[4];
#pragma unroll
    for (int s4 = 0; s4 < 4; ++s4) qf[s4] = *(const h8v*)(QH + (long)(b * SEQ + tq) * 512 + (g * 4 + r) * 64 + s4 * 16 + hh * 8);
    float nrefC, nrefS, nrefW;
    {
        float qn2 = 0.f;
#pragma unroll
        for (int s4 = 0; s4 < 4; ++s4)
#pragma unroll
            for (int j = 0; j < 8; ++j) { const float f = (float)qf[s4][j]; qn2 += f * f; }
        qn2 += __shfl_xor(qn2, 32);
        const unsigned* cw = (const unsigned*)(ws + OFF_CTRL);
        const float mb = __uint_as_float(cw[KMAX_BIAS]);
        nrefC = 10.0f - mb - sqrtf(qn2 * __uint_as_float(cw[KMAX_KC + bg])) * 1.0005f;
        nrefS = 10.0f - mb - sqrtf(qn2 * __uint_as_float(cw[KMAX_KS + bg])) * 1.0005f;
        nrefW = 10.0f - mb - sqrtf(qn2 * __uint_as_float(cw[KMAX_KW + bg])) * 1.0005f;
    }
    const float* gp = (const float*)(ws + OFF_GATES) + (long)(b * SEQ + tq) * 24 + (g * 4 + r) * 3;
    const float g0 = gp[0], g1 = gp[1], g2 = gp[2];
    f16v of0, of1;
#pragma unroll
    for (int i = 0; i < 16; ++i) { of0[i] = 0.f; of1[i] = 0.f; }

    u4v rk[2], rvv[2];
    auto stage_gload_r = [&](u4v (&rk_)[2], u4v (&rv_)[2], const half_t* Kg, const half_t* Vg, long ldv, int key0, bool withv) __attribute__((always_inline)) {
#pragma unroll
        for (int i = 0; i < 2; ++i) {
            const int ci = tid + 256 * i, row = ci >> 3, of = ci & 7;
            rk_[i] = *(const u4v*)(Kg + (long)(key0 + row) * 64 + of * 8);
            if (withv) rv_[i] = *(const u4v*)(Vg + (long)row * ldv + key0 + of * 8);
        }
    };
    auto stage_lstore_r = [&](NsaStage& st, const u4v (&rk_)[2], const u4v (&rv_)[2], bool withv) __attribute__((always_inline)) {
#pragma unroll
        for (int i = 0; i < 2; ++i) {
            const int ci = tid + 256 * i, row = ci >> 3, of = ci & 7;
            *(u4v*)&st.K[row][of * 8] = rk_[i];
            if (withv) {
                *(u2v*)&st.V[row][of * 8] = (u2v){rv_[i][0], rv_[i][1]};
                *(u2v*)&st.V[row][of * 8 + 4] = (u2v){rv_[i][2], rv_[i][3]};
            }
        }
    };
    auto stage_gload = [&](const half_t* Kg, const half_t* Vg, long ldv, int key0, bool withv) __attribute__((always_inline)) { stage_gload_r(rk, rvv, Kg, Vg, ldv, key0, withv); };
    auto stage_lstore = [&](NsaStage& st, bool withv) __attribute__((always_inline)) { stage_lstore_r(st, rk, rvv, withv); };
    auto qk32 = [&](const NsaStage& st, int mt, float init) __attribute__((always_inline)) -> f16v {
        f16v s;
#pragma unroll
        for (int i = 0; i < 16; ++i) s[i] = init;
#pragma unroll
        for (int s4 = 0; s4 < 4; ++s4) {
            const h8v a = *(const h8v*)&st.K[32 * mt + c][s4 * 16 + hh * 8];
            s = mfma32(a, qf[s4], s);
        }
        return s;
    };
    auto pv32 = [&](const NsaStage& st, int mt, const f16v& pr, f16v& oa, f16v& ob) __attribute__((always_inline)) {
#pragma unroll
        for (int ks = 0; ks < 2; ++ks) {
            h8v pb;
#pragma unroll
            for (int jj = 0; jj < 8; ++jj) pb[jj] = (half_t)pr[8 * ks + jj];
#pragma unroll
            for (int md = 0; md < 2; ++md) {
                const h4v lo = *(const h4v*)&st.V[32 * md + c][32 * mt + 16 * ks + 4 * hh];
                const h4v hi = *(const h4v*)&st.V[32 * md + c][32 * mt + 16 * ks + 8 + 4 * hh];
                const h8v a = {lo[0], lo[1], lo[2], lo[3], hi[0], hi[1], hi[2], hi[3]};
                if (md == 0) oa = mfma32(a, pb, oa); else ob = mfma32(a, pb, ob);
            }
        }
    };
    NsaStage& st0 = *(NsaStage*)(smem + NSA_ST0);
    NsaStage& st1 = *(NsaStage*)(smem + NSA_RB);

    for (int rep = 0; rep < (PROBE_PHASE == 22 ? 2 : 1); ++rep) {
        __syncthreads();
        const half_t* KC = (const half_t*)(ws + OFF_KCMP) + (long)bg * 1024 * 64;
        const half_t* VCT = (const half_t*)(ws + OFF_VCMPT) + (long)bg * 64 * 1024;
        const int nst = ((t0 >> 4) >> 6) + 1;
        auto cmp_scores = [&](f16v& s, int kbase) __attribute__((always_inline)) {
            const bool far = (t0w - (16 * (kbase + 31) + 31)) >= 1513;
            if (far) {
#pragma unroll
                for (int rr = 0; rr < 16; ++rr) s[rr] += cfar;
            } else {
#pragma unroll
                for (int rr = 0; rr < 16; ++rr) {
                    const int k = kbase + (rr & 3) + 8 * (rr >> 2) + 4 * hh;
                    const int dist = tq - (16 * k + 31);
                    const int di = dist < 0 ? 0 : (dist > LUTN - 1 ? LUTN - 1 : dist);
                    s[rr] = (dist >= 0) ? s[rr] + (float)lut[di * 4 + r] : NEGF;
                }
            }
        };
        float l = 0.f;
        stage_gload(KC, VCT, 1024, 0, false);
#pragma unroll 1
        for (int sg = 0; sg < nst; ++sg) {
            stage_lstore(st0, false);
            __syncthreads();
            if (sg + 1 < nst) stage_gload(KC, VCT, 1024, (sg + 1) * 64, false);
#pragma unroll
            for (int mt = 0; mt < 2; ++mt) {
                const int kbase = sg * 64 + mt * 32;
                if (16 * kbase + 31 <= tlast) {
                    f16v s = qk32(st0, mt, nrefC);
                    cmp_scores(s, kbase);
#pragma unroll
                    for (int rr = 0; rr < 16; ++rr) l += fast_exp2(s[rr]);
                }
            }
            __syncthreads();
        }
        l += __shfl_xor(l, 32);
        const float ml2 = (l > 0.f) ? __builtin_amdgcn_logf(l) : 1e30f;
        f16v oc0, oc1;
#pragma unroll
        for (int i = 0; i < 16; ++i) { oc0[i] = 0.f; oc1[i] = 0.f; }
        float carryL = 0.f;
        stage_gload(KC, VCT, 1024, 0, true);
#pragma unroll 1
        for (int sg = 0; sg < nst; ++sg) {
            stage_lstore(st0, true);
            __syncthreads();
            if (sg + 1 < nst) stage_gload(KC, VCT, 1024, (sg + 1) * 64, true);
#pragma unroll
            for (int mt = 0; mt < 2; ++mt) {
                const int kbase = sg * 64 + mt * 32;
                const int kt = sg * 2 + mt;
                if (16 * kbase + 31 <= tlast) {
                    f16v s = qk32(st0, mt, nrefC);
                    cmp_scores(s, kbase);
#pragma unroll
                    for (int rr = 0; rr < 16; ++rr) s[rr] = fast_exp2(s[rr] - ml2);
                    float Gs[4], Ls[4];
#pragma unroll
                    for (int jg = 0; jg < 4; ++jg) {
                        float G = s[4 * jg] + s[4 * jg + 1] + s[4 * jg + 2] + s[4 * jg + 3];
                        float L = s[4 * jg + 3];
                        G += __shfl_xor(G, 1); G += __shfl_xor(G, 2);
                        L += __shfl_xor(L, 1); L += __shfl_xor(L, 2);
                        Gs[jg] = G; Ls[jg] = L;
                    }
                    float Lo[4];
#pragma unroll
                    for (int jg = 0; jg < 4; ++jg) Lo[jg] = __shfl_xor(Ls[jg], 32);
                    if (r == 0) {
#pragma unroll
                        for (int jg = 0; jg < 4; ++jg) {
                            const float prevL = hh ? Lo[jg] : (jg == 0 ? carryL : Lo[jg - 1]);
                            imp[w][qi][8 * kt + 2 * jg + hh] = Gs[jg] + prevL;
                        }
                    }
                    carryL = Lo[3];
                    pv32(st0, mt, s, oc0, oc1);
                }
            }
            __syncthreads();
        }
#pragma unroll
        for (int i = 0; i < 16; ++i) { of0[i] += (rep == 0 ? g0 : 0.0f) * oc0[i]; of1[i] += (rep == 0 ? g0 : 0.0f) * oc1[i]; }
    }
    {
        const int q2 = lane >> 3, sub = lane & 7;
        const int tq2 = t0w + q2;
        const int cur = tq2 >> 6;
        unsigned key[32];
#pragma unroll
        for (int i = 0; i < 32; ++i) {
            const int sb = sub + 8 * i;
            const float v = imp[w][q2][sb];
            unsigned u = (__float_as_uint(v) & 0x7FFFFF00u) | (unsigned)(255 - sb);
            if (sb == 0 || sb == cur || sb == cur - 1) u |= 0x80000000u;
            if (sb > cur) u = 0u;
            key[i] = u;
        }
#pragma unroll 1
        for (int round = 0; round < 16; ++round) {
            unsigned best = key[0];
#pragma unroll
            for (int i = 1; i < 32; ++i) best = best > key[i] ? best : key[i];
#pragma unroll
            for (int o = 1; o <= 4; o <<= 1) { const unsigned ob = (unsigned)__shfl_xor((int)best, o); best = best > ob ? best : ob; }
            if (sub == 0) sel[w][q2][round] = best ? (int)(255u - (best & 0xFFu)) : -1;
#pragma unroll
            for (int i = 0; i < 32; ++i) key[i] = (key[i] == best) ? 0u : key[i];
        }
    }
    for (int i = tid; i < 256; i += NTHREADS) masks[i] = 0u;
    __syncthreads();
    for (int e = lane; e < 128; e += 64) {
        const int q2 = e >> 4, bi = e & 15;
        const int blk = sel[w][q2][bi];
        if (blk >= 0) atomicOr(&masks[blk], 1u << (8 * w + q2));
    }
    __syncthreads();
    auto block_attend = [&](const NsaStage& st, int key0, bool colsel, bool window, float nref, float& l, f16v& oa, f16v& ob) __attribute__((always_inline)) {
        const bool far = !window && (t0w - (key0 + 63)) >= 1513;
        f16v s0, s1;
        if (far) {
            const float init = colsel ? (cfar + nref) : NEGF;
            s0 = qk32(st, 0, init); s1 = qk32(st, 1, init);
        } else {
            s0 = qk32(st, 0, nref); s1 = qk32(st, 1, nref);
#pragma unroll
            for (int rr = 0; rr < 16; ++rr) {
                const int pos = key0 + (rr & 3) + 8 * (rr >> 2) + 4 * hh;
                {
                    const int dist = tq - pos;
                    const bool valid = colsel && dist >= 0 && (!window || dist < 512);
                    const int di = dist < 0 ? 0 : (dist > LUTN - 1 ? LUTN - 1 : dist);
                    s0[rr] = valid ? s0[rr] + (float)lut[di * 4 + r] : NEGF;
                }
                {
                    const int dist = tq - pos - 32;
                    const bool valid = colsel && dist >= 0 && (!window || dist < 512);
                    const int di = dist < 0 ? 0 : (dist > LUTN - 1 ? LUTN - 1 : dist);
                    s1[rr] = valid ? s1[rr] + (float)lut[di * 4 + r] : NEGF;
                }
            }
        }
#pragma unroll
        for (int rr = 0; rr < 16; ++rr) { s0[rr] = fast_exp2(s0[rr]); l += s0[rr]; }
#pragma unroll
        for (int rr = 0; rr < 16; ++rr) { s1[rr] = fast_exp2(s1[rr]); l += s1[rr]; }
        pv32(st, 0, s0, oa, ob);
        pv32(st, 1, s1, oa, ob);
    };
    unsigned char* blist = (unsigned char*)(smem + NSA_SEL);
    volatile int* bcount = (volatile int*)(smem + NSA_SEL + 256);
    if (w == 0) {
        const int jmaxb = (t0 + 31) >> 6;
        int base = 0;
#pragma unroll 1
        for (int rnd = 0; rnd < 4; ++rnd) {
            const int bb = rnd * 64 + lane;
            const bool f = (bb <= jmaxb) && (masks[bb] != 0u);
            const unsigned long long bal = __ballot(f);
            const int pos = base + __popcll(bal & ((1ull << lane) - 1ull));
            if (f) blist[pos] = (unsigned char)bb;
            base += __popcll(bal);
        }
        if (lane == 0) *bcount = base;
    }
    for (int rep = 0; rep < (PROBE_PHASE == 20 ? 2 : 1); ++rep) {
        __syncthreads();
        const half_t* KS = (const half_t*)(ws + OFF_KS) + (long)bg * SEQ * 64;
        const half_t* VST = (const half_t*)(ws + OFF_VST) + (long)bg * 64 * SEQ;
        f16v os0, os1;
#pragma unroll
        for (int i = 0; i < 16; ++i) { os0[i] = 0.f; os1[i] = 0.f; }
        float l = 0.f;
        const int nblk = *bcount;
        u4v kA[2], vA[2], kB[2], vB[2];
        if (nblk > 0) stage_gload_r(kA, vA, KS, VST, SEQ, (int)blist[0] * 64, true);
        if (nblk > 1) stage_gload_r(kB, vB, KS, VST, SEQ, (int)blist[1] * 64, true);
        if (nblk > 0) stage_lstore_r(st0, kA, vA, true);
        __syncthreads();
#define SEL_STAGE(i_, ST, STN, KX, VX, KY, VY) { \
            const int i__ = (i_); \
            if (i__ < nblk) { \
                if (i__ + 2 < nblk) stage_gload_r(KX, VX, KS, VST, SEQ, (int)blist[i__ + 2] * 64, true); \
                const int j = (int)blist[i__]; \
                const unsigned mk = masks[j]; \
                if ((mk >> (8 * w)) & 0xFFu) { \
                    const bool colsel = (mk >> (8 * w + qi)) & 1u; \
                    block_attend(ST, j * 64, colsel, false, nrefS, l, os0, os1); \
                } \
                if (i__ + 1 < nblk) stage_lstore_r(STN, KY, VY, true); \
                __syncthreads(); \
            } }
#pragma unroll 1
        for (int i = 0; i < nblk; i += 2) {
            SEL_STAGE(i, st0, st1, kA, vA, kB, vB);
            SEL_STAGE(i + 1, st1, st0, kB, vB, kA, vA);
        }
        const float lt = l + __shfl_xor(l, 32);
        const float sc = ((lt > 0.f) ? g1 / lt : 0.f) * (rep == 0 ? 1.0f : 0.0f);
#pragma unroll
        for (int i = 0; i < 16; ++i) { of0[i] += sc * os0[i]; of1[i] += sc * os1[i]; }
    }
    __syncthreads();
    for (int rep = 0; rep < (PROBE_PHASE == 21 ? 2 : 1); ++rep) {
        __syncthreads();
        const half_t* KW = (const half_t*)(ws + OFF_KW) + (long)bg * SEQ * 64;
        const half_t* VWT = (const half_t*)(ws + OFF_VWT) + (long)bg * 64 * SEQ;
        f16v ow0, ow1;
#pragma unroll
        for (int i = 0; i < 16; ++i) { ow0[i] = 0.f; ow1[i] = 0.f; }
        float l = 0.f;
        const int jmax = (t0 + 31) >> 6;
        int j = (t0 >= 511) ? ((t0 - 511) >> 6) : 0;
        int buf = 0;
        stage_gload(KW, VWT, SEQ, j * 64, true);
#pragma unroll 1
        while (j <= jmax) {
            NsaStage& st = buf ? st1 : st0;
            stage_lstore(st, true);
            __syncthreads();
            if (j + 1 <= jmax) stage_gload(KW, VWT, SEQ, (j + 1) * 64, true);
            block_attend(st, j * 64, true, true, nrefW, l, ow0, ow1);
            buf ^= 1; ++j;
        }
        const float lt = l + __shfl_xor(l, 32);
        const float sc = ((lt > 0.f) ? g2 / lt : 0.f) * (rep == 0 ? 1.0f : 0.0f);
#pragma unroll
        for (int i = 0; i < 16; ++i) { of0[i] += sc * ow0[i]; of1[i] += sc * ow1[i]; }
    }
    {
        half_t* orow = (half_t*)(ws + OFF_MIXED) + (long)(b * SEQ + tq) * 1024 + (g * 4 + r) * 64;
#pragma unroll
        for (int md = 0; md < 2; ++md)
#pragma unroll
            for (int rg = 0; rg < 4; ++rg) {
                h4v o;
#pragma unroll
                for (int e = 0; e < 4; ++e) o[e] = (half_t)((md == 0) ? of0[4 * rg + e] : of1[4 * rg + e]);
                *(h4v*)(orow + 32 * md + 8 * rg + 4 * hh) = o;
            }
    }
    __syncthreads();
}

__device__ __forceinline__ void phase_attn(const Params& p, char* smem, int cidx = 64, int mode = 0) {
    unsigned* ctr = (unsigned*)(p.ws + OFF_CTRL) + cidx;
    volatile int* s_item = (volatile int*)(smem + 66048);
    const int x0 = (int)(xb_xcc_id() & 7u);
    const int lo = (mode == 2) ? 256 : 0, hi = (mode == 1) ? 256 : 512;
    for (int k = 0; k < 8; ++k) {
        const int q = (x0 + k) & 7;
        for (;;) {
            if (threadIdx.x == 0) {
                int v = -1;
                if (__hip_atomic_load(&ctr[q], __ATOMIC_RELAXED, __HIP_MEMORY_SCOPE_AGENT) < (unsigned)(hi - lo)) v = (int)atomicAdd(&ctr[q], 1u) + lo;
                *s_item = v;
            }
            __syncthreads();
            const int li = *s_item;
            __syncthreads();
            if (li < 0 || li >= hi) break;
            if (li < 256) mla_item(p, 2 * q + (li & 1), 127 - (li >> 1), smem);
            else nsa_item(p, q & 3, 511 - 2 * (li - 256) - (q >> 2), smem);
        }
    }
}

__device__ __forceinline__ void phase_outproj(const Params& p, int bid, int nb, char* smem) {
    char* ws = p.ws;
    const half_t* MIX = (const half_t*)(ws + OFF_MIXED);
    const half_t* W = (const half_t*)(ws + OFF_WOUT);
    half_t* X2H = (half_t*)(ws + OFF_X2H);
    for (int tile = bid; tile < 256 * 8; tile += nb) {
        const int tm = tile >> 3, tn = tile & 7;
        const int row0 = tm * 128, n0 = tn * 128;
        gemm_tile<true, true>(MIX + (long)row0 * 1024, 1024, W + (long)n0 * 1024, 1024, 1024, 512, smem,
            [&](f4v (&acc)[4][4], int wm, int wn, int i16, int g4) __attribute__((always_inline)) {
#pragma unroll
                for (int mi = 0; mi < 4; ++mi) {
                    const long row = row0 + wm * 64 + mi * 16 + i16;
#pragma unroll
                    for (int ni = 0; ni < 4; ++ni) {
                        const int col = n0 + wn * 64 + ni * 16 + 4 * g4;
                        float4 v = *(const float4*)(p.x + row * 1024 + col);
                        v.x += acc[mi][ni][0]; v.y += acc[mi][ni][1]; v.z += acc[mi][ni][2]; v.w += acc[mi][ni][3];
                        const h4v o = {(half_t)v.x, (half_t)v.y, (half_t)v.z, (half_t)v.w};
                        *(h4v*)(X2H + row * 1024 + col) = o;
                    }
                }
            });
    }
}

__device__ __forceinline__ void phase_peerq(const Params& p, int bid, int nb, char* smem) {
    char* ws = p.ws;
    const half_t* X2H = (const half_t*)(ws + OFF_X2H);
    const half_t* W = (const half_t*)(ws + OFF_WPQ);
    half_t* QP = (half_t*)(ws + OFF_QP);
    for (int tile = bid; tile < 256 * 16; tile += nb) {
        const int tm = tile >> 4, tn = tile & 15;
        const int row0 = tm * 128, n0 = tn * 128;
        gemm_tile<true, true>(X2H + (long)row0 * 1024, 1024, W + (long)n0 * 1024, 1024, 1024, 1024, smem,
            [&](f4v (&acc)[4][4], int wm, int wn, int i16, int g4) __attribute__((always_inline)) {
#pragma unroll
                for (int mi = 0; mi < 4; ++mi) {
                    const long row = row0 + wm * 64 + mi * 16 + i16;
#pragma unroll
                    for (int ni = 0; ni < 4; ++ni) {
                        const int col = n0 + wn * 64 + ni * 16 + 4 * g4;
                        const h4v o = {(half_t)acc[mi][ni][0], (half_t)acc[mi][ni][1], (half_t)acc[mi][ni][2], (half_t)acc[mi][ni][3]};
                        *(h4v*)(QP + row * 2048 + col) = o;
                    }
                }
            });
    }
}

__device__ __forceinline__ void topk_insert(float (&tv)[16], int (&ti)[16], float v, int id) {
#pragma unroll
    for (int k = 0; k < 16; ++k) {
        const bool gt = v > tv[k];
        const float nv = gt ? tv[k] : v; const int ni = gt ? ti[k] : id;
        tv[k] = gt ? v : tv[k]; ti[k] = gt ? id : ti[k];
        v = nv; id = ni;
    }
}
__device__ __forceinline__ unsigned rt_flip(float f) { const unsigned b = __float_as_uint(f); return b ^ ((b >> 31) ? 0xFFFFFFFFu : 0x80000000u); }
__device__ __forceinline__ float rt_unflip(unsigned u) { return __uint_as_float((u & 0x80000000u) ? (u ^ 0x80000000u) : ~u); }
__device__ __forceinline__ void rt_insert(unsigned (&tk)[16], unsigned u) {
#pragma unroll
    for (int k = 0; k < 16; ++k) { const unsigned hi = tk[k] > u ? tk[k] : u; u = tk[k] > u ? u : tk[k]; tk[k] = hi; }
}
__device__ __forceinline__ void phase_route(const Params& p, int bid, int nb, char* smem) {
    char* ws = p.ws;
    {
        const u4v* src = (const u4v*)(ws + OFF_KEYS);
        u4v* dst = (u4v*)smem;
        for (int i = threadIdx.x; i < 4096; i += NTHREADS) {
            const int n = (i >> 4) & 127, ch = i & 15;
            dst[(i & ~15) | (ch ^ (n & 15))] = src[i];
        }
    }
    __syncthreads();
    const half_t* QP = (const half_t*)(ws + OFF_QP);
    int* EID = (int*)(ws + OFF_EID);
    float* GW = (float*)(ws + OFF_GW);
    int tid_ = threadIdx.x; asm volatile("" : "+v"(tid_));
    const int lane = tid_ & 63, w = tid_ >> 6, c = lane & 31, hh = lane >> 5;
#pragma unroll 1
    for (long blk = bid; blk < (long)NTOK * 8 / 128; blk += nb) {
        const long th = blk * 128 + w * 32 + c;
        unsigned tkA[16], tkB[16];
#pragma unroll
        for (int half = 0; half < 2; ++half) {
            unsigned (&tk)[16] = half ? tkB : tkA;
#pragma unroll
            for (int k = 0; k < 16; ++k) tk[k] = 0u;
            h8v qf[8];
#pragma unroll
            for (int ks = 0; ks < 8; ++ks) qf[ks] = *(const h8v*)(QP + th * 256 + half * 128 + ks * 16 + hh * 8);
#pragma unroll 1
            for (int mt = 0; mt < 4; ++mt) {
                f16v s;
#pragma unroll
                for (int i = 0; i < 16; ++i) s[i] = 0.f;
                const int n = mt * 32 + c;
                const char* kb = smem + (half * 128 + n) * 256;
#pragma unroll
                for (int ks = 0; ks < 8; ++ks) {
                    const h8v a = *(const h8v*)(kb + (((2 * ks + hh) ^ (n & 15)) << 4));
                    s = mfma32(a, qf[ks], s);
                }
#pragma unroll
                for (int r = 0; r < 16; ++r) {
                    const int key = mt * 32 + (r & 3) + 8 * (r >> 2) + 4 * hh;
                    rt_insert(tk, (rt_flip(s[r]) & ~0x7Fu) | (unsigned)(127 - key));
                }
            }
            unsigned other[16];
#pragma unroll
            for (int k = 0; k < 16; ++k) other[k] = (unsigned)__shfl_xor((int)tk[k], 32);
#pragma unroll
            for (int k = 0; k < 16; ++k) rt_insert(tk, other[k]);
        }
        float v1[16], v2[16]; int i1[16], i2[16];
#pragma unroll
        for (int k = 0; k < 16; ++k) {
            v1[k] = rt_unflip(tkA[k] & ~0x7Fu); i1[k] = 127 - (int)(tkA[k] & 0x7Fu);
            v2[k] = rt_unflip(tkB[k] & ~0x7Fu); i2[k] = 127 - (int)(tkB[k] & 0x7Fu);
        }
        float fv[16]; int fi[16];
#pragma unroll
        for (int k = 0; k < 16; ++k) { fv[k] = -3.0e38f; fi[k] = 0; }
        {
            constexpr int NP = 50;
            int pi[NP], pj[NP]; int np = 0;
#pragma unroll
            for (int i = 0; i < 16; ++i)
#pragma unroll
                for (int j = 0; j < 16; ++j)
                    if ((i + 1) * (j + 1) <= 16) { pi[np] = i; pj[np] = j; ++np; }
#pragma unroll
            for (int q = 0; q < NP / 2; ++q) {
                const float va = v1[pi[2 * q]] + v2[pj[2 * q]], vb = v1[pi[2 * q + 1]] + v2[pj[2 * q + 1]];
                const int ea = i1[pi[2 * q]] * 128 + i2[pj[2 * q]], eb = i1[pi[2 * q + 1]] * 128 + i2[pj[2 * q + 1]];
                topk_insert(fv, fi, hh ? vb : va, hh ? eb : ea);
            }
        }
        {
            float ov[16]; int oi[16];
#pragma unroll
            for (int k = 0; k < 16; ++k) { ov[k] = __shfl_xor(fv[k], 32); oi[k] = __shfl_xor(fi[k], 32); }
#pragma unroll
            for (int k = 0; k < 16; ++k) topk_insert(fv, fi, ov[k], oi[k]);
        }
        if (hh == 0) {
            float sum = 0.f, ex[16];
#pragma unroll
            for (int k = 0; k < 16; ++k) { ex[k] = __expf(fv[k] - fv[0]); sum += ex[k]; }
            const float inv = 1.0f / sum;
#pragma unroll
            for (int k4 = 0; k4 < 4; ++k4) {
                *(int4*)(EID + th * 16 + 4 * k4) = make_int4(fi[4 * k4], fi[4 * k4 + 1], fi[4 * k4 + 2], fi[4 * k4 + 3]);
                *(float4*)(GW + th * 16 + 4 * k4) = make_float4(ex[4 * k4] * inv, ex[4 * k4 + 1] * inv, ex[4 * k4 + 2] * inv, ex[4 * k4 + 3] * inv);
            }
        }
    }
}

__device__ __forceinline__ int peer_next_task(unsigned* q, int xpref, int ntask_per_slice, volatile int* s_task) {
    if (threadIdx.x == 0) {
        int res = -1;
        for (int k = 0; k < 4; ++k) {
            const int x = (xpref + k) & 3;
            if (__hip_atomic_load(&q[x], __ATOMIC_RELAXED, __HIP_MEMORY_SCOPE_AGENT) >= (unsigned)ntask_per_slice) continue;
            const unsigned c = atomicAdd(&q[x], 1u);
            if (c < (unsigned)ntask_per_slice) { res = x * ntask_per_slice + (int)c; break; }
        }
        *s_task = res;
    }
    __syncthreads();
    const int r = *s_task;
    __syncthreads();
    return r;
}
template <int PMODE>
__device__ __forceinline__ void phase_peer_udot(const Params& p, char* smem, int qoff = 16) {
    char* ws = p.ws;
    unsigned* q = (unsigned*)(ws + OFF_CTRL) + qoff;
    volatile int* s_task = (volatile int*)(smem + 66048);
    const unsigned char* U4 = (const unsigned char*)(ws + OFF_U16);
    const half_t* X2H = (const half_t*)(ws + OFF_X2H);
    const int* EID = (const int*)(ws + OFF_EID);
    float* PD = (float*)(ws + OFF_PD);
    const int xpref = (int)(xb_xcc_id() & 3u);
    for (;;) {
        const int task = peer_next_task(q, xpref, 512, s_task);
        if (task < 0) break;
        const int x = task >> 9, chunk = task & 511;
        int tid_ = threadIdx.x; asm volatile("" : "+v"(tid_));
        const int lane = tid_ & 63, w = tid_ >> 6, seg = lane & 7, eg = lane >> 3;
        h2v gs[16];
#pragma unroll
        for (int i = 0; i < 16; ++i) gs[i] = (h2v){(half_t)p.norm2_g[256 * x + 32 * seg + 2 * i], (half_t)p.norm2_g[256 * x + 32 * seg + 2 * i + 1]};
        const unsigned char* Ux = U4 + (long)x * 16384 * 128 + 16 * seg;
        const int tbase = chunk * 64 + w * 16;
        const int* Eb = EID + (long)tbase * 128 + 16 * eg;
        const half_t* Xb = X2H + (long)tbase * 1024 + 256 * x + 32 * seg;
#define LOAD_E(dst, k) { const u4v* ep_ = (const u4v*)(Eb + (long)(k) * 128); dst[0] = ep_[0]; dst[1] = ep_[1]; dst[2] = ep_[2]; dst[3] = ep_[3]; }
#define ISSUE_U8(uu, e_, hf) { _Pragma("unroll") for (int i = 0; i < 8; ++i) uu[i] = *(const u4v*)(Ux + (long)e_[2 * (hf) + (i >> 2)][i & 3] * 128); }
        h2v hs[16];
        auto load_h = [&](int k) __attribute__((always_inline)) {
#pragma unroll
            for (int c4 = 0; c4 < 4; ++c4) {
                const h8v xv = *(const h8v*)(Xb + (long)k * 1024 + 8 * c4);
#pragma unroll
                for (int i = 0; i < 4; ++i) hs[4 * c4 + i] = (h2v){xv[2 * i], xv[2 * i + 1]} * gs[4 * c4 + i];
            }
        };
        auto compute8 = [&](const u4v (&uu)[8]) __attribute__((always_inline)) -> float {
            float res = 0.f;
            if (PMODE == 1) {
                unsigned acc_ = 0;
#pragma unroll
                for (int i = 0; i < 8; ++i) acc_ ^= uu[i][0] ^ uu[i][1] ^ uu[i][2] ^ uu[i][3];
                return __builtin_bit_cast(float, acc_);
            }
#pragma unroll
            for (int i = 0; i < 8; ++i) {
                float d = 0.f;
#pragma unroll
                for (int j = 0; j < 4; ++j) {
                    d = __builtin_amdgcn_fdot2(hs[4 * j], __builtin_amdgcn_cvt_scalef32_pk_f16_fp4(uu[i][j], 1.0f, 0), d, false);
                    d = __builtin_amdgcn_fdot2(hs[4 * j + 1], __builtin_amdgcn_cvt_scalef32_pk_f16_fp4(uu[i][j], 1.0f, 1), d, false);
                    d = __builtin_amdgcn_fdot2(hs[4 * j + 2], __builtin_amdgcn_cvt_scalef32_pk_f16_fp4(uu[i][j], 1.0f, 2), d, false);
                    d = __builtin_amdgcn_fdot2(hs[4 * j + 3], __builtin_amdgcn_cvt_scalef32_pk_f16_fp4(uu[i][j], 1.0f, 3), d, false);
                }
                d = red8(d);
                res = (seg == i) ? d : res;
            }
            return res;
        };
        u4v uA[8], uB[8];
        u4v eC[4], eN[4];
        LOAD_E(eC, 0);
        ISSUE_U8(uA, eC, 0);
#pragma unroll 1
        for (int k = 0; k < 16; ++k) {
            ISSUE_U8(uB, eC, 1);
            if (k + 1 < 16) LOAD_E(eN, k + 1);
            load_h(k);
            const float r0 = compute8(uA);
            if (k + 1 < 16) ISSUE_U8(uA, eN, 0);
            const float r1 = compute8(uB);
            float* po = (PMODE == 1 ? (float*)(p.ws + OFF_HC1) + (((long)(tbase + k) * 128 + 16 * eg + seg) & 0xFFFFF)
                                    : PD + ((long)x * NTOK + tbase + k) * 128 + 16 * eg + seg);
            po[0] = r0; po[8] = r1;
#pragma unroll
            for (int i = 0; i < 4; ++i) eC[i] = eN[i];
        }
    }
}
__device__ __forceinline__ void phase_peer_coef(const Params& p, int bid, int nb) {
    char* ws = p.ws;
    const half_t* X2H = (const half_t*)(ws + OFF_X2H);
    const float* PD = (const float*)(ws + OFF_PD);
    const float* GW = (const float*)(ws + OFF_GW);
    const int* EID = (const int*)(ws + OFF_EID);
    const float* ESC = (const float*)(ws + OFF_ESC);
    float* COEF = (float*)(ws + OFF_COEF);
    int tx_ = threadIdx.x; asm volatile("" : "+v"(tx_));
    const int lane = tx_ & 63;
    const long wv = ((long)bid * NTHREADS + tx_) >> 6, nwv = ((long)nb * NTHREADS) >> 6;
    for (long t = wv; t < NTOK; t += nwv) {
        const h8v a = *(const h8v*)(X2H + t * 1024 + 8 * lane), b2 = *(const h8v*)(X2H + t * 1024 + 512 + 8 * lane);
        float ss = 0.f;
#pragma unroll
        for (int i = 0; i < 8; ++i) { const float f0 = (float)a[i], f1 = (float)b2[i]; ss += f0 * f0 + f1 * f1; }
        ss = wave_sum(ss);
        const float rs = rsqrtf(ss * (1.0f / 1024.f) + EPS);
        float d0 = 0.f, d1 = 0.f;
#pragma unroll
        for (int x = 0; x < 4; ++x) {
            const float* pp = PD + ((long)x * NTOK + t) * 128;
            d0 += pp[lane]; d1 += pp[64 + lane];
        }
        const int e0 = EID[t * 128 + lane], e1 = EID[t * 128 + 64 + lane];
        COEF[t * 128 + lane] = GW[t * 128 + lane] * gelu_exact(d0 * rs * ESC[e0]) * ESC[16384 + e0];
        COEF[t * 128 + 64 + lane] = GW[t * 128 + 64 + lane] * gelu_exact(d1 * rs * ESC[e1]) * ESC[16384 + e1];
    }
}
__device__ __forceinline__ void phase_peer_vacc(const Params& p, char* smem) {
    char* ws = p.ws;
    unsigned* q = (unsigned*)(ws + OFF_CTRL) + 32;
    volatile int* s_task = (volatile int*)(smem + 66048);
    const unsigned char* V4 = (const unsigned char*)(ws + OFF_V16);
    const int* EID = (const int*)(ws + OFF_EID);
    const float* COEF = (const float*)(ws + OFF_COEF);
    float* SSQ = (float*)(ws + OFF_SSQ);
    const int xpref = (int)(xb_xcc_id() & 3u);
    for (;;) {
        const int task = peer_next_task(q, xpref, 512, s_task);
        if (task < 0) break;
        const int x = task >> 9, chunk = task & 511;
        int tid_ = threadIdx.x; asm volatile("" : "+v"(tid_));
        const int lane = tid_ & 63, w = tid_ >> 6, seg = lane & 7, eg = lane >> 3;
        const unsigned char* Vx = V4 + (long)x * 16384 * 128 + 16 * seg;
#pragma unroll 1
        for (int round = 0; round < 2; ++round) {
            const int t = chunk * 64 + w * 16 + round * 8 + eg;
            const int* Eb = EID + (long)t * 128;
            const float* Cb = COEF + (long)t * 128;
#define LOAD_EC(e_, c_, ci) { const u4v* ep_ = (const u4v*)(Eb + 8 * (ci)); const f4v* cp_ = (const f4v*)(Cb + 8 * (ci)); e_[0] = ep_[0]; e_[1] = ep_[1]; c_[0] = cp_[0]; c_[1] = cp_[1]; }
#define ISSUE_V(vv, e_) { _Pragma("unroll") for (int i = 0; i < 8; ++i) vv[i] = *(const u4v*)(Vx + (long)e_[i >> 2][i & 3] * 128); }
            float acc[32];
#pragma unroll
            for (int i = 0; i < 32; ++i) acc[i] = 0.f;
            auto compute = [&](const f4v (&c_)[2], const u4v (&vv)[8]) __attribute__((always_inline)) {
#pragma unroll
                for (int i = 0; i < 8; ++i) {
                    const float cf = c_[i >> 2][i & 3];
#pragma unroll
                    for (int j = 0; j < 4; ++j) {
#pragma unroll
                        for (int bsel = 0; bsel < 4; ++bsel) {
                            const h2v hv = (bsel == 0) ? __builtin_amdgcn_cvt_scalef32_pk_f16_fp4(vv[i][j], 1.0f, 0)
                                         : (bsel == 1) ? __builtin_amdgcn_cvt_scalef32_pk_f16_fp4(vv[i][j], 1.0f, 1)
                                         : (bsel == 2) ? __builtin_amdgcn_cvt_scalef32_pk_f16_fp4(vv[i][j], 1.0f, 2)
                                                       : __builtin_amdgcn_cvt_scalef32_pk_f16_fp4(vv[i][j], 1.0f, 3);
                            acc[8 * j + 2 * bsel] += cf * (float)hv[0];
                            acc[8 * j + 2 * bsel + 1] += cf * (float)hv[1];
                        }
                    }
                }
            };
            u4v vvA[8];
            u4v eA[2], eB[2]; f4v cA[2], cB[2];
            LOAD_EC(eA, cA, 0); LOAD_EC(eB, cB, 1);
#pragma unroll 1
            for (int ci = 0; ci < 16; ci += 2) {
                ISSUE_V(vvA, eA);
                compute(cA, vvA);
                if (ci + 2 < 16) LOAD_EC(eA, cA, ci + 2);
                ISSUE_V(vvA, eB);
                compute(cB, vvA);
                if (ci + 2 < 16) LOAD_EC(eB, cB, ci + 3);
            }
            half_t* xr = (half_t*)(ws + OFF_X2H) + (long)t * 1024 + 256 * x + 32 * seg;
            float ssq = 0.f;
#pragma unroll
            for (int i8 = 0; i8 < 4; ++i8) {
                h8v xv = *(const h8v*)(xr + 8 * i8);
#pragma unroll
                for (int e = 0; e < 8; ++e) {
                    const float f = (float)xv[e] + acc[8 * i8 + e];
                    ssq += f * f;
                    xv[e] = (half_t)f;
                }
                *(h8v*)(xr + 8 * i8) = xv;
            }
            ssq = red8(ssq);
            if (seg == 0) SSQ[(long)x * NTOK + t] = ssq;
        }
    }
}
__device__ __forceinline__ void phase_final_norm(const Params& p, int bid, int nb) {
    const float* SSQ = (const float*)(p.ws + OFF_SSQ);
    int tx_ = threadIdx.x; asm volatile("" : "+v"(tx_));
    const int lane = tx_ & 63;
    const long wv = ((long)bid * NTHREADS + tx_) >> 6, nwv = ((long)nb * NTHREADS) >> 6;
    for (long t = wv; t < NTOK; t += nwv) {
        float ss = 0.f;
#pragma unroll
        for (int x = 0; x < 4; ++x) ss += SSQ[(long)x * NTOK + t];
        const float rf = rsqrtf(ss * (1.0f / 1024.f) + EPS);
        const half_t* xh = (const half_t*)(p.ws + OFF_X2H) + t * 1024;
        float4* xr = (float4*)(p.out + t * 1024);
#pragma unroll
        for (int i = 0; i < 4; ++i) {
            const h4v hv = *(const h4v*)(xh + 4 * (lane + 64 * i));
            const float4 g = ((const float4*)p.final_g)[lane + 64 * i];
            float4 v;
            v.x = (float)hv[0] * rf * g.x; v.y = (float)hv[1] * rf * g.y; v.z = (float)hv[2] * rf * g.z; v.w = (float)hv[3] * rf * g.w;
            xr[lane + 64 * i] = v;
        }
    }
}

#define XB_TMO      128
#define XB_XCNT(j)  (256  + 64 * (j))
#define XB_XSUB(j)  (1280 + 64 * (j))
#define XB_XGEN(j)  (2304 + 64 * (j))
#define XB_TOP      3328
#define XB_TOPGEN   3392
#define XCD_BAR_WORDS 3456
#define XB_SPIN_CAP (1u << 22)
__device__ __forceinline__ unsigned xb_ld(unsigned* p)              { return __hip_atomic_load(p, __ATOMIC_RELAXED, __HIP_MEMORY_SCOPE_AGENT); }
__device__ __forceinline__ unsigned xb_add(unsigned* p, unsigned v) { return __hip_atomic_fetch_add(p, v, __ATOMIC_RELAXED, __HIP_MEMORY_SCOPE_AGENT); }
__device__ __forceinline__ unsigned xb_xcc_id() { return (unsigned)__builtin_amdgcn_s_getreg((3 << 11) | 20) & 0xFu; }
#define XB_SPIN(cond, bar) do { unsigned _sp = 0; while (cond) { __builtin_amdgcn_s_sleep(1); \
    if ((++_sp & 255u) == 0u) { if (xb_ld(&(bar)[XB_TMO])) break; if (_sp > XB_SPIN_CAP) { atomicAdd(&(bar)[XB_TMO], 1u); break; } } } } while (0)
struct XcdBarrier { unsigned* bar; unsigned x; volatile unsigned* st; };
__device__ __forceinline__ XcdBarrier xcd_barrier_post(unsigned* bar, volatile unsigned* st) {
    XcdBarrier b; b.bar = bar; b.x = xb_xcc_id(); b.st = st;
    if (threadIdx.x == 0) (void)xb_add(&bar[XB_XCNT(b.x)], 1u);
    return b;
}
__device__ __forceinline__ void xcd_barrier_complete(unsigned* bar, unsigned x, unsigned& nloc, unsigned& nx) {
    const unsigned G = gridDim.x * gridDim.y * gridDim.z;
    unsigned sum, cnt, mine, sp = 0u;
    for (;;) {
        sum = 0u; cnt = 0u; mine = 0u;
#pragma unroll
        for (unsigned j = 0; j < 16; ++j) { const unsigned c = xb_ld(&bar[XB_XCNT(j)]); sum += c; cnt += (c > 0u) ? 1u : 0u; mine = (j == x) ? c : mine; }
        if (sum == G) break;
        __builtin_amdgcn_s_sleep(1);
        if ((++sp & 255u) == 0u) { if (xb_ld(&bar[XB_TMO])) break; if (sp > XB_SPIN_CAP) { atomicAdd(&bar[XB_TMO], 1u); break; } }
    }
    nloc = mine > 0u ? mine : 1u; nx = cnt > 0u ? cnt : 1u;
}
__device__ __forceinline__ void xcd_barrier(const XcdBarrier& b) {
    asm volatile("s_waitcnt vmcnt(0)" ::: "memory");
    __syncthreads();
    if (threadIdx.x == 0) {
        unsigned* bar = b.bar;
        __builtin_amdgcn_s_waitcnt(0);
        unsigned nloc = b.st[0], nx = b.st[1];
        if (nloc == 0u) { xcd_barrier_complete(bar, b.x, nloc, nx); b.st[0] = nloc; b.st[1] = nx; }
        const unsigned old = xb_add(&bar[XB_XSUB(b.x)], 1u);
        const unsigned gen = old / nloc;
        if (old + 1u == (gen + 1u) * nloc) {
            __builtin_amdgcn_fence(__ATOMIC_RELEASE, "agent");
            asm volatile("s_waitcnt vmcnt(0)" ::: "memory");
            const unsigned og = xb_add(&bar[XB_TOP], 1u);
            const unsigned tg = og / nx;
            if (og + 1u == (tg + 1u) * nx) xb_add(&bar[XB_TOPGEN], 1u);
            else XB_SPIN(xb_ld(&bar[XB_TOPGEN]) == tg, bar);
            __builtin_amdgcn_fence(__ATOMIC_ACQUIRE, "agent");
            xb_add(&bar[XB_XGEN(b.x)], 1u);
            asm volatile("s_waitcnt vmcnt(0)" ::: "memory");
        } else {
            XB_SPIN(xb_ld(&bar[XB_XGEN(b.x)]) == gen, bar);
            __builtin_amdgcn_fence(__ATOMIC_ACQUIRE, "agent");
            asm volatile("s_waitcnt vmcnt(0)" ::: "memory");
        }
    }
    __syncthreads();
}

template <int PH>
__global__ void __launch_bounds__(NTHREADS, 2) phase_kernel(Params p) {
    extern __shared__ __attribute__((aligned(16))) char smem[];
    const int bid = blockIdx.x, nb = gridDim.x;
    if (PH == 0) phase_prep(p, bid, nb, smem);
    if (PH == 1) phase_inproj(p, bid, nb, smem);
    if (PH == 2) phase_p2(p, bid, nb, smem);
    if (PH == 3) phase_cmp2(p, bid, nb);
    if (PH == 4) phase_attn(p, smem);
    if (PH == 5) phase_outproj(p, bid, nb, smem);
    if (PH == 6) phase_peerq(p, bid, nb, smem);
    if (PH == 7) phase_route(p, bid, nb, smem);
}

__global__ void __launch_bounds__(NTHREADS, 2) mega_kernel(Params p) {
    extern __shared__ __attribute__((aligned(16))) char smem[];
    const int bid = blockIdx.x, nb = gridDim.x;
    {
        volatile unsigned* xbst = (volatile unsigned*)(smem + 66064);
        if (threadIdx.x == 0) { xbst[0] = 0u; xbst[1] = 0u; }
        __syncthreads();
        (void)xcd_barrier_post((unsigned*)(p.ws + OFF_BAR), xbst);
    }
#define GRID_SYNC() { XcdBarrier gb_; gb_.bar = (unsigned*)(p.ws + OFF_BAR); gb_.x = xb_xcc_id(); gb_.st = (volatile unsigned*)(smem + 66064); xcd_barrier(gb_); }
    phase_prep(p, bid, nb, smem); GRID_SYNC();
    if (PROBE_PHASE == 0) { phase_prep(p, bid, nb, smem); GRID_SYNC(); }
    phase_inproj(p, bid, nb, smem); GRID_SYNC();
    if (PROBE_PHASE == 1) { phase_inproj(p, bid, nb, smem); GRID_SYNC(); }
    phase_p2(p, bid, nb, smem); GRID_SYNC();
    if (PROBE_PHASE == 2) { phase_p2(p, bid, nb, smem); GRID_SYNC(); }
    phase_cmp2(p, bid, nb); GRID_SYNC();
    phase_attn(p, smem, 64, 0); GRID_SYNC();
    if (PROBE_PHASE == 3) { phase_attn(p, smem, 80, 0); GRID_SYNC(); }
    if (PROBE_PHASE == 9) { phase_attn(p, smem, 80, 1); GRID_SYNC(); }
    if (PROBE_PHASE == 13) { phase_attn(p, smem, 80, 2); GRID_SYNC(); }
    phase_outproj(p, bid, nb, smem); GRID_SYNC();
    if (PROBE_PHASE == 4) { phase_outproj(p, bid, nb, smem); GRID_SYNC(); }
    phase_peerq(p, bid, nb, smem); GRID_SYNC();
    if (PROBE_PHASE == 5) { phase_peerq(p, bid, nb, smem); GRID_SYNC(); }
    phase_route(p, bid, nb, smem); GRID_SYNC();
    if (PROBE_PHASE == 6) { phase_route(p, bid, nb, smem); GRID_SYNC(); }
    if (PROBE_PHASE == 8) { GRID_SYNC(); GRID_SYNC(); GRID_SYNC(); GRID_SYNC(); GRID_SYNC(); GRID_SYNC(); GRID_SYNC(); GRID_SYNC(); }
    phase_peer_udot<0>(p, smem); GRID_SYNC();
    if (PROBE_PHASE == 10) { phase_peer_udot<0>(p, smem, 48); GRID_SYNC(); }
    if (PROBE_PHASE == 12) { phase_peer_udot<1>(p, smem, 48); GRID_SYNC(); }
    phase_peer_coef(p, bid, nb); GRID_SYNC();
    if (PROBE_PHASE == 11) { phase_peer_coef(p, bid, nb); GRID_SYNC(); }
    phase_peer_vacc(p, smem); GRID_SYNC();
    phase_final_norm(p, bid, nb);
}

extern "C" void kernel_launch(void* const* d_in, const int* in_sizes, int n_in, void* d_out, int out_size, void* d_ws, size_t ws_size, hipStream_t stream) {
    (void)in_sizes; (void)n_in; (void)out_size;
    if (ws_size < WS_NEED) { fprintf(stderr, "kernel_launch: workspace too small (%zu < %zu)\n", ws_size, (size_t)WS_NEED); return; }
    Params p{};
    p.x = (const float*)d_in[0]; p.pos = (const int*)d_in[1]; p.norm1_g = (const float*)d_in[2]; p.w_in = (const float*)d_in[3];
    p.cmp_pos = (const float*)d_in[4]; p.cmp_k_w1 = (const float*)d_in[5]; p.cmp_k_w2 = (const float*)d_in[6];
    p.cmp_v_w1 = (const float*)d_in[7]; p.cmp_v_w2 = (const float*)d_in[8]; p.t5_bias = (const float*)d_in[9];
    p.q_norm_g = (const float*)d_in[10]; p.w_q_up = (const float*)d_in[11]; p.kv_norm_g = (const float*)d_in[12]; p.w_kv_up = (const float*)d_in[13];
    p.grp_norm_nsa = (const float*)d_in[14]; p.grp_norm_mla = (const float*)d_in[15]; p.w_out = (const float*)d_in[16]; p.norm2_g = (const float*)d_in[17];
    p.peer_wq = (const float*)d_in[18]; p.peer_keys1 = (const float*)d_in[19]; p.peer_keys2 = (const float*)d_in[20];
    p.peer_u = (const float*)d_in[21]; p.peer_v = (const float*)d_in[22]; p.final_g = (const float*)d_in[23];
    p.out = (float*)d_out; p.ws = (char*)d_ws;
#if MULTI_LAUNCH
    const int G = 512;
    phase_kernel<0><<<G, NTHREADS, 0, stream>>>(p);
    phase_kernel<1><<<G, NTHREADS, 0, stream>>>(p);
    phase_kernel<2><<<G, NTHREADS, 0, stream>>>(p);
    phase_kernel<3><<<G, NTHREADS, 0, stream>>>(p);
    phase_kernel<4><<<G, NTHREADS, 0, stream>>>(p);
    phase_kernel<5><<<G, NTHREADS, 0, stream>>>(p);
    phase_kernel<6><<<G, NTHREADS, 0, stream>>>(p);
    phase_kernel<7><<<G, NTHREADS, 0, stream>>>(p);
    phase_kernel<8><<<G, NTHREADS, 0, stream>>>(p);
#else
    static int grid_blocks = 0;
    if (!grid_blocks) {
        int dev = 0, cus = 0, per_cu = 0;
        (void)hipGetDevice(&dev);
        (void)hipDeviceGetAttribute(&cus, hipDeviceAttributeMultiprocessorCount, dev);
        (void)hipFuncSetAttribute((const void*)mega_kernel, hipFuncAttributeMaxDynamicSharedMemorySize, SMEM_BYTES);
        (void)hipOccupancyMaxActiveBlocksPerMultiprocessor(&per_cu, mega_kernel, NTHREADS, SMEM_BYTES);
        if (per_cu > 2) per_cu = 2;
        grid_blocks = cus * per_cu;
    }
    (void)hipMemsetAsync((char*)d_ws + OFF_BAR, 0, 16384, stream);
    void* args[] = {&p};
    hipError_t e = hipLaunchCooperativeKernel((void*)mega_kernel, dim3(grid_blocks), dim3(NTHREADS), args, SMEM_BYTES, stream);
    if (e != hipSuccess) fprintf(stderr, "cooperative launch failed: %s (grid %d)\n", hipGetErrorString(e), grid_blocks);
#endif
}
```

```cpp
#include <hip/hip_runtime.h>
#include <hip/hip_cooperative_groups.h>
#include <cstdio>
#include <cstdint>
namespace cg = cooperative_groups;

#ifndef MULTI_LAUNCH
#define MULTI_LAUNCH 0
#endif

#ifndef PROBE_PHASE
#define PROBE_PHASE -1
#endif

typedef _Float16 half_t;
typedef _Float16 h2v __attribute__((ext_vector_type(2)));
typedef _Float16 h4v __attribute__((ext_vector_type(4)));
typedef _Float16 h8v __attribute__((ext_vector_type(8)));
typedef float f4v __attribute__((ext_vector_type(4)));
typedef unsigned u4v __attribute__((ext_vector_type(4)));
typedef unsigned u2v __attribute__((ext_vector_type(2)));
typedef float f16v __attribute__((ext_vector_type(16)));

constexpr int BATCH = 2, SEQ = 16384, DM = 1024, NTOK = BATCH * SEQ;
constexpr int NIN = 1720, NINP = 1792;
constexpr int NCMP = 1023, NCMPP = 1024;
constexpr float EPS = 1e-6f;
constexpr float LOG2E = 1.4426950408889634f;
constexpr float QS_NSA = 0.125f * LOG2E;
constexpr float QS_MLA = 0.10206207261596575f * LOG2E;
constexpr float NEGF = -1e30f;
constexpr int LUTN = 1536;
constexpr float USCALE = 128.0f, VSCALE = 16.0f;

constexpr size_t al256(size_t x) { return (x + 255) & ~(size_t)255; }
constexpr size_t OFF_CTRL = 0;
constexpr size_t OFF_LUT = 4096;
constexpr size_t OFF_CB = OFF_LUT + 2 * LUTN * 4 * 4;
constexpr size_t OFF_WIN = 65536;
constexpr size_t OFF_WQUP = OFF_WIN + (size_t)NINP * 1024 * 2;
constexpr size_t OFF_WKVUP = OFF_WQUP + 768 * 256 * 2;
constexpr size_t OFF_WC1 = OFF_WKVUP + 1024 * 128 * 2;
constexpr size_t OFF_WOUT = OFF_WC1 + 2 * 256 * 2048 * 2;
constexpr size_t OFF_WPQ = OFF_WOUT + 1024 * 1024 * 2;
constexpr size_t OFF_KEYS = OFF_WPQ + 2048 * 1024 * 2;
constexpr size_t OFF_U16 = al256(OFF_KEYS + 2 * 128 * 128 * 2);
constexpr size_t OFF_V16 = OFF_U16 + (size_t)16384 * 1024 * 2;
constexpr size_t OFF_H1 = OFF_V16 + (size_t)16384 * 1024 * 2;
constexpr size_t OFF_MIXED = OFF_H1;
constexpr size_t OFF_QH = OFF_H1 + (size_t)NTOK * 1024 * 2;
constexpr size_t SZ_KV = (size_t)2 * 2 * SEQ * 64 * 2;
constexpr size_t OFF_KC = OFF_QH + (size_t)NTOK * 512 * 2;
constexpr size_t OFF_VC = OFF_KC + SZ_KV;
constexpr size_t OFF_KS = OFF_VC + SZ_KV;
constexpr size_t OFF_VST = OFF_KS + SZ_KV;
constexpr size_t OFF_KW = OFF_VST + SZ_KV;
constexpr size_t OFF_VWT = OFF_KW + SZ_KV;
constexpr size_t OFF_GATES = OFF_VWT + SZ_KV;
constexpr size_t OFF_CQ = OFF_GATES + (size_t)NTOK * 24 * 4;
constexpr size_t OFF_CKV = OFF_CQ + (size_t)NTOK * 256 * 2;
constexpr size_t OFF_X2H = OFF_QH;
constexpr size_t OFF_QM = OFF_CKV + (size_t)NTOK * 128 * 2;
constexpr size_t OFF_KM = OFF_QM + (size_t)NTOK * 8 * 96 * 2;
constexpr size_t OFF_VT = OFF_KM + (size_t)NTOK * 8 * 96 * 2;
constexpr size_t OFF_QP = OFF_QM;
constexpr size_t OFF_PD = OFF_QM;
constexpr size_t OFF_COEF = OFF_H1;
constexpr size_t OFF_SSQ = OFF_H1 + (size_t)NTOK * 128 * 4;
constexpr size_t OFF_HC1 = OFF_VT + (size_t)NTOK * 8 * 64 * 2;
constexpr size_t OFF_KCMP = OFF_HC1 + (size_t)8 * 1024 * 256 * 2;
constexpr size_t OFF_VCMPT = OFF_KCMP + (size_t)4 * 1024 * 64 * 2;
constexpr size_t OFF_EID = OFF_VCMPT + (size_t)4 * 1024 * 64 * 2;
constexpr size_t OFF_GW = OFF_EID + (size_t)NTOK * 128 * 4;
constexpr size_t OFF_BAR = OFF_GW + (size_t)NTOK * 128 * 4;
constexpr size_t OFF_ESC = OFF_BAR + 16384;
constexpr size_t WS_NEED = OFF_ESC + 2 * 16384 * 4;

struct Params {
    const float* x; const int* pos; const float* norm1_g; const float* w_in; const float* cmp_pos;
    const float* cmp_k_w1; const float* cmp_k_w2; const float* cmp_v_w1; const float* cmp_v_w2; const float* t5_bias;
    const float* q_norm_g; const float* w_q_up; const float* kv_norm_g; const float* w_kv_up;
    const float* grp_norm_nsa; const float* grp_norm_mla; const float* w_out; const float* norm2_g;
    const float* peer_wq; const float* peer_keys1; const float* peer_keys2; const float* peer_u; const float* peer_v; const float* final_g;
    float* out; char* ws;
};

constexpr int SMEM_BYTES = 67584;
constexpr int NTHREADS = 256;

__device__ __forceinline__ f4v mfma16(h8v a, h8v b, f4v c) { return __builtin_amdgcn_mfma_f32_16x16x32_f16(a, b, c, 0, 0, 0); }
__device__ __forceinline__ f16v mfma32(h8v a, h8v b, f16v c) { return __builtin_amdgcn_mfma_f32_32x32x16_f16(a, b, c, 0, 0, 0); }
__device__ __forceinline__ float wave_sum(float v) {
#pragma unroll
    for (int o = 32; o >= 1; o >>= 1) v += __shfl_xor(v, o);
    return v;
}
__device__ __forceinline__ float gelu_exact(float v) { return 0.5f * v * (1.0f + erff(v * 0.70710678118654752f)); }
__device__ __forceinline__ float fast_exp2(float v) { return __builtin_amdgcn_exp2f(v); }
__device__ __forceinline__ int t5_bucket(int d) {
    if (d < 16) return d < 0 ? 0 : d;
    int b = 16;
    b += (d >= 22); b += (d >= 30); b += (d >= 40); b += (d >= 54); b += (d >= 73); b += (d >= 99); b += (d >= 134); b += (d >= 182);
    b += (d >= 246); b += (d >= 332); b += (d >= 450); b += (d >= 609); b += (d >= 825); b += (d >= 1117); b += (d >= 1513);
    return b;
}

__device__ __forceinline__ unsigned xb_xcc_id();
__device__ __forceinline__ float red8(float v) {
    v += __builtin_bit_cast(float, __builtin_amdgcn_update_dpp(0, __builtin_bit_cast(int, v), 0xB1, 0xF, 0xF, true));
    v += __builtin_bit_cast(float, __builtin_amdgcn_update_dpp(0, __builtin_bit_cast(int, v), 0x4E, 0xF, 0xF, true));
    v += __builtin_bit_cast(float, __builtin_amdgcn_update_dpp(0, __builtin_bit_cast(int, v), 0x141, 0xF, 0xF, true));
    return v;
}

__device__ __forceinline__ void phase_prep(const Params& p, int bid, int nb, char* smem) {
    int tx_ = threadIdx.x; asm volatile("" : "+v"(tx_));
    const long tid = (long)bid * NTHREADS + tx_;
    const long nth = (long)nb * NTHREADS;
    char* ws = p.ws;
    if (tid < 1024) ((unsigned*)(ws + OFF_CTRL))[tid] = 0u;
    {
        float* lut = (float*)(ws + OFF_LUT);
        for (long e = tid; e < 2 * LUTN * 4; e += nth) {
            int r = e & 3, d = (e >> 2) % LUTN, g = (int)(e / (4 * LUTN));
            lut[e] = p.t5_bias[t5_bucket(d) * 8 + g * 4 + r] * LOG2E;
        }
    }
    {
        float* cb = (float*)(ws + OFF_CB);
        for (long e = tid; e < 512; e += nth) {
            int kv = (int)(e >> 8), n = (int)(e & 255);
            const float* w1 = kv ? p.cmp_v_w1 : p.cmp_k_w1;
            float s = 0.f;
            for (int k = 0; k < 2048; ++k) s += p.cmp_pos[k] * w1[(long)k * 256 + n];
            cb[e] = s;
        }
    }
    {
        float (*tl)[65] = (float (*)[65])smem;
        const int tx = tx_;
        const int jt[8] = {0, 448, 496, 528, 656, 784, 1040, 1552};
        for (int tile = bid; tile < 1552; tile += nb) {
            int job = 0;
#pragma unroll
            for (int j = 1; j < 7; ++j) job += (tile >= jt[j]) ? 1 : 0;
            const int lt = tile - jt[job];
            int K, N, ldsrc; const float* src; const float* gain; half_t* dst;
            switch (job) {
                case 0: K = 1024; N = NINP; ldsrc = NIN; src = p.w_in; gain = nullptr; dst = (half_t*)(ws + OFF_WIN); break;
                case 1: K = 256; N = 768; ldsrc = 768; src = p.w_q_up; gain = p.q_norm_g; dst = (half_t*)(ws + OFF_WQUP); break;
                case 2: K = 128; N = 1024; ldsrc = 1024; src = p.w_kv_up; gain = p.kv_norm_g; dst = (half_t*)(ws + OFF_WKVUP); break;
                case 3: K = 2048; N = 256; ldsrc = 256; src = p.cmp_k_w1; gain = nullptr; dst = (half_t*)(ws + OFF_WC1); break;
                case 4: K = 2048; N = 256; ldsrc = 256; src = p.cmp_v_w1; gain = nullptr; dst = (half_t*)(ws + OFF_WC1) + 256L * 2048; break;
                case 5: K = 1024; N = 1024; ldsrc = 1024; src = p.w_out; gain = nullptr; dst = (half_t*)(ws + OFF_WOUT); break;
                default: K = 1024; N = 2048; ldsrc = 2048; src = p.peer_wq; gain = p.norm2_g; dst = (half_t*)(ws + OFF_WPQ); break;
            }
            const int ntn = N >> 6;
            const int k0 = (lt / ntn) * 64, n0 = (lt % ntn) * 64;
            {
                const int r = tx >> 4, c4 = (tx & 15) * 4;
                const int n = n0 + c4;
                int sc = n;
                if (job == 0) {
                    if (n < 1280) sc = n;
                    else if (n < 1536) sc = 1304 + (n - 1280);
                    else if (n < 1664) sc = 1560 + (n - 1536);
                    else if (n < 1696) sc = 1688 + (n - 1664);
                    else if (n < 1720) sc = 1280 + (n - 1696);
                    else sc = -1;
                }
#pragma unroll
                for (int i = 0; i < 4; ++i) {
                    const int k = k0 + r + 16 * i;
                    float4 v = make_float4(0.f, 0.f, 0.f, 0.f);
                    if (sc >= 0) v = *(const float4*)(src + (long)k * ldsrc + sc);
                    float gk = 1.0f;
                    if (gain) gk = gain[k];
                    if (job == 5) gk = (k < 512) ? p.grp_norm_nsa[k] : p.grp_norm_mla[k - 512];
                    tl[r + 16 * i][c4] = v.x * gk; tl[r + 16 * i][c4 + 1] = v.y * gk; tl[r + 16 * i][c4 + 2] = v.z * gk; tl[r + 16 * i][c4 + 3] = v.w * gk;
                }
            }
            __syncthreads();
            {
                const int nl = tx >> 2, kq = (tx & 3) * 16;
                h8v o0, o1;
#pragma unroll
                for (int j = 0; j < 8; ++j) { o0[j] = (half_t)tl[kq + j][nl]; o1[j] = (half_t)tl[kq + 8 + j][nl]; }
                half_t* d = dst + (long)(n0 + nl) * K + k0 + kq;
                *(h8v*)d = o0; *(h8v*)(d + 8) = o1;
            }
            __syncthreads();
        }
    }
    {
        half_t* W = (half_t*)(ws + OFF_KEYS);
        for (long e = tid; e < 2 * 16384; e += nth) {
            W[e] = (half_t)(e < 16384 ? p.peer_keys1[e] : p.peer_keys2[e - 16384]);
        }
    }
    {
        unsigned char* U4 = (unsigned char*)(ws + OFF_U16);
        unsigned char* V4 = (unsigned char*)(ws + OFF_V16);
        float* ESC = (float*)(ws + OFF_ESC);
        const int ln = tx_ & 63;
        const long wv = tid >> 6, nwv = nth >> 6;
        for (long job = wv; job < 2L * 16384; job += nwv) {
            const int tbl = (int)(job >> 14), e = (int)(job & 16383);
            const float4* src = (const float4*)((tbl ? p.peer_v : p.peer_u) + (long)e * 1024 + 16 * ln);
            float4 a[4]; float amax = 0.f;
#pragma unroll
            for (int i = 0; i < 4; ++i) { a[i] = src[i]; amax = fmaxf(amax, fmaxf(fmaxf(fabsf(a[i].x), fabsf(a[i].y)), fmaxf(fabsf(a[i].z), fabsf(a[i].w)))); }
#pragma unroll
            for (int o = 32; o >= 1; o >>= 1) amax = fmaxf(amax, __shfl_xor(amax, o));
            const float sc = (amax > 0.f) ? exp2f(ceilf(log2f(amax * (1.0f / 6.0f)))) : 1.0f;
            const float inv = 1.0f / sc;
            unsigned w0 = 0u, w1 = 0u;
            w0 = __builtin_amdgcn_cvt_scalef32_pk_fp4_f32(w0, a[0].x * inv, a[0].y * inv, 1.0f, 0);
            w0 = __builtin_amdgcn_cvt_scalef32_pk_fp4_f32(w0, a[0].z * inv, a[0].w * inv, 1.0f, 1);
            w0 = __builtin_amdgcn_cvt_scalef32_pk_fp4_f32(w0, a[1].x * inv, a[1].y * inv, 1.0f, 2);
            w0 = __builtin_amdgcn_cvt_scalef32_pk_fp4_f32(w0, a[1].z * inv, a[1].w * inv, 1.0f, 3);
            w1 = __builtin_amdgcn_cvt_scalef32_pk_fp4_f32(w1, a[2].x * inv, a[2].y * inv, 1.0f, 0);
            w1 = __builtin_amdgcn_cvt_scalef32_pk_fp4_f32(w1, a[2].z * inv, a[2].w * inv, 1.0f, 1);
            w1 = __builtin_amdgcn_cvt_scalef32_pk_fp4_f32(w1, a[3].x * inv, a[3].y * inv, 1.0f, 2);
            w1 = __builtin_amdgcn_cvt_scalef32_pk_fp4_f32(w1, a[3].z * inv, a[3].w * inv, 1.0f, 3);
            unsigned char* dst = (tbl ? V4 : U4) + (((long)(ln >> 4) * 16384 + e) * 128) + (ln & 15) * 8;
            *(u2v*)dst = (u2v){w0, w1};
            if (ln == 0) ESC[tbl * 16384 + e] = sc;
        }
    }
    {
        half_t* H1 = (half_t*)(ws + OFF_H1);
        const int lane = threadIdx.x & 63;
        const long wv = tid >> 6, nwv = nth >> 6;
        for (long row = wv; row < NTOK; row += nwv) {
            const float4* xr = (const float4*)(p.x + row * 1024);
            float4 v[4]; float ss = 0.f;
#pragma unroll
            for (int i = 0; i < 4; ++i) { v[i] = xr[lane + 64 * i]; ss += v[i].x * v[i].x + v[i].y * v[i].y + v[i].z * v[i].z + v[i].w * v[i].w; }
            ss = wave_sum(ss);
            const float rs = rsqrtf(ss * (1.0f / 1024.f) + EPS);
#pragma unroll
            for (int i = 0; i < 4; ++i) {
                float4 g = ((const float4*)p.norm1_g)[lane + 64 * i];
                h4v o = {(half_t)(v[i].x * rs * g.x), (half_t)(v[i].y * rs * g.y), (half_t)(v[i].z * rs * g.z), (half_t)(v[i].w * rs * g.w)};
                ((h4v*)(H1 + row * 1024))[lane + 64 * i] = o;
            }
        }
    }
}

constexpr int GEMM_RS_OFF = 66560;
template <bool SCALE, bool SWAP, class Epi>
__device__ __forceinline__ void gemm_tile(const half_t* __restrict__ A, long lda, const half_t* __restrict__ Bt, long ldb, int K, int ksplit, char* smem_raw, Epi epi) {
    half_t* sA = (half_t*)smem_raw;
    half_t* sB = (half_t*)(smem_raw + 32768);
    float* rs0 = (float*)(smem_raw + GEMM_RS_OFF);
    int tid_ = threadIdx.x; asm volatile("" : "+v"(tid_));
    const int tid = tid_, lane = tid & 63, w = tid >> 6, wm = w >> 1, wn = w & 1;
    const int i16 = lane & 15, g4 = lane >> 4;
    const int lr = tid >> 3, off = tid & 7;
    if (SCALE) {
        const int rg = lane >> 3, ch = lane & 7;
        const int ncg = K >> 6, cgs = ksplit >> 6;
#pragma unroll 1
        for (int rr = 0; rr < 4; ++rr) {
            const int row = w * 32 + rr * 8 + rg;
            const half_t* ap = A + (long)row * lda + ch * 8;
            float s0 = 0.f, s1 = 0.f;
#pragma unroll 8
            for (int cg = 0; cg < ncg; ++cg) {
                const h8v v = *(const h8v*)(ap + cg * 64);
                float d = 0.f;
#pragma unroll
                for (int j = 0; j < 4; ++j) d = __builtin_amdgcn_fdot2((h2v){v[2 * j], v[2 * j + 1]}, (h2v){v[2 * j], v[2 * j + 1]}, d, false);
                if (cg < cgs) s0 += d; else s1 += d;
            }
            s0 = red8(s0); s1 = red8(s1);
            if (ch == 0) {
                rs0[row] = rsqrtf(s0 / (float)ksplit + EPS);
                if (ksplit < K) rs0[128 + row] = rsqrtf(s1 / (float)(K - ksplit) + EPS);
            }
        }
    }
    f4v acc[4][4];
#pragma unroll
    for (int a = 0; a < 4; ++a)
#pragma unroll
        for (int b = 0; b < 4; ++b) acc[a][b] = (f4v){0.f, 0.f, 0.f, 0.f};
    const int nk = K >> 6;
    const int srow = w * 32 + (lane >> 3);
    const int schunk = ((lane & 7) ^ ((lane >> 3) & 7)) << 3;
    const half_t* gA = A + (long)srow * lda + schunk;
    const half_t* gB = Bt + (long)srow * ldb + schunk;
    auto issue = [&](int k0, int stage) __attribute__((always_inline)) {
#pragma unroll
        for (int g = 0; g < 4; ++g) {
            __builtin_amdgcn_global_load_lds((const __attribute__((address_space(1))) void*)(gA + (long)(g * 8) * lda + k0),
                                             (__attribute__((address_space(3))) void*)(sA + stage * 8192 + (w * 32 + g * 8) * 64), 16, 0, 0);
            __builtin_amdgcn_global_load_lds((const __attribute__((address_space(1))) void*)(gB + (long)(g * 8) * ldb + k0),
                                             (__attribute__((address_space(3))) void*)(sB + stage * 8192 + (w * 32 + g * 8) * 64), 16, 0, 0);
        }
    };
    issue(0, 0);
    __syncthreads();
#pragma unroll 1
    for (int kt = 0; kt < nk; ++kt) {
        const int cur = (kt & 1) * 8192;
        if (kt + 1 < nk) issue((kt + 1) * 64, (kt + 1) & 1);
        if (SCALE && kt * 64 == ksplit) {
#pragma unroll
            for (int mi = 0; mi < 4; ++mi) {
                if (SWAP) {
                    const int row = wm * 64 + mi * 16 + i16;
                    const float ratio = rs0[row] / rs0[128 + row];
#pragma unroll
                    for (int ni = 0; ni < 4; ++ni) acc[mi][ni] *= ratio;
                } else {
#pragma unroll
                    for (int r = 0; r < 4; ++r) {
                        const int row = wm * 64 + mi * 16 + g4 * 4 + r;
                        const float ratio = rs0[row] / rs0[128 + row];
#pragma unroll
                        for (int ni = 0; ni < 4; ++ni) acc[mi][ni][r] *= ratio;
                    }
                }
            }
        }
#pragma unroll
        for (int kk = 0; kk < 2; ++kk) {
            const int cofs = (((kk * 4 + g4) ^ (i16 & 7)) << 3);
            h8v af[4], bf[4];
#pragma unroll
            for (int mi = 0; mi < 4; ++mi) af[mi] = *(const h8v*)(sA + cur + (wm * 64 + mi * 16 + i16) * 64 + cofs);
#pragma unroll
            for (int ni = 0; ni < 4; ++ni) bf[ni] = *(const h8v*)(sB + cur + (wn * 64 + ni * 16 + i16) * 64 + cofs);
#pragma unroll
            for (int mi = 0; mi < 4; ++mi)
#pragma unroll
                for (int ni = 0; ni < 4; ++ni) acc[mi][ni] = SWAP ? mfma16(bf[ni], af[mi], acc[mi][ni]) : mfma16(af[mi], bf[ni], acc[mi][ni]);
        }
        __syncthreads();
    }
    if (SCALE) {
        const int fin = (ksplit < K) ? 128 : 0;
#pragma unroll
        for (int mi = 0; mi < 4; ++mi) {
            if (SWAP) {
                const float rsv = rs0[fin + wm * 64 + mi * 16 + i16];
#pragma unroll
                for (int ni = 0; ni < 4; ++ni) acc[mi][ni] *= rsv;
            } else {
#pragma unroll
                for (int r = 0; r < 4; ++r) {
                    const float rsv = rs0[fin + wm * 64 + mi * 16 + g4 * 4 + r];
#pragma unroll
                    for (int ni = 0; ni < 4; ++ni) acc[mi][ni][r] *= rsv;
                }
            }
        }
    }
    epi(acc, wm, wn, i16, g4);
    __syncthreads();
}

__device__ __forceinline__ void rope_pair(float x1, float x2, int pos, int i, float& o1, float& o2) {
    const float inv = __builtin_amdgcn_exp2f(-(float)i * (13.287712379549449f / 16.0f));
    double t = (double)pos * (double)inv * 0.15915494309189535;
    t -= __builtin_rint(t);
    const float fr = (float)t;
    const float sn = __builtin_amdgcn_sinf(fr), cs = __builtin_amdgcn_cosf(fr);
    o1 = x1 * cs - x2 * sn; o2 = x1 * sn + x2 * cs;
}

__device__ __forceinline__ void phase_inproj(const Params& p, int bid, int nb, char* smem) {
    char* ws = p.ws;
    const half_t* H1 = (const half_t*)(ws + OFF_H1);
    const half_t* W = (const half_t*)(ws + OFF_WIN);
    half_t* QH = (half_t*)(ws + OFF_QH);
    half_t* KM = (half_t*)(ws + OFF_KM);
    half_t* CQ = (half_t*)(ws + OFF_CQ);
    half_t* CKV = (half_t*)(ws + OFF_CKV);
    float* GATES = (float*)(ws + OFF_GATES);
    const int NT_N = NINP / 128, NT_M = NTOK / 128;
    for (int tile = bid; tile < NT_M * NT_N; tile += nb) {
        const int tm = tile / NT_N, tn = tile % NT_N;
        const int row0 = tm * 128, n0 = tn * 128;
        const half_t* Ap = H1 + (long)row0 * 1024;
        const half_t* Bp = W + (long)n0 * 1024;
        if (tn == 7 || tn == 9) {
            gemm_tile<false, false>(Ap, 1024, Bp, 1024, 1024, 1024, smem,
                [&](f4v (&acc)[4][4], int wm, int wn, int i16, int g4) __attribute__((always_inline)) {
                    half_t* base = (half_t*)(ws + (tn == 7 ? OFF_VST : OFF_VWT));
#pragma unroll
                    for (int ni = 0; ni < 4; ++ni) {
                        const int c = wn * 64 + ni * 16 + i16, gg = c >> 6, d = c & 63;
#pragma unroll
                        for (int mi = 0; mi < 4; ++mi) {
                            const int rbase = row0 + wm * 64 + mi * 16 + g4 * 4;
                            const int b = rbase >> 14, s0 = rbase & (SEQ - 1);
                            const h4v o = {(half_t)acc[mi][ni][0], (half_t)acc[mi][ni][1], (half_t)acc[mi][ni][2], (half_t)acc[mi][ni][3]};
                            *(h4v*)(base + ((long)((b * 2 + gg) * 64 + d)) * SEQ + s0) = o;
                        }
                    }
                });
        } else {
            gemm_tile<false, true>(Ap, 1024, Bp, 1024, 1024, 1024, smem,
                [&](f4v (&acc)[4][4], int wm, int wn, int i16, int g4) __attribute__((always_inline)) {
#pragma unroll
                    for (int mi = 0; mi < 4; ++mi) {
                        const int t = row0 + wm * 64 + mi * 16 + i16;
                        const int b = t >> 14, sq = t & (SEQ - 1);
#pragma unroll
                        for (int ni = 0; ni < 4; ++ni) {
                            const int cb = n0 + wn * 64 + ni * 16;
                            const int n = cb + 4 * g4;
                            const f4v a = acc[mi][ni];
                            if (cb < 512) {
                                const h4v o = {(half_t)(a[0] * QS_NSA), (half_t)(a[1] * QS_NSA), (half_t)(a[2] * QS_NSA), (half_t)(a[3] * QS_NSA)};
                                *(h4v*)(QH + (long)t * 512 + n) = o;
                            } else if (cb < 1280) {
                                const int which = (cb - 512) >> 7;
                                const int c = (n - 512) & 127, gg = c >> 6, d = c & 63;
                                half_t* base = (half_t*)(ws + OFF_KC + (size_t)which * SZ_KV);
                                const h4v o = {(half_t)a[0], (half_t)a[1], (half_t)a[2], (half_t)a[3]};
                                *(h4v*)(base + ((long)(b * 2 + gg) * SEQ + sq) * 64 + d) = o;
                            } else if (cb < 1536) {
                                const h4v o = {(half_t)a[0], (half_t)a[1], (half_t)a[2], (half_t)a[3]};
                                *(h4v*)(CQ + (long)t * 256 + (n - 1280)) = o;
                            } else if (cb < 1664) {
                                const h4v o = {(half_t)a[0], (half_t)a[1], (half_t)a[2], (half_t)a[3]};
                                *(h4v*)(CKV + (long)t * 128 + (n - 1536)) = o;
                            } else if (cb == 1664) {
                                const f4v a2 = acc[mi][(ni + 1) & 3];
                                h4v o1, o2;
                                const int pos = p.pos[t];
#pragma unroll
                                for (int r = 0; r < 4; ++r) {
                                    float x1, x2;
                                    rope_pair(a[r], a2[r], pos, 4 * g4 + r, x1, x2);
                                    o1[r] = (half_t)x1; o2[r] = (half_t)x2;
                                }
#pragma unroll
                                for (int h = 0; h < 8; ++h) {
                                    half_t* kr = KM + ((long)(b * 8 + h) * SEQ + sq) * 96 + 64 + 4 * g4;
                                    *(h4v*)kr = o1; *(h4v*)(kr + 16) = o2;
                                }
                            } else if (cb >= 1696) {
                                const int j = n - 1696;
                                if (j < 24) {
                                    float4 o;
                                    o.x = 1.0f / (1.0f + __expf(-a[0])); o.y = 1.0f / (1.0f + __expf(-a[1]));
                                    o.z = 1.0f / (1.0f + __expf(-a[2])); o.w = 1.0f / (1.0f + __expf(-a[3]));
                                    *(float4*)(GATES + (long)t * 24 + j) = o;
                                }
                            }
                        }
                    }
                });
        }
    }
}

__device__ __forceinline__ void phase_p2(const Params& p, int bid, int nb, char* smem) {
    char* ws = p.ws;
    const int NTA = 256 * 6, NTB = 256 * 8, NTC = 128;
    for (int tile = bid; tile < NTA + NTB + NTC; tile += nb) {
        if (tile < NTC) {
            const int nt = tile & 1, mt = (tile >> 1) & 7, bg = (tile >> 4) & 3, kv = tile >> 6;
            const half_t* A = (const half_t*)(ws + (kv ? OFF_VC : OFF_KC)) + (long)bg * SEQ * 64 + (long)mt * 128 * 1024;
            const half_t* Bt = (const half_t*)(ws + OFF_WC1) + ((long)kv * 256 + nt * 128) * 2048;
            const float* cbv = (const float*)(ws + OFF_CB) + kv * 256;
            half_t* HC = (half_t*)(ws + OFF_HC1) + ((long)(kv * 4 + bg) * 1024) * 256;
            gemm_tile<false, true>(A, 1024, Bt, 2048, 2048, 2048, smem,
                [&](f4v (&acc)[4][4], int wm, int wn, int i16, int g4) __attribute__((always_inline)) {
#pragma unroll
                    for (int mi = 0; mi < 4; ++mi) {
                        const int m = mt * 128 + wm * 64 + mi * 16 + i16;
#pragma unroll
                        for (int ni = 0; ni < 4; ++ni) {
                            const int n = nt * 128 + wn * 64 + ni * 16 + 4 * g4;
                            const float4 bias = *(const float4*)(cbv + n);
                            const h4v o = {(half_t)gelu_exact(acc[mi][ni][0] + bias.x), (half_t)gelu_exact(acc[mi][ni][1] + bias.y),
                                           (half_t)gelu_exact(acc[mi][ni][2] + bias.z), (half_t)gelu_exact(acc[mi][ni][3] + bias.w)};
                            if (m < NCMP) *(h4v*)(HC + (long)m * 256 + n) = o;
                        }
                    }
                });
        } else if (tile < NTC + NTA) {
            const int t2 = tile - NTC;
            const int tm = t2 / 6, tn = t2 % 6;
            const int row0 = tm * 128, n0 = tn * 128;
            half_t* QM = (half_t*)(ws + OFF_QM);
            gemm_tile<true, true>((const half_t*)(ws + OFF_CQ) + (long)row0 * 256, 256, (const half_t*)(ws + OFF_WQUP) + (long)n0 * 256, 256, 256, 256, smem,
                [&](f4v (&acc)[4][4], int wm, int wn, int i16, int g4) __attribute__((always_inline)) {
#pragma unroll
                    for (int mi = 0; mi < 4; ++mi) {
                        const int t = row0 + wm * 64 + mi * 16 + i16;
                        const int b = t >> 14, sq = t & (SEQ - 1);
#pragma unroll
                        for (int ni = 0; ni < 4; ++ni) {
                            const int cb = n0 + wn * 64 + ni * 16;
                            const int h = cb / 96, d0 = cb - h * 96;
                            half_t* qr = QM + ((long)(b * 8 + h) * SEQ + sq) * 96;
                            const f4v a = acc[mi][ni];
                            if (d0 < 64) {
                                const h4v o = {(half_t)(a[0] * QS_MLA), (half_t)(a[1] * QS_MLA), (half_t)(a[2] * QS_MLA), (half_t)(a[3] * QS_MLA)};
                                *(h4v*)(qr + d0 + 4 * g4) = o;
                            } else if (d0 == 64) {
                                const f4v a2 = acc[mi][(ni + 1) & 3];
                                const int pos = p.pos[t];
                                h4v o1, o2;
#pragma unroll
                                for (int r = 0; r < 4; ++r) {
                                    float x1, x2;
                                    rope_pair(a[r] * QS_MLA, a2[r] * QS_MLA, pos, 4 * g4 + r, x1, x2);
                                    o1[r] = (half_t)x1; o2[r] = (half_t)x2;
                                }
                                *(h4v*)(qr + 64 + 4 * g4) = o1; *(h4v*)(qr + 80 + 4 * g4) = o2;
                            }
                        }
                    }
                });
        } else {
            const int t2 = tile - NTC - NTA;
            const int tm = t2 >> 3, tn = t2 & 7;
            const int row0 = tm * 128, n0 = tn * 128;
            half_t* KM = (half_t*)(ws + OFF_KM);
            half_t* VT = (half_t*)(ws + OFF_VT);
            gemm_tile<true, false>((const half_t*)(ws + OFF_CKV) + (long)row0 * 128, 128, (const half_t*)(ws + OFF_WKVUP) + (long)n0 * 128, 128, 128, 128, smem,
                [&](f4v (&acc)[4][4], int wm, int wn, int i16, int g4) __attribute__((always_inline)) {
                    const int h = tn;
#pragma unroll
                    for (int ni = 0; ni < 4; ++ni) {
                        const int d0 = wn * 64 + ni * 16;
#pragma unroll
                        for (int mi = 0; mi < 4; ++mi) {
                            const int rbase = row0 + wm * 64 + mi * 16 + g4 * 4;
                            const int b = rbase >> 14, s0 = rbase & (SEQ - 1);
                            if (d0 < 64) {
#pragma unroll
                                for (int r = 0; r < 4; ++r) KM[((long)(b * 8 + h) * SEQ + s0 + r) * 96 + d0 + i16] = (half_t)acc[mi][ni][r];
                            } else {
                                const h4v o = {(half_t)acc[mi][ni][0], (half_t)acc[mi][ni][1], (half_t)acc[mi][ni][2], (half_t)acc[mi][ni][3]};
                                *(h4v*)(VT + ((long)(b * 8 + h) * 64 + (d0 - 64 + i16)) * SEQ + s0) = o;
                            }
                        }
                    }
                });
        }
    }
}

constexpr int KMAX_KS = 128, KMAX_KW = 132, KMAX_KC = 136, KMAX_KM = 140, KMAX_BIAS = 156;
__device__ __forceinline__ void phase_cmp2(const Params& p, int bid, int nb) {
    char* ws = p.ws;
    unsigned* ctr = (unsigned*)(ws + OFF_CTRL);
    int tx_ = threadIdx.x; asm volatile("" : "+v"(tx_));
    const long tid = (long)bid * NTHREADS + tx_, nth = (long)nb * NTHREADS;
    const int lane = tx_ & 63;
    const half_t* HC = (const half_t*)(ws + OFF_HC1);
    half_t* KC = (half_t*)(ws + OFF_KCMP);
    half_t* VCT = (half_t*)(ws + OFF_VCMPT);
    for (long e = tid; e < 2L * 4 * 1024 * 64; e += nth) {
        const int d = (int)(e & 63), n = (int)((e >> 6) & 1023), bg = (int)((e >> 16) & 3), kv = (int)(e >> 18);
        float s = 0.f;
        if (n < NCMP) {
            const half_t* hr = HC + ((long)(kv * 4 + bg) * 1024 + n) * 256;
            const float* w2 = kv ? p.cmp_v_w2 : p.cmp_k_w2;
            for (int j = 0; j < 256; ++j) s += (float)hr[j] * w2[j * 64 + d];
        }
        const half_t sh = (half_t)s;
        if (kv == 0) {
            KC[((long)bg * 1024 + n) * 64 + d] = sh;
            const float nn = wave_sum((float)sh * (float)sh);
            if (lane == 0) atomicMax(&ctr[KMAX_KC + bg], __float_as_uint(nn));
        } else VCT[((long)bg * 64 + d) * 1024 + n] = sh;
    }
    {
        const int sub = lane & 7;
        const long grp = tid >> 3, ngrp = nth >> 3;
        for (int which = 0; which < 2; ++which) {
            const half_t* Kb = (const half_t*)(ws + (which ? OFF_KW : OFF_KS));
            float mx[4] = {0.f, 0.f, 0.f, 0.f};
            for (long row = grp; row < 4L * SEQ; row += ngrp) {
                const h8v v = *(const h8v*)(Kb + row * 64 + sub * 8);
                float d = 0.f;
#pragma unroll
                for (int j = 0; j < 4; ++j) d = __builtin_amdgcn_fdot2((h2v){v[2 * j], v[2 * j + 1]}, (h2v){v[2 * j], v[2 * j + 1]}, d, false);
                d = red8(d);
                const int bg = (int)(row >> 14);
#pragma unroll
                for (int q = 0; q < 4; ++q) mx[q] = (bg == q) ? fmaxf(mx[q], d) : mx[q];
            }
#pragma unroll
            for (int q = 0; q < 4; ++q) {
                float m = mx[q];
#pragma unroll
                for (int o = 32; o >= 1; o >>= 1) m = fmaxf(m, __shfl_xor(m, o));
                if (lane == 0 && m > 0.f) atomicMax(&ctr[(which ? KMAX_KW : KMAX_KS) + q], __float_as_uint(m));
            }
        }
        const half_t* Km = (const half_t*)(ws + OFF_KM);
        const long wv = tid >> 6, nwv = nth >> 6;
        for (long blk = wv; blk < 16L * SEQ / 64; blk += nwv) {
            const int bh = (int)(blk / (SEQ / 64));
            float mloc = 0.f;
#pragma unroll 1
            for (int rr = 0; rr < 8; ++rr) {
                const long row = blk * 64 + rr * 8 + (lane >> 3);
                const half_t* kr = Km + row * 96 + sub * 8;
                float d = 0.f;
                {
                    const h8v v = *(const h8v*)kr;
#pragma unroll
                    for (int j = 0; j < 4; ++j) d = __builtin_amdgcn_fdot2((h2v){v[2 * j], v[2 * j + 1]}, (h2v){v[2 * j], v[2 * j + 1]}, d, false);
                }
                if (sub < 4) {
                    const h8v v = *(const h8v*)(kr + 64);
#pragma unroll
                    for (int j = 0; j < 4; ++j) d = __builtin_amdgcn_fdot2((h2v){v[2 * j], v[2 * j + 1]}, (h2v){v[2 * j], v[2 * j + 1]}, d, false);
                }
                d = red8(d);
                mloc = fmaxf(mloc, d);
            }
#pragma unroll
            for (int o = 32; o >= 1; o >>= 1) mloc = fmaxf(mloc, __shfl_xor(mloc, o));
            if (lane == 0) atomicMax(&ctr[KMAX_KM + bh], __float_as_uint(mloc));
        }
    }
    if (tid == 0) {
        float mb = 0.f;
        for (int i = 0; i < 256; ++i) mb = fmaxf(mb, p.t5_bias[i] * LOG2E);
        ctr[KMAX_BIAS] = __float_as_uint(mb);
    }
}

struct MlaSmem { half_t K[2][64][104]; half_t V[2][64][68]; };

__device__ __forceinline__ void mla_item(const Params& p, int bh, int qb, char* smem) {
    MlaSmem& sm = *(MlaSmem*)smem;
    char* ws = p.ws;
    const int b = bh >> 3, h = bh & 7;
    const half_t* Qp = (const half_t*)(ws + OFF_QM) + ((long)bh * SEQ + qb * 128) * 96;
    const half_t* Kp = (const half_t*)(ws + OFF_KM) + (long)bh * SEQ * 96;
    const half_t* Vp = (const half_t*)(ws + OFF_VT) + (long)bh * 64 * SEQ;
    half_t* MIX = (half_t*)(ws + OFF_MIXED);
    int tid_ = threadIdx.x; asm volatile("" : "+v"(tid_));
    const int tid = tid_, lane = tid & 63, w = tid >> 6;
    const int c = lane & 31, hh = lane >> 5;
    const int tq = qb * 128 + w * 32 + c;
    h8v qf[6];
#pragma unroll
    for (int s6 = 0; s6 < 6; ++s6) qf[s6] = *(const h8v*)(Qp + (long)(w * 32 + c) * 96 + s6 * 16 + hh * 8);
    f16v o0, o1;
#pragma unroll
    for (int i = 0; i < 16; ++i) { o0[i] = 0.f; o1[i] = 0.f; }
    float qn2 = 0.f;
#pragma unroll
    for (int s6 = 0; s6 < 6; ++s6)
#pragma unroll
        for (int j = 0; j < 8; ++j) { const float f = (float)qf[s6][j]; qn2 += f * f; }
    qn2 += __shfl_xor(qn2, 32);
    const float kmax2 = __uint_as_float(((const unsigned*)(ws + OFF_CTRL))[KMAX_KM + bh]);
    const float nmref = 10.0f - sqrtf(qn2 * kmax2) * 1.0005f;
    float l = 0.f;
    const int ntiles = 2 * qb + 2;
    auto gload = [&](int j, u4v (&rk)[3], u4v (&rv)[2]) __attribute__((always_inline)) {
#pragma unroll
        for (int i = 0; i < 3; ++i) {
            const int ci = tid + 256 * i, key = ci / 12, of = ci % 12;
            rk[i] = *(const u4v*)(Kp + (long)(j * 64 + key) * 96 + of * 8);
        }
#pragma unroll
        for (int i = 0; i < 2; ++i) {
            const int ci = tid + 256 * i, dim = ci >> 3, of = ci & 7;
            rv[i] = *(const u4v*)(Vp + (long)dim * SEQ + j * 64 + of * 8);
        }
    };
    auto lstore = [&](int buf, const u4v (&rk)[3], const u4v (&rv)[2]) __attribute__((always_inline)) {
#pragma unroll
        for (int i = 0; i < 3; ++i) {
            const int ci = tid + 256 * i, key = ci / 12, of = ci % 12;
            *(u4v*)&sm.K[buf][key][of * 8] = rk[i];
        }
#pragma unroll
        for (int i = 0; i < 2; ++i) {
            const int ci = tid + 256 * i, dim = ci >> 3, of = ci & 7;
            *(u2v*)&sm.V[buf][dim][of * 8] = (u2v){rv[i][0], rv[i][1]};
            *(u2v*)&sm.V[buf][dim][of * 8 + 4] = (u2v){rv[i][2], rv[i][3]};
        }
    };
    const int qmin = qb * 128 + w * 32;
    auto compute = [&](int j, int buf) __attribute__((always_inline)) {
        if (64 * j <= qmin + 31) {
            f16v s0, s1;
#pragma unroll
            for (int i = 0; i < 16; ++i) { s0[i] = nmref; s1[i] = nmref; }
#pragma unroll
            for (int s6 = 0; s6 < 6; ++s6) {
                const h8v a0 = *(const h8v*)&sm.K[buf][c][s6 * 16 + hh * 8];
                const h8v a1 = *(const h8v*)&sm.K[buf][32 + c][s6 * 16 + hh * 8];
                s0 = mfma32(a0, qf[s6], s0);
                s1 = mfma32(a1, qf[s6], s1);
            }
            if (64 * j + 63 > qmin) {
#pragma unroll
                for (int r = 0; r < 16; ++r) {
                    const int key = 64 * j + (r & 3) + 8 * (r >> 2) + 4 * hh;
                    if (key > tq) s0[r] = NEGF;
                    if (key + 32 > tq) s1[r] = NEGF;
                }
            }
#pragma unroll
            for (int r = 0; r < 16; ++r) { s0[r] = fast_exp2(s0[r]); l += s0[r]; }
#pragma unroll
            for (int r = 0; r < 16; ++r) { s1[r] = fast_exp2(s1[r]); l += s1[r]; }
#pragma unroll
            for (int ks = 0; ks < 4; ++ks) {
                h8v pb;
#pragma unroll
                for (int jj = 0; jj < 8; ++jj) pb[jj] = (half_t)((ks < 2) ? s0[8 * (ks & 1) + jj] : s1[8 * (ks & 1) + jj]);
#pragma unroll
                for (int md = 0; md < 2; ++md) {
                    const h4v lo = *(const h4v*)&sm.V[buf][32 * md + c][16 * ks + 4 * hh];
                    const h4v hi = *(const h4v*)&sm.V[buf][32 * md + c][16 * ks + 8 + 4 * hh];
                    const h8v a = {lo[0], lo[1], lo[2], lo[3], hi[0], hi[1], hi[2], hi[3]};
                    if (md == 0) o0 = mfma32(a, pb, o0); else o1 = mfma32(a, pb, o1);
                }
            }
        }
    };
    u4v rkA[3], rvA[2], rkB[3], rvB[2];
    gload(0, rkA, rvA);
    gload(1, rkB, rvB);
    lstore(0, rkA, rvA);
    __syncthreads();
#pragma unroll 1
    for (int j = 0; j < ntiles; j += 2) {
        if (j + 2 < ntiles) gload(j + 2, rkA, rvA);
        compute(j, 0);
        lstore(1, rkB, rvB);
        __syncthreads();
        if (j + 3 < ntiles) gload(j + 3, rkB, rvB);
        compute(j + 1, 1);
        if (j + 2 < ntiles) lstore(0, rkA, rvA);
        __syncthreads();
    }
    const float lt = l + __shfl_xor(l, 32);
    const float inv = 1.0f / lt;
    half_t* orow = MIX + (long)(b * SEQ + tq) * 1024 + 512 + h * 64;
#pragma unroll
    for (int md = 0; md < 2; ++md)
#pragma unroll
        for (int rg = 0; rg < 4; ++rg) {
            h4v o;
#pragma unroll
            for (int e = 0; e < 4; ++e) o[e] = (half_t)(((md == 0) ? o0[4 * rg + e] : o1[4 * rg + e]) * inv);
            *(h4v*)(orow + 32 * md + 8 * rg + 4 * hh) = o;
        }
}

struct NsaStage { half_t K[64][72]; half_t V[64][68]; };
constexpr int NSA_LUT = 0;
constexpr int NSA_ST0 = 12288;
constexpr int NSA_RB = NSA_ST0 + 17920;
constexpr int NSA_SEL = NSA_RB + 32768;
constexpr int NSA_MASK = NSA_SEL + 2048;
constexpr int NSA_END = NSA_MASK + 1024;
constexpr float MINIT = -30000.0f;

__device__ __forceinline__ void nsa_item(const Params& p, int bg, int qt, char* smem) {
    char* ws = p.ws;
    half_t* lut = (half_t*)(smem + NSA_LUT);
    float (*imp)[8][256] = (float (*)[8][256])(smem + NSA_RB);
    int (*sel)[8][16] = (int (*)[8][16])(smem + NSA_SEL);
    unsigned* masks = (unsigned*)(smem + NSA_MASK);
    const int b = bg >> 1, g = bg & 1;
    int tid_ = threadIdx.x; asm volatile("" : "+v"(tid_));
    const int tid = tid_, lane = tid & 63, w = tid >> 6;
    const int c = lane & 31, hh = lane >> 5;
    const int qi = c >> 2, r = c & 3;
    const int t0 = qt * 32;
    const int t0w = t0 + w * 8;
    const int tq = t0w + qi;
    const int tlast = t0w + 7;
    {
        const float* lg = (const float*)(ws + OFF_LUT) + (long)g * LUTN * 4;
        for (int i = tid; i < LUTN * 4; i += NTHREADS) lut[i] = (half_t)lg[i];
        float* im = &imp[0][0][0];
        for (int i = tid; i < 4 * 8 * 256; i += NTHREADS) im[i] = 0.f;
    }
    __syncthreads();
    const float cfar = (float)lut[(LUTN - 1) * 4 + r];
    const half_t* QH = (const half_t*)(ws + OFF_QH);
    h8v qf[4];
#pragma unroll
    for (int s4 = 0; s4 < 4; ++s4) qf[s4] = *(const h8v*)(QH + (long)(b * SEQ + tq) * 512 + (g * 4 + r) * 64 + s4 * 16 + hh * 8);
    float nrefC, nrefS, nrefW;
    {
        float qn2 = 0.f;
#pragma unroll
        for (int s4 = 0; s4 < 4; ++s4)
#pragma unroll
            for (int j = 0; j < 8; ++j) { const float f = (float)qf[s4][j]; qn2 += f * f; }
        qn2 += __shfl_xor(qn2, 32);
        const unsigned* cw = (const unsigned*)(ws + OFF_CTRL);
        const float mb = __uint_as_float(cw[KMAX_BIAS]);
        nrefC = 10.0f - mb - sqrtf(qn2 * __uint_as_float(cw[KMAX_KC + bg])) * 1.0005f;
        nrefS = 10.0f - mb - sqrtf(qn2 * __uint_as_float(cw[KMAX_KS + bg])) * 1.0005f;
        nrefW = 10.0f - mb - sqrtf(qn2 * __uint_as_float(cw[KMAX_KW + bg])) * 1.0005f;
    }
    const float* gp = (const float*)(ws + OFF_GATES) + (long)(b * SEQ + tq) * 24 + (g * 4 + r) * 3;
    const float g0 = gp[0], g1 = gp[1], g2 = gp[2];
    f16v of0, of1;
#pragma unroll
    for (int i = 0; i < 16; ++i) { of0[i] = 0.f; of1[i] = 0.f; }

    u4v rk[2], rvv[2];
    auto stage_gload_r = [&](u4v (&rk_)[2], u4v (&rv_)[2], const half_t* Kg, const half_t* Vg, long ldv, int key0, bool withv) __attribute__((always_inline)) {
#pragma unroll
        for (int i = 0; i < 2; ++i) {
            const int ci = tid + 256 * i, row = ci >> 3, of = ci & 7;
            rk_[i] = *(const u4v*)(Kg + (long)(key0 + row) * 64 + of * 8);
            if (withv) rv_[i] = *(const u4v*)(Vg + (long)row * ldv + key0 + of * 8);
        }
    };
    auto stage_lstore_r = [&](NsaStage& st, const u4v (&rk_)[2], const u4v (&rv_)[2], bool withv) __attribute__((always_inline)) {
#pragma unroll
        for (int i = 0; i < 2; ++i) {
            const int ci = tid + 256 * i, row = ci >> 3, of = ci & 7;
            *(u4v*)&st.K[row][of * 8] = rk_[i];
            if (withv) {
                *(u2v*)&st.V[row][of * 8] = (u2v){rv_[i][0], rv_[i][1]};
                *(u2v*)&st.V[row][of * 8 + 4] = (u2v){rv_[i][2], rv_[i][3]};
            }
        }
    };
    auto stage_gload = [&](const half_t* Kg, const half_t* Vg, long ldv, int key0, bool withv) __attribute__((always_inline)) { stage_gload_r(rk, rvv, Kg, Vg, ldv, key0, withv); };
    auto stage_lstore = [&](NsaStage& st, bool withv) __attribute__((always_inline)) { stage_lstore_r(st, rk, rvv, withv); };
    auto qk32 = [&](const NsaStage& st, int mt, float init) __attribute__((always_inline)) -> f16v {
        f16v s;
#pragma unroll
        for (int i = 0; i < 16; ++i) s[i] = init;
#pragma unroll
        for (int s4 = 0; s4 < 4; ++s4) {
            const h8v a = *(const h8v*)&st.K[32 * mt + c][s4 * 16 + hh * 8];
            s = mfma32(a, qf[s4], s);
        }
        return s;
    };
    auto pv32 = [&](const NsaStage& st, int mt, const f16v& pr, f16v& oa, f16v& ob) __attribute__((always_inline)) {
#pragma unroll
        for (int ks = 0; ks < 2; ++ks) {
            h8v pb;
#pragma unroll
            for (int jj = 0; jj < 8; ++jj) pb[jj] = (half_t)pr[8 * ks + jj];
#pragma unroll
            for (int md = 0; md < 2; ++md) {
                const h4v lo = *(const h4v*)&st.V[32 * md + c][32 * mt + 16 * ks + 4 * hh];
                const h4v hi = *(const h4v*)&st.V[32 * md + c][32 * mt + 16 * ks + 8 + 4 * hh];
                const h8v a = {lo[0], lo[1], lo[2], lo[3], hi[0], hi[1], hi[2], hi[3]};
                if (md == 0) oa = mfma32(a, pb, oa); else ob = mfma32(a, pb, ob);
            }
        }
    };
    NsaStage& st0 = *(NsaStage*)(smem + NSA_ST0);
    NsaStage& st1 = *(NsaStage*)(smem + NSA_RB);

    for (int rep = 0; rep < (PROBE_PHASE == 22 ? 2 : 1); ++rep) {
        __syncthreads();
        const half_t* KC = (const half_t*)(ws + OFF_KCMP) + (long)bg * 1024 * 64;
        const half_t* VCT = (const half_t*)(ws + OFF_VCMPT) + (long)bg * 64 * 1024;
        const int nst = ((t0 >> 4) >> 6) + 1;
        auto cmp_scores = [&](f16v& s, int kbase) __attribute__((always_inline)) {
            const bool far = (t0w - (16 * (kbase + 31) + 31)) >= 1513;
            if (far) {
#pragma unroll
                for (int rr = 0; rr < 16; ++rr) s[rr] += cfar;
            } else {
#pragma unroll
                for (int rr = 0; rr < 16; ++rr) {
                    const int k = kbase + (rr & 3) + 8 * (rr >> 2) + 4 * hh;
                    const int dist = tq - (16 * k + 31);
                    const int di = dist < 0 ? 0 : (dist > LUTN - 1 ? LUTN - 1 : dist);
                    s[rr] = (dist >= 0) ? s[rr] + (float)lut[di * 4 + r] : NEGF;
                }
            }
        };
        float l = 0.f;
        stage_gload(KC, VCT, 1024, 0, false);
#pragma unroll 1
        for (int sg = 0; sg < nst; ++sg) {
            stage_lstore(st0, false);
            __syncthreads();
            if (sg + 1 < nst) stage_gload(KC, VCT, 1024, (sg + 1) * 64, false);
#pragma unroll
            for (int mt = 0; mt < 2; ++mt) {
                const int kbase = sg * 64 + mt * 32;
                if (16 * kbase + 31 <= tlast) {
                    f16v s = qk32(st0, mt, nrefC);
                    cmp_scores(s, kbase);
#pragma unroll
                    for (int rr = 0; rr < 16; ++rr) l += fast_exp2(s[rr]);
                }
            }
            __syncthreads();
        }
        l += __shfl_xor(l, 32);
        const float ml2 = (l > 0.f) ? __builtin_amdgcn_logf(l) : 1e30f;
        f16v oc0, oc1;
#pragma unroll
        for (int i = 0; i < 16; ++i) { oc0[i] = 0.f; oc1[i] = 0.f; }
        float carryL = 0.f;
        stage_gload(KC, VCT, 1024, 0, true);
#pragma unroll 1
        for (int sg = 0; sg < nst; ++sg) {
            stage_lstore(st0, true);
            __syncthreads();
            if (sg + 1 < nst) stage_gload(KC, VCT, 1024, (sg + 1) * 64, true);
#pragma unroll
            for (int mt = 0; mt < 2; ++mt) {
                const int kbase = sg * 64 + mt * 32;
                const int kt = sg * 2 + mt;
                if (16 * kbase + 31 <= tlast) {
                    f16v s = qk32(st0, mt, nrefC);
                    cmp_scores(s, kbase);
#pragma unroll
                    for (int rr = 0; rr < 16; ++rr) s[rr] = fast_exp2(s[rr] - ml2);
                    float Gs[4], Ls[4];
#pragma unroll
                    for (int jg = 0; jg < 4; ++jg) {
                        float G = s[4 * jg] + s[4 * jg + 1] + s[4 * jg + 2] + s[4 * jg + 3];
                        float L = s[4 * jg + 3];
                        G += __shfl_xor(G, 1); G += __shfl_xor(G, 2);
                        L += __shfl_xor(L, 1); L += __shfl_xor(L, 2);
                        Gs[jg] = G; Ls[jg] = L;
                    }
                    float Lo[4];
#pragma unroll
                    for (int jg = 0; jg < 4; ++jg) Lo[jg] = __shfl_xor(Ls[jg], 32);
                    if (r == 0) {
#pragma unroll
                        for (int jg = 0; jg < 4; ++jg) {
                            const float prevL = hh ? Lo[jg] : (jg == 0 ? carryL : Lo[jg - 1]);
                            imp[w][qi][8 * kt + 2 * jg + hh] = Gs[jg] + prevL;
                        }
                    }
                    carryL = Lo[3];
                    pv32(st0, mt, s, oc0, oc1);
                }
            }
            __syncthreads();
        }
#pragma unroll
        for (int i = 0; i < 16; ++i) { of0[i] += (rep == 0 ? g0 : 0.0f) * oc0[i]; of1[i] += (rep == 0 ? g0 : 0.0f) * oc1[i]; }
    }
    {
        const int q2 = lane >> 3, sub = lane & 7;
        const int tq2 = t0w + q2;
        const int cur = tq2 >> 6;
        unsigned key[32];
#pragma unroll
        for (int i = 0; i < 32; ++i) {
            const int sb = sub + 8 * i;
            const float v = imp[w][q2][sb];
            unsigned u = (__float_as_uint(v) & 0x7FFFFF00u) | (unsigned)(255 - sb);
            if (sb == 0 || sb == cur || sb == cur - 1) u |= 0x80000000u;
            if (sb > cur) u = 0u;
            key[i] = u;
        }
#pragma unroll 1
        for (int round = 0; round < 16; ++round) {
            unsigned best = key[0];
#pragma unroll
            for (int i = 1; i < 32; ++i) best = best > key[i] ? best : key[i];
#pragma unroll
            for (int o = 1; o <= 4; o <<= 1) { const unsigned ob = (unsigned)__shfl_xor((int)best, o); best = best > ob ? best : ob; }
            if (sub == 0) sel[w][q2][round] = best ? (int)(255u - (best & 0xFFu)) : -1;
#pragma unroll
            for (int i = 0; i < 32; ++i) key[i] = (key[i] == best) ? 0u : key[i];
        }
    }
    for (int i = tid; i < 256; i += NTHREADS) masks[i] = 0u;
    __syncthreads();
    for (int e = lane; e < 128; e += 64) {
        const int q2 = e >> 4, bi = e & 15;
        const int blk = sel[w][q2][bi];
        if (blk >= 0) atomicOr(&masks[blk], 1u << (8 * w + q2));
    }
    __syncthreads();
    auto block_attend = [&](const NsaStage& st, int key0, bool colsel, bool window, float nref, float& l, f16v& oa, f16v& ob) __attribute__((always_inline)) {
        const bool far = !window && (t0w - (key0 + 63)) >= 1513;
        f16v s0, s1;
        if (far) {
            const float init = colsel ? (cfar + nref) : NEGF;
            s0 = qk32(st, 0, init); s1 = qk32(st, 1, init);
        } else {
            s0 = qk32(st, 0, nref); s1 = qk32(st, 1, nref);
#pragma unroll
            for (int rr = 0; rr < 16; ++rr) {
                const int pos = key0 + (rr & 3) + 8 * (rr >> 2) + 4 * hh;
                {
                    const int dist = tq - pos;
                    const bool valid = colsel && dist >= 0 && (!window || dist < 512);
                    const int di = dist < 0 ? 0 : (dist > LUTN - 1 ? LUTN - 1 : dist);
                    s0[rr] = valid ? s0[rr] + (float)lut[di * 4 + r] : NEGF;
                }
                {
                    const int dist = tq - pos - 32;
                    const bool valid = colsel && dist >= 0 && (!window || dist < 512);
                    const int di = dist < 0 ? 0 : (dist > LUTN - 1 ? LUTN - 1 : dist);
                    s1[rr] = valid ? s1[rr] + (float)lut[di * 4 + r] : NEGF;
                }
            }
        }
#pragma unroll
        for (int rr = 0; rr < 16; ++rr) { s0[rr] = fast_exp2(s0[rr]); l += s0[rr]; }
#pragma unroll
        for (int rr = 0; rr < 16; ++rr) { s1[rr] = fast_exp2(s1[rr]); l += s1[rr]; }
        pv32(st, 0, s0, oa, ob);
        pv32(st, 1, s1, oa, ob);
    };
    unsigned char* blist = (unsigned char*)(smem + NSA_SEL);
    volatile int* bcount = (volatile int*)(smem + NSA_SEL + 256);
    if (w == 0) {
        const int jmaxb = (t0 + 31) >> 6;
        int base = 0;
#pragma unroll 1
        for (int rnd = 0; rnd < 4; ++rnd) {
            const int bb = rnd * 64 + lane;
            const bool f = (bb <= jmaxb) && (masks[bb] != 0u);
            const unsigned long long bal = __ballot(f);
            const int pos = base + __popcll(bal & ((1ull << lane) - 1ull));
            if (f) blist[pos] = (unsigned char)bb;
            base += __popcll(bal);
        }
        if (lane == 0) *bcount = base;
    }
    for (int rep = 0; rep < (PROBE_PHASE == 20 ? 2 : 1); ++rep) {
        __syncthreads();
        const half_t* KS = (const half_t*)(ws + OFF_KS) + (long)bg * SEQ * 64;
        const half_t* VST = (const half_t*)(ws + OFF_VST) + (long)bg * 64 * SEQ;
        f16v os0, os1;
#pragma unroll
        for (int i = 0; i < 16; ++i) { os0[i] = 0.f; os1[i] = 0.f; }
        float l = 0.f;
        const int nblk = *bcount;
        u4v kA[2], vA[2], kB[2], vB[2];
        if (nblk > 0) stage_gload_r(kA, vA, KS, VST, SEQ, (int)blist[0] * 64, true);
        if (nblk > 1) stage_gload_r(kB, vB, KS, VST, SEQ, (int)blist[1] * 64, true);
        if (nblk > 0) stage_lstore_r(st0, kA, vA, true);
        __syncthreads();
#define SEL_STAGE(i_, ST, STN, KX, VX, KY, VY) { \
            const int i__ = (i_); \
            if (i__ < nblk) { \
                if (i__ + 2 < nblk) stage_gload_r(KX, VX, KS, VST, SEQ, (int)blist[i__ + 2] * 64, true); \
                const int j = (int)blist[i__]; \
                const unsigned mk = masks[j]; \
                if ((mk >> (8 * w)) & 0xFFu) { \
                    const bool colsel = (mk >> (8 * w + qi)) & 1u; \
                    block_attend(ST, j * 64, colsel, false, nrefS, l, os0, os1); \
                } \
                if (i__ + 1 < nblk) stage_lstore_r(STN, KY, VY, true); \
                __syncthreads(); \
            } }
#pragma unroll 1
        for (int i = 0; i < nblk; i += 2) {
            SEL_STAGE(i, st0, st1, kA, vA, kB, vB);
            SEL_STAGE(i + 1, st1, st0, kB, vB, kA, vA);
        }
        const float lt = l + __shfl_xor(l, 32);
        const float sc = ((lt > 0.f) ? g1 / lt : 0.f) * (rep == 0 ? 1.0f : 0.0f);
#pragma unroll
        for (int i = 0; i < 16; ++i) { of0[i] += sc * os0[i]; of1[i] += sc * os1[i]; }
    }
    __syncthreads();
    for (int rep = 0; rep < (PROBE_PHASE == 21 ? 2 : 1); ++rep) {
        __syncthreads();
        const half_t* KW = (const half_t*)(ws + OFF_KW) + (long)bg * SEQ * 64;
        const half_t* VWT = (const half_t*)(ws + OFF_VWT) + (long)bg * 64 * SEQ;
        f16v ow0, ow1;
#pragma unroll
        for (int i = 0; i < 16; ++i) { ow0[i] = 0.f; ow1[i] = 0.f; }
        float l = 0.f;
        const int jmax = (t0 + 31) >> 6;
        int j = (t0 >= 511) ? ((t0 - 511) >> 6) : 0;
        int buf = 0;
        stage_gload(KW, VWT, SEQ, j * 64, true);
#pragma unroll 1
        while (j <= jmax) {
            NsaStage& st = buf ? st1 : st0;
            stage_lstore(st, true);
            __syncthreads();
            if (j + 1 <= jmax) stage_gload(KW, VWT, SEQ, (j + 1) * 64, true);
            block_attend(st, j * 64, true, true, nrefW, l, ow0, ow1);
            buf ^= 1; ++j;
        }
        const float lt = l + __shfl_xor(l, 32);
        const float sc = ((lt > 0.f) ? g2 / lt : 0.f) * (rep == 0 ? 1.0f : 0.0f);
#pragma unroll
        for (int i = 0; i < 16; ++i) { of0[i] += sc * ow0[i]; of1[i] += sc * ow1[i]; }
    }
    {
        half_t* orow = (half_t*)(ws + OFF_MIXED) + (long)(b * SEQ + tq) * 1024 + (g * 4 + r) * 64;
#pragma unroll
        for (int md = 0; md < 2; ++md)
#pragma unroll
            for (int rg = 0; rg < 4; ++rg) {
                h4v o;
#pragma unroll
                for (int e = 0; e < 4; ++e) o[e] = (half_t)((md == 0) ? of0[4 * rg + e] : of1[4 * rg + e]);
                *(h4v*)(orow + 32 * md + 8 * rg + 4 * hh) = o;
            }
    }
    __syncthreads();
}

__device__ __forceinline__ void phase_attn(const Params& p, char* smem, int cidx = 64, int mode = 0) {
    unsigned* ctr = (unsigned*)(p.ws + OFF_CTRL) + cidx;
    volatile int* s_item = (volatile int*)(smem + 66048);
    const int x0 = (int)(xb_xcc_id() & 7u);
    const int lo = (mode == 2) ? 256 : 0, hi = (mode == 1) ? 256 : 512;
    for (int k = 0; k < 8; ++k) {
        const int q = (x0 + k) & 7;
        for (;;) {
            if (threadIdx.x == 0) {
                int v = -1;
                if (__hip_atomic_load(&ctr[q], __ATOMIC_RELAXED, __HIP_MEMORY_SCOPE_AGENT) < (unsigned)(hi - lo)) v = (int)atomicAdd(&ctr[q], 1u) + lo;
                *s_item = v;
            }
            __syncthreads();
            const int li = *s_item;
            __syncthreads();
            if (li < 0 || li >= hi) break;
            if (li < 256) mla_item(p, 2 * q + (li & 1), 127 - (li >> 1), smem);
            else nsa_item(p, q & 3, 511 - 2 * (li - 256) - (q >> 2), smem);
        }
    }
}

__device__ __forceinline__ void phase_outproj(const Params& p, int bid, int nb, char* smem) {
    char* ws = p.ws;
    const half_t* MIX = (const half_t*)(ws + OFF_MIXED);
    const half_t* W = (const half_t*)(ws + OFF_WOUT);
    half_t* X2H = (half_t*)(ws + OFF_X2H);
    for (int tile = bid; tile < 256 * 8; tile += nb) {
        const int tm = tile >> 3, tn = tile & 7;
        const int row0 = tm * 128, n0 = tn * 128;
        gemm_tile<true, true>(MIX + (long)row0 * 1024, 1024, W + (long)n0 * 1024, 1024, 1024, 512, smem,
            [&](f4v (&acc)[4][4], int wm, int wn, int i16, int g4) __attribute__((always_inline)) {
#pragma unroll
                for (int mi = 0; mi < 4; ++mi) {
                    const long row = row0 + wm * 64 + mi * 16 + i16;
#pragma unroll
                    for (int ni = 0; ni < 4; ++ni) {
                        const int col = n0 + wn * 64 + ni * 16 + 4 * g4;
                        float4 v = *(const float4*)(p.x + row * 1024 + col);
                        v.x += acc[mi][ni][0]; v.y += acc[mi][ni][1]; v.z += acc[mi][ni][2]; v.w += acc[mi][ni][3];
                        const h4v o = {(half_t)v.x, (half_t)v.y, (half_t)v.z, (half_t)v.w};
                        *(h4v*)(X2H + row * 1024 + col) = o;
                    }
                }
            });
    }
}

__device__ __forceinline__ void phase_peerq(const Params& p, int bid, int nb, char* smem) {
    char* ws = p.ws;
    const half_t* X2H = (const half_t*)(ws + OFF_X2H);
    const half_t* W = (const half_t*)(ws + OFF_WPQ);
    half_t* QP = (half_t*)(ws + OFF_QP);
    for (int tile = bid; tile < 256 * 16; tile += nb) {
        const int tm = tile >> 4, tn = tile & 15;
        const int row0 = tm * 128, n0 = tn * 128;
        gemm_tile<true, true>(X2H + (long)row0 * 1024, 1024, W + (long)n0 * 1024, 1024, 1024, 1024, smem,
            [&](f4v (&acc)[4][4], int wm, int wn, int i16, int g4) __attribute__((always_inline)) {
#pragma unroll
                for (int mi = 0; mi < 4; ++mi) {
                    const long row = row0 + wm * 64 + mi * 16 + i16;
#pragma unroll
                    for (int ni = 0; ni < 4; ++ni) {
                        const int col = n0 + wn * 64 + ni * 16 + 4 * g4;
                        const h4v o = {(half_t)acc[mi][ni][0], (half_t)acc[mi][ni][1], (half_t)acc[mi][ni][2], (half_t)acc[mi][ni][3]};
                        *(h4v*)(QP + row * 2048 + col) = o;
                    }
                }
            });
    }
}

__device__ __forceinline__ void topk_insert(float (&tv)[16], int (&ti)[16], float v, int id) {
#pragma unroll
    for (int k = 0; k < 16; ++k) {
        const bool gt = v > tv[k];
        const float nv = gt ? tv[k] : v; const int ni = gt ? ti[k] : id;
        tv[k] = gt ? v : tv[k]; ti[k] = gt ? id : ti[k];
        v = nv; id = ni;
    }
}
__device__ __forceinline__ unsigned rt_flip(float f) { const unsigned b = __float_as_uint(f); return b ^ ((b >> 31) ? 0xFFFFFFFFu : 0x80000000u); }
__device__ __forceinline__ float rt_unflip(unsigned u) { return __uint_as_float((u & 0x80000000u) ? (u ^ 0x80000000u) : ~u); }
__device__ __forceinline__ void rt_insert(unsigned (&tk)[16], unsigned u) {
#pragma unroll
    for (int k = 0; k < 16; ++k) { const unsigned hi = tk[k] > u ? tk[k] : u; u = tk[k] > u ? u : tk[k]; tk[k] = hi; }
}
__device__ __forceinline__ void phase_route(const Params& p, int bid, int nb, char* smem) {
    char* ws = p.ws;
    {
        const u4v* src = (const u4v*)(ws + OFF_KEYS);
        u4v* dst = (u4v*)smem;
        for (int i = threadIdx.x; i < 4096; i += NTHREADS) {
            const int n = (i >> 4) & 127, ch = i & 15;
            dst[(i & ~15) | (ch ^ (n & 15))] = src[i];
        }
    }
    __syncthreads();
    const half_t* QP = (const half_t*)(ws + OFF_QP);
    int* EID = (int*)(ws + OFF_EID);
    float* GW = (float*)(ws + OFF_GW);
    int tid_ = threadIdx.x; asm volatile("" : "+v"(tid_));
    const int lane = tid_ & 63, w = tid_ >> 6, c = lane & 31, hh = lane >> 5;
#pragma unroll 1
    for (long blk = bid; blk < (long)NTOK * 8 / 128; blk += nb) {
        const long th = blk * 128 + w * 32 + c;
        unsigned tkA[16], tkB[16];
#pragma unroll
        for (int half = 0; half < 2; ++half) {
            unsigned (&tk)[16] = half ? tkB : tkA;
#pragma unroll
            for (int k = 0; k < 16; ++k) tk[k] = 0u;
            h8v qf[8];
#pragma unroll
            for (int ks = 0; ks < 8; ++ks) qf[ks] = *(const h8v*)(QP + th * 256 + half * 128 + ks * 16 + hh * 8);
#pragma unroll 1
            for (int mt = 0; mt < 4; ++mt) {
                f16v s;
#pragma unroll
                for (int i = 0; i < 16; ++i) s[i] = 0.f;
                const int n = mt * 32 + c;
                const char* kb = smem + (half * 128 + n) * 256;
#pragma unroll
                for (int ks = 0; ks < 8; ++ks) {
                    const h8v a = *(const h8v*)(kb + (((2 * ks + hh) ^ (n & 15)) << 4));
                    s = mfma32(a, qf[ks], s);
                }
#pragma unroll
                for (int r = 0; r < 16; ++r) {
                    const int key = mt * 32 + (r & 3) + 8 * (r >> 2) + 4 * hh;
                    rt_insert(tk, (rt_flip(s[r]) & ~0x7Fu) | (unsigned)(127 - key));
                }
            }
            unsigned other[16];
#pragma unroll
            for (int k = 0; k < 16; ++k) other[k] = (unsigned)__shfl_xor((int)tk[k], 32);
#pragma unroll
            for (int k = 0; k < 16; ++k) rt_insert(tk, other[k]);
        }
        float v1[16], v2[16]; int i1[16], i2[16];
#pragma unroll
        for (int k = 0; k < 16; ++k) {
            v1[k] = rt_unflip(tkA[k] & ~0x7Fu); i1[k] = 127 - (int)(tkA[k] & 0x7Fu);
            v2[k] = rt_unflip(tkB[k] & ~0x7Fu); i2[k] = 127 - (int)(tkB[k] & 0x7Fu);
        }
        float fv[16]; int fi[16];
#pragma unroll
        for (int k = 0; k < 16; ++k) { fv[k] = -3.0e38f; fi[k] = 0; }
        {
            constexpr int NP = 50;
            int pi[NP], pj[NP]; int np = 0;
#pragma unroll
            for (int i = 0; i < 16; ++i)
#pragma unroll
                for (int j = 0; j < 16; ++j)
                    if ((i + 1) * (j + 1) <= 16) { pi[np] = i; pj[np] = j; ++np; }
#pragma unroll
            for (int q = 0; q < NP / 2; ++q) {
                const float va = v1[pi[2 * q]] + v2[pj[2 * q]], vb = v1[pi[2 * q + 1]] + v2[pj[2 * q + 1]];
                const int ea = i1[pi[2 * q]] * 128 + i2[pj[2 * q]], eb = i1[pi[2 * q + 1]] * 128 + i2[pj[2 * q + 1]];
                topk_insert(fv, fi, hh ? vb : va, hh ? eb : ea);
            }
        }
        {
            float ov[16]; int oi[16];
#pragma unroll
            for (int k = 0; k < 16; ++k) { ov[k] = __shfl_xor(fv[k], 32); oi[k] = __shfl_xor(fi[k], 32); }
#pragma unroll
            for (int k = 0; k < 16; ++k) topk_insert(fv, fi, ov[k], oi[k]);
        }
        if (hh == 0) {
            float sum = 0.f, ex[16];
#pragma unroll
            for (int k = 0; k < 16; ++k) { ex[k] = __expf(fv[k] - fv[0]); sum += ex[k]; }
            const float inv = 1.0f / sum;
#pragma unroll
            for (int k4 = 0; k4 < 4; ++k4) {
                *(int4*)(EID + th * 16 + 4 * k4) = make_int4(fi[4 * k4], fi[4 * k4 + 1], fi[4 * k4 + 2], fi[4 * k4 + 3]);
                *(float4*)(GW + th * 16 + 4 * k4) = make_float4(ex[4 * k4] * inv, ex[4 * k4 + 1] * inv, ex[4 * k4 + 2] * inv, ex[4 * k4 + 3] * inv);
            }
        }
    }
}

__device__ __forceinline__ int peer_next_task(unsigned* q, int xpref, int ntask_per_slice, volatile int* s_task) {
    if (threadIdx.x == 0) {
        int res = -1;
        for (int k = 0; k < 4; ++k) {
            const int x = (xpref + k) & 3;
            if (__hip_atomic_load(&q[x], __ATOMIC_RELAXED, __HIP_MEMORY_SCOPE_AGENT) >= (unsigned)ntask_per_slice) continue;
            const unsigned c = atomicAdd(&q[x], 1u);
            if (c < (unsigned)ntask_per_slice) { res = x * ntask_per_slice + (int)c; break; }
        }
        *s_task = res;
    }
    __syncthreads();
    const int r = *s_task;
    __syncthreads();
    return r;
}
template <int PMODE>
__device__ __forceinline__ void phase_peer_udot(const Params& p, char* smem, int qoff = 16) {
    char* ws = p.ws;
    unsigned* q = (unsigned*)(ws + OFF_CTRL) + qoff;
    volatile int* s_task = (volatile int*)(smem + 66048);
    const unsigned char* U4 = (const unsigned char*)(ws + OFF_U16);
    const half_t* X2H = (const half_t*)(ws + OFF_X2H);
    const int* EID = (const int*)(ws + OFF_EID);
    float* PD = (float*)(ws + OFF_PD);
    const int xpref = (int)(xb_xcc_id() & 3u);
    for (;;) {
        const int task = peer_next_task(q, xpref, 512, s_task);
        if (task < 0) break;
        const int x = task >> 9, chunk = task & 511;
        int tid_ = threadIdx.x; asm volatile("" : "+v"(tid_));
        const int lane = tid_ & 63, w = tid_ >> 6, seg = lane & 7, eg = lane >> 3;
        h2v gs[16];
#pragma unroll
        for (int i = 0; i < 16; ++i) gs[i] = (h2v){(half_t)p.norm2_g[256 * x + 32 * seg + 2 * i], (half_t)p.norm2_g[256 * x + 32 * seg + 2 * i + 1]};
        const unsigned char* Ux = U4 + (long)x * 16384 * 128 + 16 * seg;
        const int tbase = chunk * 64 + w * 16;
        const int* Eb = EID + (long)tbase * 128 + 16 * eg;
        const half_t* Xb = X2H + (long)tbase * 1024 + 256 * x + 32 * seg;
#define LOAD_E(dst, k) { const u4v* ep_ = (const u4v*)(Eb + (long)(k) * 128); dst[0] = ep_[0]; dst[1] = ep_[1]; dst[2] = ep_[2]; dst[3] = ep_[3]; }
#define ISSUE_U8(uu, e_, hf) { _Pragma("unroll") for (int i = 0; i < 8; ++i) uu[i] = *(const u4v*)(Ux + (long)e_[2 * (hf) + (i >> 2)][i & 3] * 128); }
        h2v hs[16];
        auto load_h = [&](int k) __attribute__((always_inline)) {
#pragma unroll
            for (int c4 = 0; c4 < 4; ++c4) {
                const h8v xv = *(const h8v*)(Xb + (long)k * 1024 + 8 * c4);
#pragma unroll
                for (int i = 0; i < 4; ++i) hs[4 * c4 + i] = (h2v){xv[2 * i], xv[2 * i + 1]} * gs[4 * c4 + i];
            }
        };
        auto compute8 = [&](const u4v (&uu)[8]) __attribute__((always_inline)) -> float {
            float res = 0.f;
            if (PMODE == 1) {
                unsigned acc_ = 0;
#pragma unroll
                for (int i = 0; i < 8; ++i) acc_ ^= uu[i][0] ^ uu[i][1] ^ uu[i][2] ^ uu[i][3];
                return __builtin_bit_cast(float, acc_);
            }
#pragma unroll
            for (int i = 0; i < 8; ++i) {
                float d = 0.f;
#pragma unroll
                for (int j = 0; j < 4; ++j) {
                    d = __builtin_amdgcn_fdot2(hs[4 * j], __builtin_amdgcn_cvt_scalef32_pk_f16_fp4(uu[i][j], 1.0f, 0), d, false);
                    d = __builtin_amdgcn_fdot2(hs[4 * j + 1], __builtin_amdgcn_cvt_scalef32_pk_f16_fp4(uu[i][j], 1.0f, 1), d, false);
                    d = __builtin_amdgcn_fdot2(hs[4 * j + 2], __builtin_amdgcn_cvt_scalef32_pk_f16_fp4(uu[i][j], 1.0f, 2), d, false);
                    d = __builtin_amdgcn_fdot2(hs[4 * j + 3], __builtin_amdgcn_cvt_scalef32_pk_f16_fp4(uu[i][j], 1.0f, 3), d, false);
                }
                d = red8(d);
                res = (seg == i) ? d : res;
            }
            return res;
        };
        u4v uA[8], uB[8];
        u4v eC[4], eN[4];
        LOAD_E(eC, 0);
        ISSUE_U8(uA, eC, 0);
#pragma unroll 1
        for (int k = 0; k < 16; ++k) {
            ISSUE_U8(uB, eC, 1);
            if (k + 1 < 16) LOAD_E(eN, k + 1);
            load_h(k);
            const float r0 = compute8(uA);
            if (k + 1 < 16) ISSUE_U8(uA, eN, 0);
            const float r1 = compute8(uB);
            float* po = (PMODE == 1 ? (float*)(p.ws + OFF_HC1) + (((long)(tbase + k) * 128 + 16 * eg + seg) & 0xFFFFF)
                                    : PD + ((long)x * NTOK + tbase + k) * 128 + 16 * eg + seg);
            po[0] = r0; po[8] = r1;
#pragma unroll
            for (int i = 0; i < 4; ++i) eC[i] = eN[i];
        }
    }
}
__device__ __forceinline__ void phase_peer_coef(const Params& p, int bid, int nb) {
    char* ws = p.ws;
    const half_t* X2H = (const half_t*)(ws + OFF_X2H);
    const float* PD = (const float*)(ws + OFF_PD);
    const float* GW = (const float*)(ws + OFF_GW);
    const int* EID = (const int*)(ws + OFF_EID);
    const float* ESC = (const float*)(ws + OFF_ESC);
    float* COEF = (float*)(ws + OFF_COEF);
    int tx_ = threadIdx.x; asm volatile("" : "+v"(tx_));
    const int lane = tx_ & 63;
    const long wv = ((long)bid * NTHREADS + tx_) >> 6, nwv = ((long)nb * NTHREADS) >> 6;
    for (long t = wv; t < NTOK; t += nwv) {
        const h8v a = *(const h8v*)(X2H + t * 1024 + 8 * lane), b2 = *(const h8v*)(X2H + t * 1024 + 512 + 8 * lane);
        float ss = 0.f;
#pragma unroll
        for (int i = 0; i < 8; ++i) { const float f0 = (float)a[i], f1 = (float)b2[i]; ss += f0 * f0 + f1 * f1; }
        ss = wave_sum(ss);
        const float rs = rsqrtf(ss * (1.0f / 1024.f) + EPS);
        float d0 = 0.f, d1 = 0.f;
#pragma unroll
        for (int x = 0; x < 4; ++x) {
            const float* pp = PD + ((long)x * NTOK + t) * 128;
            d0 += pp[lane]; d1 += pp[64 + lane];
        }
        const int e0 = EID[t * 128 + lane], e1 = EID[t * 128 + 64 + lane];
        COEF[t * 128 + lane] = GW[t * 128 + lane] * gelu_exact(d0 * rs * ESC[e0]) * ESC[16384 + e0];
        COEF[t * 128 + 64 + lane] = GW[t * 128 + 64 + lane] * gelu_exact(d1 * rs * ESC[e1]) * ESC[16384 + e1];
    }
}
__device__ __forceinline__ void phase_peer_vacc(const Params& p, char* smem) {
    char* ws = p.ws;
    unsigned* q = (unsigned*)(ws + OFF_CTRL) + 32;
    volatile int* s_task = (volatile int*)(smem + 66048);
    const unsigned char* V4 = (const unsigned char*)(ws + OFF_V16);
    const int* EID = (const int*)(ws + OFF_EID);
    const float* COEF = (const float*)(ws + OFF_COEF);
    float* SSQ = (float*)(ws + OFF_SSQ);
    const int xpref = (int)(xb_xcc_id() & 3u);
    for (;;) {
        const int task = peer_next_task(q, xpref, 512, s_task);
        if (task < 0) break;
        const int x = task >> 9, chunk = task & 511;
        int tid_ = threadIdx.x; asm volatile("" : "+v"(tid_));
        const int lane = tid_ & 63, w = tid_ >> 6, seg = lane & 7, eg = lane >> 3;
        const unsigned char* Vx = V4 + (long)x * 16384 * 128 + 16 * seg;
#pragma unroll 1
        for (int round = 0; round < 2; ++round) {
            const int t = chunk * 64 + w * 16 + round * 8 + eg;
            const int* Eb = EID + (long)t * 128;
            const float* Cb = COEF + (long)t * 128;
#define LOAD_EC(e_, c_, ci) { const u4v* ep_ = (const u4v*)(Eb + 8 * (ci)); const f4v* cp_ = (const f4v*)(Cb + 8 * (ci)); e_[0] = ep_[0]; e_[1] = ep_[1]; c_[0] = cp_[0]; c_[1] = cp_[1]; }
#define ISSUE_V(vv, e_) { _Pragma("unroll") for (int i = 0; i < 8; ++i) vv[i] = *(const u4v*)(Vx + (long)e_[i >> 2][i & 3] * 128); }
            h2v acc2[16];
#pragma unroll
            for (int i = 0; i < 16; ++i) acc2[i] = (h2v){(half_t)0.f, (half_t)0.f};
            auto compute = [&](const f4v (&c_)[2], const u4v (&vv)[8]) __attribute__((always_inline)) {
#pragma unroll
                for (int i = 0; i < 8; ++i) {
                    const half_t ch = (half_t)c_[i >> 2][i & 3];
                    const h2v cf2 = (h2v){ch, ch};
#pragma unroll
                    for (int j = 0; j < 4; ++j) {
                        acc2[4 * j] = __builtin_elementwise_fma((h2v)__builtin_amdgcn_cvt_scalef32_pk_f16_fp4(vv[i][j], 1.0f, 0), cf2, acc2[4 * j]);
                        acc2[4 * j + 1] = __builtin_elementwise_fma((h2v)__builtin_amdgcn_cvt_scalef32_pk_f16_fp4(vv[i][j], 1.0f, 1), cf2, acc2[4 * j + 1]);
                        acc2[4 * j + 2] = __builtin_elementwise_fma((h2v)__builtin_amdgcn_cvt_scalef32_pk_f16_fp4(vv[i][j], 1.0f, 2), cf2, acc2[4 * j + 2]);
                        acc2[4 * j + 3] = __builtin_elementwise_fma((h2v)__builtin_amdgcn_cvt_scalef32_pk_f16_fp4(vv[i][j], 1.0f, 3), cf2, acc2[4 * j + 3]);
                    }
                }
            };
            u4v vvA[8], vvB[8];
            u4v eA[2], eB[2]; f4v cA[2], cB[2];
            LOAD_EC(eA, cA, 0); LOAD_EC(eB, cB, 1);
            ISSUE_V(vvA, eA);
#pragma unroll 1
            for (int ci = 0; ci < 16; ci += 2) {
                ISSUE_V(vvB, eB);
                compute(cA, vvA);
                if (ci + 2 < 16) { LOAD_EC(eA, cA, ci + 2); ISSUE_V(vvA, eA); }
                compute(cB, vvB);
                if (ci + 2 < 16) LOAD_EC(eB, cB, ci + 3);
            }
            half_t* xr = (half_t*)(ws + OFF_X2H) + (long)t * 1024 + 256 * x + 32 * seg;
            float ssq = 0.f;
#pragma unroll
            for (int i8 = 0; i8 < 4; ++i8) {
                h8v xv = *(const h8v*)(xr + 8 * i8);
#pragma unroll
                for (int e = 0; e < 8; ++e) {
                    const float f = (float)xv[e] + (float)acc2[4 * i8 + (e >> 1)][e & 1];
                    ssq += f * f;
                    xv[e] = (half_t)f;
                }
                *(h8v*)(xr + 8 * i8) = xv;
            }
            ssq = red8(ssq);
            if (seg == 0) SSQ[(long)x * NTOK + t] = ssq;
        }
    }
}
__device__ __forceinline__ void phase_final_norm(const Params& p, int bid, int nb) {
    const float* SSQ = (const float*)(p.ws + OFF_SSQ);
    int tx_ = threadIdx.x; asm volatile("" : "+v"(tx_));
    const int lane = tx_ & 63;
    const long wv = ((long)bid * NTHREADS + tx_) >> 6, nwv = ((long)nb * NTHREADS) >> 6;
    for (long t = wv; t < NTOK; t += nwv) {
        float ss = 0.f;
#pragma unroll
        for (int x = 0; x < 4; ++x) ss += SSQ[(long)x * NTOK + t];
        const float rf = rsqrtf(ss * (1.0f / 1024.f) + EPS);
        const half_t* xh = (const half_t*)(p.ws + OFF_X2H) + t * 1024;
        float4* xr = (float4*)(p.out + t * 1024);
#pragma unroll
        for (int i = 0; i < 4; ++i) {
            const h4v hv = *(const h4v*)(xh + 4 * (lane + 64 * i));
            const float4 g = ((const float4*)p.final_g)[lane + 64 * i];
            float4 v;
            v.x = (float)hv[0] * rf * g.x; v.y = (float)hv[1] * rf * g.y; v.z = (float)hv[2] * rf * g.z; v.w = (float)hv[3] * rf * g.w;
            xr[lane + 64 * i] = v;
        }
    }
}

#define XB_TMO      128
#define XB_XCNT(j)  (256  + 64 * (j))
#define XB_XSUB(j)  (1280 + 64 * (j))
#define XB_XGEN(j)  (2304 + 64 * (j))
#define XB_TOP      3328
#define XB_TOPGEN   3392
#define XCD_BAR_WORDS 3456
#define XB_SPIN_CAP (1u << 22)
__device__ __forceinline__ unsigned xb_ld(unsigned* p)              { return __hip_atomic_load(p, __ATOMIC_RELAXED, __HIP_MEMORY_SCOPE_AGENT); }
__device__ __forceinline__ unsigned xb_add(unsigned* p, unsigned v) { return __hip_atomic_fetch_add(p, v, __ATOMIC_RELAXED, __HIP_MEMORY_SCOPE_AGENT); }
__device__ __forceinline__ unsigned xb_xcc_id() { return (unsigned)__builtin_amdgcn_s_getreg((3 << 11) | 20) & 0xFu; }
#define XB_SPIN(cond, bar) do { unsigned _sp = 0; while (cond) { __builtin_amdgcn_s_sleep(1); \
    if ((++_sp & 255u) == 0u) { if (xb_ld(&(bar)[XB_TMO])) break; if (_sp > XB_SPIN_CAP) { atomicAdd(&(bar)[XB_TMO], 1u); break; } } } } while (0)
struct XcdBarrier { unsigned* bar; unsigned x; volatile unsigned* st; };
__device__ __forceinline__ XcdBarrier xcd_barrier_post(unsigned* bar, volatile unsigned* st) {
    XcdBarrier b; b.bar = bar; b.x = xb_xcc_id(); b.st = st;
    if (threadIdx.x == 0) (void)xb_add(&bar[XB_XCNT(b.x)], 1u);
    return b;
}
__device__ __forceinline__ void xcd_barrier_complete(unsigned* bar, unsigned x, unsigned& nloc, unsigned& nx) {
    const unsigned G = gridDim.x * gridDim.y * gridDim.z;
    unsigned sum, cnt, mine, sp = 0u;
    for (;;) {
        sum = 0u; cnt = 0u; mine = 0u;
#pragma unroll
        for (unsigned j = 0; j < 16; ++j) { const unsigned c = xb_ld(&bar[XB_XCNT(j)]); sum += c; cnt += (c > 0u) ? 1u : 0u; mine = (j == x) ? c : mine; }
        if (sum == G) break;
        __builtin_amdgcn_s_sleep(1);
        if ((++sp & 255u) == 0u) { if (xb_ld(&bar[XB_TMO])) break; if (sp > XB_SPIN_CAP) { atomicAdd(&bar[XB_TMO], 1u); break; } }
    }
    nloc = mine > 0u ? mine : 1u; nx = cnt > 0u ? cnt : 1u;
}
__device__ __forceinline__ void xcd_barrier(const XcdBarrier& b) {
    asm volatile("s_waitcnt vmcnt(0)" ::: "memory");
    __syncthreads();
    if (threadIdx.x == 0) {
        unsigned* bar = b.bar;
        __builtin_amdgcn_s_waitcnt(0);
        unsigned nloc = b.st[0], nx = b.st[1];
        if (nloc == 0u) { xcd_barrier_complete(bar, b.x, nloc, nx); b.st[0] = nloc; b.st[1] = nx; }
        const unsigned old = xb_add(&bar[XB_XSUB(b.x)], 1u);
        const unsigned gen = old / nloc;
        if (old + 1u == (gen + 1u) * nloc) {
            __builtin_amdgcn_fence(__ATOMIC_RELEASE, "agent");
            asm volatile("s_waitcnt vmcnt(0)" ::: "memory");
            const unsigned og = xb_add(&bar[XB_TOP], 1u);
            const unsigned tg = og / nx;
            if (og + 1u == (tg + 1u) * nx) xb_add(&bar[XB_TOPGEN], 1u);
            else XB_SPIN(xb_ld(&bar[XB_TOPGEN]) == tg, bar);
            __builtin_amdgcn_fence(__ATOMIC_ACQUIRE, "agent");
            xb_add(&bar[XB_XGEN(b.x)], 1u);
            asm volatile("s_waitcnt vmcnt(0)" ::: "memory");
        } else {
            XB_SPIN(xb_ld(&bar[XB_XGEN(b.x)]) == gen, bar);
            __builtin_amdgcn_fence(__ATOMIC_ACQUIRE, "agent");
            asm volatile("s_waitcnt vmcnt(0)" ::: "memory");
        }
    }
    __syncthreads();
}

template <int PH>
__global__ void __launch_bounds__(NTHREADS, 2) phase_kernel(Params p) {
    extern __shared__ __attribute__((aligned(16))) char smem[];
    const int bid = blockIdx.x, nb = gridDim.x;
    if (PH == 0) phase_prep(p, bid, nb, smem);
    if (PH == 1) phase_inproj(p, bid, nb, smem);
    if (PH == 2) phase_p2(p, bid, nb, smem);
    if (PH == 3) phase_cmp2(p, bid, nb);
    if (PH == 4) phase_attn(p, smem);
    if (PH == 5) phase_outproj(p, bid, nb, smem);
    if (PH == 6) phase_peerq(p, bid, nb, smem);
    if (PH == 7) phase_route(p, bid, nb, smem);
}

__global__ void __launch_bounds__(NTHREADS, 2) mega_kernel(Params p) {
    extern __shared__ __attribute__((aligned(16))) char smem[];
    const int bid = blockIdx.x, nb = gridDim.x;
    {
        volatile unsigned* xbst = (volatile unsigned*)(smem + 66064);
        if (threadIdx.x == 0) { xbst[0] = 0u; xbst[1] = 0u; }
        __syncthreads();
        (void)xcd_barrier_post((unsigned*)(p.ws + OFF_BAR), xbst);
    }
#define GRID_SYNC() { XcdBarrier gb_; gb_.bar = (unsigned*)(p.ws + OFF_BAR); gb_.x = xb_xcc_id(); gb_.st = (volatile unsigned*)(smem + 66064); xcd_barrier(gb_); }
    phase_prep(p, bid, nb, smem); GRID_SYNC();
    if (PROBE_PHASE == 0) { phase_prep(p, bid, nb, smem); GRID_SYNC(); }
    phase_inproj(p, bid, nb, smem); GRID_SYNC();
    if (PROBE_PHASE == 1) { phase_inproj(p, bid, nb, smem); GRID_SYNC(); }
    phase_p2(p, bid, nb, smem); GRID_SYNC();
    if (PROBE_PHASE == 2) { phase_p2(p, bid, nb, smem); GRID_SYNC(); }
    phase_cmp2(p, bid, nb); GRID_SYNC();
    phase_attn(p, smem, 64, 0); GRID_SYNC();
    if (PROBE_PHASE == 3) { phase_attn(p, smem, 80, 0); GRID_SYNC(); }
    if (PROBE_PHASE == 9) { phase_attn(p, smem, 80, 1); GRID_SYNC(); }
    if (PROBE_PHASE == 13) { phase_attn(p, smem, 80, 2); GRID_SYNC(); }
    phase_outproj(p, bid, nb, smem); GRID_SYNC();
    if (PROBE_PHASE == 4) { phase_outproj(p, bid, nb, smem); GRID_SYNC(); }
    phase_peerq(p, bid, nb, smem); GRID_SYNC();
    if (PROBE_PHASE == 5) { phase_peerq(p, bid, nb, smem); GRID_SYNC(); }
    phase_route(p, bid, nb, smem); GRID_SYNC();
    if (PROBE_PHASE == 6) { phase_route(p, bid, nb, smem); GRID_SYNC(); }
    if (PROBE_PHASE == 8) { GRID_SYNC(); GRID_SYNC(); GRID_SYNC(); GRID_SYNC(); GRID_SYNC(); GRID_SYNC(); GRID_SYNC(); GRID_SYNC(); }
    phase_peer_udot<0>(p, smem); GRID_SYNC();
    if (PROBE_PHASE == 10) { phase_peer_udot<0>(p, smem, 48); GRID_SYNC(); }
    if (PROBE_PHASE == 12) { phase_peer_udot<1>(p, smem, 48); GRID_SYNC(); }
    phase_peer_coef(p, bid, nb); GRID_SYNC();
    if (PROBE_PHASE == 11) { phase_peer_coef(p, bid, nb); GRID_SYNC(); }
    phase_peer_vacc(p, smem); GRID_SYNC();
    phase_final_norm(p, bid, nb);
}

extern "C" void kernel_launch(void* const* d_in, const int* in_sizes, int n_in, void* d_out, int out_size, void* d_ws, size_t ws_size, hipStream_t stream) {
    (void)in_sizes; (void)n_in; (void)out_size;
    if (ws_size < WS_NEED) { fprintf(stderr, "kernel_launch: workspace too small (%zu < %zu)\n", ws_size, (size_t)WS_NEED); return; }
    Params p{};
    p.x = (const float*)d_in[0]; p.pos = (const int*)d_in[1]; p.norm1_g = (const float*)d_in[2]; p.w_in = (const float*)d_in[3];
    p.cmp_pos = (const float*)d_in[4]; p.cmp_k_w1 = (const float*)d_in[5]; p.cmp_k_w2 = (const float*)d_in[6];
    p.cmp_v_w1 = (const float*)d_in[7]; p.cmp_v_w2 = (const float*)d_in[8]; p.t5_bias = (const float*)d_in[9];
    p.q_norm_g = (const float*)d_in[10]; p.w_q_up = (const float*)d_in[11]; p.kv_norm_g = (const float*)d_in[12]; p.w_kv_up = (const float*)d_in[13];
    p.grp_norm_nsa = (const float*)d_in[14]; p.grp_norm_mla = (const float*)d_in[15]; p.w_out = (const float*)d_in[16]; p.norm2_g = (const float*)d_in[17];
    p.peer_wq = (const float*)d_in[18]; p.peer_keys1 = (const float*)d_in[19]; p.peer_keys2 = (const float*)d_in[20];
    p.peer_u = (const float*)d_in[21]; p.peer_v = (const float*)d_in[22]; p.final_g = (const float*)d_in[23];
    p.out = (float*)d_out; p.ws = (char*)d_ws;
#if MULTI_LAUNCH
    const int G = 512;
    phase_kernel<0><<<G, NTHREADS, 0, stream>>>(p);
    phase_kernel<1><<<G, NTHREADS, 0, stream>>>(p);
    phase_kernel<2><<<G, NTHREADS, 0, stream>>>(p);
    phase_kernel<3><<<G, NTHREADS, 0, stream>>>(p);
    phase_kernel<4><<<G, NTHREADS, 0, stream>>>(p);
    phase_kernel<5><<<G, NTHREADS, 0, stream>>>(p);
    phase_kernel<6><<<G, NTHREADS, 0, stream>>>(p);
    phase_kernel<7><<<G, NTHREADS, 0, stream>>>(p);
    phase_kernel<8><<<G, NTHREADS, 0, stream>>>(p);
#else
    static int grid_blocks = 0;
    if (!grid_blocks) {
        int dev = 0, cus = 0, per_cu = 0;
        (void)hipGetDevice(&dev);
        (void)hipDeviceGetAttribute(&cus, hipDeviceAttributeMultiprocessorCount, dev);
        (void)hipFuncSetAttribute((const void*)mega_kernel, hipFuncAttributeMaxDynamicSharedMemorySize, SMEM_BYTES);
        (void)hipOccupancyMaxActiveBlocksPerMultiprocessor(&per_cu, mega_kernel, NTHREADS, SMEM_BYTES);
        if (per_cu > 2) per_cu = 2;
        grid_blocks = cus * per_cu;
    }
    (void)hipMemsetAsync((char*)d_ws + OFF_BAR, 0, 16384, stream);
    void* args[] = {&p};
    hipError_t e = hipLaunchCooperativeKernel((void*)mega_kernel, dim3(grid_blocks), dim3(NTHREADS), args, SMEM_BYTES, stream);
    if (e != hipSuccess) fprintf(stderr, "cooperative launch failed: %s (grid %d)\n", hipGetErrorString(e), grid_blocks);
#endif
}
```

```cpp
#include <hip/hip_runtime.h>
#include <hip/hip_cooperative_groups.h>
#include <cstdio>
#include <cstdint>
namespace cg = cooperative_groups;

#ifndef MULTI_LAUNCH
#define MULTI_LAUNCH 0
#endif

#ifndef PROBE_PHASE
#define PROBE_PHASE -1
#endif

typedef _Float16 half_t;
typedef _Float16 h2v __attribute__((ext_vector_type(2)));
typedef _Float16 h4v __attribute__((ext_vector_type(4)));
typedef _Float16 h8v __attribute__((ext_vector_type(8)));
typedef float f4v __attribute__((ext_vector_type(4)));
typedef unsigned u4v __attribute__((ext_vector_type(4)));
typedef unsigned u2v __attribute__((ext_vector_type(2)));
typedef float f16v __attribute__((ext_vector_type(16)));

constexpr int BATCH = 2, SEQ = 16384, DM = 1024, NTOK = BATCH * SEQ;
constexpr int NIN = 1720, NINP = 1792;
constexpr int NCMP = 1023, NCMPP = 1024;
constexpr float EPS = 1e-6f;
constexpr float LOG2E = 1.4426950408889634f;
constexpr float QS_NSA = 0.125f * LOG2E;
constexpr float QS_MLA = 0.10206207261596575f * LOG2E;
constexpr float NEGF = -1e30f;
constexpr int LUTN = 1536;
constexpr float USCALE = 128.0f, VSCALE = 16.0f;

constexpr size_t al256(size_t x) { return (x + 255) & ~(size_t)255; }
constexpr size_t OFF_CTRL = 0;
constexpr size_t OFF_LUT = 4096;
constexpr size_t OFF_CB = OFF_LUT + 2 * LUTN * 4 * 4;
constexpr size_t OFF_WIN = 65536;
constexpr size_t OFF_WQUP = OFF_WIN + (size_t)NINP * 1024 * 2;
constexpr size_t OFF_WKVUP = OFF_WQUP + 768 * 256 * 2;
constexpr size_t OFF_WC1 = OFF_WKVUP + 1024 * 128 * 2;
constexpr size_t OFF_WOUT = OFF_WC1 + 2 * 256 * 2048 * 2;
constexpr size_t OFF_WPQ = OFF_WOUT + 1024 * 1024 * 2;
constexpr size_t OFF_KEYS = OFF_WPQ + 2048 * 1024 * 2;
constexpr size_t OFF_U16 = al256(OFF_KEYS + 2 * 128 * 128 * 2);
constexpr size_t OFF_V16 = OFF_U16 + (size_t)16384 * 1024 * 2;
constexpr size_t OFF_H1 = OFF_V16 + (size_t)16384 * 1024 * 2;
constexpr size_t OFF_MIXED = OFF_H1;
constexpr size_t OFF_QH = OFF_H1 + (size_t)NTOK * 1024 * 2;
constexpr size_t SZ_KV = (size_t)2 * 2 * SEQ * 64 * 2;
constexpr size_t OFF_KC = OFF_QH + (size_t)NTOK * 512 * 2;
constexpr size_t OFF_VC = OFF_KC + SZ_KV;
constexpr size_t OFF_KS = OFF_VC + SZ_KV;
constexpr size_t OFF_VST = OFF_KS + SZ_KV;
constexpr size_t OFF_KW = OFF_VST + SZ_KV;
constexpr size_t OFF_VWT = OFF_KW + SZ_KV;
constexpr size_t OFF_GATES = OFF_VWT + SZ_KV;
constexpr size_t OFF_CQ = OFF_GATES + (size_t)NTOK * 24 * 4;
constexpr size_t OFF_CKV = OFF_CQ + (size_t)NTOK * 256 * 2;
constexpr size_t OFF_X2H = OFF_QH;
constexpr size_t OFF_QM = OFF_CKV + (size_t)NTOK * 128 * 2;
constexpr size_t OFF_KM = OFF_QM + (size_t)NTOK * 8 * 96 * 2;
constexpr size_t OFF_VT = OFF_KM + (size_t)NTOK * 8 * 96 * 2;
constexpr size_t OFF_QP = OFF_QM;
constexpr size_t OFF_PD = OFF_QM;
constexpr size_t OFF_COEF = OFF_H1;
constexpr size_t OFF_SSQ = OFF_H1 + (size_t)NTOK * 128 * 4;
constexpr size_t OFF_HC1 = OFF_VT + (size_t)NTOK * 8 * 64 * 2;
constexpr size_t OFF_KCMP = OFF_HC1 + (size_t)8 * 1024 * 256 * 2;
constexpr size_t OFF_VCMPT = OFF_KCMP + (size_t)4 * 1024 * 64 * 2;
constexpr size_t OFF_EID = OFF_VCMPT + (size_t)4 * 1024 * 64 * 2;
constexpr size_t OFF_GW = OFF_EID + (size_t)NTOK * 128 * 4;
constexpr size_t OFF_BAR = OFF_GW + (size_t)NTOK * 128 * 4;
constexpr size_t OFF_ESC = OFF_BAR + 16384;
constexpr size_t WS_NEED = OFF_ESC + 2 * 16384 * 4;

struct Params {
    const float* x; const int* pos; const float* norm1_g; const float* w_in; const float* cmp_pos;
    const float* cmp_k_w1; const float* cmp_k_w2; const float* cmp_v_w1; const float* cmp_v_w2; const float* t5_bias;
    const float* q_norm_g; const float* w_q_up; const float* kv_norm_g; const float* w_kv_up;
    const float* grp_norm_nsa; const float* grp_norm_mla; const float* w_out; const float* norm2_g;
    const float* peer_wq; const float* peer_keys1; const float* peer_keys2; const float* peer_u; const float* peer_v; const float* final_g;
    float* out; char* ws;
};

constexpr int SMEM_BYTES = 67584;
constexpr int NTHREADS = 256;

__device__ __forceinline__ f4v mfma16(h8v a, h8v b, f4v c) { return __builtin_amdgcn_mfma_f32_16x16x32_f16(a, b, c, 0, 0, 0); }
__device__ __forceinline__ f16v mfma32(h8v a, h8v b, f16v c) { return __builtin_amdgcn_mfma_f32_32x32x16_f16(a, b, c, 0, 0, 0); }
__device__ __forceinline__ float shx(int lane, float v, int m) { return __builtin_bit_cast(float, __builtin_amdgcn_ds_bpermute((lane ^ m) << 2, __builtin_bit_cast(int, v))); }
__device__ __forceinline__ int shx(int lane, int v, int m) { return __builtin_amdgcn_ds_bpermute((lane ^ m) << 2, v); }
__device__ __forceinline__ float wave_sum(float v, int lane) {
#pragma unroll
    for (int o = 32; o >= 1; o >>= 1) v += shx(lane, v, o);
    return v;
}
__device__ __forceinline__ float gelu_exact(float v) { return 0.5f * v * (1.0f + erff(v * 0.70710678118654752f)); }
__device__ __forceinline__ float fast_exp2(float v) { return __builtin_amdgcn_exp2f(v); }
__device__ __forceinline__ int t5_bucket(int d) {
    if (d < 16) return d < 0 ? 0 : d;
    int b = 16;
    b += (d >= 22); b += (d >= 30); b += (d >= 40); b += (d >= 54); b += (d >= 73); b += (d >= 99); b += (d >= 134); b += (d >= 182);
    b += (d >= 246); b += (d >= 332); b += (d >= 450); b += (d >= 609); b += (d >= 825); b += (d >= 1117); b += (d >= 1513);
    return b;
}

__device__ __forceinline__ unsigned xb_xcc_id();
__device__ __forceinline__ float red8(float v) {
    v += __builtin_bit_cast(float, __builtin_amdgcn_update_dpp(0, __builtin_bit_cast(int, v), 0xB1, 0xF, 0xF, true));
    v += __builtin_bit_cast(float, __builtin_amdgcn_update_dpp(0, __builtin_bit_cast(int, v), 0x4E, 0xF, 0xF, true));
    v += __builtin_bit_cast(float, __builtin_amdgcn_update_dpp(0, __builtin_bit_cast(int, v), 0x141, 0xF, 0xF, true));
    return v;
}

__device__ __forceinline__ void phase_prep(const Params& p, int bid, int nb, char* smem) {
    int tx_ = threadIdx.x; asm volatile("" : "+v"(tx_));
    const long tid = (long)bid * NTHREADS + tx_;
    const long nth = (long)nb * NTHREADS;
    char* ws = p.ws;
    if (tid < 1024) ((unsigned*)(ws + OFF_CTRL))[tid] = 0u;
    {
        float* lut = (float*)(ws + OFF_LUT);
        for (long e = tid; e < 2 * LUTN * 4; e += nth) {
            int r = e & 3, d = (e >> 2) % LUTN, g = (int)(e / (4 * LUTN));
            lut[e] = p.t5_bias[t5_bucket(d) * 8 + g * 4 + r] * LOG2E;
        }
    }
    {
        float* cb = (float*)(ws + OFF_CB);
        for (long e = tid; e < 512; e += nth) {
            int kv = (int)(e >> 8), n = (int)(e & 255);
            const float* w1 = kv ? p.cmp_v_w1 : p.cmp_k_w1;
            float s = 0.f;
            for (int k = 0; k < 2048; ++k) s += p.cmp_pos[k] * w1[(long)k * 256 + n];
            cb[e] = s;
        }
    }
    {
        float (*tl)[65] = (float (*)[65])smem;
        const int tx = tx_;
        const int jt[8] = {0, 448, 496, 528, 656, 784, 1040, 1552};
        for (int tile = bid; tile < 1552; tile += nb) {
            int job = 0;
#pragma unroll
            for (int j = 1; j < 7; ++j) job += (tile >= jt[j]) ? 1 : 0;
            const int lt = tile - jt[job];
            int K, N, ldsrc; const float* src; const float* gain; half_t* dst;
            switch (job) {
                case 0: K = 1024; N = NINP; ldsrc = NIN; src = p.w_in; gain = nullptr; dst = (half_t*)(ws + OFF_WIN); break;
                case 1: K = 256; N = 768; ldsrc = 768; src = p.w_q_up; gain = p.q_norm_g; dst = (half_t*)(ws + OFF_WQUP); break;
                case 2: K = 128; N = 1024; ldsrc = 1024; src = p.w_kv_up; gain = p.kv_norm_g; dst = (half_t*)(ws + OFF_WKVUP); break;
                case 3: K = 2048; N = 256; ldsrc = 256; src = p.cmp_k_w1; gain = nullptr; dst = (half_t*)(ws + OFF_WC1); break;
                case 4: K = 2048; N = 256; ldsrc = 256; src = p.cmp_v_w1; gain = nullptr; dst = (half_t*)(ws + OFF_WC1) + 256L * 2048; break;
                case 5: K = 1024; N = 1024; ldsrc = 1024; src = p.w_out; gain = nullptr; dst = (half_t*)(ws + OFF_WOUT); break;
                default: K = 1024; N = 2048; ldsrc = 2048; src = p.peer_wq; gain = p.norm2_g; dst = (half_t*)(ws + OFF_WPQ); break;
            }
            const int ntn = N >> 6;
            const int k0 = (lt / ntn) * 64, n0 = (lt % ntn) * 64;
            {
                const int r = tx >> 4, c4 = (tx & 15) * 4;
                const int n = n0 + c4;
                int sc = n;
                if (job == 0) {
                    if (n < 1280) sc = n;
                    else if (n < 1536) sc = 1304 + (n - 1280);
                    else if (n < 1664) sc = 1560 + (n - 1536);
                    else if (n < 1696) sc = 1688 + (n - 1664);
                    else if (n < 1720) sc = 1280 + (n - 1696);
                    else sc = -1;
                }
#pragma unroll
                for (int i = 0; i < 4; ++i) {
                    const int k = k0 + r + 16 * i;
                    float4 v = make_float4(0.f, 0.f, 0.f, 0.f);
                    if (sc >= 0) v = *(const float4*)(src + (long)k * ldsrc + sc);
                    float gk = 1.0f;
                    if (gain) gk = gain[k];
                    if (job == 5) gk = (k < 512) ? p.grp_norm_nsa[k] : p.grp_norm_mla[k - 512];
                    tl[r + 16 * i][c4] = v.x * gk; tl[r + 16 * i][c4 + 1] = v.y * gk; tl[r + 16 * i][c4 + 2] = v.z * gk; tl[r + 16 * i][c4 + 3] = v.w * gk;
                }
            }
            __syncthreads();
            {
                const int nl = tx >> 2, kq = (tx & 3) * 16;
                h8v o0, o1;
#pragma unroll
                for (int j = 0; j < 8; ++j) { o0[j] = (half_t)tl[kq + j][nl]; o1[j] = (half_t)tl[kq + 8 + j][nl]; }
                half_t* d = dst + (long)(n0 + nl) * K + k0 + kq;
                *(h8v*)d = o0; *(h8v*)(d + 8) = o1;
            }
            __syncthreads();
        }
    }
    {
        half_t* W = (half_t*)(ws + OFF_KEYS);
        for (long e = tid; e < 2 * 16384; e += nth) {
            W[e] = (half_t)(e < 16384 ? p.peer_keys1[e] : p.peer_keys2[e - 16384]);
        }
    }
    {
        unsigned char* U4 = (unsigned char*)(ws + OFF_U16);
        unsigned char* V4 = (unsigned char*)(ws + OFF_V16);
        float* ESC = (float*)(ws + OFF_ESC);
        const int ln = tx_ & 63;
        const long wv = tid >> 6, nwv = nth >> 6;
        for (long job = wv; job < 2L * 16384; job += nwv) {
            const int tbl = (int)(job >> 14), e = (int)(job & 16383);
            const float4* src = (const float4*)((tbl ? p.peer_v : p.peer_u) + (long)e * 1024 + 16 * ln);
            float4 a[4]; float amax = 0.f;
#pragma unroll
            for (int i = 0; i < 4; ++i) { a[i] = src[i]; amax = fmaxf(amax, fmaxf(fmaxf(fabsf(a[i].x), fabsf(a[i].y)), fmaxf(fabsf(a[i].z), fabsf(a[i].w)))); }
#pragma unroll
            for (int o = 32; o >= 1; o >>= 1) amax = fmaxf(amax, shx(ln, amax, o));
            const float sc = (amax > 0.f) ? exp2f(ceilf(log2f(amax * (1.0f / 6.0f)))) : 1.0f;
            const float inv = 1.0f / sc;
            unsigned w0 = 0u, w1 = 0u;
            w0 = __builtin_amdgcn_cvt_scalef32_pk_fp4_f32(w0, a[0].x * inv, a[0].y * inv, 1.0f, 0);
            w0 = __builtin_amdgcn_cvt_scalef32_pk_fp4_f32(w0, a[0].z * inv, a[0].w * inv, 1.0f, 1);
            w0 = __builtin_amdgcn_cvt_scalef32_pk_fp4_f32(w0, a[1].x * inv, a[1].y * inv, 1.0f, 2);
            w0 = __builtin_amdgcn_cvt_scalef32_pk_fp4_f32(w0, a[1].z * inv, a[1].w * inv, 1.0f, 3);
            w1 = __builtin_amdgcn_cvt_scalef32_pk_fp4_f32(w1, a[2].x * inv, a[2].y * inv, 1.0f, 0);
            w1 = __builtin_amdgcn_cvt_scalef32_pk_fp4_f32(w1, a[2].z * inv, a[2].w * inv, 1.0f, 1);
            w1 = __builtin_amdgcn_cvt_scalef32_pk_fp4_f32(w1, a[3].x * inv, a[3].y * inv, 1.0f, 2);
            w1 = __builtin_amdgcn_cvt_scalef32_pk_fp4_f32(w1, a[3].z * inv, a[3].w * inv, 1.0f, 3);
            unsigned char* dst = (tbl ? V4 : U4) + (((long)(ln >> 4) * 16384 + e) * 128) + (ln & 15) * 8;
            *(u2v*)dst = (u2v){w0, w1};
            if (ln == 0) ESC[tbl * 16384 + e] = sc;
        }
    }
    {
        half_t* H1 = (half_t*)(ws + OFF_H1);
        const int lane = threadIdx.x & 63;
        const long wv = tid >> 6, nwv = nth >> 6;
        for (long row = wv; row < NTOK; row += nwv) {
            const float4* xr = (const float4*)(p.x + row * 1024);
            float4 v[4]; float ss = 0.f;
#pragma unroll
            for (int i = 0; i < 4; ++i) { v[i] = xr[lane + 64 * i]; ss += v[i].x * v[i].x + v[i].y * v[i].y + v[i].z * v[i].z + v[i].w * v[i].w; }
            ss = wave_sum(ss, lane);
            const float rs = rsqrtf(ss * (1.0f / 1024.f) + EPS);
#pragma unroll
            for (int i = 0; i < 4; ++i) {
                float4 g = ((const float4*)p.norm1_g)[lane + 64 * i];
                h4v o = {(half_t)(v[i].x * rs * g.x), (half_t)(v[i].y * rs * g.y), (half_t)(v[i].z * rs * g.z), (half_t)(v[i].w * rs * g.w)};
                ((h4v*)(H1 + row * 1024))[lane + 64 * i] = o;
            }
        }
    }
}

constexpr int GEMM_RS_OFF = 66560;
template <bool SCALE, bool SWAP, class Epi>
__device__ __forceinline__ void gemm_tile(const half_t* __restrict__ A, long lda, const half_t* __restrict__ Bt, long ldb, int K, int ksplit, char* smem_raw, Epi epi) {
    half_t* sA = (half_t*)smem_raw;
    half_t* sB = (half_t*)(smem_raw + 32768);
    float* rs0 = (float*)(smem_raw + GEMM_RS_OFF);
    int tid_ = threadIdx.x; asm volatile("" : "+v"(tid_));
    const int tid = tid_, lane = tid & 63, w = tid >> 6, wm = w >> 1, wn = w & 1;
    const int i16 = lane & 15, g4 = lane >> 4;
    const int lr = tid >> 3, off = tid & 7;
    if (SCALE) {
        const int rg = lane >> 3, ch = lane & 7;
        const int ncg = K >> 6, cgs = ksplit >> 6;
#pragma unroll 1
        for (int rr = 0; rr < 4; ++rr) {
            const int row = w * 32 + rr * 8 + rg;
            const half_t* ap = A + (long)row * lda + ch * 8;
            float s0 = 0.f, s1 = 0.f;
#pragma unroll 8
            for (int cg = 0; cg < ncg; ++cg) {
                const h8v v = *(const h8v*)(ap + cg * 64);
                float d = 0.f;
#pragma unroll
                for (int j = 0; j < 4; ++j) d = __builtin_amdgcn_fdot2((h2v){v[2 * j], v[2 * j + 1]}, (h2v){v[2 * j], v[2 * j + 1]}, d, false);
                if (cg < cgs) s0 += d; else s1 += d;
            }
            s0 = red8(s0); s1 = red8(s1);
            if (ch == 0) {
                rs0[row] = rsqrtf(s0 / (float)ksplit + EPS);
                if (ksplit < K) rs0[128 + row] = rsqrtf(s1 / (float)(K - ksplit) + EPS);
            }
        }
    }
    f4v acc[4][4];
#pragma unroll
    for (int a = 0; a < 4; ++a)
#pragma unroll
        for (int b = 0; b < 4; ++b) acc[a][b] = (f4v){0.f, 0.f, 0.f, 0.f};
    const int nk = K >> 6;
    const int srow = w * 32 + (lane >> 3);
    const int schunk = ((lane & 7) ^ ((lane >> 3) & 7)) << 3;
    const half_t* gA = A + (long)srow * lda + schunk;
    const half_t* gB = Bt + (long)srow * ldb + schunk;
    auto issue = [&](int k0, int stage) __attribute__((always_inline)) {
#pragma unroll
        for (int g = 0; g < 4; ++g) {
            __builtin_amdgcn_global_load_lds((const __attribute__((address_space(1))) void*)(gA + (long)(g * 8) * lda + k0),
                                             (__attribute__((address_space(3))) void*)(sA + stage * 8192 + (w * 32 + g * 8) * 64), 16, 0, 0);
            __builtin_amdgcn_global_load_lds((const __attribute__((address_space(1))) void*)(gB + (long)(g * 8) * ldb + k0),
                                             (__attribute__((address_space(3))) void*)(sB + stage * 8192 + (w * 32 + g * 8) * 64), 16, 0, 0);
        }
    };
    issue(0, 0);
    __syncthreads();
#pragma unroll 1
    for (int kt = 0; kt < nk; ++kt) {
        const int cur = (kt & 1) * 8192;
        if (kt + 1 < nk) issue((kt + 1) * 64, (kt + 1) & 1);
        if (SCALE && kt * 64 == ksplit) {
#pragma unroll
            for (int mi = 0; mi < 4; ++mi) {
                if (SWAP) {
                    const int row = wm * 64 + mi * 16 + i16;
                    const float ratio = rs0[row] / rs0[128 + row];
#pragma unroll
                    for (int ni = 0; ni < 4; ++ni) acc[mi][ni] *= ratio;
                } else {
#pragma unroll
                    for (int r = 0; r < 4; ++r) {
                        const int row = wm * 64 + mi * 16 + g4 * 4 + r;
                        const float ratio = rs0[row] / rs0[128 + row];
#pragma unroll
                        for (int ni = 0; ni < 4; ++ni) acc[mi][ni][r] *= ratio;
                    }
                }
            }
        }
#pragma unroll
        for (int kk = 0; kk < 2; ++kk) {
            const int cofs = (((kk * 4 + g4) ^ (i16 & 7)) << 3);
            h8v af[4], bf[4];
#pragma unroll
            for (int mi = 0; mi < 4; ++mi) af[mi] = *(const h8v*)(sA + cur + (wm * 64 + mi * 16 + i16) * 64 + cofs);
#pragma unroll
            for (int ni = 0; ni < 4; ++ni) bf[ni] = *(const h8v*)(sB + cur + (wn * 64 + ni * 16 + i16) * 64 + cofs);
#pragma unroll
            for (int mi = 0; mi < 4; ++mi)
#pragma unroll
                for (int ni = 0; ni < 4; ++ni) acc[mi][ni] = SWAP ? mfma16(bf[ni], af[mi], acc[mi][ni]) : mfma16(af[mi], bf[ni], acc[mi][ni]);
        }
        __syncthreads();
    }
    if (SCALE) {
        const int fin = (ksplit < K) ? 128 : 0;
#pragma unroll
        for (int mi = 0; mi < 4; ++mi) {
            if (SWAP) {
                const float rsv = rs0[fin + wm * 64 + mi * 16 + i16];
#pragma unroll
                for (int ni = 0; ni < 4; ++ni) acc[mi][ni] *= rsv;
            } else {
#pragma unroll
                for (int r = 0; r < 4; ++r) {
                    const float rsv = rs0[fin + wm * 64 + mi * 16 + g4 * 4 + r];
#pragma unroll
                    for (int ni = 0; ni < 4; ++ni) acc[mi][ni][r] *= rsv;
                }
            }
        }
    }
    epi(acc, wm, wn, i16, g4);
    __syncthreads();
}

__device__ __forceinline__ void rope_pair(float x1, float x2, int pos, int i, float& o1, float& o2) {
    const float inv = __builtin_amdgcn_exp2f(-(float)i * (13.287712379549449f / 16.0f));
    double t = (double)pos * (double)inv * 0.15915494309189535;
    t -= __builtin_rint(t);
    const float fr = (float)t;
    const float sn = __builtin_amdgcn_sinf(fr), cs = __builtin_amdgcn_cosf(fr);
    o1 = x1 * cs - x2 * sn; o2 = x1 * sn + x2 * cs;
}

__device__ __forceinline__ void phase_inproj(const Params& p, int bid, int nb, char* smem) {
    char* ws = p.ws;
    const half_t* H1 = (const half_t*)(ws + OFF_H1);
    const half_t* W = (const half_t*)(ws + OFF_WIN);
    half_t* QH = (half_t*)(ws + OFF_QH);
    half_t* KM = (half_t*)(ws + OFF_KM);
    half_t* CQ = (half_t*)(ws + OFF_CQ);
    half_t* CKV = (half_t*)(ws + OFF_CKV);
    float* GATES = (float*)(ws + OFF_GATES);
    const int NT_N = NINP / 128, NT_M = NTOK / 128;
    for (int tile = bid; tile < NT_M * NT_N; tile += nb) {
        const int tm = tile / NT_N, tn = tile % NT_N;
        const int row0 = tm * 128, n0 = tn * 128;
        const half_t* Ap = H1 + (long)row0 * 1024;
        const half_t* Bp = W + (long)n0 * 1024;
        if (tn == 7 || tn == 9) {
            gemm_tile<false, false>(Ap, 1024, Bp, 1024, 1024, 1024, smem,
                [&](f4v (&acc)[4][4], int wm, int wn, int i16, int g4) __attribute__((always_inline)) {
                    half_t* base = (half_t*)(ws + (tn == 7 ? OFF_VST : OFF_VWT));
#pragma unroll
                    for (int ni = 0; ni < 4; ++ni) {
                        const int c = wn * 64 + ni * 16 + i16, gg = c >> 6, d = c & 63;
#pragma unroll
                        for (int mi = 0; mi < 4; ++mi) {
                            const int rbase = row0 + wm * 64 + mi * 16 + g4 * 4;
                            const int b = rbase >> 14, s0 = rbase & (SEQ - 1);
                            const h4v o = {(half_t)acc[mi][ni][0], (half_t)acc[mi][ni][1], (half_t)acc[mi][ni][2], (half_t)acc[mi][ni][3]};
                            *(h4v*)(base + ((long)((b * 2 + gg) * 64 + d)) * SEQ + s0) = o;
                        }
                    }
                });
        } else {
            gemm_tile<false, true>(Ap, 1024, Bp, 1024, 1024, 1024, smem,
                [&](f4v (&acc)[4][4], int wm, int wn, int i16, int g4) __attribute__((always_inline)) {
#pragma unroll
                    for (int mi = 0; mi < 4; ++mi) {
                        const int t = row0 + wm * 64 + mi * 16 + i16;
                        const int b = t >> 14, sq = t & (SEQ - 1);
#pragma unroll
                        for (int ni = 0; ni < 4; ++ni) {
                            const int cb = n0 + wn * 64 + ni * 16;
                            const int n = cb + 4 * g4;
                            const f4v a = acc[mi][ni];
                            if (cb < 512) {
                                const h4v o = {(half_t)(a[0] * QS_NSA), (half_t)(a[1] * QS_NSA), (half_t)(a[2] * QS_NSA), (half_t)(a[3] * QS_NSA)};
                                *(h4v*)(QH + (long)t * 512 + n) = o;
                            } else if (cb < 1280) {
                                const int which = (cb - 512) >> 7;
                                const int c = (n - 512) & 127, gg = c >> 6, d = c & 63;
                                half_t* base = (half_t*)(ws + OFF_KC + (size_t)which * SZ_KV);
                                const h4v o = {(half_t)a[0], (half_t)a[1], (half_t)a[2], (half_t)a[3]};
                                *(h4v*)(base + ((long)(b * 2 + gg) * SEQ + sq) * 64 + d) = o;
                            } else if (cb < 1536) {
                                const h4v o = {(half_t)a[0], (half_t)a[1], (half_t)a[2], (half_t)a[3]};
                                *(h4v*)(CQ + (long)t * 256 + (n - 1280)) = o;
                            } else if (cb < 1664) {
                                const h4v o = {(half_t)a[0], (half_t)a[1], (half_t)a[2], (half_t)a[3]};
                                *(h4v*)(CKV + (long)t * 128 + (n - 1536)) = o;
                            } else if (cb == 1664) {
                                const f4v a2 = acc[mi][(ni + 1) & 3];
                                h4v o1, o2;
                                const int pos = p.pos[t];
#pragma unroll
                                for (int r = 0; r < 4; ++r) {
                                    float x1, x2;
                                    rope_pair(a[r], a2[r], pos, 4 * g4 + r, x1, x2);
                                    o1[r] = (half_t)x1; o2[r] = (half_t)x2;
                                }
#pragma unroll
                                for (int h = 0; h < 8; ++h) {
                                    half_t* kr = KM + ((long)(b * 8 + h) * SEQ + sq) * 96 + 64 + 4 * g4;
                                    *(h4v*)kr = o1; *(h4v*)(kr + 16) = o2;
                                }
                            } else if (cb >= 1696) {
                                const int j = n - 1696;
                                if (j < 24) {
                                    float4 o;
                                    o.x = 1.0f / (1.0f + __expf(-a[0])); o.y = 1.0f / (1.0f + __expf(-a[1]));
                                    o.z = 1.0f / (1.0f + __expf(-a[2])); o.w = 1.0f / (1.0f + __expf(-a[3]));
                                    *(float4*)(GATES + (long)t * 24 + j) = o;
                                }
                            }
                        }
                    }
                });
        }
    }
}

__device__ __forceinline__ void phase_p2(const Params& p, int bid, int nb, char* smem) {
    char* ws = p.ws;
    const int NTA = 256 * 6, NTB = 256 * 8, NTC = 128;
    for (int tile = bid; tile < NTA + NTB + NTC; tile += nb) {
        if (tile < NTC) {
            const int nt = tile & 1, mt = (tile >> 1) & 7, bg = (tile >> 4) & 3, kv = tile >> 6;
            const half_t* A = (const half_t*)(ws + (kv ? OFF_VC : OFF_KC)) + (long)bg * SEQ * 64 + (long)mt * 128 * 1024;
            const half_t* Bt = (const half_t*)(ws + OFF_WC1) + ((long)kv * 256 + nt * 128) * 2048;
            const float* cbv = (const float*)(ws + OFF_CB) + kv * 256;
            half_t* HC = (half_t*)(ws + OFF_HC1) + ((long)(kv * 4 + bg) * 1024) * 256;
            gemm_tile<false, true>(A, 1024, Bt, 2048, 2048, 2048, smem,
                [&](f4v (&acc)[4][4], int wm, int wn, int i16, int g4) __attribute__((always_inline)) {
#pragma unroll
                    for (int mi = 0; mi < 4; ++mi) {
                        const int m = mt * 128 + wm * 64 + mi * 16 + i16;
#pragma unroll
                        for (int ni = 0; ni < 4; ++ni) {
                            const int n = nt * 128 + wn * 64 + ni * 16 + 4 * g4;
                            const float4 bias = *(const float4*)(cbv + n);
                            const h4v o = {(half_t)gelu_exact(acc[mi][ni][0] + bias.x), (half_t)gelu_exact(acc[mi][ni][1] + bias.y),
                                           (half_t)gelu_exact(acc[mi][ni][2] + bias.z), (half_t)gelu_exact(acc[mi][ni][3] + bias.w)};
                            if (m < NCMP) *(h4v*)(HC + (long)m * 256 + n) = o;
                        }
                    }
                });
        } else if (tile < NTC + NTA) {
            const int t2 = tile - NTC;
            const int tm = t2 / 6, tn = t2 % 6;
            const int row0 = tm * 128, n0 = tn * 128;
            half_t* QM = (half_t*)(ws + OFF_QM);
            gemm_tile<true, true>((const half_t*)(ws + OFF_CQ) + (long)row0 * 256, 256, (const half_t*)(ws + OFF_WQUP) + (long)n0 * 256, 256, 256, 256, smem,
                [&](f4v (&acc)[4][4], int wm, int wn, int i16, int g4) __attribute__((always_inline)) {
#pragma unroll
                    for (int mi = 0; mi < 4; ++mi) {
                        const int t = row0 + wm * 64 + mi * 16 + i16;
                        const int b = t >> 14, sq = t & (SEQ - 1);
#pragma unroll
                        for (int ni = 0; ni < 4; ++ni) {
                            const int cb = n0 + wn * 64 + ni * 16;
                            const int h = cb / 96, d0 = cb - h * 96;
                            half_t* qr = QM + ((long)(b * 8 + h) * SEQ + sq) * 96;
                            const f4v a = acc[mi][ni];
                            if (d0 < 64) {
                                const h4v o = {(half_t)(a[0] * QS_MLA), (half_t)(a[1] * QS_MLA), (half_t)(a[2] * QS_MLA), (half_t)(a[3] * QS_MLA)};
                                *(h4v*)(qr + d0 + 4 * g4) = o;
                            } else if (d0 == 64) {
                                const f4v a2 = acc[mi][(ni + 1) & 3];
                                const int pos = p.pos[t];
                                h4v o1, o2;
#pragma unroll
                                for (int r = 0; r < 4; ++r) {
                                    float x1, x2;
                                    rope_pair(a[r] * QS_MLA, a2[r] * QS_MLA, pos, 4 * g4 + r, x1, x2);
                                    o1[r] = (half_t)x1; o2[r] = (half_t)x2;
                                }
                                *(h4v*)(qr + 64 + 4 * g4) = o1; *(h4v*)(qr + 80 + 4 * g4) = o2;
                            }
                        }
                    }
                });
        } else {
            const int t2 = tile - NTC - NTA;
            const int tm = t2 >> 3, tn = t2 & 7;
            const int row0 = tm * 128, n0 = tn * 128;
            half_t* KM = (half_t*)(ws + OFF_KM);
            half_t* VT = (half_t*)(ws + OFF_VT);
            gemm_tile<true, false>((const half_t*)(ws + OFF_CKV) + (long)row0 * 128, 128, (const half_t*)(ws + OFF_WKVUP) + (long)n0 * 128, 128, 128, 128, smem,
                [&](f4v (&acc)[4][4], int wm, int wn, int i16, int g4) __attribute__((always_inline)) {
                    const int h = tn;
#pragma unroll
                    for (int ni = 0; ni < 4; ++ni) {
                        const int d0 = wn * 64 + ni * 16;
#pragma unroll
                        for (int mi = 0; mi < 4; ++mi) {
                            const int rbase = row0 + wm * 64 + mi * 16 + g4 * 4;
                            const int b = rbase >> 14, s0 = rbase & (SEQ - 1);
                            if (d0 < 64) {
#pragma unroll
                                for (int r = 0; r < 4; ++r) KM[((long)(b * 8 + h) * SEQ + s0 + r) * 96 + d0 + i16] = (half_t)acc[mi][ni][r];
                            } else {
                                const h4v o = {(half_t)acc[mi][ni][0], (half_t)acc[mi][ni][1], (half_t)acc[mi][ni][2], (half_t)acc[mi][ni][3]};
                                *(h4v*)(VT + ((long)(b * 8 + h) * 64 + (d0 - 64 + i16)) * SEQ + s0) = o;
                            }
                        }
                    }
                });
        }
    }
}

constexpr int KMAX_KS = 128, KMAX_KW = 132, KMAX_KC = 136, KMAX_KM = 140, KMAX_BIAS = 156;
__device__ __forceinline__ void phase_cmp2(const Params& p, int bid, int nb) {
    char* ws = p.ws;
    unsigned* ctr = (unsigned*)(ws + OFF_CTRL);
    int tx_ = threadIdx.x; asm volatile("" : "+v"(tx_));
    const long tid = (long)bid * NTHREADS + tx_, nth = (long)nb * NTHREADS;
    const int lane = tx_ & 63;
    const half_t* HC = (const half_t*)(ws + OFF_HC1);
    half_t* KC = (half_t*)(ws + OFF_KCMP);
    half_t* VCT = (half_t*)(ws + OFF_VCMPT);
    for (long e = tid; e < 2L * 4 * 1024 * 64; e += nth) {
        const int d = (int)(e & 63), n = (int)((e >> 6) & 1023), bg = (int)((e >> 16) & 3), kv = (int)(e >> 18);
        float s = 0.f;
        if (n < NCMP) {
            const half_t* hr = HC + ((long)(kv * 4 + bg) * 1024 + n) * 256;
            const float* w2 = kv ? p.cmp_v_w2 : p.cmp_k_w2;
            for (int j = 0; j < 256; ++j) s += (float)hr[j] * w2[j * 64 + d];
        }
        const half_t sh = (half_t)s;
        if (kv == 0) {
            KC[((long)bg * 1024 + n) * 64 + d] = sh;
            const float nn = wave_sum((float)sh * (float)sh, lane);
            if (lane == 0) atomicMax(&ctr[KMAX_KC + bg], __float_as_uint(nn));
        } else VCT[((long)bg * 64 + d) * 1024 + n] = sh;
    }
    {
        const int sub = lane & 7;
        const long grp = tid >> 3, ngrp = nth >> 3;
        for (int which = 0; which < 2; ++which) {
            const half_t* Kb = (const half_t*)(ws + (which ? OFF_KW : OFF_KS));
            float mx[4] = {0.f, 0.f, 0.f, 0.f};
            for (long row = grp; row < 4L * SEQ; row += ngrp) {
                const h8v v = *(const h8v*)(Kb + row * 64 + sub * 8);
                float d = 0.f;
#pragma unroll
                for (int j = 0; j < 4; ++j) d = __builtin_amdgcn_fdot2((h2v){v[2 * j], v[2 * j + 1]}, (h2v){v[2 * j], v[2 * j + 1]}, d, false);
                d = red8(d);
                const int bg = (int)(row >> 14);
#pragma unroll
                for (int q = 0; q < 4; ++q) mx[q] = (bg == q) ? fmaxf(mx[q], d) : mx[q];
            }
#pragma unroll
            for (int q = 0; q < 4; ++q) {
                float m = mx[q];
#pragma unroll
                for (int o = 32; o >= 1; o >>= 1) m = fmaxf(m, shx(lane, m, o));
                if (lane == 0 && m > 0.f) atomicMax(&ctr[(which ? KMAX_KW : KMAX_KS) + q], __float_as_uint(m));
            }
        }
        const half_t* Km = (const half_t*)(ws + OFF_KM);
        const long wv = tid >> 6, nwv = nth >> 6;
        for (long blk = wv; blk < 16L * SEQ / 64; blk += nwv) {
            const int bh = (int)(blk / (SEQ / 64));
            float mloc = 0.f;
#pragma unroll 1
            for (int rr = 0; rr < 8; ++rr) {
                const long row = blk * 64 + rr * 8 + (lane >> 3);
                const half_t* kr = Km + row * 96 + sub * 8;
                float d = 0.f;
                {
                    const h8v v = *(const h8v*)kr;
#pragma unroll
                    for (int j = 0; j < 4; ++j) d = __builtin_amdgcn_fdot2((h2v){v[2 * j], v[2 * j + 1]}, (h2v){v[2 * j], v[2 * j + 1]}, d, false);
                }
                if (sub < 4) {
                    const h8v v = *(const h8v*)(kr + 64);
#pragma unroll
                    for (int j = 0; j < 4; ++j) d = __builtin_amdgcn_fdot2((h2v){v[2 * j], v[2 * j + 1]}, (h2v){v[2 * j], v[2 * j + 1]}, d, false);
                }
                d = red8(d);
                mloc = fmaxf(mloc, d);
            }
#pragma unroll
            for (int o = 32; o >= 1; o >>= 1) mloc = fmaxf(mloc, shx(lane, mloc, o));
            if (lane == 0) atomicMax(&ctr[KMAX_KM + bh], __float_as_uint(mloc));
        }
    }
    if (tid == 0) {
        float mb = 0.f;
        for (int i = 0; i < 256; ++i) mb = fmaxf(mb, p.t5_bias[i] * LOG2E);
        ctr[KMAX_BIAS] = __float_as_uint(mb);
    }
}

struct MlaSmem { half_t K[2][64][104]; half_t V[2][64][68]; };

__device__ __forceinline__ void mla_item(const Params& p, int bh, int qb, char* smem) {
    MlaSmem& sm = *(MlaSmem*)smem;
    char* ws = p.ws;
    const int b = bh >> 3, h = bh & 7;
    const half_t* Qp = (const half_t*)(ws + OFF_QM) + ((long)bh * SEQ + qb * 128) * 96;
    const half_t* Kp = (const half_t*)(ws + OFF_KM) + (long)bh * SEQ * 96;
    const half_t* Vp = (const half_t*)(ws + OFF_VT) + (long)bh * 64 * SEQ;
    half_t* MIX = (half_t*)(ws + OFF_MIXED);
    int tid_ = threadIdx.x; asm volatile("" : "+v"(tid_));
    const int tid = tid_, lane = tid & 63, w = tid >> 6;
    const int c = lane & 31, hh = lane >> 5;
    const int tq = qb * 128 + w * 32 + c;
    h8v qf[6];
#pragma unroll
    for (int s6 = 0; s6 < 6; ++s6) qf[s6] = *(const h8v*)(Qp + (long)(w * 32 + c) * 96 + s6 * 16 + hh * 8);
    f16v o0, o1;
#pragma unroll
    for (int i = 0; i < 16; ++i) { o0[i] = 0.f; o1[i] = 0.f; }
    float qn2 = 0.f;
#pragma unroll
    for (int s6 = 0; s6 < 6; ++s6)
#pragma unroll
        for (int j = 0; j < 8; ++j) { const float f = (float)qf[s6][j]; qn2 += f * f; }
    qn2 += shx(lane, qn2, 32);
    const float kmax2 = __uint_as_float(((const unsigned*)(ws + OFF_CTRL))[KMAX_KM + bh]);
    const float nmref = 10.0f - sqrtf(qn2 * kmax2) * 1.0005f;
    float l = 0.f;
    const int ntiles = 2 * qb + 2;
    auto gload = [&](int j, u4v (&rk)[3], u4v (&rv)[2]) __attribute__((always_inline)) {
#pragma unroll
        for (int i = 0; i < 3; ++i) {
            const int ci = tid + 256 * i, key = ci / 12, of = ci % 12;
            rk[i] = *(const u4v*)(Kp + (long)(j * 64 + key) * 96 + of * 8);
        }
#pragma unroll
        for (int i = 0; i < 2; ++i) {
            const int ci = tid + 256 * i, dim = ci >> 3, of = ci & 7;
            rv[i] = *(const u4v*)(Vp + (long)dim * SEQ + j * 64 + of * 8);
        }
    };
    auto lstore = [&](int buf, const u4v (&rk)[3], const u4v (&rv)[2]) __attribute__((always_inline)) {
#pragma unroll
        for (int i = 0; i < 3; ++i) {
            const int ci = tid + 256 * i, key = ci / 12, of = ci % 12;
            *(u4v*)&sm.K[buf][key][of * 8] = rk[i];
        }
#pragma unroll
        for (int i = 0; i < 2; ++i) {
            const int ci = tid + 256 * i, dim = ci >> 3, of = ci & 7;
            *(u2v*)&sm.V[buf][dim][of * 8] = (u2v){rv[i][0], rv[i][1]};
            *(u2v*)&sm.V[buf][dim][of * 8 + 4] = (u2v){rv[i][2], rv[i][3]};
        }
    };
    const int qmin = qb * 128 + w * 32;
    auto compute = [&](int j, int buf) __attribute__((always_inline)) {
        if (64 * j <= qmin + 31) {
            f16v s0, s1;
#pragma unroll
            for (int i = 0; i < 16; ++i) { s0[i] = nmref; s1[i] = nmref; }
#pragma unroll
            for (int s6 = 0; s6 < 6; ++s6) {
                const h8v a0 = *(const h8v*)&sm.K[buf][c][s6 * 16 + hh * 8];
                const h8v a1 = *(const h8v*)&sm.K[buf][32 + c][s6 * 16 + hh * 8];
                s0 = mfma32(a0, qf[s6], s0);
                s1 = mfma32(a1, qf[s6], s1);
            }
            if (64 * j + 63 > qmin) {
#pragma unroll
                for (int r = 0; r < 16; ++r) {
                    const int key = 64 * j + (r & 3) + 8 * (r >> 2) + 4 * hh;
                    if (key > tq) s0[r] = NEGF;
                    if (key + 32 > tq) s1[r] = NEGF;
                }
            }
#pragma unroll
            for (int r = 0; r < 16; ++r) { s0[r] = fast_exp2(s0[r]); l += s0[r]; }
#pragma unroll
            for (int r = 0; r < 16; ++r) { s1[r] = fast_exp2(s1[r]); l += s1[r]; }
#pragma unroll
            for (int ks = 0; ks < 4; ++ks) {
                h8v pb;
#pragma unroll
                for (int jj = 0; jj < 8; ++jj) pb[jj] = (half_t)((ks < 2) ? s0[8 * (ks & 1) + jj] : s1[8 * (ks & 1) + jj]);
#pragma unroll
                for (int md = 0; md < 2; ++md) {
                    const h4v lo = *(const h4v*)&sm.V[buf][32 * md + c][16 * ks + 4 * hh];
                    const h4v hi = *(const h4v*)&sm.V[buf][32 * md + c][16 * ks + 8 + 4 * hh];
                    const h8v a = {lo[0], lo[1], lo[2], lo[3], hi[0], hi[1], hi[2], hi[3]};
                    if (md == 0) o0 = mfma32(a, pb, o0); else o1 = mfma32(a, pb, o1);
                }
            }
        }
    };
    u4v rkA[3], rvA[2], rkB[3], rvB[2];
    gload(0, rkA, rvA);
    gload(1, rkB, rvB);
    lstore(0, rkA, rvA);
    __syncthreads();
#pragma unroll 1
    for (int j = 0; j < ntiles; j += 2) {
        if (j + 2 < ntiles) gload(j + 2, rkA, rvA);
        compute(j, 0);
        lstore(1, rkB, rvB);
        __syncthreads();
        if (j + 3 < ntiles) gload(j + 3, rkB, rvB);
        compute(j + 1, 1);
        if (j + 2 < ntiles) lstore(0, rkA, rvA);
        __syncthreads();
    }
    const float lt = l + shx(lane, l, 32);
    const float inv = 1.0f / lt;
    half_t* orow = MIX + (long)(b * SEQ + tq) * 1024 + 512 + h * 64;
#pragma unroll
    for (int md = 0; md < 2; ++md)
#pragma unroll
        for (int rg = 0; rg < 4; ++rg) {
            h4v o;
#pragma unroll
            for (int e = 0; e < 4; ++e) o[e] = (half_t)(((md == 0) ? o0[4 * rg + e] : o1[4 * rg + e]) * inv);
            *(h4v*)(orow + 32 * md + 8 * rg + 4 * hh) = o;
        }
}

struct NsaStage { half_t K[64][72]; half_t V[64][68]; };
constexpr int NSA_LUT = 0;
constexpr int NSA_ST0 = 12288;
constexpr int NSA_RB = NSA_ST0 + 17920;
constexpr int NSA_SEL = NSA_RB + 32768;
constexpr int NSA_MASK = NSA_SEL + 2048;
constexpr int NSA_END = NSA_MASK + 1024;
constexpr float MINIT = -30000.0f;

__device__ __forceinline__ void nsa_item(const Params& p, int bg, int qt, char* smem) {
    char* ws = p.ws;
    half_t* lut = (half_t*)(smem + NSA_LUT);
    float (*imp)[8][256] = (float (*)[8][256])(smem + NSA_RB);
    int (*sel)[8][16] = (int (*)[8][16])(smem + NSA_SEL);
    unsigned* masks = (unsigned*)(smem + NSA_MASK);
    const int b = bg >> 1, g = bg & 1;
    int tid_ = threadIdx.x; asm volatile("" : "+v"(tid_));
    const int tid = tid_, lane = tid & 63, w = tid >> 6;
    const int c = lane & 31, hh = lane >> 5;
    const int qi = c >> 2, r = c & 3;
    const int t0 = qt * 32;
    const int t0w = t0 + w * 8;
    const int tq = t0w + qi;
    const int tlast = t0w + 7;
    {
        const float* lg = (const float*)(ws + OFF_LUT) + (long)g * LUTN * 4;
        for (int i = tid; i < LUTN * 4; i += NTHREADS) lut[i] = (half_t)lg[i];
        float* im = &imp[0][0][0];
        for (int i = tid; i < 4 * 8 * 256; i += NTHREADS) im[i] = 0.f;
    }
    __syncthreads();
    const float cfar = (float)lut[(LUTN - 1) * 4 + r];
    const half_t* QH = (const half_t*)(ws + OFF_QH);
    h8v qf[4];
#pragma unroll
    for (int s4 = 0; s4 < 4; ++s4) qf[s4] = *(const h8v*)(QH + (long)(b * SEQ + tq) * 512 + (g * 4 + r) * 64 + s4 * 16 + hh * 8);
    float nrefC, nrefS, nrefW;
    {
        float qn2 = 0.f;
#pragma unroll
        for (int s4 = 0; s4 < 4; ++s4)
#pragma unroll
            for (int j = 0; j < 8; ++j) { const float f = (float)qf[s4][j]; qn2 += f * f; }
        qn2 += shx(lane, qn2, 32);
        const unsigned* cw = (const unsigned*)(ws + OFF_CTRL);
        const float mb = __uint_as_float(cw[KMAX_BIAS]);
        nrefC = 10.0f - mb - sqrtf(qn2 * __uint_as_float(cw[KMAX_KC + bg])) * 1.0005f;
        nrefS = 10.0f - mb - sqrtf(qn2 * __uint_as_float(cw[KMAX_KS + bg])) * 1.0005f;
        nrefW = 10.0f - mb - sqrtf(qn2 * __uint_as_float(cw[KMAX_KW + bg])) * 1.0005f;
    }
    const float* gp = (const float*)(ws + OFF_GATES) + (long)(b * SEQ + tq) * 24 + (g * 4 + r) * 3;
    const float g0 = gp[0], g1 = gp[1], g2 = gp[2];
    f16v of0, of1;
#pragma unroll
    for (int i = 0; i < 16; ++i) { of0[i] = 0.f; of1[i] = 0.f; }

    u4v rk[2], rvv[2];
    auto stage_gload_r = [&](u4v (&rk_)[2], u4v (&rv_)[2], const half_t* Kg, const half_t* Vg, long ldv, int key0, bool withv) __attribute__((always_inline)) {
#pragma unroll
        for (int i = 0; i < 2; ++i) {
            const int ci = tid + 256 * i, row = ci >> 3, of = ci & 7;
            rk_[i] = *(const u4v*)(Kg + (long)(key0 + row) * 64 + of * 8);
            if (withv) rv_[i] = *(const u4v*)(Vg + (long)row * ldv + key0 + of * 8);
        }
    };
    auto stage_lstore_r = [&](NsaStage& st, const u4v (&rk_)[2], const u4v (&rv_)[2], bool withv) __attribute__((always_inline)) {
#pragma unroll
        for (int i = 0; i < 2; ++i) {
            const int ci = tid + 256 * i, row = ci >> 3, of = ci & 7;
            *(u4v*)&st.K[row][of * 8] = rk_[i];
            if (withv) {
                *(u2v*)&st.V[row][of * 8] = (u2v){rv_[i][0], rv_[i][1]};
                *(u2v*)&st.V[row][of * 8 + 4] = (u2v){rv_[i][2], rv_[i][3]};
            }
        }
    };
    auto stage_gload = [&](const half_t* Kg, const half_t* Vg, long ldv, int key0, bool withv) __attribute__((always_inline)) { stage_gload_r(rk, rvv, Kg, Vg, ldv, key0, withv); };
    auto stage_lstore = [&](NsaStage& st, bool withv) __attribute__((always_inline)) { stage_lstore_r(st, rk, rvv, withv); };
    auto qk32 = [&](const NsaStage& st, int mt, float init) __attribute__((always_inline)) -> f16v {
        f16v s;
#pragma unroll
        for (int i = 0; i < 16; ++i) s[i] = init;
#pragma unroll
        for (int s4 = 0; s4 < 4; ++s4) {
            const h8v a = *(const h8v*)&st.K[32 * mt + c][s4 * 16 + hh * 8];
            s = mfma32(a, qf[s4], s);
        }
        return s;
    };
    auto pv32 = [&](const NsaStage& st, int mt, const f16v& pr, f16v& oa, f16v& ob) __attribute__((always_inline)) {
#pragma unroll
        for (int ks = 0; ks < 2; ++ks) {
            h8v pb;
#pragma unroll
            for (int jj = 0; jj < 8; ++jj) pb[jj] = (half_t)pr[8 * ks + jj];
#pragma unroll
            for (int md = 0; md < 2; ++md) {
                const h4v lo = *(const h4v*)&st.V[32 * md + c][32 * mt + 16 * ks + 4 * hh];
                const h4v hi = *(const h4v*)&st.V[32 * md + c][32 * mt + 16 * ks + 8 + 4 * hh];
                const h8v a = {lo[0], lo[1], lo[2], lo[3], hi[0], hi[1], hi[2], hi[3]};
                if (md == 0) oa = mfma32(a, pb, oa); else ob = mfma32(a, pb, ob);
            }
        }
    };
    NsaStage& st0 = *(NsaStage*)(smem + NSA_ST0);
    NsaStage& st1 = *(NsaStage*)(smem + NSA_RB);

    for (int rep = 0; rep < (PROBE_PHASE == 22 ? 2 : 1); ++rep) {
        __syncthreads();
        const half_t* KC = (const half_t*)(ws + OFF_KCMP) + (long)bg * 1024 * 64;
        const half_t* VCT = (const half_t*)(ws + OFF_VCMPT) + (long)bg * 64 * 1024;
        const int nst = ((t0 >> 4) >> 6) + 1;
        auto cmp_scores = [&](f16v& s, int kbase) __attribute__((always_inline)) {
            const bool far = (t0w - (16 * (kbase + 31) + 31)) >= 1513;
            if (far) {
#pragma unroll
                for (int rr = 0; rr < 16; ++rr) s[rr] += cfar;
            } else {
#pragma unroll
                for (int rr = 0; rr < 16; ++rr) {
                    const int k = kbase + (rr & 3) + 8 * (rr >> 2) + 4 * hh;
                    const int dist = tq - (16 * k + 31);
                    const int di = dist < 0 ? 0 : (dist > LUTN - 1 ? LUTN - 1 : dist);
                    s[rr] = (dist >= 0) ? s[rr] + (float)lut[di * 4 + r] : NEGF;
                }
            }
        };
        float l = 0.f;
        stage_gload(KC, VCT, 1024, 0, false);
#pragma unroll 1
        for (int sg = 0; sg < nst; ++sg) {
            stage_lstore(st0, false);
            __syncthreads();
            if (sg + 1 < nst) stage_gload(KC, VCT, 1024, (sg + 1) * 64, false);
#pragma unroll
            for (int mt = 0; mt < 2; ++mt) {
                const int kbase = sg * 64 + mt * 32;
                if (16 * kbase + 31 <= tlast) {
                    f16v s = qk32(st0, mt, nrefC);
                    cmp_scores(s, kbase);
#pragma unroll
                    for (int rr = 0; rr < 16; ++rr) l += fast_exp2(s[rr]);
                }
            }
            __syncthreads();
        }
        l += shx(lane, l, 32);
        const float ml2 = (l > 0.f) ? __builtin_amdgcn_logf(l) : 1e30f;
        f16v oc0, oc1;
#pragma unroll
        for (int i = 0; i < 16; ++i) { oc0[i] = 0.f; oc1[i] = 0.f; }
        float carryL = 0.f;
        stage_gload(KC, VCT, 1024, 0, true);
#pragma unroll 1
        for (int sg = 0; sg < nst; ++sg) {
            stage_lstore(st0, true);
            __syncthreads();
            if (sg + 1 < nst) stage_gload(KC, VCT, 1024, (sg + 1) * 64, true);
#pragma unroll
            for (int mt = 0; mt < 2; ++mt) {
                const int kbase = sg * 64 + mt * 32;
                const int kt = sg * 2 + mt;
                if (16 * kbase + 31 <= tlast) {
                    f16v s = qk32(st0, mt, nrefC);
                    cmp_scores(s, kbase);
#pragma unroll
                    for (int rr = 0; rr < 16; ++rr) s[rr] = fast_exp2(s[rr] - ml2);
                    float Gs[4], Ls[4];
#pragma unroll
                    for (int jg = 0; jg < 4; ++jg) {
                        float G = s[4 * jg] + s[4 * jg + 1] + s[4 * jg + 2] + s[4 * jg + 3];
                        float L = s[4 * jg + 3];
                        G += shx(lane, G, 1); G += shx(lane, G, 2);
                        L += shx(lane, L, 1); L += shx(lane, L, 2);
                        Gs[jg] = G; Ls[jg] = L;
                    }
                    float Lo[4];
#pragma unroll
                    for (int jg = 0; jg < 4; ++jg) Lo[jg] = shx(lane, Ls[jg], 32);
                    if (r == 0) {
#pragma unroll
                        for (int jg = 0; jg < 4; ++jg) {
                            const float prevL = hh ? Lo[jg] : (jg == 0 ? carryL : Lo[jg - 1]);
                            imp[w][qi][8 * kt + 2 * jg + hh] = Gs[jg] + prevL;
                        }
                    }
                    carryL = Lo[3];
                    pv32(st0, mt, s, oc0, oc1);
                }
            }
            __syncthreads();
        }
#pragma unroll
        for (int i = 0; i < 16; ++i) { of0[i] += (rep == 0 ? g0 : 0.0f) * oc0[i]; of1[i] += (rep == 0 ? g0 : 0.0f) * oc1[i]; }
    }
    {
        const int q2 = lane >> 3, sub = lane & 7;
        const int tq2 = t0w + q2;
        const int cur = tq2 >> 6;
        unsigned key[32];
#pragma unroll
        for (int i = 0; i < 32; ++i) {
            const int sb = sub + 8 * i;
            const float v = imp[w][q2][sb];
            unsigned u = (__float_as_uint(v) & 0x7FFFFF00u) | (unsigned)(255 - sb);
            if (sb == 0 || sb == cur || sb == cur - 1) u |= 0x80000000u;
            if (sb > cur) u = 0u;
            key[i] = u;
        }
#pragma unroll 1
        for (int round = 0; round < 16; ++round) {
            unsigned best = key[0];
#pragma unroll
            for (int i = 1; i < 32; ++i) best = best > key[i] ? best : key[i];
#pragma unroll
            for (int o = 1; o <= 4; o <<= 1) { const unsigned ob = (unsigned)shx(lane, (int)best, o); best = best > ob ? best : ob; }
            if (sub == 0) sel[w][q2][round] = best ? (int)(255u - (best & 0xFFu)) : -1;
#pragma unroll
            for (int i = 0; i < 32; ++i) key[i] = (key[i] == best) ? 0u : key[i];
        }
    }
    for (int i = tid; i < 256; i += NTHREADS) masks[i] = 0u;
    __syncthreads();
    for (int e = lane; e < 128; e += 64) {
        const int q2 = e >> 4, bi = e & 15;
        const int blk = sel[w][q2][bi];
        if (blk >= 0) atomicOr(&masks[blk], 1u << (8 * w + q2));
    }
    __syncthreads();
    auto block_attend = [&](const NsaStage& st, int key0, bool colsel, bool window, float nref, float& l, f16v& oa, f16v& ob) __attribute__((always_inline)) {
        const bool far = !window && (t0w - (key0 + 63)) >= 1513;
        f16v s0, s1;
        if (far) {
            const float init = colsel ? (cfar + nref) : NEGF;
            s0 = qk32(st, 0, init); s1 = qk32(st, 1, init);
        } else {
            s0 = qk32(st, 0, nref); s1 = qk32(st, 1, nref);
#pragma unroll
            for (int rr = 0; rr < 16; ++rr) {
                const int pos = key0 + (rr & 3) + 8 * (rr >> 2) + 4 * hh;
                {
                    const int dist = tq - pos;
                    const bool valid = colsel && dist >= 0 && (!window || dist < 512);
                    const int di = dist < 0 ? 0 : (dist > LUTN - 1 ? LUTN - 1 : dist);
                    s0[rr] = valid ? s0[rr] + (float)lut[di * 4 + r] : NEGF;
                }
                {
                    const int dist = tq - pos - 32;
                    const bool valid = colsel && dist >= 0 && (!window || dist < 512);
                    const int di = dist < 0 ? 0 : (dist > LUTN - 1 ? LUTN - 1 : dist);
                    s1[rr] = valid ? s1[rr] + (float)lut[di * 4 + r] : NEGF;
                }
            }
        }
#pragma unroll
        for (int rr = 0; rr < 16; ++rr) { s0[rr] = fast_exp2(s0[rr]); l += s0[rr]; }
#pragma unroll
        for (int rr = 0; rr < 16; ++rr) { s1[rr] = fast_exp2(s1[rr]); l += s1[rr]; }
        pv32(st, 0, s0, oa, ob);
        pv32(st, 1, s1, oa, ob);
    };
    unsigned char* blist = (unsigned char*)(smem + NSA_SEL);
    volatile int* bcount = (volatile int*)(smem + NSA_SEL + 256);
    if (w == 0) {
        const int jmaxb = (t0 + 31) >> 6;
        int base = 0;
#pragma unroll 1
        for (int rnd = 0; rnd < 4; ++rnd) {
            const int bb = rnd * 64 + lane;
            const bool f = (bb <= jmaxb) && (masks[bb] != 0u);
            const unsigned long long bal = __ballot(f);
            const int pos = base + __popcll(bal & ((1ull << lane) - 1ull));
            if (f) blist[pos] = (unsigned char)bb;
            base += __popcll(bal);
        }
        if (lane == 0) *bcount = base;
    }
    for (int rep = 0; rep < (PROBE_PHASE == 20 ? 2 : 1); ++rep) {
        __syncthreads();
        const half_t* KS = (const half_t*)(ws + OFF_KS) + (long)bg * SEQ * 64;
        const half_t* VST = (const half_t*)(ws + OFF_VST) + (long)bg * 64 * SEQ;
        f16v os0, os1;
#pragma unroll
        for (int i = 0; i < 16; ++i) { os0[i] = 0.f; os1[i] = 0.f; }
        float l = 0.f;
        const int nblk = *bcount;
        u4v kA[2], vA[2], kB[2], vB[2];
        if (nblk > 0) stage_gload_r(kA, vA, KS, VST, SEQ, (int)blist[0] * 64, true);
        if (nblk > 1) stage_gload_r(kB, vB, KS, VST, SEQ, (int)blist[1] * 64, true);
        if (nblk > 0) stage_lstore_r(st0, kA, vA, true);
        __syncthreads();
#define SEL_STAGE(i_, ST, STN, KX, VX, KY, VY) { \
            const int i__ = (i_); \
            if (i__ < nblk) { \
                if (i__ + 2 < nblk) stage_gload_r(KX, VX, KS, VST, SEQ, (int)blist[i__ + 2] * 64, true); \
                const int j = (int)blist[i__]; \
                const unsigned mk = masks[j]; \
                if ((mk >> (8 * w)) & 0xFFu) { \
                    const bool colsel = (mk >> (8 * w + qi)) & 1u; \
                    block_attend(ST, j * 64, colsel, false, nrefS, l, os0, os1); \
                } \
                if (i__ + 1 < nblk) stage_lstore_r(STN, KY, VY, true); \
                __syncthreads(); \
            } }
#pragma unroll 1
        for (int i = 0; i < nblk; i += 2) {
            SEL_STAGE(i, st0, st1, kA, vA, kB, vB);
            SEL_STAGE(i + 1, st1, st0, kB, vB, kA, vA);
        }
        const float lt = l + shx(lane, l, 32);
        const float sc = ((lt > 0.f) ? g1 / lt : 0.f) * (rep == 0 ? 1.0f : 0.0f);
#pragma unroll
        for (int i = 0; i < 16; ++i) { of0[i] += sc * os0[i]; of1[i] += sc * os1[i]; }
    }
    __syncthreads();
    for (int rep = 0; rep < (PROBE_PHASE == 21 ? 2 : 1); ++rep) {
        __syncthreads();
        const half_t* KW = (const half_t*)(ws + OFF_KW) + (long)bg * SEQ * 64;
        const half_t* VWT = (const half_t*)(ws + OFF_VWT) + (long)bg * 64 * SEQ;
        f16v ow0, ow1;
#pragma unroll
        for (int i = 0; i < 16; ++i) { ow0[i] = 0.f; ow1[i] = 0.f; }
        float l = 0.f;
        const int jmax = (t0 + 31) >> 6;
        int j = (t0 >= 511) ? ((t0 - 511) >> 6) : 0;
        int buf = 0;
        stage_gload(KW, VWT, SEQ, j * 64, true);
#pragma unroll 1
        while (j <= jmax) {
            NsaStage& st = buf ? st1 : st0;
            stage_lstore(st, true);
            __syncthreads();
            if (j + 1 <= jmax) stage_gload(KW, VWT, SEQ, (j + 1) * 64, true);
            block_attend(st, j * 64, true, true, nrefW, l, ow0, ow1);
            buf ^= 1; ++j;
        }
        const float lt = l + shx(lane, l, 32);
        const float sc = ((lt > 0.f) ? g2 / lt : 0.f) * (rep == 0 ? 1.0f : 0.0f);
#pragma unroll
        for (int i = 0; i < 16; ++i) { of0[i] += sc * ow0[i]; of1[i] += sc * ow1[i]; }
    }
    {
        half_t* orow = (half_t*)(ws + OFF_MIXED) + (long)(b * SEQ + tq) * 1024 + (g * 4 + r) * 64;
#pragma unroll
        for (int md = 0; md < 2; ++md)
#pragma unroll
            for (int rg = 0; rg < 4; ++rg) {
                h4v o;
#pragma unroll
                for (int e = 0; e < 4; ++e) o[e] = (half_t)((md == 0) ? of0[4 * rg + e] : of1[4 * rg + e]);
                *(h4v*)(orow + 32 * md + 8 * rg + 4 * hh) = o;
            }
    }
    __syncthreads();
}

__device__ __forceinline__ void phase_attn(const Params& p, char* smem, int cidx = 64, int mode = 0) {
    volatile int* s_item = (volatile int*)(smem + 66048);
    const int lo = (mode == 2) ? 256 : 0, hi = (mode == 1) ? 256 : 512;
    for (;;) {
        if (threadIdx.x == 0) {
            unsigned* ctr = (unsigned*)(p.ws + OFF_CTRL) + cidx;
            const int x0 = (int)(xb_xcc_id() & 7u);
            int v = -1, qq = 0;
            for (int k = 0; k < 8; ++k) {
                const int q = (x0 + k) & 7;
                if (__hip_atomic_load(&ctr[q], __ATOMIC_RELAXED, __HIP_MEMORY_SCOPE_AGENT) >= (unsigned)(hi - lo)) continue;
                const int c = (int)atomicAdd(&ctr[q], 1u);
                if (c < hi - lo) { v = c + lo; qq = q; break; }
            }
            s_item[0] = v; s_item[1] = qq;
        }
        __syncthreads();
        const int li = s_item[0], q = s_item[1];
        __syncthreads();
        if (li < 0) break;
        if (li < 256) mla_item(p, 2 * q + (li & 1), 127 - (li >> 1), smem);
        else nsa_item(p, q & 3, 511 - 2 * (li - 256) - (q >> 2), smem);
    }
}

__device__ __forceinline__ void phase_outproj(const Params& p, int bid, int nb, char* smem) {
    char* ws = p.ws;
    const half_t* MIX = (const half_t*)(ws + OFF_MIXED);
    const half_t* W = (const half_t*)(ws + OFF_WOUT);
    half_t* X2H = (half_t*)(ws + OFF_X2H);
    for (int tile = bid; tile < 256 * 8; tile += nb) {
        const int tm = tile >> 3, tn = tile & 7;
        const int row0 = tm * 128, n0 = tn * 128;
        gemm_tile<true, true>(MIX + (long)row0 * 1024, 1024, W + (long)n0 * 1024, 1024, 1024, 512, smem,
            [&](f4v (&acc)[4][4], int wm, int wn, int i16, int g4) __attribute__((always_inline)) {
#pragma unroll
                for (int mi = 0; mi < 4; ++mi) {
                    const long row = row0 + wm * 64 + mi * 16 + i16;
#pragma unroll
                    for (int ni = 0; ni < 4; ++ni) {
                        const int col = n0 + wn * 64 + ni * 16 + 4 * g4;
                        float4 v = *(const float4*)(p.x + row * 1024 + col);
                        v.x += acc[mi][ni][0]; v.y += acc[mi][ni][1]; v.z += acc[mi][ni][2]; v.w += acc[mi][ni][3];
                        const h4v o = {(half_t)v.x, (half_t)v.y, (half_t)v.z, (half_t)v.w};
                        *(h4v*)(X2H + row * 1024 + col) = o;
                    }
                }
            });
    }
}

__device__ __forceinline__ void phase_peerq(const Params& p, int bid, int nb, char* smem) {
    char* ws = p.ws;
    const half_t* X2H = (const half_t*)(ws + OFF_X2H);
    const half_t* W = (const half_t*)(ws + OFF_WPQ);
    half_t* QP = (half_t*)(ws + OFF_QP);
    for (int tile = bid; tile < 256 * 16; tile += nb) {
        const int tm = tile >> 4, tn = tile & 15;
        const int row0 = tm * 128, n0 = tn * 128;
        gemm_tile<true, true>(X2H + (long)row0 * 1024, 1024, W + (long)n0 * 1024, 1024, 1024, 1024, smem,
            [&](f4v (&acc)[4][4], int wm, int wn, int i16, int g4) __attribute__((always_inline)) {
#pragma unroll
                for (int mi = 0; mi < 4; ++mi) {
                    const long row = row0 + wm * 64 + mi * 16 + i16;
#pragma unroll
                    for (int ni = 0; ni < 4; ++ni) {
                        const int col = n0 + wn * 64 + ni * 16 + 4 * g4;
                        const h4v o = {(half_t)acc[mi][ni][0], (half_t)acc[mi][ni][1], (half_t)acc[mi][ni][2], (half_t)acc[mi][ni][3]};
                        *(h4v*)(QP + row * 2048 + col) = o;
                    }
                }
            });
    }
}

__device__ __forceinline__ void topk_insert(float (&tv)[16], int (&ti)[16], float v, int id) {
#pragma unroll
    for (int k = 0; k < 16; ++k) {
        const bool gt = v > tv[k];
        const float nv = gt ? tv[k] : v; const int ni = gt ? ti[k] : id;
        tv[k] = gt ? v : tv[k]; ti[k] = gt ? id : ti[k];
        v = nv; id = ni;
    }
}
__device__ __forceinline__ unsigned rt_flip(float f) { const unsigned b = __float_as_uint(f); return b ^ ((b >> 31) ? 0xFFFFFFFFu : 0x80000000u); }
__device__ __forceinline__ float rt_unflip(unsigned u) { return __uint_as_float((u & 0x80000000u) ? (u ^ 0x80000000u) : ~u); }
__device__ __forceinline__ void rt_insert(unsigned (&tk)[16], unsigned u) {
#pragma unroll
    for (int k = 0; k < 16; ++k) { const unsigned hi = tk[k] > u ? tk[k] : u; u = tk[k] > u ? u : tk[k]; tk[k] = hi; }
}
__device__ __forceinline__ void phase_route(const Params& p, int bid, int nb, char* smem) {
    char* ws = p.ws;
    {
        const u4v* src = (const u4v*)(ws + OFF_KEYS);
        u4v* dst = (u4v*)smem;
        for (int i = threadIdx.x; i < 4096; i += NTHREADS) {
            const int n = (i >> 4) & 127, ch = i & 15;
            dst[(i & ~15) | (ch ^ (n & 15))] = src[i];
        }
    }
    __syncthreads();
    const half_t* QP = (const half_t*)(ws + OFF_QP);
    int* EID = (int*)(ws + OFF_EID);
    float* GW = (float*)(ws + OFF_GW);
    int tid_ = threadIdx.x; asm volatile("" : "+v"(tid_));
    const int lane = tid_ & 63, w = tid_ >> 6, c = lane & 31, hh = lane >> 5;
#pragma unroll 1
    for (long blk = bid; blk < (long)NTOK * 8 / 128; blk += nb) {
        const long th = blk * 128 + w * 32 + c;
        unsigned tkA[16], tkB[16];
#pragma unroll
        for (int half = 0; half < 2; ++half) {
            unsigned (&tk)[16] = half ? tkB : tkA;
#pragma unroll
            for (int k = 0; k < 16; ++k) tk[k] = 0u;
            h8v qf[8];
#pragma unroll
            for (int ks = 0; ks < 8; ++ks) qf[ks] = *(const h8v*)(QP + th * 256 + half * 128 + ks * 16 + hh * 8);
#pragma unroll 1
            for (int mt = 0; mt < 4; ++mt) {
                f16v s;
#pragma unroll
                for (int i = 0; i < 16; ++i) s[i] = 0.f;
                const int n = mt * 32 + c;
                const char* kb = smem + (half * 128 + n) * 256;
#pragma unroll
                for (int ks = 0; ks < 8; ++ks) {
                    const h8v a = *(const h8v*)(kb + (((2 * ks + hh) ^ (n & 15)) << 4));
                    s = mfma32(a, qf[ks], s);
                }
#pragma unroll
                for (int r = 0; r < 16; ++r) {
                    const int key = mt * 32 + (r & 3) + 8 * (r >> 2) + 4 * hh;
                    rt_insert(tk, (rt_flip(s[r]) & ~0x7Fu) | (unsigned)(127 - key));
                }
            }
            unsigned other[16];
#pragma unroll
            for (int k = 0; k < 16; ++k) other[k] = (unsigned)shx(lane, (int)tk[k], 32);
#pragma unroll
            for (int k = 0; k < 16; ++k) rt_insert(tk, other[k]);
        }
        float v1[16], v2[16]; int i1[16], i2[16];
#pragma unroll
        for (int k = 0; k < 16; ++k) {
            v1[k] = rt_unflip(tkA[k] & ~0x7Fu); i1[k] = 127 - (int)(tkA[k] & 0x7Fu);
            v2[k] = rt_unflip(tkB[k] & ~0x7Fu); i2[k] = 127 - (int)(tkB[k] & 0x7Fu);
        }
        float fv[16]; int fi[16];
#pragma unroll
        for (int k = 0; k < 16; ++k) { fv[k] = -3.0e38f; fi[k] = 0; }
        {
            constexpr int NP = 50;
            int pi[NP], pj[NP]; int np = 0;
#pragma unroll
            for (int i = 0; i < 16; ++i)
#pragma unroll
                for (int j = 0; j < 16; ++j)
                    if ((i + 1) * (j + 1) <= 16) { pi[np] = i; pj[np] = j; ++np; }
#pragma unroll
            for (int q = 0; q < NP / 2; ++q) {
                const float va = v1[pi[2 * q]] + v2[pj[2 * q]], vb = v1[pi[2 * q + 1]] + v2[pj[2 * q + 1]];
                const int ea = i1[pi[2 * q]] * 128 + i2[pj[2 * q]], eb = i1[pi[2 * q + 1]] * 128 + i2[pj[2 * q + 1]];
                topk_insert(fv, fi, hh ? vb : va, hh ? eb : ea);
            }
        }
        {
            float ov[16]; int oi[16];
#pragma unroll
            for (int k = 0; k < 16; ++k) { ov[k] = shx(lane, fv[k], 32); oi[k] = shx(lane, fi[k], 32); }
#pragma unroll
            for (int k = 0; k < 16; ++k) topk_insert(fv, fi, ov[k], oi[k]);
        }
        if (hh == 0) {
            float sum = 0.f, ex[16];
#pragma unroll
            for (int k = 0; k < 16; ++k) { ex[k] = __expf(fv[k] - fv[0]); sum += ex[k]; }
            const float inv = 1.0f / sum;
#pragma unroll
            for (int k4 = 0; k4 < 4; ++k4) {
                *(int4*)(EID + th * 16 + 4 * k4) = make_int4(fi[4 * k4], fi[4 * k4 + 1], fi[4 * k4 + 2], fi[4 * k4 + 3]);
                *(float4*)(GW + th * 16 + 4 * k4) = make_float4(ex[4 * k4] * inv, ex[4 * k4 + 1] * inv, ex[4 * k4 + 2] * inv, ex[4 * k4 + 3] * inv);
            }
        }
    }
}

__device__ __forceinline__ int peer_next_task(unsigned* q, int xpref, int ntask_per_slice, volatile int* s_task) {
    if (threadIdx.x == 0) {
        int res = -1;
        for (int k = 0; k < 4; ++k) {
            const int x = (xpref + k) & 3;
            if (__hip_atomic_load(&q[x], __ATOMIC_RELAXED, __HIP_MEMORY_SCOPE_AGENT) >= (unsigned)ntask_per_slice) continue;
            const unsigned c = atomicAdd(&q[x], 1u);
            if (c < (unsigned)ntask_per_slice) { res = x * ntask_per_slice + (int)c; break; }
        }
        *s_task = res;
    }
    __syncthreads();
    const int r = *s_task;
    __syncthreads();
    return r;
}
template <int PMODE>
__device__ __forceinline__ void phase_peer_udot(const Params& p, char* smem, int qoff = 16) {
    char* ws = p.ws;
    unsigned* q = (unsigned*)(ws + OFF_CTRL) + qoff;
    volatile int* s_task = (volatile int*)(smem + 66048);
    const unsigned char* U4 = (const unsigned char*)(ws + OFF_U16);
    const half_t* X2H = (const half_t*)(ws + OFF_X2H);
    const int* EID = (const int*)(ws + OFF_EID);
    float* PD = (float*)(ws + OFF_PD);
    const int xpref = (int)(xb_xcc_id() & 3u);
    for (;;) {
        const int task = peer_next_task(q, xpref, 512, s_task);
        if (task < 0) break;
        const int x = task >> 9, chunk = task & 511;
        int tid_ = threadIdx.x; asm volatile("" : "+v"(tid_));
        const int lane = tid_ & 63, w = tid_ >> 6, seg = lane & 7, eg = lane >> 3;
        h2v gs[16];
#pragma unroll
        for (int i = 0; i < 16; ++i) gs[i] = (h2v){(half_t)p.norm2_g[256 * x + 32 * seg + 2 * i], (half_t)p.norm2_g[256 * x + 32 * seg + 2 * i + 1]};
        const unsigned char* Ux = U4 + (long)x * 16384 * 128 + 16 * seg;
        const int tbase = chunk * 64 + w * 16;
        const int* Eb = EID + (long)tbase * 128 + 16 * eg;
        const half_t* Xb = X2H + (long)tbase * 1024 + 256 * x + 32 * seg;
#define LOAD_E(dst, k) { const u4v* ep_ = (const u4v*)(Eb + (long)(k) * 128); dst[0] = ep_[0]; dst[1] = ep_[1]; dst[2] = ep_[2]; dst[3] = ep_[3]; }
#define ISSUE_U8(uu, e_, hf) { _Pragma("unroll") for (int i = 0; i < 8; ++i) uu[i] = *(const u4v*)(Ux + (long)e_[2 * (hf) + (i >> 2)][i & 3] * 128); }
        h2v hs[16];
        auto load_h = [&](int k) __attribute__((always_inline)) {
#pragma unroll
            for (int c4 = 0; c4 < 4; ++c4) {
                const h8v xv = *(const h8v*)(Xb + (long)k * 1024 + 8 * c4);
#pragma unroll
                for (int i = 0; i < 4; ++i) hs[4 * c4 + i] = (h2v){xv[2 * i], xv[2 * i + 1]} * gs[4 * c4 + i];
            }
        };
        auto compute8 = [&](const u4v (&uu)[8]) __attribute__((always_inline)) -> float {
            float res = 0.f;
            if (PMODE == 1) {
                unsigned acc_ = 0;
#pragma unroll
                for (int i = 0; i < 8; ++i) acc_ ^= uu[i][0] ^ uu[i][1] ^ uu[i][2] ^ uu[i][3];
                return __builtin_bit_cast(float, acc_);
            }
#pragma unroll
            for (int i = 0; i < 8; ++i) {
                float d = 0.f;
#pragma unroll
                for (int j = 0; j < 4; ++j) {
                    d = __builtin_amdgcn_fdot2(hs[4 * j], __builtin_amdgcn_cvt_scalef32_pk_f16_fp4(uu[i][j], 1.0f, 0), d, false);
                    d = __builtin_amdgcn_fdot2(hs[4 * j + 1], __builtin_amdgcn_cvt_scalef32_pk_f16_fp4(uu[i][j], 1.0f, 1), d, false);
                    d = __builtin_amdgcn_fdot2(hs[4 * j + 2], __builtin_amdgcn_cvt_scalef32_pk_f16_fp4(uu[i][j], 1.0f, 2), d, false);
                    d = __builtin_amdgcn_fdot2(hs[4 * j + 3], __builtin_amdgcn_cvt_scalef32_pk_f16_fp4(uu[i][j], 1.0f, 3), d, false);
                }
                d = red8(d);
                res = (seg == i) ? d : res;
            }
            return res;
        };
        u4v uA[8], uB[8];
        u4v eC[4], eN[4];
        LOAD_E(eC, 0);
        ISSUE_U8(uA, eC, 0);
#pragma unroll 1
        for (int k = 0; k < 16; ++k) {
            ISSUE_U8(uB, eC, 1);
            if (k + 1 < 16) LOAD_E(eN, k + 1);
            load_h(k);
            const float r0 = compute8(uA);
            if (k + 1 < 16) ISSUE_U8(uA, eN, 0);
            const float r1 = compute8(uB);
            float* po = (PMODE == 1 ? (float*)(p.ws + OFF_HC1) + (((long)(tbase + k) * 128 + 16 * eg + seg) & 0xFFFFF)
                                    : PD + ((long)x * NTOK + tbase + k) * 128 + 16 * eg + seg);
            po[0] = r0; po[8] = r1;
#pragma unroll
            for (int i = 0; i < 4; ++i) eC[i] = eN[i];
        }
    }
}
__device__ __forceinline__ void phase_peer_coef(const Params& p, int bid, int nb) {
    char* ws = p.ws;
    const half_t* X2H = (const half_t*)(ws + OFF_X2H);
    const float* PD = (const float*)(ws + OFF_PD);
    const float* GW = (const float*)(ws + OFF_GW);
    const int* EID = (const int*)(ws + OFF_EID);
    const float* ESC = (const float*)(ws + OFF_ESC);
    float* COEF = (float*)(ws + OFF_COEF);
    int tx_ = threadIdx.x; asm volatile("" : "+v"(tx_));
    const int lane = tx_ & 63;
    const long wv = ((long)bid * NTHREADS + tx_) >> 6, nwv = ((long)nb * NTHREADS) >> 6;
    for (long t = wv; t < NTOK; t += nwv) {
        const h8v a = *(const h8v*)(X2H + t * 1024 + 8 * lane), b2 = *(const h8v*)(X2H + t * 1024 + 512 + 8 * lane);
        float ss = 0.f;
#pragma unroll
        for (int i = 0; i < 8; ++i) { const float f0 = (float)a[i], f1 = (float)b2[i]; ss += f0 * f0 + f1 * f1; }
        ss = wave_sum(ss, lane);
        const float rs = rsqrtf(ss * (1.0f / 1024.f) + EPS);
        float d0 = 0.f, d1 = 0.f;
#pragma unroll
        for (int x = 0; x < 4; ++x) {
            const float* pp = PD + ((long)x * NTOK + t) * 128;
            d0 += pp[lane]; d1 += pp[64 + lane];
        }
        const int e0 = EID[t * 128 + lane], e1 = EID[t * 128 + 64 + lane];
        COEF[t * 128 + lane] = GW[t * 128 + lane] * gelu_exact(d0 * rs * ESC[e0]) * ESC[16384 + e0];
        COEF[t * 128 + 64 + lane] = GW[t * 128 + 64 + lane] * gelu_exact(d1 * rs * ESC[e1]) * ESC[16384 + e1];
    }
}
__device__ __forceinline__ void phase_peer_vacc(const Params& p, char* smem) {
    char* ws = p.ws;
    unsigned* q = (unsigned*)(ws + OFF_CTRL) + 32;
    volatile int* s_task = (volatile int*)(smem + 66048);
    const unsigned char* V4 = (const unsigned char*)(ws + OFF_V16);
    const int* EID = (const int*)(ws + OFF_EID);
    const float* COEF = (const float*)(ws + OFF_COEF);
    float* SSQ = (float*)(ws + OFF_SSQ);
    const int xpref = (int)(xb_xcc_id() & 3u);
    for (;;) {
        const int task = peer_next_task(q, xpref, 512, s_task);
        if (task < 0) break;
        const int x = task >> 9, chunk = task & 511;
        int tid_ = threadIdx.x; asm volatile("" : "+v"(tid_));
        const int lane = tid_ & 63, w = tid_ >> 6, seg = lane & 7, eg = lane >> 3;
        const unsigned char* Vx = V4 + (long)x * 16384 * 128 + 16 * seg;
#pragma unroll 1
        for (int round = 0; round < 2; ++round) {
            const int t = chunk * 64 + w * 16 + round * 8 + eg;
            const int* Eb = EID + (long)t * 128;
            const float* Cb = COEF + (long)t * 128;
#define LOAD_EC(e_, c_, ci) { const u4v* ep_ = (const u4v*)(Eb + 8 * (ci)); const f4v* cp_ = (const f4v*)(Cb + 8 * (ci)); e_[0] = ep_[0]; e_[1] = ep_[1]; c_[0] = cp_[0]; c_[1] = cp_[1]; }
#define ISSUE_V(vv, e_) { _Pragma("unroll") for (int i = 0; i < 8; ++i) vv[i] = *(const u4v*)(Vx + (long)e_[i >> 2][i & 3] * 128); }
            h2v acc2[16];
#pragma unroll
            for (int i = 0; i < 16; ++i) acc2[i] = (h2v){(half_t)0.f, (half_t)0.f};
            auto compute = [&](const f4v (&c_)[2], const u4v (&vv)[8]) __attribute__((always_inline)) {
#pragma unroll
                for (int i = 0; i < 8; ++i) {
                    const half_t ch = (half_t)c_[i >> 2][i & 3];
                    const h2v cf2 = (h2v){ch, ch};
#pragma unroll
                    for (int j = 0; j < 4; ++j) {
                        acc2[4 * j] = __builtin_elementwise_fma((h2v)__builtin_amdgcn_cvt_scalef32_pk_f16_fp4(vv[i][j], 1.0f, 0), cf2, acc2[4 * j]);
                        acc2[4 * j + 1] = __builtin_elementwise_fma((h2v)__builtin_amdgcn_cvt_scalef32_pk_f16_fp4(vv[i][j], 1.0f, 1), cf2, acc2[4 * j + 1]);
                        acc2[4 * j + 2] = __builtin_elementwise_fma((h2v)__builtin_amdgcn_cvt_scalef32_pk_f16_fp4(vv[i][j], 1.0f, 2), cf2, acc2[4 * j + 2]);
                        acc2[4 * j + 3] = __builtin_elementwise_fma((h2v)__builtin_amdgcn_cvt_scalef32_pk_f16_fp4(vv[i][j], 1.0f, 3), cf2, acc2[4 * j + 3]);
                    }
                }
            };
            u4v vvA[8], vvB[8];
            u4v eA[2], eB[2]; f4v cA[2], cB[2];
            LOAD_EC(eA, cA, 0); LOAD_EC(eB, cB, 1);
            ISSUE_V(vvA, eA);
#pragma unroll 1
            for (int ci = 0; ci < 16; ci += 2) {
                ISSUE_V(vvB, eB);
                compute(cA, vvA);
                if (ci + 2 < 16) { LOAD_EC(eA, cA, ci + 2); ISSUE_V(vvA, eA); }
                compute(cB, vvB);
                if (ci + 2 < 16) LOAD_EC(eB, cB, ci + 3);
            }
            half_t* xr = (half_t*)(ws + OFF_X2H) + (long)t * 1024 + 256 * x + 32 * seg;
            float ssq = 0.f;
#pragma unroll
            for (int i8 = 0; i8 < 4; ++i8) {
                h8v xv = *(const h8v*)(xr + 8 * i8);
#pragma unroll
                for (int e = 0; e < 8; ++e) {
                    const float f = (float)xv[e] + (float)acc2[4 * i8 + (e >> 1)][e & 1];
                    ssq += f * f;
                    xv[e] = (half_t)f;
                }
                *(h8v*)(xr + 8 * i8) = xv;
            }
            ssq = red8(ssq);
            if (seg == 0) SSQ[(long)x * NTOK + t] = ssq;
        }
    }
}
__device__ __forceinline__ void phase_final_norm(const Params& p, int bid, int nb) {
    const float* SSQ = (const float*)(p.ws + OFF_SSQ);
    int tx_ = threadIdx.x; asm volatile("" : "+v"(tx_));
    const int lane = tx_ & 63;
    const long wv = ((long)bid * NTHREADS + tx_) >> 6, nwv = ((long)nb * NTHREADS) >> 6;
    for (long t = wv; t < NTOK; t += nwv) {
        float ss = 0.f;
#pragma unroll
        for (int x = 0; x < 4; ++x) ss += SSQ[(long)x * NTOK + t];
        const float rf = rsqrtf(ss * (1.0f / 1024.f) + EPS);
        const half_t* xh = (const half_t*)(p.ws + OFF_X2H) + t * 1024;
        float4* xr = (float4*)(p.out + t * 1024);
#pragma unroll
        for (int i = 0; i < 4; ++i) {
            const h4v hv = *(const h4v*)(xh + 4 * (lane + 64 * i));
            const float4 g = ((const float4*)p.final_g)[lane + 64 * i];
            float4 v;
            v.x = (float)hv[0] * rf * g.x; v.y = (float)hv[1] * rf * g.y; v.z = (float)hv[2] * rf * g.z; v.w = (float)hv[3] * rf * g.w;
            xr[lane + 64 * i] = v;
        }
    }
}

#define XB_TMO      128
#define XB_XCNT(j)  (256  + 64 * (j))
#define XB_XSUB(j)  (1280 + 64 * (j))
#define XB_XGEN(j)  (2304 + 64 * (j))
#define XB_TOP      3328
#define XB_TOPGEN   3392
#define XCD_BAR_WORDS 3456
#define XB_SPIN_CAP (1u << 22)
__device__ __forceinline__ unsigned xb_ld(unsigned* p)              { return __hip_atomic_load(p, __ATOMIC_RELAXED, __HIP_MEMORY_SCOPE_AGENT); }
__device__ __forceinline__ unsigned xb_add(unsigned* p, unsigned v) { return __hip_atomic_fetch_add(p, v, __ATOMIC_RELAXED, __HIP_MEMORY_SCOPE_AGENT); }
__device__ __forceinline__ unsigned xb_xcc_id() { return (unsigned)__builtin_amdgcn_s_getreg((3 << 11) | 20) & 0xFu; }
#define XB_SPIN(cond, bar) do { unsigned _sp = 0; while (cond) { __builtin_amdgcn_s_sleep(1); \
    if ((++_sp & 255u) == 0u) { if (xb_ld(&(bar)[XB_TMO])) break; if (_sp > XB_SPIN_CAP) { atomicAdd(&(bar)[XB_TMO], 1u); break; } } } } while (0)
struct XcdBarrier { unsigned* bar; unsigned x; volatile unsigned* st; };
__device__ __forceinline__ XcdBarrier xcd_barrier_post(unsigned* bar, volatile unsigned* st) {
    XcdBarrier b; b.bar = bar; b.x = xb_xcc_id(); b.st = st;
    if (threadIdx.x == 0) (void)xb_add(&bar[XB_XCNT(b.x)], 1u);
    return b;
}
__device__ __forceinline__ void xcd_barrier_complete(unsigned* bar, unsigned x, unsigned& nloc, unsigned& nx) {
    const unsigned G = gridDim.x * gridDim.y * gridDim.z;
    unsigned sum, cnt, mine, sp = 0u;
    for (;;) {
        sum = 0u; cnt = 0u; mine = 0u;
#pragma unroll
        for (unsigned j = 0; j < 16; ++j) { const unsigned c = xb_ld(&bar[XB_XCNT(j)]); sum += c; cnt += (c > 0u) ? 1u : 0u; mine = (j == x) ? c : mine; }
        if (sum == G) break;
        __builtin_amdgcn_s_sleep(1);
        if ((++sp & 255u) == 0u) { if (xb_ld(&bar[XB_TMO])) break; if (sp > XB_SPIN_CAP) { atomicAdd(&bar[XB_TMO], 1u); break; } }
    }
    nloc = mine > 0u ? mine : 1u; nx = cnt > 0u ? cnt : 1u;
}
__device__ __forceinline__ void xcd_barrier(const XcdBarrier& b) {
    asm volatile("s_waitcnt vmcnt(0)" ::: "memory");
    __syncthreads();
    if (threadIdx.x == 0) {
        unsigned* bar = b.bar;
        __builtin_amdgcn_s_waitcnt(0);
        unsigned nloc = b.st[0], nx = b.st[1];
        if (nloc == 0u) { xcd_barrier_complete(bar, b.x, nloc, nx); b.st[0] = nloc; b.st[1] = nx; }
        const unsigned old = xb_add(&bar[XB_XSUB(b.x)], 1u);
        const unsigned gen = old / nloc;
        if (old + 1u == (gen + 1u) * nloc) {
            __builtin_amdgcn_fence(__ATOMIC_RELEASE, "agent");
            asm volatile("s_waitcnt vmcnt(0)" ::: "memory");
            const unsigned og = xb_add(&bar[XB_TOP], 1u);
            const unsigned tg = og / nx;
            if (og + 1u == (tg + 1u) * nx) xb_add(&bar[XB_TOPGEN], 1u);
            else XB_SPIN(xb_ld(&bar[XB_TOPGEN]) == tg, bar);
            __builtin_amdgcn_fence(__ATOMIC_ACQUIRE, "agent");
            xb_add(&bar[XB_XGEN(b.x)], 1u);
            asm volatile("s_waitcnt vmcnt(0)" ::: "memory");
        } else {
            XB_SPIN(xb_ld(&bar[XB_XGEN(b.x)]) == gen, bar);
            __builtin_amdgcn_fence(__ATOMIC_ACQUIRE, "agent");
            asm volatile("s_waitcnt vmcnt(0)" ::: "memory");
        }
    }
    __syncthreads();
}

template <int PH>
__global__ void __launch_bounds__(NTHREADS, 2) phase_kernel(Params p) {
    extern __shared__ __attribute__((aligned(16))) char smem[];
    const int bid = blockIdx.x, nb = gridDim.x;
    if (PH == 0) phase_prep(p, bid, nb, smem);
    if (PH == 1) phase_inproj(p, bid, nb, smem);
    if (PH == 2) phase_p2(p, bid, nb, smem);
    if (PH == 3) phase_cmp2(p, bid, nb);
    if (PH == 4) phase_attn(p, smem);
    if (PH == 5) phase_outproj(p, bid, nb, smem);
    if (PH == 6) phase_peerq(p, bid, nb, smem);
    if (PH == 7) phase_route(p, bid, nb, smem);
}

__global__ void __launch_bounds__(NTHREADS, 2) mega_kernel(Params p) {
    extern __shared__ __attribute__((aligned(16))) char smem[];
    const int bid = blockIdx.x, nb = gridDim.x;
    {
        volatile unsigned* xbst = (volatile unsigned*)(smem + 66064);
        if (threadIdx.x == 0) { xbst[0] = 0u; xbst[1] = 0u; }
        __syncthreads();
        (void)xcd_barrier_post((unsigned*)(p.ws + OFF_BAR), xbst);
    }
#define GRID_SYNC() { XcdBarrier gb_; gb_.bar = (unsigned*)(p.ws + OFF_BAR); gb_.x = xb_xcc_id(); gb_.st = (volatile unsigned*)(smem + 66064); xcd_barrier(gb_); }
    phase_prep(p, bid, nb, smem); GRID_SYNC();
    if (PROBE_PHASE == 0) { phase_prep(p, bid, nb, smem); GRID_SYNC(); }
    phase_inproj(p, bid, nb, smem); GRID_SYNC();
    if (PROBE_PHASE == 1) { phase_inproj(p, bid, nb, smem); GRID_SYNC(); }
    phase_p2(p, bid, nb, smem); GRID_SYNC();
    if (PROBE_PHASE == 2) { phase_p2(p, bid, nb, smem); GRID_SYNC(); }
    phase_cmp2(p, bid, nb); GRID_SYNC();
    phase_attn(p, smem, 64, 0); GRID_SYNC();
    if (PROBE_PHASE == 3) { phase_attn(p, smem, 80, 0); GRID_SYNC(); }
    if (PROBE_PHASE == 9) { phase_attn(p, smem, 80, 1); GRID_SYNC(); }
    if (PROBE_PHASE == 13) { phase_attn(p, smem, 80, 2); GRID_SYNC(); }
    phase_outproj(p, bid, nb, smem); GRID_SYNC();
    if (PROBE_PHASE == 4) { phase_outproj(p, bid, nb, smem); GRID_SYNC(); }
    phase_peerq(p, bid, nb, smem); GRID_SYNC();
    if (PROBE_PHASE == 5) { phase_peerq(p, bid, nb, smem); GRID_SYNC(); }
    phase_route(p, bid, nb, smem); GRID_SYNC();
    if (PROBE_PHASE == 6) { phase_route(p, bid, nb, smem); GRID_SYNC(); }
    if (PROBE_PHASE == 8) { GRID_SYNC(); GRID_SYNC(); GRID_SYNC(); GRID_SYNC(); GRID_SYNC(); GRID_SYNC(); GRID_SYNC(); GRID_SYNC(); }
    phase_peer_udot<0>(p, smem); GRID_SYNC();
    if (PROBE_PHASE == 10) { phase_peer_udot<0>(p, smem, 48); GRID_SYNC(); }
    if (PROBE_PHASE == 12) { phase_peer_udot<1>(p, smem, 48); GRID_SYNC(); }
    phase_peer_coef(p, bid, nb); GRID_SYNC();
    if (PROBE_PHASE == 11) { phase_peer_coef(p, bid, nb); GRID_SYNC(); }
    phase_peer_vacc(p, smem); GRID_SYNC();
    phase_final_norm(p, bid, nb);
}

extern "C" void kernel_launch(void* const* d_in, const int* in_sizes, int n_in, void* d_out, int out_size, void* d_ws, size_t ws_size, hipStream_t stream) {
    (void)in_sizes; (void)n_in; (void)out_size;
    if (ws_size < WS_NEED) { fprintf(stderr, "kernel_launch: workspace too small (%zu < %zu)\n", ws_size, (size_t)WS_NEED); return; }
    Params p{};
    p.x = (const float*)d_in[0]; p.pos = (const int*)d_in[1]; p.norm1_g = (const float*)d_in[2]; p.w_in = (const float*)d_in[3];
    p.cmp_pos = (const float*)d_in[4]; p.cmp_k_w1 = (const float*)d_in[5]; p.cmp_k_w2 = (const float*)d_in[6];
    p.cmp_v_w1 = (const float*)d_in[7]; p.cmp_v_w2 = (const float*)d_in[8]; p.t5_bias = (const float*)d_in[9];
    p.q_norm_g = (const float*)d_in[10]; p.w_q_up = (const float*)d_in[11]; p.kv_norm_g = (const float*)d_in[12]; p.w_kv_up = (const float*)d_in[13];
    p.grp_norm_nsa = (const float*)d_in[14]; p.grp_norm_mla = (const float*)d_in[15]; p.w_out = (const float*)d_in[16]; p.norm2_g = (const float*)d_in[17];
    p.peer_wq = (const float*)d_in[18]; p.peer_keys1 = (const float*)d_in[19]; p.peer_keys2 = (const float*)d_in[20];
    p.peer_u = (const float*)d_in[21]; p.peer_v = (const float*)d_in[22]; p.final_g = (const float*)d_in[23];
    p.out = (float*)d_out; p.ws = (char*)d_ws;
#if MULTI_LAUNCH
    const int G = 512;
    phase_kernel<0><<<G, NTHREADS, 0, stream>>>(p);
    phase_kernel<1><<<G, NTHREADS, 0, stream>>>(p);
    phase_kernel<2><<<G, NTHREADS, 0, stream>>>(p);
    phase_kernel<3><<<G, NTHREADS, 0, stream>>>(p);
    phase_kernel<4><<<G, NTHREADS, 0, stream>>>(p);
    phase_kernel<5><<<G, NTHREADS, 0, stream>>>(p);
    phase_kernel<6><<<G, NTHREADS, 0, stream>>>(p);
    phase_kernel<7><<<G, NTHREADS, 0, stream>>>(p);
    phase_kernel<8><<<G, NTHREADS, 0, stream>>>(p);
#else
    static int grid_blocks = 0;
    if (!grid_blocks) {
        int dev = 0, cus = 0, per_cu = 0;
        (void)hipGetDevice(&dev);
        (void)hipDeviceGetAttribute(&cus, hipDeviceAttributeMultiprocessorCount, dev);
        (void)hipFuncSetAttribute((const void*)mega_kernel, hipFuncAttributeMaxDynamicSharedMemorySize, SMEM_BYTES);
        (void)hipOccupancyMaxActiveBlocksPerMultiprocessor(&per_cu, mega_kernel, NTHREADS, SMEM_BYTES);
        if (per_cu > 2) per_cu = 2;
        grid_blocks = cus * per_cu;
    }
    (void)hipMemsetAsync((char*)d_ws + OFF_BAR, 0, 16384, stream);
    void* args[] = {&p};
    hipError_t e = hipLaunchCooperativeKernel((void*)mega_kernel, dim3(grid_blocks), dim3(NTHREADS), args, SMEM_BYTES, stream);
    if (e != hipSuccess) fprintf(stderr, "cooperative launch failed: %s (grid %d)\n", hipGetErrorString(e), grid_blocks);
#endif
}
```

```cpp
#include <hip/hip_runtime.h>
#include <hip/hip_cooperative_groups.h>
#include <cstdio>
#include <cstdint>
namespace cg = cooperative_groups;

#ifndef MULTI_LAUNCH
#define MULTI_LAUNCH 0
#endif

#ifndef PROBE_PHASE
#define PROBE_PHASE -1
#endif

typedef _Float16 half_t;
typedef _Float16 h2v __attribute__((ext_vector_type(2)));
typedef _Float16 h4v __attribute__((ext_vector_type(4)));
typedef _Float16 h8v __attribute__((ext_vector_type(8)));
typedef float f4v __attribute__((ext_vector_type(4)));
typedef unsigned u4v __attribute__((ext_vector_type(4)));
typedef unsigned u2v __attribute__((ext_vector_type(2)));
typedef float f16v __attribute__((ext_vector_type(16)));

constexpr int BATCH = 2, SEQ = 16384, DM = 1024, NTOK = BATCH * SEQ;
constexpr int NIN = 1720, NINP = 1792;
constexpr int NCMP = 1023, NCMPP = 1024;
constexpr float EPS = 1e-6f;
constexpr float LOG2E = 1.4426950408889634f;
constexpr float QS_NSA = 0.125f * LOG2E;
constexpr float QS_MLA = 0.10206207261596575f * LOG2E;
constexpr float NEGF = -1e30f;
constexpr int LUTN = 1536;
constexpr float USCALE = 128.0f, VSCALE = 16.0f;

constexpr size_t al256(size_t x) { return (x + 255) & ~(size_t)255; }
constexpr size_t OFF_CTRL = 0;
constexpr size_t OFF_LUT = 4096;
constexpr size_t OFF_CB = OFF_LUT + 2 * LUTN * 4 * 4;
constexpr size_t OFF_WIN = 65536;
constexpr size_t OFF_WQUP = OFF_WIN + (size_t)NINP * 1024 * 2;
constexpr size_t OFF_WKVUP = OFF_WQUP + 768 * 256 * 2;
constexpr size_t OFF_WC1 = OFF_WKVUP + 1024 * 128 * 2;
constexpr size_t OFF_WOUT = OFF_WC1 + 2 * 256 * 2048 * 2;
constexpr size_t OFF_WPQ = OFF_WOUT + 1024 * 1024 * 2;
constexpr size_t OFF_KEYS = OFF_WPQ + 2048 * 1024 * 2;
constexpr size_t OFF_U16 = al256(OFF_KEYS + 2 * 128 * 128 * 2);
constexpr size_t OFF_V16 = OFF_U16 + (size_t)16384 * 1024 * 2;
constexpr size_t OFF_H1 = OFF_V16 + (size_t)16384 * 1024 * 2;
constexpr size_t OFF_MIXED = OFF_H1;
constexpr size_t OFF_QH = OFF_H1 + (size_t)NTOK * 1024 * 2;
constexpr size_t SZ_KV = (size_t)2 * 2 * SEQ * 64 * 2;
constexpr size_t OFF_KC = OFF_QH + (size_t)NTOK * 512 * 2;
constexpr size_t OFF_VC = OFF_KC + SZ_KV;
constexpr size_t OFF_KS = OFF_VC + SZ_KV;
constexpr size_t OFF_VST = OFF_KS + SZ_KV;
constexpr size_t OFF_KW = OFF_VST + SZ_KV;
constexpr size_t OFF_VWT = OFF_KW + SZ_KV;
constexpr size_t OFF_GATES = OFF_VWT + SZ_KV;
constexpr size_t OFF_CQ = OFF_GATES + (size_t)NTOK * 24 * 4;
constexpr size_t OFF_CKV = OFF_CQ + (size_t)NTOK * 256 * 2;
constexpr size_t OFF_X2H = OFF_QH;
constexpr size_t OFF_QM = OFF_CKV + (size_t)NTOK * 128 * 2;
constexpr size_t OFF_KM = OFF_QM + (size_t)NTOK * 8 * 96 * 2;
constexpr size_t OFF_VT = OFF_KM + (size_t)NTOK * 8 * 96 * 2;
constexpr size_t OFF_QP = OFF_QM;
constexpr size_t OFF_PD = OFF_QM;
constexpr size_t OFF_COEF = OFF_H1;
constexpr size_t OFF_SSQ = OFF_H1 + (size_t)NTOK * 128 * 4;
constexpr size_t OFF_HC1 = OFF_VT + (size_t)NTOK * 8 * 64 * 2;
constexpr size_t OFF_KCMP = OFF_HC1 + (size_t)8 * 1024 * 256 * 2;
constexpr size_t OFF_VCMPT = OFF_KCMP + (size_t)4 * 1024 * 64 * 2;
constexpr size_t OFF_EID = OFF_VCMPT + (size_t)4 * 1024 * 64 * 2;
constexpr size_t OFF_GW = OFF_EID + (size_t)NTOK * 128 * 4;
constexpr size_t OFF_BAR = OFF_GW + (size_t)NTOK * 128 * 4;
constexpr size_t OFF_ESC = OFF_BAR + 16384;
constexpr size_t WS_NEED = OFF_ESC + 2 * 16384 * 4;

struct Params {
    const float* x; const int* pos; const float* norm1_g; const float* w_in; const float* cmp_pos;
    const float* cmp_k_w1; const float* cmp_k_w2; const float* cmp_v_w1; const float* cmp_v_w2; const float* t5_bias;
    const float* q_norm_g; const float* w_q_up; const float* kv_norm_g; const float* w_kv_up;
    const float* grp_norm_nsa; const float* grp_norm_mla; const float* w_out; const float* norm2_g;
    const float* peer_wq; const float* peer_keys1; const float* peer_keys2; const float* peer_u; const float* peer_v; const float* final_g;
    float* out; char* ws;
};

constexpr int SMEM_BYTES = 67584;
constexpr int NTHREADS = 256;

__device__ __forceinline__ f4v mfma16(h8v a, h8v b, f4v c) { return __builtin_amdgcn_mfma_f32_16x16x32_f16(a, b, c, 0, 0, 0); }
__device__ __forceinline__ f16v mfma32(h8v a, h8v b, f16v c) { return __builtin_amdgcn_mfma_f32_32x32x16_f16(a, b, c, 0, 0, 0); }
__device__ __forceinline__ float shx(int lane, float v, int m) { return __builtin_bit_cast(float, __builtin_amdgcn_ds_bpermute((lane ^ m) << 2, __builtin_bit_cast(int, v))); }
__device__ __forceinline__ int shx(int lane, int v, int m) { return __builtin_amdgcn_ds_bpermute((lane ^ m) << 2, v); }
__device__ __forceinline__ float wave_sum(float v, int lane) {
#pragma unroll
    for (int o = 32; o >= 1; o >>= 1) v += shx(lane, v, o);
    return v;
}
__device__ __forceinline__ float gelu_exact(float v) { return 0.5f * v * (1.0f + erff(v * 0.70710678118654752f)); }
__device__ __forceinline__ float fast_exp2(float v) { return __builtin_amdgcn_exp2f(v); }
__device__ __forceinline__ int t5_bucket(int d) {
    if (d < 16) return d < 0 ? 0 : d;
    int b = 16;
    b += (d >= 22); b += (d >= 30); b += (d >= 40); b += (d >= 54); b += (d >= 73); b += (d >= 99); b += (d >= 134); b += (d >= 182);
    b += (d >= 246); b += (d >= 332); b += (d >= 450); b += (d >= 609); b += (d >= 825); b += (d >= 1117); b += (d >= 1513);
    return b;
}

__device__ __forceinline__ unsigned xb_xcc_id();
__device__ __forceinline__ float red8(float v) {
    v += __builtin_bit_cast(float, __builtin_amdgcn_update_dpp(0, __builtin_bit_cast(int, v), 0xB1, 0xF, 0xF, true));
    v += __builtin_bit_cast(float, __builtin_amdgcn_update_dpp(0, __builtin_bit_cast(int, v), 0x4E, 0xF, 0xF, true));
    v += __builtin_bit_cast(float, __builtin_amdgcn_update_dpp(0, __builtin_bit_cast(int, v), 0x141, 0xF, 0xF, true));
    return v;
}

__device__ __forceinline__ void phase_prep(const Params& p, int bid, int nb, char* smem) {
    int tx_ = threadIdx.x; asm volatile("" : "+v"(tx_));
    const long tid = (long)bid * NTHREADS + tx_;
    const long nth = (long)nb * NTHREADS;
    char* ws = p.ws;
    if (tid < 1024) ((unsigned*)(ws + OFF_CTRL))[tid] = 0u;
    {
        float* lut = (float*)(ws + OFF_LUT);
        for (long e = tid; e < 2 * LUTN * 4; e += nth) {
            int r = e & 3, d = (e >> 2) % LUTN, g = (int)(e / (4 * LUTN));
            lut[e] = p.t5_bias[t5_bucket(d) * 8 + g * 4 + r] * LOG2E;
        }
    }
    {
        float* cb = (float*)(ws + OFF_CB);
        for (long e = tid; e < 512; e += nth) {
            int kv = (int)(e >> 8), n = (int)(e & 255);
            const float* w1 = kv ? p.cmp_v_w1 : p.cmp_k_w1;
            float s = 0.f;
            for (int k = 0; k < 2048; ++k) s += p.cmp_pos[k] * w1[(long)k * 256 + n];
            cb[e] = s;
        }
    }
    {
        float (*tl)[65] = (float (*)[65])smem;
        const int tx = tx_;
        const int jt[8] = {0, 448, 496, 528, 656, 784, 1040, 1552};
        for (int tile = bid; tile < 1552; tile += nb) {
            int job = 0;
#pragma unroll
            for (int j = 1; j < 7; ++j) job += (tile >= jt[j]) ? 1 : 0;
            const int lt = tile - jt[job];
            int K, N, ldsrc; const float* src; const float* gain; half_t* dst;
            switch (job) {
                case 0: K = 1024; N = NINP; ldsrc = NIN; src = p.w_in; gain = nullptr; dst = (half_t*)(ws + OFF_WIN); break;
                case 1: K = 256; N = 768; ldsrc = 768; src = p.w_q_up; gain = p.q_norm_g; dst = (half_t*)(ws + OFF_WQUP); break;
                case 2: K = 128; N = 1024; ldsrc = 1024; src = p.w_kv_up; gain = p.kv_norm_g; dst = (half_t*)(ws + OFF_WKVUP); break;
                case 3: K = 2048; N = 256; ldsrc = 256; src = p.cmp_k_w1; gain = nullptr; dst = (half_t*)(ws + OFF_WC1); break;
                case 4: K = 2048; N = 256; ldsrc = 256; src = p.cmp_v_w1; gain = nullptr; dst = (half_t*)(ws + OFF_WC1) + 256L * 2048; break;
                case 5: K = 1024; N = 1024; ldsrc = 1024; src = p.w_out; gain = nullptr; dst = (half_t*)(ws + OFF_WOUT); break;
                default: K = 1024; N = 2048; ldsrc = 2048; src = p.peer_wq; gain = p.norm2_g; dst = (half_t*)(ws + OFF_WPQ); break;
            }
            const int ntn = N >> 6;
            const int k0 = (lt / ntn) * 64, n0 = (lt % ntn) * 64;
            {
                const int r = tx >> 4, c4 = (tx & 15) * 4;
                const int n = n0 + c4;
                int sc = n;
                if (job == 0) {
                    if (n < 1280) sc = n;
                    else if (n < 1536) sc = 1304 + (n - 1280);
                    else if (n < 1664) sc = 1560 + (n - 1536);
                    else if (n < 1696) sc = 1688 + (n - 1664);
                    else if (n < 1720) sc = 1280 + (n - 1696);
                    else sc = -1;
                }
#pragma unroll
                for (int i = 0; i < 4; ++i) {
                    const int k = k0 + r + 16 * i;
                    float4 v = make_float4(0.f, 0.f, 0.f, 0.f);
                    if (sc >= 0) v = *(const float4*)(src + (long)k * ldsrc + sc);
                    float gk = 1.0f;
                    if (gain) gk = gain[k];
                    if (job == 5) gk = (k < 512) ? p.grp_norm_nsa[k] : p.grp_norm_mla[k - 512];
                    tl[r + 16 * i][c4] = v.x * gk; tl[r + 16 * i][c4 + 1] = v.y * gk; tl[r + 16 * i][c4 + 2] = v.z * gk; tl[r + 16 * i][c4 + 3] = v.w * gk;
                }
            }
            __syncthreads();
            {
                const int nl = tx >> 2, kq = (tx & 3) * 16;
                h8v o0, o1;
#pragma unroll
                for (int j = 0; j < 8; ++j) { o0[j] = (half_t)tl[kq + j][nl]; o1[j] = (half_t)tl[kq + 8 + j][nl]; }
                half_t* d = dst + (long)(n0 + nl) * K + k0 + kq;
                *(h8v*)d = o0; *(h8v*)(d + 8) = o1;
            }
            __syncthreads();
        }
    }
    {
        half_t* W = (half_t*)(ws + OFF_KEYS);
        for (long e = tid; e < 2 * 16384; e += nth) {
            W[e] = (half_t)(e < 16384 ? p.peer_keys1[e] : p.peer_keys2[e - 16384]);
        }
    }
    {
        unsigned char* U4 = (unsigned char*)(ws + OFF_U16);
        unsigned char* V4 = (unsigned char*)(ws + OFF_V16);
        float* ESC = (float*)(ws + OFF_ESC);
        const int ln = tx_ & 63;
        const long wv = tid >> 6, nwv = nth >> 6;
        for (long job = wv; job < 2L * 16384; job += nwv) {
            const int tbl = (int)(job >> 14), e = (int)(job & 16383);
            const float4* src = (const float4*)((tbl ? p.peer_v : p.peer_u) + (long)e * 1024 + 16 * ln);
            float4 a[4]; float amax = 0.f;
#pragma unroll
            for (int i = 0; i < 4; ++i) { a[i] = src[i]; amax = fmaxf(amax, fmaxf(fmaxf(fabsf(a[i].x), fabsf(a[i].y)), fmaxf(fabsf(a[i].z), fabsf(a[i].w)))); }
#pragma unroll
            for (int o = 32; o >= 1; o >>= 1) amax = fmaxf(amax, shx(ln, amax, o));
            const float sc = (amax > 0.f) ? exp2f(ceilf(log2f(amax * (1.0f / 6.0f)))) : 1.0f;
            const float inv = 1.0f / sc;
            unsigned w0 = 0u, w1 = 0u;
            w0 = __builtin_amdgcn_cvt_scalef32_pk_fp4_f32(w0, a[0].x * inv, a[0].y * inv, 1.0f, 0);
            w0 = __builtin_amdgcn_cvt_scalef32_pk_fp4_f32(w0, a[0].z * inv, a[0].w * inv, 1.0f, 1);
            w0 = __builtin_amdgcn_cvt_scalef32_pk_fp4_f32(w0, a[1].x * inv, a[1].y * inv, 1.0f, 2);
            w0 = __builtin_amdgcn_cvt_scalef32_pk_fp4_f32(w0, a[1].z * inv, a[1].w * inv, 1.0f, 3);
            w1 = __builtin_amdgcn_cvt_scalef32_pk_fp4_f32(w1, a[2].x * inv, a[2].y * inv, 1.0f, 0);
            w1 = __builtin_amdgcn_cvt_scalef32_pk_fp4_f32(w1, a[2].z * inv, a[2].w * inv, 1.0f, 1);
            w1 = __builtin_amdgcn_cvt_scalef32_pk_fp4_f32(w1, a[3].x * inv, a[3].y * inv, 1.0f, 2);
            w1 = __builtin_amdgcn_cvt_scalef32_pk_fp4_f32(w1, a[3].z * inv, a[3].w * inv, 1.0f, 3);
            unsigned char* dst = (tbl ? V4 : U4) + (((long)(ln >> 4) * 16384 + e) * 128) + (ln & 15) * 8;
            *(u2v*)dst = (u2v){w0, w1};
            if (ln == 0) ESC[tbl * 16384 + e] = sc;
        }
    }
    {
        half_t* H1 = (half_t*)(ws + OFF_H1);
        const int lane = threadIdx.x & 63;
        const long wv = tid >> 6, nwv = nth >> 6;
        for (long row = wv; row < NTOK; row += nwv) {
            const float4* xr = (const float4*)(p.x + row * 1024);
            float4 v[4]; float ss = 0.f;
#pragma unroll
            for (int i = 0; i < 4; ++i) { v[i] = xr[lane + 64 * i]; ss += v[i].x * v[i].x + v[i].y * v[i].y + v[i].z * v[i].z + v[i].w * v[i].w; }
            ss = wave_sum(ss, lane);
            const float rs = rsqrtf(ss * (1.0f / 1024.f) + EPS);
#pragma unroll
            for (int i = 0; i < 4; ++i) {
                float4 g = ((const float4*)p.norm1_g)[lane + 64 * i];
                h4v o = {(half_t)(v[i].x * rs * g.x), (half_t)(v[i].y * rs * g.y), (half_t)(v[i].z * rs * g.z), (half_t)(v[i].w * rs * g.w)};
                ((h4v*)(H1 + row * 1024))[lane + 64 * i] = o;
            }
        }
    }
}

constexpr int GEMM_RS_OFF = 66560;
template <bool SCALE, bool SWAP, class Epi>
__device__ __forceinline__ void gemm_tile(const half_t* __restrict__ A, long lda, const half_t* __restrict__ Bt, long ldb, int K, int ksplit, char* smem_raw, Epi epi) {
    half_t* sA = (half_t*)smem_raw;
    half_t* sB = (half_t*)(smem_raw + 32768);
    float* rs0 = (float*)(smem_raw + GEMM_RS_OFF);
    int tid_ = threadIdx.x; asm volatile("" : "+v"(tid_));
    const int tid = tid_, lane = tid & 63, w = tid >> 6, wm = w >> 1, wn = w & 1;
    const int i16 = lane & 15, g4 = lane >> 4;
    const int lr = tid >> 3, off = tid & 7;
    if (SCALE) {
        const int rg = lane >> 3, ch = lane & 7;
        const int ncg = K >> 6, cgs = ksplit >> 6;
#pragma unroll 1
        for (int rr = 0; rr < 4; ++rr) {
            const int row = w * 32 + rr * 8 + rg;
            const half_t* ap = A + (long)row * lda + ch * 8;
            float s0 = 0.f, s1 = 0.f;
#pragma unroll 8
            for (int cg = 0; cg < ncg; ++cg) {
                const h8v v = *(const h8v*)(ap + cg * 64);
                float d = 0.f;
#pragma unroll
                for (int j = 0; j < 4; ++j) d = __builtin_amdgcn_fdot2((h2v){v[2 * j], v[2 * j + 1]}, (h2v){v[2 * j], v[2 * j + 1]}, d, false);
                if (cg < cgs) s0 += d; else s1 += d;
            }
            s0 = red8(s0); s1 = red8(s1);
            if (ch == 0) {
                rs0[row] = rsqrtf(s0 / (float)ksplit + EPS);
                if (ksplit < K) rs0[128 + row] = rsqrtf(s1 / (float)(K - ksplit) + EPS);
            }
        }
    }
    f4v acc[4][4];
#pragma unroll
    for (int a = 0; a < 4; ++a)
#pragma unroll
        for (int b = 0; b < 4; ++b) acc[a][b] = (f4v){0.f, 0.f, 0.f, 0.f};
    const int nk = K >> 6;
    const int srow = w * 32 + (lane >> 3);
    const int schunk = ((lane & 7) ^ ((lane >> 3) & 7)) << 3;
    const half_t* gA = A + (long)srow * lda + schunk;
    const half_t* gB = Bt + (long)srow * ldb + schunk;
    auto issue = [&](int k0, int stage) __attribute__((always_inline)) {
#pragma unroll
        for (int g = 0; g < 4; ++g) {
            __builtin_amdgcn_global_load_lds((const __attribute__((address_space(1))) void*)(gA + (long)(g * 8) * lda + k0),
                                             (__attribute__((address_space(3))) void*)(sA + stage * 8192 + (w * 32 + g * 8) * 64), 16, 0, 0);
            __builtin_amdgcn_global_load_lds((const __attribute__((address_space(1))) void*)(gB + (long)(g * 8) * ldb + k0),
                                             (__attribute__((address_space(3))) void*)(sB + stage * 8192 + (w * 32 + g * 8) * 64), 16, 0, 0);
        }
    };
    issue(0, 0);
    __syncthreads();
#pragma unroll 1
    for (int kt = 0; kt < nk; ++kt) {
        const int cur = (kt & 1) * 8192;
        if (kt + 1 < nk) issue((kt + 1) * 64, (kt + 1) & 1);
        if (SCALE && kt * 64 == ksplit) {
#pragma unroll
            for (int mi = 0; mi < 4; ++mi) {
                if (SWAP) {
                    const int row = wm * 64 + mi * 16 + i16;
                    const float ratio = rs0[row] / rs0[128 + row];
#pragma unroll
                    for (int ni = 0; ni < 4; ++ni) acc[mi][ni] *= ratio;
                } else {
#pragma unroll
                    for (int r = 0; r < 4; ++r) {
                        const int row = wm * 64 + mi * 16 + g4 * 4 + r;
                        const float ratio = rs0[row] / rs0[128 + row];
#pragma unroll
                        for (int ni = 0; ni < 4; ++ni) acc[mi][ni][r] *= ratio;
                    }
                }
            }
        }
#pragma unroll
        for (int kk = 0; kk < 2; ++kk) {
            const int cofs = (((kk * 4 + g4) ^ (i16 & 7)) << 3);
            h8v af[4], bf[4];
#pragma unroll
            for (int mi = 0; mi < 4; ++mi) af[mi] = *(const h8v*)(sA + cur + (wm * 64 + mi * 16 + i16) * 64 + cofs);
#pragma unroll
            for (int ni = 0; ni < 4; ++ni) bf[ni] = *(const h8v*)(sB + cur + (wn * 64 + ni * 16 + i16) * 64 + cofs);
#pragma unroll
            for (int mi = 0; mi < 4; ++mi)
#pragma unroll
                for (int ni = 0; ni < 4; ++ni) acc[mi][ni] = SWAP ? mfma16(bf[ni], af[mi], acc[mi][ni]) : mfma16(af[mi], bf[ni], acc[mi][ni]);
        }
        __syncthreads();
    }
    if (SCALE) {
        const int fin = (ksplit < K) ? 128 : 0;
#pragma unroll
        for (int mi = 0; mi < 4; ++mi) {
            if (SWAP) {
                const float rsv = rs0[fin + wm * 64 + mi * 16 + i16];
#pragma unroll
                for (int ni = 0; ni < 4; ++ni) acc[mi][ni] *= rsv;
            } else {
#pragma unroll
                for (int r = 0; r < 4; ++r) {
                    const float rsv = rs0[fin + wm * 64 + mi * 16 + g4 * 4 + r];
#pragma unroll
                    for (int ni = 0; ni < 4; ++ni) acc[mi][ni][r] *= rsv;
                }
            }
        }
    }
    epi(acc, wm, wn, i16, g4);
    __syncthreads();
}

__device__ __forceinline__ void rope_pair(float x1, float x2, int pos, int i, float& o1, float& o2) {
    const float inv = __builtin_amdgcn_exp2f(-(float)i * (13.287712379549449f / 16.0f));
    double t = (double)pos * (double)inv * 0.15915494309189535;
    t -= __builtin_rint(t);
    const float fr = (float)t;
    const float sn = __builtin_amdgcn_sinf(fr), cs = __builtin_amdgcn_cosf(fr);
    o1 = x1 * cs - x2 * sn; o2 = x1 * sn + x2 * cs;
}

#define GEMM_TILE_LOOP(NTM, NTN) \
    const bool swz_ = ((nb & 7) == 0) && (((NTM) & 7) == 0); \
    const int nx_ = swz_ ? ((NTM) >> 3) * (NTN) : (NTM) * (NTN); \
    for (int L_ = swz_ ? (bid >> 3) : bid; L_ < nx_; L_ += swz_ ? (nb >> 3) : nb)
#define GEMM_TILE_OF(NTN) (swz_ ? ((L_ / (NTN)) * 8 + (bid & 7)) * (NTN) + (L_ % (NTN)) : L_)

__device__ __forceinline__ void phase_inproj(const Params& p, int bid, int nb, char* smem) {
    char* ws = p.ws;
    const half_t* H1 = (const half_t*)(ws + OFF_H1);
    const half_t* W = (const half_t*)(ws + OFF_WIN);
    half_t* QH = (half_t*)(ws + OFF_QH);
    half_t* KM = (half_t*)(ws + OFF_KM);
    half_t* CQ = (half_t*)(ws + OFF_CQ);
    half_t* CKV = (half_t*)(ws + OFF_CKV);
    float* GATES = (float*)(ws + OFF_GATES);
    const int NT_N = NINP / 128, NT_M = NTOK / 128;
    GEMM_TILE_LOOP(NT_M, NT_N) {
        const int tile = GEMM_TILE_OF(NT_N);
        const int tm = tile / NT_N, tn = tile % NT_N;
        const int row0 = tm * 128, n0 = tn * 128;
        const half_t* Ap = H1 + (long)row0 * 1024;
        const half_t* Bp = W + (long)n0 * 1024;
        if (tn == 7 || tn == 9) {
            gemm_tile<false, false>(Ap, 1024, Bp, 1024, 1024, 1024, smem,
                [&](f4v (&acc)[4][4], int wm, int wn, int i16, int g4) __attribute__((always_inline)) {
                    half_t* base = (half_t*)(ws + (tn == 7 ? OFF_VST : OFF_VWT));
#pragma unroll
                    for (int ni = 0; ni < 4; ++ni) {
                        const int c = wn * 64 + ni * 16 + i16, gg = c >> 6, d = c & 63;
#pragma unroll
                        for (int mi = 0; mi < 4; ++mi) {
                            const int rbase = row0 + wm * 64 + mi * 16 + g4 * 4;
                            const int b = rbase >> 14, s0 = rbase & (SEQ - 1);
                            const h4v o = {(half_t)acc[mi][ni][0], (half_t)acc[mi][ni][1], (half_t)acc[mi][ni][2], (half_t)acc[mi][ni][3]};
                            *(h4v*)(base + ((long)((b * 2 + gg) * 64 + d)) * SEQ + s0) = o;
                        }
                    }
                });
        } else {
            gemm_tile<false, true>(Ap, 1024, Bp, 1024, 1024, 1024, smem,
                [&](f4v (&acc)[4][4], int wm, int wn, int i16, int g4) __attribute__((always_inline)) {
#pragma unroll
                    for (int mi = 0; mi < 4; ++mi) {
                        const int t = row0 + wm * 64 + mi * 16 + i16;
                        const int b = t >> 14, sq = t & (SEQ - 1);
#pragma unroll
                        for (int ni = 0; ni < 4; ++ni) {
                            const int cb = n0 + wn * 64 + ni * 16;
                            const int n = cb + 4 * g4;
                            const f4v a = acc[mi][ni];
                            if (cb < 512) {
                                const h4v o = {(half_t)(a[0] * QS_NSA), (half_t)(a[1] * QS_NSA), (half_t)(a[2] * QS_NSA), (half_t)(a[3] * QS_NSA)};
                                *(h4v*)(QH + (long)t * 512 + n) = o;
                            } else if (cb < 1280) {
                                const int which = (cb - 512) >> 7;
                                const int c = (n - 512) & 127, gg = c >> 6, d = c & 63;
                                half_t* base = (half_t*)(ws + OFF_KC + (size_t)which * SZ_KV);
                                const h4v o = {(half_t)a[0], (half_t)a[1], (half_t)a[2], (half_t)a[3]};
                                *(h4v*)(base + ((long)(b * 2 + gg) * SEQ + sq) * 64 + d) = o;
                            } else if (cb < 1536) {
                                const h4v o = {(half_t)a[0], (half_t)a[1], (half_t)a[2], (half_t)a[3]};
                                *(h4v*)(CQ + (long)t * 256 + (n - 1280)) = o;
                            } else if (cb < 1664) {
                                const h4v o = {(half_t)a[0], (half_t)a[1], (half_t)a[2], (half_t)a[3]};
                                *(h4v*)(CKV + (long)t * 128 + (n - 1536)) = o;
                            } else if (cb == 1664) {
                                const f4v a2 = acc[mi][(ni + 1) & 3];
                                h4v o1, o2;
                                const int pos = p.pos[t];
#pragma unroll
                                for (int r = 0; r < 4; ++r) {
                                    float x1, x2;
                                    rope_pair(a[r], a2[r], pos, 4 * g4 + r, x1, x2);
                                    o1[r] = (half_t)x1; o2[r] = (half_t)x2;
                                }
#pragma unroll
                                for (int h = 0; h < 8; ++h) {
                                    half_t* kr = KM + ((long)(b * 8 + h) * SEQ + sq) * 96 + 64 + 4 * g4;
                                    *(h4v*)kr = o1; *(h4v*)(kr + 16) = o2;
                                }
                            } else if (cb >= 1696) {
                                const int j = n - 1696;
                                if (j < 24) {
                                    float4 o;
                                    o.x = 1.0f / (1.0f + __expf(-a[0])); o.y = 1.0f / (1.0f + __expf(-a[1]));
                                    o.z = 1.0f / (1.0f + __expf(-a[2])); o.w = 1.0f / (1.0f + __expf(-a[3]));
                                    *(float4*)(GATES + (long)t * 24 + j) = o;
                                }
                            }
                        }
                    }
                });
        }
    }
}

__device__ __forceinline__ void phase_p2(const Params& p, int bid, int nb, char* smem) {
    char* ws = p.ws;
    const int NTA = 256 * 6, NTB = 256 * 8, NTC = 128;
    for (int tile = bid; tile < NTA + NTB + NTC; tile += nb) {
        if (tile < NTC) {
            const int nt = tile & 1, mt = (tile >> 1) & 7, bg = (tile >> 4) & 3, kv = tile >> 6;
            const half_t* A = (const half_t*)(ws + (kv ? OFF_VC : OFF_KC)) + (long)bg * SEQ * 64 + (long)mt * 128 * 1024;
            const half_t* Bt = (const half_t*)(ws + OFF_WC1) + ((long)kv * 256 + nt * 128) * 2048;
            const float* cbv = (const float*)(ws + OFF_CB) + kv * 256;
            half_t* HC = (half_t*)(ws + OFF_HC1) + ((long)(kv * 4 + bg) * 1024) * 256;
            gemm_tile<false, true>(A, 1024, Bt, 2048, 2048, 2048, smem,
                [&](f4v (&acc)[4][4], int wm, int wn, int i16, int g4) __attribute__((always_inline)) {
#pragma unroll
                    for (int mi = 0; mi < 4; ++mi) {
                        const int m = mt * 128 + wm * 64 + mi * 16 + i16;
#pragma unroll
                        for (int ni = 0; ni < 4; ++ni) {
                            const int n = nt * 128 + wn * 64 + ni * 16 + 4 * g4;
                            const float4 bias = *(const float4*)(cbv + n);
                            const h4v o = {(half_t)gelu_exact(acc[mi][ni][0] + bias.x), (half_t)gelu_exact(acc[mi][ni][1] + bias.y),
                                           (half_t)gelu_exact(acc[mi][ni][2] + bias.z), (half_t)gelu_exact(acc[mi][ni][3] + bias.w)};
                            if (m < NCMP) *(h4v*)(HC + (long)m * 256 + n) = o;
                        }
                    }
                });
        } else if (tile < NTC + NTA) {
            const int t2 = tile - NTC;
            const int tm = t2 / 6, tn = t2 % 6;
            const int row0 = tm * 128, n0 = tn * 128;
            half_t* QM = (half_t*)(ws + OFF_QM);
            gemm_tile<true, true>((const half_t*)(ws + OFF_CQ) + (long)row0 * 256, 256, (const half_t*)(ws + OFF_WQUP) + (long)n0 * 256, 256, 256, 256, smem,
                [&](f4v (&acc)[4][4], int wm, int wn, int i16, int g4) __attribute__((always_inline)) {
#pragma unroll
                    for (int mi = 0; mi < 4; ++mi) {
                        const int t = row0 + wm * 64 + mi * 16 + i16;
                        const int b = t >> 14, sq = t & (SEQ - 1);
#pragma unroll
                        for (int ni = 0; ni < 4; ++ni) {
                            const int cb = n0 + wn * 64 + ni * 16;
                            const int h = cb / 96, d0 = cb - h * 96;
                            half_t* qr = QM + ((long)(b * 8 + h) * SEQ + sq) * 96;
                            const f4v a = acc[mi][ni];
                            if (d0 < 64) {
                                const h4v o = {(half_t)(a[0] * QS_MLA), (half_t)(a[1] * QS_MLA), (half_t)(a[2] * QS_MLA), (half_t)(a[3] * QS_MLA)};
                                *(h4v*)(qr + d0 + 4 * g4) = o;
                            } else if (d0 == 64) {
                                const f4v a2 = acc[mi][(ni + 1) & 3];
                                const int pos = p.pos[t];
                                h4v o1, o2;
#pragma unroll
                                for (int r = 0; r < 4; ++r) {
                                    float x1, x2;
                                    rope_pair(a[r] * QS_MLA, a2[r] * QS_MLA, pos, 4 * g4 + r, x1, x2);
                                    o1[r] = (half_t)x1; o2[r] = (half_t)x2;
                                }
                                *(h4v*)(qr + 64 + 4 * g4) = o1; *(h4v*)(qr + 80 + 4 * g4) = o2;
                            }
                        }
                    }
                });
        } else {
            const int t2 = tile - NTC - NTA;
            const int tm = t2 >> 3, tn = t2 & 7;
            const int row0 = tm * 128, n0 = tn * 128;
            half_t* KM = (half_t*)(ws + OFF_KM);
            half_t* VT = (half_t*)(ws + OFF_VT);
            gemm_tile<true, false>((const half_t*)(ws + OFF_CKV) + (long)row0 * 128, 128, (const half_t*)(ws + OFF_WKVUP) + (long)n0 * 128, 128, 128, 128, smem,
                [&](f4v (&acc)[4][4], int wm, int wn, int i16, int g4) __attribute__((always_inline)) {
                    const int h = tn;
#pragma unroll
                    for (int ni = 0; ni < 4; ++ni) {
                        const int d0 = wn * 64 + ni * 16;
#pragma unroll
                        for (int mi = 0; mi < 4; ++mi) {
                            const int rbase = row0 + wm * 64 + mi * 16 + g4 * 4;
                            const int b = rbase >> 14, s0 = rbase & (SEQ - 1);
                            if (d0 < 64) {
#pragma unroll
                                for (int r = 0; r < 4; ++r) KM[((long)(b * 8 + h) * SEQ + s0 + r) * 96 + d0 + i16] = (half_t)acc[mi][ni][r];
                            } else {
                                const h4v o = {(half_t)acc[mi][ni][0], (half_t)acc[mi][ni][1], (half_t)acc[mi][ni][2], (half_t)acc[mi][ni][3]};
                                *(h4v*)(VT + ((long)(b * 8 + h) * 64 + (d0 - 64 + i16)) * SEQ + s0) = o;
                            }
                        }
                    }
                });
        }
    }
}

constexpr int KMAX_KS = 128, KMAX_KW = 132, KMAX_KC = 136, KMAX_KM = 140, KMAX_BIAS = 156;
__device__ __forceinline__ void phase_cmp2(const Params& p, int bid, int nb) {
    char* ws = p.ws;
    unsigned* ctr = (unsigned*)(ws + OFF_CTRL);
    int tx_ = threadIdx.x; asm volatile("" : "+v"(tx_));
    const long tid = (long)bid * NTHREADS + tx_, nth = (long)nb * NTHREADS;
    const int lane = tx_ & 63;
    const half_t* HC = (const half_t*)(ws + OFF_HC1);
    half_t* KC = (half_t*)(ws + OFF_KCMP);
    half_t* VCT = (half_t*)(ws + OFF_VCMPT);
    for (long e = tid; e < 2L * 4 * 1024 * 64; e += nth) {
        const int d = (int)(e & 63), n = (int)((e >> 6) & 1023), bg = (int)((e >> 16) & 3), kv = (int)(e >> 18);
        float s = 0.f;
        if (n < NCMP) {
            const half_t* hr = HC + ((long)(kv * 4 + bg) * 1024 + n) * 256;
            const float* w2 = kv ? p.cmp_v_w2 : p.cmp_k_w2;
            for (int j = 0; j < 256; ++j) s += (float)hr[j] * w2[j * 64 + d];
        }
        const half_t sh = (half_t)s;
        if (kv == 0) {
            KC[((long)bg * 1024 + n) * 64 + d] = sh;
            const float nn = wave_sum((float)sh * (float)sh, lane);
            if (lane == 0) atomicMax(&ctr[KMAX_KC + bg], __float_as_uint(nn));
        } else VCT[((long)bg * 64 + d) * 1024 + n] = sh;
    }
    {
        const int sub = lane & 7;
        const long grp = tid >> 3, ngrp = nth >> 3;
        for (int which = 0; which < 2; ++which) {
            const half_t* Kb = (const half_t*)(ws + (which ? OFF_KW : OFF_KS));
            float mx[4] = {0.f, 0.f, 0.f, 0.f};
            for (long row = grp; row < 4L * SEQ; row += ngrp) {
                const h8v v = *(const h8v*)(Kb + row * 64 + sub * 8);
                float d = 0.f;
#pragma unroll
                for (int j = 0; j < 4; ++j) d = __builtin_amdgcn_fdot2((h2v){v[2 * j], v[2 * j + 1]}, (h2v){v[2 * j], v[2 * j + 1]}, d, false);
                d = red8(d);
                const int bg = (int)(row >> 14);
#pragma unroll
                for (int q = 0; q < 4; ++q) mx[q] = (bg == q) ? fmaxf(mx[q], d) : mx[q];
            }
#pragma unroll
            for (int q = 0; q < 4; ++q) {
                float m = mx[q];
#pragma unroll
                for (int o = 32; o >= 1; o >>= 1) m = fmaxf(m, shx(lane, m, o));
                if (lane == 0 && m > 0.f) atomicMax(&ctr[(which ? KMAX_KW : KMAX_KS) + q], __float_as_uint(m));
            }
        }
        const half_t* Km = (const half_t*)(ws + OFF_KM);
        const long wv = tid >> 6, nwv = nth >> 6;
        for (long blk = wv; blk < 16L * SEQ / 64; blk += nwv) {
            const int bh = (int)(blk / (SEQ / 64));
            float mloc = 0.f;
#pragma unroll 1
            for (int rr = 0; rr < 8; ++rr) {
                const long row = blk * 64 + rr * 8 + (lane >> 3);
                const half_t* kr = Km + row * 96 + sub * 8;
                float d = 0.f;
                {
                    const h8v v = *(const h8v*)kr;
#pragma unroll
                    for (int j = 0; j < 4; ++j) d = __builtin_amdgcn_fdot2((h2v){v[2 * j], v[2 * j + 1]}, (h2v){v[2 * j], v[2 * j + 1]}, d, false);
                }
                if (sub < 4) {
                    const h8v v = *(const h8v*)(kr + 64);
#pragma unroll
                    for (int j = 0; j < 4; ++j) d = __builtin_amdgcn_fdot2((h2v){v[2 * j], v[2 * j + 1]}, (h2v){v[2 * j], v[2 * j + 1]}, d, false);
                }
                d = red8(d);
                mloc = fmaxf(mloc, d);
            }
#pragma unroll
            for (int o = 32; o >= 1; o >>= 1) mloc = fmaxf(mloc, shx(lane, mloc, o));
            if (lane == 0) atomicMax(&ctr[KMAX_KM + bh], __float_as_uint(mloc));
        }
    }
    if (tid == 0) {
        float mb = 0.f;
        for (int i = 0; i < 256; ++i) mb = fmaxf(mb, p.t5_bias[i] * LOG2E);
        ctr[KMAX_BIAS] = __float_as_uint(mb);
    }
}

struct MlaSmem { half_t K[2][64][104]; half_t V[2][64][68]; };

__device__ __forceinline__ void mla_item(const Params& p, int bh, int qb, char* smem) {
    MlaSmem& sm = *(MlaSmem*)smem;
    char* ws = p.ws;
    const int b = bh >> 3, h = bh & 7;
    const half_t* Qp = (const half_t*)(ws + OFF_QM) + ((long)bh * SEQ + qb * 128) * 96;
    const half_t* Kp = (const half_t*)(ws + OFF_KM) + (long)bh * SEQ * 96;
    const half_t* Vp = (const half_t*)(ws + OFF_VT) + (long)bh * 64 * SEQ;
    half_t* MIX = (half_t*)(ws + OFF_MIXED);
    int tid_ = threadIdx.x; asm volatile("" : "+v"(tid_));
    const int tid = tid_, lane = tid & 63, w = tid >> 6;
    const int c = lane & 31, hh = lane >> 5;
    const int tq = qb * 128 + w * 32 + c;
    h8v qf[6];
#pragma unroll
    for (int s6 = 0; s6 < 6; ++s6) qf[s6] = *(const h8v*)(Qp + (long)(w * 32 + c) * 96 + s6 * 16 + hh * 8);
    f16v o0, o1;
#pragma unroll
    for (int i = 0; i < 16; ++i) { o0[i] = 0.f; o1[i] = 0.f; }
    float qn2 = 0.f;
#pragma unroll
    for (int s6 = 0; s6 < 6; ++s6)
#pragma unroll
        for (int j = 0; j < 8; ++j) { const float f = (float)qf[s6][j]; qn2 += f * f; }
    qn2 += shx(lane, qn2, 32);
    const float kmax2 = __uint_as_float(((const unsigned*)(ws + OFF_CTRL))[KMAX_KM + bh]);
    const float nmref = 10.0f - sqrtf(qn2 * kmax2) * 1.0005f;
    float l = 0.f;
    const int ntiles = 2 * qb + 2;
    auto gload = [&](int j, u4v (&rk)[3], u4v (&rv)[2]) __attribute__((always_inline)) {
#pragma unroll
        for (int i = 0; i < 3; ++i) {
            const int ci = tid + 256 * i, key = ci / 12, of = ci % 12;
            rk[i] = *(const u4v*)(Kp + (long)(j * 64 + key) * 96 + of * 8);
        }
#pragma unroll
        for (int i = 0; i < 2; ++i) {
            const int ci = tid + 256 * i, dim = ci >> 3, of = ci & 7;
            rv[i] = *(const u4v*)(Vp + (long)dim * SEQ + j * 64 + of * 8);
        }
    };
    auto lstore = [&](int buf, const u4v (&rk)[3], const u4v (&rv)[2]) __attribute__((always_inline)) {
#pragma unroll
        for (int i = 0; i < 3; ++i) {
            const int ci = tid + 256 * i, key = ci / 12, of = ci % 12;
            *(u4v*)&sm.K[buf][key][of * 8] = rk[i];
        }
#pragma unroll
        for (int i = 0; i < 2; ++i) {
            const int ci = tid + 256 * i, dim = ci >> 3, of = ci & 7;
            *(u2v*)&sm.V[buf][dim][of * 8] = (u2v){rv[i][0], rv[i][1]};
            *(u2v*)&sm.V[buf][dim][of * 8 + 4] = (u2v){rv[i][2], rv[i][3]};
        }
    };
    const int qmin = qb * 128 + w * 32;
    auto compute = [&](int j, int buf) __attribute__((always_inline)) {
        if (64 * j <= qmin + 31) {
            f16v s0, s1;
#pragma unroll
            for (int i = 0; i < 16; ++i) { s0[i] = nmref; s1[i] = nmref; }
#pragma unroll
            for (int s6 = 0; s6 < 6; ++s6) {
                const h8v a0 = *(const h8v*)&sm.K[buf][c][s6 * 16 + hh * 8];
                const h8v a1 = *(const h8v*)&sm.K[buf][32 + c][s6 * 16 + hh * 8];
                s0 = mfma32(a0, qf[s6], s0);
                s1 = mfma32(a1, qf[s6], s1);
            }
            if (64 * j + 63 > qmin) {
#pragma unroll
                for (int r = 0; r < 16; ++r) {
                    const int key = 64 * j + (r & 3) + 8 * (r >> 2) + 4 * hh;
                    if (key > tq) s0[r] = NEGF;
                    if (key + 32 > tq) s1[r] = NEGF;
                }
            }
#pragma unroll
            for (int r = 0; r < 16; ++r) { s0[r] = fast_exp2(s0[r]); l += s0[r]; }
#pragma unroll
            for (int r = 0; r < 16; ++r) { s1[r] = fast_exp2(s1[r]); l += s1[r]; }
#pragma unroll
            for (int ks = 0; ks < 4; ++ks) {
                h8v pb;
#pragma unroll
                for (int jj = 0; jj < 8; ++jj) pb[jj] = (half_t)((ks < 2) ? s0[8 * (ks & 1) + jj] : s1[8 * (ks & 1) + jj]);
#pragma unroll
                for (int md = 0; md < 2; ++md) {
                    const h4v lo = *(const h4v*)&sm.V[buf][32 * md + c][16 * ks + 4 * hh];
                    const h4v hi = *(const h4v*)&sm.V[buf][32 * md + c][16 * ks + 8 + 4 * hh];
                    const h8v a = {lo[0], lo[1], lo[2], lo[3], hi[0], hi[1], hi[2], hi[3]};
                    if (md == 0) o0 = mfma32(a, pb, o0); else o1 = mfma32(a, pb, o1);
                }
            }
        }
    };
    u4v rkA[3], rvA[2], rkB[3], rvB[2];
    gload(0, rkA, rvA);
    gload(1, rkB, rvB);
    lstore(0, rkA, rvA);
    __syncthreads();
#pragma unroll 1
    for (int j = 0; j < ntiles; j += 2) {
        if (j + 2 < ntiles) gload(j + 2, rkA, rvA);
        compute(j, 0);
        lstore(1, rkB, rvB);
        __syncthreads();
        if (j + 3 < ntiles) gload(j + 3, rkB, rvB);
        compute(j + 1, 1);
        if (j + 2 < ntiles) lstore(0, rkA, rvA);
        __syncthreads();
    }
    const float lt = l + shx(lane, l, 32);
    const float inv = 1.0f / lt;
    half_t* orow = MIX + (long)(b * SEQ + tq) * 1024 + 512 + h * 64;
#pragma unroll
    for (int md = 0; md < 2; ++md)
#pragma unroll
        for (int rg = 0; rg < 4; ++rg) {
            h4v o;
#pragma unroll
            for (int e = 0; e < 4; ++e) o[e] = (half_t)(((md == 0) ? o0[4 * rg + e] : o1[4 * rg + e]) * inv);
            *(h4v*)(orow + 32 * md + 8 * rg + 4 * hh) = o;
        }
}

struct NsaStage { half_t K[64][72]; half_t V[64][68]; };
constexpr int NSA_LUT = 0;
constexpr int NSA_ST0 = 12288;
constexpr int NSA_RB = NSA_ST0 + 17920;
constexpr int NSA_SEL = NSA_RB + 32768;
constexpr int NSA_MASK = NSA_SEL + 2048;
constexpr int NSA_END = NSA_MASK + 1024;
constexpr float MINIT = -30000.0f;

__device__ __forceinline__ void nsa_item(const Params& p, int bg, int qt, char* smem) {
    char* ws = p.ws;
    half_t* lut = (half_t*)(smem + NSA_LUT);
    float (*imp)[8][256] = (float (*)[8][256])(smem + NSA_RB);
    int (*sel)[8][16] = (int (*)[8][16])(smem + NSA_SEL);
    unsigned* masks = (unsigned*)(smem + NSA_MASK);
    const int b = bg >> 1, g = bg & 1;
    int tid_ = threadIdx.x; asm volatile("" : "+v"(tid_));
    const int tid = tid_, lane = tid & 63, w = tid >> 6;
    const int c = lane & 31, hh = lane >> 5;
    const int qi = c >> 2, r = c & 3;
    const int t0 = qt * 32;
    const int t0w = t0 + w * 8;
    const int tq = t0w + qi;
    const int tlast = t0w + 7;
    {
        const float* lg = (const float*)(ws + OFF_LUT) + (long)g * LUTN * 4;
        for (int i = tid; i < LUTN * 4; i += NTHREADS) lut[i] = (half_t)lg[i];
        float* im = &imp[0][0][0];
        for (int i = tid; i < 4 * 8 * 256; i += NTHREADS) im[i] = 0.f;
    }
    __syncthreads();
    const float cfar = (float)lut[(LUTN - 1) * 4 + r];
    const half_t* QH = (const half_t*)(ws + OFF_QH);
    h8v qf[4];
#pragma unroll
    for (int s4 = 0; s4 < 4; ++s4) qf[s4] = *(const h8v*)(QH + (long)(b * SEQ + tq) * 512 + (g * 4 + r) * 64 + s4 * 16 + hh * 8);
    float nrefC, nrefS, nrefW;
    {
        float qn2 = 0.f;
#pragma unroll
        for (int s4 = 0; s4 < 4; ++s4)
#pragma unroll
            for (int j = 0; j < 8; ++j) { const float f = (float)qf[s4][j]; qn2 += f * f; }
        qn2 += shx(lane, qn2, 32);
        const unsigned* cw = (const unsigned*)(ws + OFF_CTRL);
        const float mb = __uint_as_float(cw[KMAX_BIAS]);
        nrefC = 10.0f - mb - sqrtf(qn2 * __uint_as_float(cw[KMAX_KC + bg])) * 1.0005f;
        nrefS = 10.0f - mb - sqrtf(qn2 * __uint_as_float(cw[KMAX_KS + bg])) * 1.0005f;
        nrefW = 10.0f - mb - sqrtf(qn2 * __uint_as_float(cw[KMAX_KW + bg])) * 1.0005f;
    }
    const float* gp = (const float*)(ws + OFF_GATES) + (long)(b * SEQ + tq) * 24 + (g * 4 + r) * 3;
    const float g0 = gp[0], g1 = gp[1], g2 = gp[2];
    f16v of0, of1;
#pragma unroll
    for (int i = 0; i < 16; ++i) { of0[i] = 0.f; of1[i] = 0.f; }

    u4v rk[2], rvv[2];
    auto stage_gload_r = [&](u4v (&rk_)[2], u4v (&rv_)[2], const half_t* Kg, const half_t* Vg, long ldv, int key0, bool withv) __attribute__((always_inline)) {
#pragma unroll
        for (int i = 0; i < 2; ++i) {
            const int ci = tid + 256 * i, row = ci >> 3, of = ci & 7;
            rk_[i] = *(const u4v*)(Kg + (long)(key0 + row) * 64 + of * 8);
            if (withv) rv_[i] = *(const u4v*)(Vg + (long)row * ldv + key0 + of * 8);
        }
    };
    auto stage_lstore_r = [&](NsaStage& st, const u4v (&rk_)[2], const u4v (&rv_)[2], bool withv) __attribute__((always_inline)) {
#pragma unroll
        for (int i = 0; i < 2; ++i) {
            const int ci = tid + 256 * i, row = ci >> 3, of = ci & 7;
            *(u4v*)&st.K[row][of * 8] = rk_[i];
            if (withv) {
                *(u2v*)&st.V[row][of * 8] = (u2v){rv_[i][0], rv_[i][1]};
                *(u2v*)&st.V[row][of * 8 + 4] = (u2v){rv_[i][2], rv_[i][3]};
            }
        }
    };
    auto stage_gload = [&](const half_t* Kg, const half_t* Vg, long ldv, int key0, bool withv) __attribute__((always_inline)) { stage_gload_r(rk, rvv, Kg, Vg, ldv, key0, withv); };
    auto stage_lstore = [&](NsaStage& st, bool withv) __attribute__((always_inline)) { stage_lstore_r(st, rk, rvv, withv); };
    auto qk32 = [&](const NsaStage& st, int mt, float init) __attribute__((always_inline)) -> f16v {
        f16v s;
#pragma unroll
        for (int i = 0; i < 16; ++i) s[i] = init;
#pragma unroll
        for (int s4 = 0; s4 < 4; ++s4) {
            const h8v a = *(const h8v*)&st.K[32 * mt + c][s4 * 16 + hh * 8];
            s = mfma32(a, qf[s4], s);
        }
        return s;
    };
    auto pv32 = [&](const NsaStage& st, int mt, const f16v& pr, f16v& oa, f16v& ob) __attribute__((always_inline)) {
#pragma unroll
        for (int ks = 0; ks < 2; ++ks) {
            h8v pb;
#pragma unroll
            for (int jj = 0; jj < 8; ++jj) pb[jj] = (half_t)pr[8 * ks + jj];
#pragma unroll
            for (int md = 0; md < 2; ++md) {
                const h4v lo = *(const h4v*)&st.V[32 * md + c][32 * mt + 16 * ks + 4 * hh];
                const h4v hi = *(const h4v*)&st.V[32 * md + c][32 * mt + 16 * ks + 8 + 4 * hh];
                const h8v a = {lo[0], lo[1], lo[2], lo[3], hi[0], hi[1], hi[2], hi[3]};
                if (md == 0) oa = mfma32(a, pb, oa); else ob = mfma32(a, pb, ob);
            }
        }
    };
    NsaStage& st0 = *(NsaStage*)(smem + NSA_ST0);
    NsaStage& st1 = *(NsaStage*)(smem + NSA_RB);

    for (int rep = 0; rep < (PROBE_PHASE == 22 ? 2 : 1); ++rep) {
        __syncthreads();
        const half_t* KC = (const half_t*)(ws + OFF_KCMP) + (long)bg * 1024 * 64;
        const half_t* VCT = (const half_t*)(ws + OFF_VCMPT) + (long)bg * 64 * 1024;
        const int nst = ((t0 >> 4) >> 6) + 1;
        auto cmp_scores = [&](f16v& s, int kbase) __attribute__((always_inline)) {
            const bool far = (t0w - (16 * (kbase + 31) + 31)) >= 1513;
            if (far) {
#pragma unroll
                for (int rr = 0; rr < 16; ++rr) s[rr] += cfar;
            } else {
#pragma unroll
                for (int rr = 0; rr < 16; ++rr) {
                    const int k = kbase + (rr & 3) + 8 * (rr >> 2) + 4 * hh;
                    const int dist = tq - (16 * k + 31);
                    const int di = dist < 0 ? 0 : (dist > LUTN - 1 ? LUTN - 1 : dist);
                    s[rr] = (dist >= 0) ? s[rr] + (float)lut[di * 4 + r] : NEGF;
                }
            }
        };
        float l = 0.f;
        stage_gload(KC, VCT, 1024, 0, false);
#pragma unroll 1
        for (int sg = 0; sg < nst; ++sg) {
            stage_lstore(st0, false);
            __syncthreads();
            if (sg + 1 < nst) stage_gload(KC, VCT, 1024, (sg + 1) * 64, false);
#pragma unroll
            for (int mt = 0; mt < 2; ++mt) {
                const int kbase = sg * 64 + mt * 32;
                if (16 * kbase + 31 <= tlast) {
                    f16v s = qk32(st0, mt, nrefC);
                    cmp_scores(s, kbase);
#pragma unroll
                    for (int rr = 0; rr < 16; ++rr) l += fast_exp2(s[rr]);
                }
            }
            __syncthreads();
        }
        l += shx(lane, l, 32);
        const float ml2 = (l > 0.f) ? __builtin_amdgcn_logf(l) : 1e30f;
        f16v oc0, oc1;
#pragma unroll
        for (int i = 0; i < 16; ++i) { oc0[i] = 0.f; oc1[i] = 0.f; }
        float carryL = 0.f;
        stage_gload(KC, VCT, 1024, 0, true);
#pragma unroll 1
        for (int sg = 0; sg < nst; ++sg) {
            stage_lstore(st0, true);
            __syncthreads();
            if (sg + 1 < nst) stage_gload(KC, VCT, 1024, (sg + 1) * 64, true);
#pragma unroll
            for (int mt = 0; mt < 2; ++mt) {
                const int kbase = sg * 64 + mt * 32;
                const int kt = sg * 2 + mt;
                if (16 * kbase + 31 <= tlast) {
                    f16v s = qk32(st0, mt, nrefC);
                    cmp_scores(s, kbase);
#pragma unroll
                    for (int rr = 0; rr < 16; ++rr) s[rr] = fast_exp2(s[rr] - ml2);
                    float Gs[4], Ls[4];
#pragma unroll
                    for (int jg = 0; jg < 4; ++jg) {
                        float G = s[4 * jg] + s[4 * jg + 1] + s[4 * jg + 2] + s[4 * jg + 3];
                        float L = s[4 * jg + 3];
                        G += shx(lane, G, 1); G += shx(lane, G, 2);
                        L += shx(lane, L, 1); L += shx(lane, L, 2);
                        Gs[jg] = G; Ls[jg] = L;
                    }
                    float Lo[4];
#pragma unroll
                    for (int jg = 0; jg < 4; ++jg) Lo[jg] = shx(lane, Ls[jg], 32);
                    if (r == 0) {
#pragma unroll
                        for (int jg = 0; jg < 4; ++jg) {
                            const float prevL = hh ? Lo[jg] : (jg == 0 ? carryL : Lo[jg - 1]);
                            imp[w][qi][8 * kt + 2 * jg + hh] = Gs[jg] + prevL;
                        }
                    }
                    carryL = Lo[3];
                    pv32(st0, mt, s, oc0, oc1);
                }
            }
            __syncthreads();
        }
#pragma unroll
        for (int i = 0; i < 16; ++i) { of0[i] += (rep == 0 ? g0 : 0.0f) * oc0[i]; of1[i] += (rep == 0 ? g0 : 0.0f) * oc1[i]; }
    }
    {
        const int q2 = lane >> 3, sub = lane & 7;
        const int tq2 = t0w + q2;
        const int cur = tq2 >> 6;
        unsigned key[32];
#pragma unroll
        for (int i = 0; i < 32; ++i) {
            const int sb = sub + 8 * i;
            const float v = imp[w][q2][sb];
            unsigned u = (__float_as_uint(v) & 0x7FFFFF00u) | (unsigned)(255 - sb);
            if (sb == 0 || sb == cur || sb == cur - 1) u |= 0x80000000u;
            if (sb > cur) u = 0u;
            key[i] = u;
        }
#pragma unroll 1
        for (int round = 0; round < 16; ++round) {
            unsigned best = key[0];
#pragma unroll
            for (int i = 1; i < 32; ++i) best = best > key[i] ? best : key[i];
#pragma unroll
            for (int o = 1; o <= 4; o <<= 1) { const unsigned ob = (unsigned)shx(lane, (int)best, o); best = best > ob ? best : ob; }
            if (sub == 0) sel[w][q2][round] = best ? (int)(255u - (best & 0xFFu)) : -1;
#pragma unroll
            for (int i = 0; i < 32; ++i) key[i] = (key[i] == best) ? 0u : key[i];
        }
    }
    for (int i = tid; i < 256; i += NTHREADS) masks[i] = 0u;
    __syncthreads();
    for (int e = lane; e < 128; e += 64) {
        const int q2 = e >> 4, bi = e & 15;
        const int blk = sel[w][q2][bi];
        if (blk >= 0) atomicOr(&masks[blk], 1u << (8 * w + q2));
    }
    __syncthreads();
    auto block_attend = [&](const NsaStage& st, int key0, bool colsel, bool window, float nref, float& l, f16v& oa, f16v& ob) __attribute__((always_inline)) {
        const bool far = !window && (t0w - (key0 + 63)) >= 1513;
        f16v s0, s1;
        if (far) {
            const float init = colsel ? (cfar + nref) : NEGF;
            s0 = qk32(st, 0, init); s1 = qk32(st, 1, init);
        } else {
            s0 = qk32(st, 0, nref); s1 = qk32(st, 1, nref);
#pragma unroll
            for (int rr = 0; rr < 16; ++rr) {
                const int pos = key0 + (rr & 3) + 8 * (rr >> 2) + 4 * hh;
                {
                    const int dist = tq - pos;
                    const bool valid = colsel && dist >= 0 && (!window || dist < 512);
                    const int di = dist < 0 ? 0 : (dist > LUTN - 1 ? LUTN - 1 : dist);
                    s0[rr] = valid ? s0[rr] + (float)lut[di * 4 + r] : NEGF;
                }
                {
                    const int dist = tq - pos - 32;
                    const bool valid = colsel && dist >= 0 && (!window || dist < 512);
                    const int di = dist < 0 ? 0 : (dist > LUTN - 1 ? LUTN - 1 : dist);
                    s1[rr] = valid ? s1[rr] + (float)lut[di * 4 + r] : NEGF;
                }
            }
        }
#pragma unroll
        for (int rr = 0; rr < 16; ++rr) { s0[rr] = fast_exp2(s0[rr]); l += s0[rr]; }
#pragma unroll
        for (int rr = 0; rr < 16; ++rr) { s1[rr] = fast_exp2(s1[rr]); l += s1[rr]; }
        pv32(st, 0, s0, oa, ob);
        pv32(st, 1, s1, oa, ob);
    };
    unsigned char* blist = (unsigned char*)(smem + NSA_SEL);
    volatile int* bcount = (volatile int*)(smem + NSA_SEL + 256);
    if (w == 0) {
        const int jmaxb = (t0 + 31) >> 6;
        int base = 0;
#pragma unroll 1
        for (int rnd = 0; rnd < 4; ++rnd) {
            const int bb = rnd * 64 + lane;
            const bool f = (bb <= jmaxb) && (masks[bb] != 0u);
            const unsigned long long bal = __ballot(f);
            const int pos = base + __popcll(bal & ((1ull << lane) - 1ull));
            if (f) blist[pos] = (unsigned char)bb;
            base += __popcll(bal);
        }
        if (lane == 0) *bcount = base;
    }
    for (int rep = 0; rep < (PROBE_PHASE == 20 ? 2 : 1); ++rep) {
        __syncthreads();
        const half_t* KS = (const half_t*)(ws + OFF_KS) + (long)bg * SEQ * 64;
        const half_t* VST = (const half_t*)(ws + OFF_VST) + (long)bg * 64 * SEQ;
        f16v os0, os1;
#pragma unroll
        for (int i = 0; i < 16; ++i) { os0[i] = 0.f; os1[i] = 0.f; }
        float l = 0.f;
        const int nblk = *bcount;
        u4v kA[2], vA[2], kB[2], vB[2];
        if (nblk > 0) stage_gload_r(kA, vA, KS, VST, SEQ, (int)blist[0] * 64, true);
        if (nblk > 1) stage_gload_r(kB, vB, KS, VST, SEQ, (int)blist[1] * 64, true);
        if (nblk > 0) stage_lstore_r(st0, kA, vA, true);
        __syncthreads();
#define SEL_STAGE(i_, ST, STN, KX, VX, KY, VY) { \
            const int i__ = (i_); \
            if (i__ < nblk) { \
                if (i__ + 2 < nblk) stage_gload_r(KX, VX, KS, VST, SEQ, (int)blist[i__ + 2] * 64, true); \
                const int j = (int)blist[i__]; \
                const unsigned mk = masks[j]; \
                if ((mk >> (8 * w)) & 0xFFu) { \
                    const bool colsel = (mk >> (8 * w + qi)) & 1u; \
                    block_attend(ST, j * 64, colsel, false, nrefS, l, os0, os1); \
                } \
                if (i__ + 1 < nblk) stage_lstore_r(STN, KY, VY, true); \
                __syncthreads(); \
            } }
#pragma unroll 1
        for (int i = 0; i < nblk; i += 2) {
            SEL_STAGE(i, st0, st1, kA, vA, kB, vB);
            SEL_STAGE(i + 1, st1, st0, kB, vB, kA, vA);
        }
        const float lt = l + shx(lane, l, 32);
        const float sc = ((lt > 0.f) ? g1 / lt : 0.f) * (rep == 0 ? 1.0f : 0.0f);
#pragma unroll
        for (int i = 0; i < 16; ++i) { of0[i] += sc * os0[i]; of1[i] += sc * os1[i]; }
    }
    __syncthreads();
    for (int rep = 0; rep < (PROBE_PHASE == 21 ? 2 : 1); ++rep) {
        __syncthreads();
        const half_t* KW = (const half_t*)(ws + OFF_KW) + (long)bg * SEQ * 64;
        const half_t* VWT = (const half_t*)(ws + OFF_VWT) + (long)bg * 64 * SEQ;
        f16v ow0, ow1;
#pragma unroll
        for (int i = 0; i < 16; ++i) { ow0[i] = 0.f; ow1[i] = 0.f; }
        float l = 0.f;
        const int jmax = (t0 + 31) >> 6;
        int j = (t0 >= 511) ? ((t0 - 511) >> 6) : 0;
        int buf = 0;
        stage_gload(KW, VWT, SEQ, j * 64, true);
#pragma unroll 1
        while (j <= jmax) {
            NsaStage& st = buf ? st1 : st0;
            stage_lstore(st, true);
            __syncthreads();
            if (j + 1 <= jmax) stage_gload(KW, VWT, SEQ, (j + 1) * 64, true);
            block_attend(st, j * 64, true, true, nrefW, l, ow0, ow1);
            buf ^= 1; ++j;
        }
        const float lt = l + shx(lane, l, 32);
        const float sc = ((lt > 0.f) ? g2 / lt : 0.f) * (rep == 0 ? 1.0f : 0.0f);
#pragma unroll
        for (int i = 0; i < 16; ++i) { of0[i] += sc * ow0[i]; of1[i] += sc * ow1[i]; }
    }
    {
        half_t* orow = (half_t*)(ws + OFF_MIXED) + (long)(b * SEQ + tq) * 1024 + (g * 4 + r) * 64;
#pragma unroll
        for (int md = 0; md < 2; ++md)
#pragma unroll
            for (int rg = 0; rg < 4; ++rg) {
                h4v o;
#pragma unroll
                for (int e = 0; e < 4; ++e) o[e] = (half_t)((md == 0) ? of0[4 * rg + e] : of1[4 * rg + e]);
                *(h4v*)(orow + 32 * md + 8 * rg + 4 * hh) = o;
            }
    }
    __syncthreads();
}

__device__ __forceinline__ void phase_attn(const Params& p, char* smem, int cidx = 64, int mode = 0) {
    volatile int* s_item = (volatile int*)(smem + 66048);
    const int lo = (mode == 2) ? 256 : 0, hi = (mode == 1) ? 256 : 512;
    for (;;) {
        if (threadIdx.x == 0) {
            unsigned* ctr = (unsigned*)(p.ws + OFF_CTRL) + cidx;
            const int x0 = (int)(xb_xcc_id() & 7u);
            int v = -1, qq = 0;
            for (int k = 0; k < 8; ++k) {
                const int q = (x0 + k) & 7;
                if (__hip_atomic_load(&ctr[q], __ATOMIC_RELAXED, __HIP_MEMORY_SCOPE_AGENT) >= (unsigned)(hi - lo)) continue;
                const int c = (int)atomicAdd(&ctr[q], 1u);
                if (c < hi - lo) { v = c + lo; qq = q; break; }
            }
            s_item[0] = v; s_item[1] = qq;
        }
        __syncthreads();
        const int li = s_item[0], q = s_item[1];
        __syncthreads();
        if (li < 0) break;
        if (li < 256) mla_item(p, 2 * q + (li & 1), 127 - (li >> 1), smem);
        else nsa_item(p, q & 3, 511 - 2 * (li - 256) - (q >> 2), smem);
    }
}

__device__ __forceinline__ void phase_outproj(const Params& p, int bid, int nb, char* smem) {
    char* ws = p.ws;
    const half_t* MIX = (const half_t*)(ws + OFF_MIXED);
    const half_t* W = (const half_t*)(ws + OFF_WOUT);
    half_t* X2H = (half_t*)(ws + OFF_X2H);
    GEMM_TILE_LOOP(256, 8) {
        const int tile = GEMM_TILE_OF(8);
        const int tm = tile >> 3, tn = tile & 7;
        const int row0 = tm * 128, n0 = tn * 128;
        gemm_tile<true, true>(MIX + (long)row0 * 1024, 1024, W + (long)n0 * 1024, 1024, 1024, 512, smem,
            [&](f4v (&acc)[4][4], int wm, int wn, int i16, int g4) __attribute__((always_inline)) {
#pragma unroll
                for (int mi = 0; mi < 4; ++mi) {
                    const long row = row0 + wm * 64 + mi * 16 + i16;
#pragma unroll
                    for (int ni = 0; ni < 4; ++ni) {
                        const int col = n0 + wn * 64 + ni * 16 + 4 * g4;
                        float4 v = *(const float4*)(p.x + row * 1024 + col);
                        v.x += acc[mi][ni][0]; v.y += acc[mi][ni][1]; v.z += acc[mi][ni][2]; v.w += acc[mi][ni][3];
                        const h4v o = {(half_t)v.x, (half_t)v.y, (half_t)v.z, (half_t)v.w};
                        *(h4v*)(X2H + row * 1024 + col) = o;
                    }
                }
            });
    }
}

__device__ __forceinline__ void phase_peerq(const Params& p, int bid, int nb, char* smem) {
    char* ws = p.ws;
    const half_t* X2H = (const half_t*)(ws + OFF_X2H);
    const half_t* W = (const half_t*)(ws + OFF_WPQ);
    half_t* QP = (half_t*)(ws + OFF_QP);
    GEMM_TILE_LOOP(256, 16) {
        const int tile = GEMM_TILE_OF(16);
        const int tm = tile >> 4, tn = tile & 15;
        const int row0 = tm * 128, n0 = tn * 128;
        gemm_tile<true, true>(X2H + (long)row0 * 1024, 1024, W + (long)n0 * 1024, 1024, 1024, 1024, smem,
            [&](f4v (&acc)[4][4], int wm, int wn, int i16, int g4) __attribute__((always_inline)) {
#pragma unroll
                for (int mi = 0; mi < 4; ++mi) {
                    const long row = row0 + wm * 64 + mi * 16 + i16;
#pragma unroll
                    for (int ni = 0; ni < 4; ++ni) {
                        const int col = n0 + wn * 64 + ni * 16 + 4 * g4;
                        const h4v o = {(half_t)acc[mi][ni][0], (half_t)acc[mi][ni][1], (half_t)acc[mi][ni][2], (half_t)acc[mi][ni][3]};
                        *(h4v*)(QP + row * 2048 + col) = o;
                    }
                }
            });
    }
}

__device__ __forceinline__ void topk_insert(float (&tv)[16], int (&ti)[16], float v, int id) {
#pragma unroll
    for (int k = 0; k < 16; ++k) {
        const bool gt = v > tv[k];
        const float nv = gt ? tv[k] : v; const int ni = gt ? ti[k] : id;
        tv[k] = gt ? v : tv[k]; ti[k] = gt ? id : ti[k];
        v = nv; id = ni;
    }
}
__device__ __forceinline__ unsigned rt_flip(float f) { const unsigned b = __float_as_uint(f); return b ^ ((b >> 31) ? 0xFFFFFFFFu : 0x80000000u); }
__device__ __forceinline__ float rt_unflip(unsigned u) { return __uint_as_float((u & 0x80000000u) ? (u ^ 0x80000000u) : ~u); }
__device__ __forceinline__ void rt_insert(unsigned (&tk)[16], unsigned u) {
#pragma unroll
    for (int k = 0; k < 16; ++k) { const unsigned hi = tk[k] > u ? tk[k] : u; u = tk[k] > u ? u : tk[k]; tk[k] = hi; }
}
__device__ __forceinline__ void phase_route(const Params& p, int bid, int nb, char* smem) {
    char* ws = p.ws;
    {
        const u4v* src = (const u4v*)(ws + OFF_KEYS);
        u4v* dst = (u4v*)smem;
        for (int i = threadIdx.x; i < 4096; i += NTHREADS) {
            const int n = (i >> 4) & 127, ch = i & 15;
            dst[(i & ~15) | (ch ^ (n & 15))] = src[i];
        }
    }
    __syncthreads();
    const half_t* QP = (const half_t*)(ws + OFF_QP);
    int* EID = (int*)(ws + OFF_EID);
    float* GW = (float*)(ws + OFF_GW);
    int tid_ = threadIdx.x; asm volatile("" : "+v"(tid_));
    const int lane = tid_ & 63, w = tid_ >> 6, c = lane & 31, hh = lane >> 5;
#pragma unroll 1
    for (long blk = bid; blk < (long)NTOK * 8 / 128; blk += nb) {
        const long th = blk * 128 + w * 32 + c;
        unsigned tkA[16], tkB[16];
#pragma unroll
        for (int half = 0; half < 2; ++half) {
            unsigned (&tk)[16] = half ? tkB : tkA;
#pragma unroll
            for (int k = 0; k < 16; ++k) tk[k] = 0u;
            h8v qf[8];
#pragma unroll
            for (int ks = 0; ks < 8; ++ks) qf[ks] = *(const h8v*)(QP + th * 256 + half * 128 + ks * 16 + hh * 8);
#pragma unroll 1
            for (int mt = 0; mt < 4; ++mt) {
                f16v s;
#pragma unroll
                for (int i = 0; i < 16; ++i) s[i] = 0.f;
                const int n = mt * 32 + c;
                const char* kb = smem + (half * 128 + n) * 256;
#pragma unroll
                for (int ks = 0; ks < 8; ++ks) {
                    const h8v a = *(const h8v*)(kb + (((2 * ks + hh) ^ (n & 15)) << 4));
                    s = mfma32(a, qf[ks], s);
                }
#pragma unroll
                for (int r = 0; r < 16; ++r) {
                    const int key = mt * 32 + (r & 3) + 8 * (r >> 2) + 4 * hh;
                    rt_insert(tk, (rt_flip(s[r]) & ~0x7Fu) | (unsigned)(127 - key));
                }
            }
            unsigned other[16];
#pragma unroll
            for (int k = 0; k < 16; ++k) other[k] = (unsigned)shx(lane, (int)tk[k], 32);
#pragma unroll
            for (int k = 0; k < 16; ++k) rt_insert(tk, other[k]);
        }
        float v1[16], v2[16]; int i1[16], i2[16];
#pragma unroll
        for (int k = 0; k < 16; ++k) {
            v1[k] = rt_unflip(tkA[k] & ~0x7Fu); i1[k] = 127 - (int)(tkA[k] & 0x7Fu);
            v2[k] = rt_unflip(tkB[k] & ~0x7Fu); i2[k] = 127 - (int)(tkB[k] & 0x7Fu);
        }
        float fv[16]; int fi[16];
#pragma unroll
        for (int k = 0; k < 16; ++k) { fv[k] = -3.0e38f; fi[k] = 0; }
        {
            constexpr int NP = 50;
            int pi[NP], pj[NP]; int np = 0;
#pragma unroll
            for (int i = 0; i < 16; ++i)
#pragma unroll
                for (int j = 0; j < 16; ++j)
                    if ((i + 1) * (j + 1) <= 16) { pi[np] = i; pj[np] = j; ++np; }
#pragma unroll
            for (int q = 0; q < NP / 2; ++q) {
                const float va = v1[pi[2 * q]] + v2[pj[2 * q]], vb = v1[pi[2 * q + 1]] + v2[pj[2 * q + 1]];
                const int ea = i1[pi[2 * q]] * 128 + i2[pj[2 * q]], eb = i1[pi[2 * q + 1]] * 128 + i2[pj[2 * q + 1]];
                topk_insert(fv, fi, hh ? vb : va, hh ? eb : ea);
            }
        }
        {
            float ov[16]; int oi[16];
#pragma unroll
            for (int k = 0; k < 16; ++k) { ov[k] = shx(lane, fv[k], 32); oi[k] = shx(lane, fi[k], 32); }
#pragma unroll
            for (int k = 0; k < 16; ++k) topk_insert(fv, fi, ov[k], oi[k]);
        }
        if (hh == 0) {
            float sum = 0.f, ex[16];
#pragma unroll
            for (int k = 0; k < 16; ++k) { ex[k] = __expf(fv[k] - fv[0]); sum += ex[k]; }
            const float inv = 1.0f / sum;
#pragma unroll
            for (int k4 = 0; k4 < 4; ++k4) {
                *(int4*)(EID + th * 16 + 4 * k4) = make_int4(fi[4 * k4], fi[4 * k4 + 1], fi[4 * k4 + 2], fi[4 * k4 + 3]);
                *(float4*)(GW + th * 16 + 4 * k4) = make_float4(ex[4 * k4] * inv, ex[4 * k4 + 1] * inv, ex[4 * k4 + 2] * inv, ex[4 * k4 + 3] * inv);
            }
        }
    }
}

__device__ __forceinline__ int peer_next_task(unsigned* q, int xpref, int ntask_per_slice, volatile int* s_task) {
    if (threadIdx.x == 0) {
        int res = -1;
        for (int k = 0; k < 4; ++k) {
            const int x = (xpref + k) & 3;
            if (__hip_atomic_load(&q[x], __ATOMIC_RELAXED, __HIP_MEMORY_SCOPE_AGENT) >= (unsigned)ntask_per_slice) continue;
            const unsigned c = atomicAdd(&q[x], 1u);
            if (c < (unsigned)ntask_per_slice) { res = x * ntask_per_slice + (int)c; break; }
        }
        *s_task = res;
    }
    __syncthreads();
    const int r = *s_task;
    __syncthreads();
    return r;
}
template <int PMODE>
__device__ __forceinline__ void phase_peer_udot(const Params& p, char* smem, int qoff = 16) {
    char* ws = p.ws;
    unsigned* q = (unsigned*)(ws + OFF_CTRL) + qoff;
    volatile int* s_task = (volatile int*)(smem + 66048);
    const unsigned char* U4 = (const unsigned char*)(ws + OFF_U16);
    const half_t* X2H = (const half_t*)(ws + OFF_X2H);
    const int* EID = (const int*)(ws + OFF_EID);
    float* PD = (float*)(ws + OFF_PD);
    const int xpref = (int)(xb_xcc_id() & 3u);
    for (;;) {
        const int task = peer_next_task(q, xpref, 512, s_task);
        if (task < 0) break;
        const int x = task >> 9, chunk = task & 511;
        int tid_ = threadIdx.x; asm volatile("" : "+v"(tid_));
        const int lane = tid_ & 63, w = tid_ >> 6, seg = lane & 7, eg = lane >> 3;
        h2v gs[16];
#pragma unroll
        for (int i = 0; i < 16; ++i) gs[i] = (h2v){(half_t)p.norm2_g[256 * x + 32 * seg + 2 * i], (half_t)p.norm2_g[256 * x + 32 * seg + 2 * i + 1]};
        const unsigned char* Ux = U4 + (long)x * 16384 * 128 + 16 * seg;
        const int tbase = chunk * 64 + w * 16;
        const int* Eb = EID + (long)tbase * 128 + 16 * eg;
        const half_t* Xb = X2H + (long)tbase * 1024 + 256 * x + 32 * seg;
#define LOAD_E(dst, k) { const u4v* ep_ = (const u4v*)(Eb + (long)(k) * 128); dst[0] = ep_[0]; dst[1] = ep_[1]; dst[2] = ep_[2]; dst[3] = ep_[3]; }
#define ISSUE_U8(uu, e_, hf) { _Pragma("unroll") for (int i = 0; i < 8; ++i) uu[i] = *(const u4v*)(Ux + (long)e_[2 * (hf) + (i >> 2)][i & 3] * 128); }
        h2v hs[16];
        auto load_h = [&](int k) __attribute__((always_inline)) {
#pragma unroll
            for (int c4 = 0; c4 < 4; ++c4) {
                const h8v xv = *(const h8v*)(Xb + (long)k * 1024 + 8 * c4);
#pragma unroll
                for (int i = 0; i < 4; ++i) hs[4 * c4 + i] = (h2v){xv[2 * i], xv[2 * i + 1]} * gs[4 * c4 + i];
            }
        };
        auto compute8 = [&](const u4v (&uu)[8]) __attribute__((always_inline)) -> float {
            float res = 0.f;
            if (PMODE == 1) {
                unsigned acc_ = 0;
#pragma unroll
                for (int i = 0; i < 8; ++i) acc_ ^= uu[i][0] ^ uu[i][1] ^ uu[i][2] ^ uu[i][3];
                return __builtin_bit_cast(float, acc_);
            }
#pragma unroll
            for (int i = 0; i < 8; ++i) {
                float d = 0.f;
#pragma unroll
                for (int j = 0; j < 4; ++j) {
                    d = __builtin_amdgcn_fdot2(hs[4 * j], __builtin_amdgcn_cvt_scalef32_pk_f16_fp4(uu[i][j], 1.0f, 0), d, false);
                    d = __builtin_amdgcn_fdot2(hs[4 * j + 1], __builtin_amdgcn_cvt_scalef32_pk_f16_fp4(uu[i][j], 1.0f, 1), d, false);
                    d = __builtin_amdgcn_fdot2(hs[4 * j + 2], __builtin_amdgcn_cvt_scalef32_pk_f16_fp4(uu[i][j], 1.0f, 2), d, false);
                    d = __builtin_amdgcn_fdot2(hs[4 * j + 3], __builtin_amdgcn_cvt_scalef32_pk_f16_fp4(uu[i][j], 1.0f, 3), d, false);
                }
                d = red8(d);
                res = (seg == i) ? d : res;
            }
            return res;
        };
        u4v uA[8], uB[8];
        u4v eC[4], eN[4];
        LOAD_E(eC, 0);
        ISSUE_U8(uA, eC, 0);
#pragma unroll 1
        for (int k = 0; k < 16; ++k) {
            ISSUE_U8(uB, eC, 1);
            if (k + 1 < 16) LOAD_E(eN, k + 1);
            load_h(k);
            const float r0 = compute8(uA);
            if (k + 1 < 16) ISSUE_U8(uA, eN, 0);
            const float r1 = compute8(uB);
            float* po = (PMODE == 1 ? (float*)(p.ws + OFF_HC1) + (((long)(tbase + k) * 128 + 16 * eg + seg) & 0xFFFFF)
                                    : PD + ((long)x * NTOK + tbase + k) * 128 + 16 * eg + seg);
            po[0] = r0; po[8] = r1;
#pragma unroll
            for (int i = 0; i < 4; ++i) eC[i] = eN[i];
        }
    }
}
__device__ __forceinline__ void phase_peer_coef(const Params& p, int bid, int nb) {
    char* ws = p.ws;
    const half_t* X2H = (const half_t*)(ws + OFF_X2H);
    const float* PD = (const float*)(ws + OFF_PD);
    const float* GW = (const float*)(ws + OFF_GW);
    const int* EID = (const int*)(ws + OFF_EID);
    const float* ESC = (const float*)(ws + OFF_ESC);
    float* COEF = (float*)(ws + OFF_COEF);
    int tx_ = threadIdx.x; asm volatile("" : "+v"(tx_));
    const int lane = tx_ & 63;
    const long wv = ((long)bid * NTHREADS + tx_) >> 6, nwv = ((long)nb * NTHREADS) >> 6;
    for (long t = wv; t < NTOK; t += nwv) {
        const h8v a = *(const h8v*)(X2H + t * 1024 + 8 * lane), b2 = *(const h8v*)(X2H + t * 1024 + 512 + 8 * lane);
        float ss = 0.f;
#pragma unroll
        for (int i = 0; i < 8; ++i) { const float f0 = (float)a[i], f1 = (float)b2[i]; ss += f0 * f0 + f1 * f1; }
        ss = wave_sum(ss, lane);
        const float rs = rsqrtf(ss * (1.0f / 1024.f) + EPS);
        float d0 = 0.f, d1 = 0.f;
#pragma unroll
        for (int x = 0; x < 4; ++x) {
            const float* pp = PD + ((long)x * NTOK + t) * 128;
            d0 += pp[lane]; d1 += pp[64 + lane];
        }
        const int e0 = EID[t * 128 + lane], e1 = EID[t * 128 + 64 + lane];
        COEF[t * 128 + lane] = GW[t * 128 + lane] * gelu_exact(d0 * rs * ESC[e0]) * ESC[16384 + e0];
        COEF[t * 128 + 64 + lane] = GW[t * 128 + 64 + lane] * gelu_exact(d1 * rs * ESC[e1]) * ESC[16384 + e1];
    }
}
__device__ __forceinline__ void phase_peer_vacc(const Params& p, char* smem) {
    char* ws = p.ws;
    unsigned* q = (unsigned*)(ws + OFF_CTRL) + 32;
    volatile int* s_task = (volatile int*)(smem + 66048);
    const unsigned char* V4 = (const unsigned char*)(ws + OFF_V16);
    const int* EID = (const int*)(ws + OFF_EID);
    const float* COEF = (const float*)(ws + OFF_COEF);
    float* SSQ = (float*)(ws + OFF_SSQ);
    const int xpref = (int)(xb_xcc_id() & 3u);
    for (;;) {
        const int task = peer_next_task(q, xpref, 512, s_task);
        if (task < 0) break;
        const int x = task >> 9, chunk = task & 511;
        int tid_ = threadIdx.x; asm volatile("" : "+v"(tid_));
        const int lane = tid_ & 63, w = tid_ >> 6, seg = lane & 7, eg = lane >> 3;
        const unsigned char* Vx = V4 + (long)x * 16384 * 128 + 16 * seg;
#pragma unroll 1
        for (int round = 0; round < 2; ++round) {
            const int t = chunk * 64 + w * 16 + round * 8 + eg;
            const int* Eb = EID + (long)t * 128;
            const float* Cb = COEF + (long)t * 128;
#define LOAD_EC(e_, c_, ci) { const u4v* ep_ = (const u4v*)(Eb + 8 * (ci)); const f4v* cp_ = (const f4v*)(Cb + 8 * (ci)); e_[0] = ep_[0]; e_[1] = ep_[1]; c_[0] = cp_[0]; c_[1] = cp_[1]; }
#define ISSUE_V(vv, e_) { _Pragma("unroll") for (int i = 0; i < 8; ++i) vv[i] = *(const u4v*)(Vx + (long)e_[i >> 2][i & 3] * 128); }
            h2v acc2[16];
#pragma unroll
            for (int i = 0; i < 16; ++i) acc2[i] = (h2v){(half_t)0.f, (half_t)0.f};
            auto compute = [&](const f4v (&c_)[2], const u4v (&vv)[8]) __attribute__((always_inline)) {
#pragma unroll
                for (int i = 0; i < 8; ++i) {
                    const half_t ch = (half_t)c_[i >> 2][i & 3];
                    const h2v cf2 = (h2v){ch, ch};
#pragma unroll
                    for (int j = 0; j < 4; ++j) {
                        acc2[4 * j] = __builtin_elementwise_fma((h2v)__builtin_amdgcn_cvt_scalef32_pk_f16_fp4(vv[i][j], 1.0f, 0), cf2, acc2[4 * j]);
                        acc2[4 * j + 1] = __builtin_elementwise_fma((h2v)__builtin_amdgcn_cvt_scalef32_pk_f16_fp4(vv[i][j], 1.0f, 1), cf2, acc2[4 * j + 1]);
                        acc2[4 * j + 2] = __builtin_elementwise_fma((h2v)__builtin_amdgcn_cvt_scalef32_pk_f16_fp4(vv[i][j], 1.0f, 2), cf2, acc2[4 * j + 2]);
                        acc2[4 * j + 3] = __builtin_elementwise_fma((h2v)__builtin_amdgcn_cvt_scalef32_pk_f16_fp4(vv[i][j], 1.0f, 3), cf2, acc2[4 * j + 3]);
                    }
                }
            };
            u4v vvA[8], vvB[8];
            u4v eA[2], eB[2]; f4v cA[2], cB[2];
            LOAD_EC(eA, cA, 0); LOAD_EC(eB, cB, 1);
            ISSUE_V(vvA, eA);
#pragma unroll 1
            for (int ci = 0; ci < 16; ci += 2) {
                ISSUE_V(vvB, eB);
                compute(cA, vvA);
                if (ci + 2 < 16) { LOAD_EC(eA, cA, ci + 2); ISSUE_V(vvA, eA); }
                compute(cB, vvB);
                if (ci + 2 < 16) LOAD_EC(eB, cB, ci + 3);
            }
            half_t* xr = (half_t*)(ws + OFF_X2H) + (long)t * 1024 + 256 * x + 32 * seg;
            float ssq = 0.f;
#pragma unroll
            for (int i8 = 0; i8 < 4; ++i8) {
                h8v xv = *(const h8v*)(xr + 8 * i8);
#pragma unroll
                for (int e = 0; e < 8; ++e) {
                    const float f = (float)xv[e] + (float)acc2[4 * i8 + (e >> 1)][e & 1];
                    ssq += f * f;
                    xv[e] = (half_t)f;
                }
                *(h8v*)(xr + 8 * i8) = xv;
            }
            ssq = red8(ssq);
            if (seg == 0) SSQ[(long)x * NTOK + t] = ssq;
        }
    }
}
__device__ __forceinline__ void phase_final_norm(const Params& p, int bid, int nb) {
    const float* SSQ = (const float*)(p.ws + OFF_SSQ);
    int tx_ = threadIdx.x; asm volatile("" : "+v"(tx_));
    const int lane = tx_ & 63;
    const long wv = ((long)bid * NTHREADS + tx_) >> 6, nwv = ((long)nb * NTHREADS) >> 6;
    for (long t = wv; t < NTOK; t += nwv) {
        float ss = 0.f;
#pragma unroll
        for (int x = 0; x < 4; ++x) ss += SSQ[(long)x * NTOK + t];
        const float rf = rsqrtf(ss * (1.0f / 1024.f) + EPS);
        const half_t* xh = (const half_t*)(p.ws + OFF_X2H) + t * 1024;
        float4* xr = (float4*)(p.out + t * 1024);
#pragma unroll
        for (int i = 0; i < 4; ++i) {
            const h4v hv = *(const h4v*)(xh + 4 * (lane + 64 * i));
            const float4 g = ((const float4*)p.final_g)[lane + 64 * i];
            float4 v;
            v.x = (float)hv[0] * rf * g.x; v.y = (float)hv[1] * rf * g.y; v.z = (float)hv[2] * rf * g.z; v.w = (float)hv[3] * rf * g.w;
            xr[lane + 64 * i] = v;
        }
    }
}

#define XB_TMO      128
#define XB_XCNT(j)  (256  + 64 * (j))
#define XB_XSUB(j)  (1280 + 64 * (j))
#define XB_XGEN(j)  (2304 + 64 * (j))
#define XB_TOP      3328
#define XB_TOPGEN   3392
#define XCD_BAR_WORDS 3456
#define XB_SPIN_CAP (1u << 22)
__device__ __forceinline__ unsigned xb_ld(unsigned* p)              { return __hip_atomic_load(p, __ATOMIC_RELAXED, __HIP_MEMORY_SCOPE_AGENT); }
__device__ __forceinline__ unsigned xb_add(unsigned* p, unsigned v) { return __hip_atomic_fetch_add(p, v, __ATOMIC_RELAXED, __HIP_MEMORY_SCOPE_AGENT); }
__device__ __forceinline__ unsigned xb_xcc_id() { return (unsigned)__builtin_amdgcn_s_getreg((3 << 11) | 20) & 0xFu; }
#define XB_SPIN(cond, bar) do { unsigned _sp = 0; while (cond) { __builtin_amdgcn_s_sleep(1); \
    if ((++_sp & 255u) == 0u) { if (xb_ld(&(bar)[XB_TMO])) break; if (_sp > XB_SPIN_CAP) { atomicAdd(&(bar)[XB_TMO], 1u); break; } } } } while (0)
struct XcdBarrier { unsigned* bar; unsigned x; volatile unsigned* st; };
__device__ __forceinline__ XcdBarrier xcd_barrier_post(unsigned* bar, volatile unsigned* st) {
    XcdBarrier b; b.bar = bar; b.x = xb_xcc_id(); b.st = st;
    if (threadIdx.x == 0) (void)xb_add(&bar[XB_XCNT(b.x)], 1u);
    return b;
}
__device__ __forceinline__ void xcd_barrier_complete(unsigned* bar, unsigned x, unsigned& nloc, unsigned& nx) {
    const unsigned G = gridDim.x * gridDim.y * gridDim.z;
    unsigned sum, cnt, mine, sp = 0u;
    for (;;) {
        sum = 0u; cnt = 0u; mine = 0u;
#pragma unroll
        for (unsigned j = 0; j < 16; ++j) { const unsigned c = xb_ld(&bar[XB_XCNT(j)]); sum += c; cnt += (c > 0u) ? 1u : 0u; mine = (j == x) ? c : mine; }
        if (sum == G) break;
        __builtin_amdgcn_s_sleep(1);
        if ((++sp & 255u) == 0u) { if (xb_ld(&bar[XB_TMO])) break; if (sp > XB_SPIN_CAP) { atomicAdd(&bar[XB_TMO], 1u); break; } }
    }
    nloc = mine > 0u ? mine : 1u; nx = cnt > 0u ? cnt : 1u;
}
__device__ __forceinline__ void xcd_barrier(const XcdBarrier& b) {
    asm volatile("s_waitcnt vmcnt(0)" ::: "memory");
    __syncthreads();
    if (threadIdx.x == 0) {
        unsigned* bar = b.bar;
        __builtin_amdgcn_s_waitcnt(0);
        unsigned nloc = b.st[0], nx = b.st[1];
        if (nloc == 0u) { xcd_barrier_complete(bar, b.x, nloc, nx); b.st[0] = nloc; b.st[1] = nx; }
        const unsigned old = xb_add(&bar[XB_XSUB(b.x)], 1u);
        const unsigned gen = old / nloc;
        if (old + 1u == (gen + 1u) * nloc) {
            __builtin_amdgcn_fence(__ATOMIC_RELEASE, "agent");
            asm volatile("s_waitcnt vmcnt(0)" ::: "memory");
            const unsigned og = xb_add(&bar[XB_TOP], 1u);
            const unsigned tg = og / nx;
            if (og + 1u == (tg + 1u) * nx) xb_add(&bar[XB_TOPGEN], 1u);
            else XB_SPIN(xb_ld(&bar[XB_TOPGEN]) == tg, bar);
            __builtin_amdgcn_fence(__ATOMIC_ACQUIRE, "agent");
            xb_add(&bar[XB_XGEN(b.x)], 1u);
            asm volatile("s_waitcnt vmcnt(0)" ::: "memory");
        } else {
            XB_SPIN(xb_ld(&bar[XB_XGEN(b.x)]) == gen, bar);
            __builtin_amdgcn_fence(__ATOMIC_ACQUIRE, "agent");
            asm volatile("s_waitcnt vmcnt(0)" ::: "memory");
        }
    }
    __syncthreads();
}

template <int PH>
__global__ void __launch_bounds__(NTHREADS, 2) phase_kernel(Params p) {
    extern __shared__ __attribute__((aligned(16))) char smem[];
    const int bid = blockIdx.x, nb = gridDim.x;
    if (PH == 0) phase_prep(p, bid, nb, smem);
    if (PH == 1) phase_inproj(p, bid, nb, smem);
    if (PH == 2) phase_p2(p, bid, nb, smem);
    if (PH == 3) phase_cmp2(p, bid, nb);
    if (PH == 4) phase_attn(p, smem);
    if (PH == 5) phase_outproj(p, bid, nb, smem);
    if (PH == 6) phase_peerq(p, bid, nb, smem);
    if (PH == 7) phase_route(p, bid, nb, smem);
}

__global__ void __launch_bounds__(NTHREADS, 2) mega_kernel(Params p) {
    extern __shared__ __attribute__((aligned(16))) char smem[];
    const int bid = blockIdx.x, nb = gridDim.x;
    {
        volatile unsigned* xbst = (volatile unsigned*)(smem + 66064);
        if (threadIdx.x == 0) { xbst[0] = 0u; xbst[1] = 0u; }
        __syncthreads();
        (void)xcd_barrier_post((unsigned*)(p.ws + OFF_BAR), xbst);
    }
#define GRID_SYNC() { XcdBarrier gb_; gb_.bar = (unsigned*)(p.ws + OFF_BAR); gb_.x = xb_xcc_id(); gb_.st = (volatile unsigned*)(smem + 66064); xcd_barrier(gb_); }
    phase_prep(p, bid, nb, smem); GRID_SYNC();
    if (PROBE_PHASE == 0) { phase_prep(p, bid, nb, smem); GRID_SYNC(); }
    phase_inproj(p, bid, nb, smem); GRID_SYNC();
    if (PROBE_PHASE == 1) { phase_inproj(p, bid, nb, smem); GRID_SYNC(); }
    phase_p2(p, bid, nb, smem); GRID_SYNC();
    if (PROBE_PHASE == 2) { phase_p2(p, bid, nb, smem); GRID_SYNC(); }
    phase_cmp2(p, bid, nb); GRID_SYNC();
    phase_attn(p, smem, 64, 0); GRID_SYNC();
    if (PROBE_PHASE == 3) { phase_attn(p, smem, 80, 0); GRID_SYNC(); }
    if (PROBE_PHASE == 9) { phase_attn(p, smem, 80, 1); GRID_SYNC(); }
    if (PROBE_PHASE == 13) { phase_attn(p, smem, 80, 2); GRID_SYNC(); }
    phase_outproj(p, bid, nb, smem); GRID_SYNC();
    if (PROBE_PHASE == 4) { phase_outproj(p, bid, nb, smem); GRID_SYNC(); }
    phase_peerq(p, bid, nb, smem); GRID_SYNC();
    if (PROBE_PHASE == 5) { phase_peerq(p, bid, nb, smem); GRID_SYNC(); }
    phase_route(p, bid, nb, smem); GRID_SYNC();
    if (PROBE_PHASE == 6) { phase_route(p, bid, nb, smem); GRID_SYNC(); }
    if (PROBE_PHASE == 8) { GRID_SYNC(); GRID_SYNC(); GRID_SYNC(); GRID_SYNC(); GRID_SYNC(); GRID_SYNC(); GRID_SYNC(); GRID_SYNC(); }
    phase_peer_udot<0>(p, smem); GRID_SYNC();
    if (PROBE_PHASE == 10) { phase_peer_udot<0>(p, smem, 48); GRID_SYNC(); }
    if (PROBE_PHASE == 12) { phase_peer_udot<1>(p, smem, 48); GRID_SYNC(); }
    phase_peer_coef(p, bid, nb); GRID_SYNC();
    if (PROBE_PHASE == 11) { phase_peer_coef(p, bid, nb); GRID_SYNC(); }
    phase_peer_vacc(p, smem); GRID_SYNC();
    phase_final_norm(p, bid, nb);
}

extern "C" void kernel_launch(void* const* d_in, const int* in_sizes, int n_in, void* d_out, int out_size, void* d_ws, size_t ws_size, hipStream_t stream) {
    (void)in_sizes; (void)n_in; (void)out_size;
    if (ws_size < WS_NEED) { fprintf(stderr, "kernel_launch: workspace too small (%zu < %zu)\n", ws_size, (size_t)WS_NEED); return; }
    Params p{};
    p.x = (const float*)d_in[0]; p.pos = (const int*)d_in[1]; p.norm1_g = (const float*)d_in[2]; p.w_in = (const float*)d_in[3];
    p.cmp_pos = (const float*)d_in[4]; p.cmp_k_w1 = (const float*)d_in[5]; p.cmp_k_w2 = (const float*)d_in[6];
    p.cmp_v_w1 = (const float*)d_in[7]; p.cmp_v_w2 = (const float*)d_in[8]; p.t5_bias = (const float*)d_in[9];
    p.q_norm_g = (const float*)d_in[10]; p.w_q_up = (const float*)d_in[11]; p.kv_norm_g = (const float*)d_in[12]; p.w_kv_up = (const float*)d_in[13];
    p.grp_norm_nsa = (const float*)d_in[14]; p.grp_norm_mla = (const float*)d_in[15]; p.w_out = (const float*)d_in[16]; p.norm2_g = (const float*)d_in[17];
    p.peer_wq = (const float*)d_in[18]; p.peer_keys1 = (const float*)d_in[19]; p.peer_keys2 = (const float*)d_in[20];
    p.peer_u = (const float*)d_in[21]; p.peer_v = (const float*)d_in[22]; p.final_g = (const float*)d_in[23];
    p.out = (float*)d_out; p.ws = (char*)d_ws;
#if MULTI_LAUNCH
    const int G = 512;
    phase_kernel<0><<<G, NTHREADS, 0, stream>>>(p);
    phase_kernel<1><<<G, NTHREADS, 0, stream>>>(p);
    phase_kernel<2><<<G, NTHREADS, 0, stream>>>(p);
    phase_kernel<3><<<G, NTHREADS, 0, stream>>>(p);
    phase_kernel<4><<<G, NTHREADS, 0, stream>>>(p);
    phase_kernel<5><<<G, NTHREADS, 0, stream>>>(p);
    phase_kernel<6><<<G, NTHREADS, 0, stream>>>(p);
    phase_kernel<7><<<G, NTHREADS, 0, stream>>>(p);
    phase_kernel<8><<<G, NTHREADS, 0, stream>>>(p);
#else
    static int grid_blocks = 0;
    if (!grid_blocks) {
        int dev = 0, cus = 0, per_cu = 0;
        (void)hipGetDevice(&dev);
        (void)hipDeviceGetAttribute(&cus, hipDeviceAttributeMultiprocessorCount, dev);
        (void)hipFuncSetAttribute((const void*)mega_kernel, hipFuncAttributeMaxDynamicSharedMemorySize, SMEM_BYTES);
        (void)hipOccupancyMaxActiveBlocksPerMultiprocessor(&per_cu, mega_kernel, NTHREADS, SMEM_BYTES);
        if (per_cu > 2) per_cu = 2;
        grid_blocks = cus * per_cu;
    }
    (void)hipMemsetAsync((char*)d_ws + OFF_BAR, 0, 16384, stream);
    void* args[] = {&p};
    hipError_t e = hipLaunchCooperativeKernel((void*)mega_kernel, dim3(grid_blocks), dim3(NTHREADS), args, SMEM_BYTES, stream);
    if (e != hipSuccess) fprintf(stderr, "cooperative launch failed: %s (grid %d)\n", hipGetErrorString(e), grid_blocks);
#endif
}
```
